# Optimizing an MI355X kernel written in HIP

```python
import math
import numpy as np
import jax
import jax.numpy as jnp
from jax import lax

D_MODEL = 1024
BATCH = 8
SEQ = 4096
DEPTH = 4

GRID_W = 64
CTX_LEN = 256
EXPAND = 2
MIX_W = EXPAND * D_MODEL
BRANCH_W = MIX_W // 2
DA_HEADS = 8
DA_V = BRANCH_W // DA_HEADS
DA_QK = DA_V // 2
DA_QK_W = DA_HEADS * 2 * DA_QK
SC_WIDTH = 3
NA_HEADS = 16
NA_DIM = BRANCH_W // NA_HEADS
WIN_ROWS = 8
WIN_COLS = 16
COL_QBLOCK = 16
COL_BAND = 2 * WIN_COLS
GLA_HEADS = 4
GLA_K_W = BRANCH_W // 2
GLA_DK = GLA_K_W // GLA_HEADS
GLA_DV = BRANCH_W // GLA_HEADS
GLA_RANK = 16
GLA_TAU = 16.0
GLA_CHUNK = 64
QBLOCK = 128
ROPE_BASE = 10000.0
EPS = 1e-6
N_EVEN = (DEPTH + 1) // 2
N_ODD = DEPTH // 2
EVEN_SIZES = (DA_QK_W, BRANCH_W, DA_QK_W, BRANCH_W, BRANCH_W, BRANCH_W, BRANCH_W, BRANCH_W)
EVEN_CTX_N = 2
ODD_SIZES = (BRANCH_W, BRANCH_W, GLA_K_W, BRANCH_W, 2 * GLA_RANK, BRANCH_W, GLA_K_W, BRANCH_W, BRANCH_W)
ODD_CTX_N = 5

kernel_name = 'hybrid_diffattn_shortconv_natten_gla'


def rmsnorm(x, g):
    xf = x.astype(jnp.float32)
    y = xf * lax.rsqrt(jnp.mean(xf * xf, axis=-1, keepdims=True) + EPS)
    return (y * g.astype(jnp.float32)).astype(x.dtype)


def split_cols(p, sizes):
    idx = np.cumsum(sizes)[:-1].tolist()
    return jnp.split(p, idx, axis=-1)


def heads(t, hd):
    return t.reshape(t.shape[0], t.shape[1], -1, hd)


def to_bht(t, hd):
    return heads(t, hd).transpose(0, 2, 1, 3)


def flip_t(t):
    return None if t is None else t[:, :, ::-1]


def axial_rope(seq, dtype):
    half = DA_QK // 2
    inv = 1.0 / (ROPE_BASE ** (jnp.arange(0, half, 2, dtype=jnp.float32) / half))
    t = jnp.arange(seq)
    row = (t // GRID_W).astype(jnp.float32)[:, None] * inv
    col = (t % GRID_W).astype(jnp.float32)[:, None] * inv
    ang = jnp.concatenate([row, row, col, col], axis=-1)
    return (jnp.cos(ang).astype(dtype)[:, None, None, :], jnp.sin(ang).astype(dtype)[:, None, None, :])


def apply_rope(x, cos, sin):
    half = DA_QK // 2
    q4 = half // 2
    def rot(t):
        return jnp.concatenate([-t[..., q4:], t[..., :q4]], axis=-1)
    r = jnp.concatenate([rot(x[..., :half]), rot(x[..., half:])], axis=-1)
    return x * cos + r * sin


def query_blocks(fn, q):
    bsz, t = q.shape[:2]
    qb = jnp.moveaxis(q.reshape((bsz, t // QBLOCK, QBLOCK) + q.shape[2:]), 1, 0)
    ob = jnp.moveaxis(lax.map(fn, qb), 0, 1)
    return ob.reshape((bsz, t) + ob.shape[3:])


def diff_attention(q, k, v, lam):
    scale = DA_QK ** -0.5
    def block(qb):
        s = jnp.einsum('bqhmd,bkhmd->bhmqk', qb, k).astype(jnp.float32) * scale
        p = jax.nn.softmax(s, axis=-1)
        a = (p[:, :, 0] - lam * p[:, :, 1]).astype(v.dtype)
        return jnp.einsum('bhqk,bkhe->bqhe', a, v)
    return query_blocks(block, q)


def dense_attention(q, k, v):
    s = jnp.einsum('bqhd,bkhd->bhqk', q, k).astype(jnp.float32) * (q.shape[-1] ** -0.5)
    p = jax.nn.softmax(s, axis=-1).astype(v.dtype)
    return jnp.einsum('bhqk,bkhd->bqhd', p, v)


def short_conv(u, w):
    ch = u.shape[-1]
    return lax.conv_general_dilated(
        u, w[:, None, :].astype(u.dtype), window_strides=(1,),
        padding=[(SC_WIDTH // 2, SC_WIDTH // 2)],
        dimension_numbers=('NWC', 'WIO', 'NWC'), feature_group_count=ch)


def neighbourhood_attention(q, k, v, kc, vc, rpb):
    bsz, seq, nh, d = q.shape
    rows = seq // GRID_W
    wr = min(WIN_ROWS, rows)
    n_cb = GRID_W // COL_QBLOCK
    scale = d ** -0.5
    r = np.arange(rows)
    row_start = np.clip(r - wr // 2, 0, rows - wr)
    row_off = row_start[:, None] + np.arange(wr)[None, :] - r[:, None] + (WIN_ROWS - 1)
    qcol = np.arange(GRID_W).reshape(n_cb, COL_QBLOCK)
    band_start = np.clip(np.arange(n_cb) * COL_QBLOCK - WIN_COLS // 2, 0, GRID_W - COL_BAND)
    kcol = band_start[:, None] + np.arange(COL_BAND)[None, :]
    win_start = np.clip(qcol - WIN_COLS // 2, 0, GRID_W - WIN_COLS)
    kc3 = kcol[:, None, :]
    col_valid = (kc3 >= win_start[..., None]) & (kc3 < win_start[..., None] + WIN_COLS)
    col_off = np.clip(kc3 - qcol[..., None] + (WIN_COLS - 1), 0, 2 * WIN_COLS - 2)
    col_mask = jnp.asarray(col_valid)[:, :, None, :]
    rpb_cols = rpb[:, :, col_off].astype(jnp.float32)
    kg = k.reshape(bsz, rows, GRID_W, nh, d)
    vg = v.reshape(bsz, rows, GRID_W, nh, d)
    qg = jnp.moveaxis(q.reshape(bsz, rows, n_cb, COL_QBLOCK, nh, d), 1, 0)
    n_loc = wr * COL_BAND

    def row_block(inp):
        q_r, rs, ro = inp
        k_band = lax.dynamic_slice_in_dim(kg, rs, wr, axis=1)[:, :, kcol]
        v_band = lax.dynamic_slice_in_dim(vg, rs, wr, axis=1)[:, :, kcol]
        s_loc = jnp.einsum('bnqhd,brnjhd->bhnqrj', q_r, k_band).astype(jnp.float32) * scale
        bias = jnp.transpose(jnp.take(rpb_cols, ro, axis=1), (0, 2, 3, 1, 4))
        s_loc = jnp.where(col_mask, s_loc + bias, -jnp.inf).reshape(bsz, nh, n_cb, COL_QBLOCK, n_loc)
        s_ctx = jnp.einsum('bnqhd,bkhd->bhnqk', q_r, kc).astype(jnp.float32) * scale
        p = jax.nn.softmax(jnp.concatenate([s_loc, s_ctx], axis=-1), axis=-1).astype(v.dtype)
        p_loc = p[..., :n_loc].reshape(bsz, nh, n_cb, COL_QBLOCK, wr, COL_BAND)
        return (jnp.einsum('bhnqrj,brnjhd->bnqhd', p_loc, v_band)
                + jnp.einsum('bhnqk,bkhd->bnqhd', p[..., n_loc:], vc))

    out = lax.map(row_block, (qg, jnp.asarray(row_start, jnp.int32), jnp.asarray(row_off, jnp.int32)))
    return jnp.moveaxis(out, 0, 1).reshape(bsz, seq, nh, d)


def gla_log_gates(lr, gate_up, gate_bias):
    out = []
    for dirn, l in enumerate(jnp.split(lr, 2, axis=-1)):
        z = (l @ gate_up[dirn] + gate_bias[dirn]).astype(jnp.float32)
        out.append(to_bht(jax.nn.log_sigmoid(z) / GLA_TAU, GLA_DK))
    return out


def gla_scan(q, k, v, logg, s0):
    bsz, nh, t, _ = k.shape
    dv = v.shape[-1]
    n = t // GLA_CHUNK
    want = q is not None
    tri = jnp.tril(jnp.ones((GLA_CHUNK, GLA_CHUNK), bool))[:, :, None]

    def chunks(a):
        return jnp.moveaxis(a.reshape(bsz, nh, n, GLA_CHUNK, a.shape[-1]), 2, 0)

    def step(state, inp):
        if want:
            qc, kc, vc, gc = inp
        else:
            kc, vc, gc = inp
        b = jnp.cumsum(gc, axis=-2)
        b_end = b[:, :, -1:, :]
        new = (jnp.exp(b_end[:, :, 0, :])[..., None] * state
               + jnp.einsum('bhsd,bhse->bhde', kc * jnp.exp(b_end - b), vc))
        if not want:
            return new, None
        qf = qc.astype(jnp.float32)
        o_inter = jnp.einsum('bhtd,bhde->bhte', qf * jnp.exp(b), state)
        decay = jnp.exp(jnp.where(tri, b[:, :, :, None, :] - b[:, :, None, :, :], -jnp.inf))
        att = jnp.einsum('bhtd,bhsd,bhtsd->bhts', qf, kc.astype(jnp.float32), decay)
        o = o_inter + jnp.einsum('bhts,bhse->bhte', att, vc.astype(jnp.float32))
        return new, o.astype(v.dtype)

    xs = tuple(chunks(a) for a in ((q, k, v, logg) if want else (k, v, logg)))
    s_fin, o = lax.scan(step, s0, xs)
    if want:
        o = jnp.moveaxis(o, 0, 2).reshape(bsz, nh, t, dv)
    return s_fin, o


def gla_out(o, g):
    o = rmsnorm(o.transpose(0, 2, 1, 3), g)
    return o.reshape(o.shape[0], o.shape[1], -1)


def even_mixer(h, hc, w_in, lam_p, subln, conv_w, lam_init, ctx_out, cos, sin):
    bsz, seq, _ = h.shape
    clen = hc.shape[1]
    ak, av, aq, ag, bh, bb, bc, bg = split_cols(h @ w_in, EVEN_SIZES)
    csz = EVEN_SIZES if ctx_out else EVEN_SIZES[:EVEN_CTX_N]
    cp = split_cols(hc @ w_in[:, :sum(csz)], csz)
    lam = (jnp.exp(jnp.sum(lam_p[0] * lam_p[1])) - jnp.exp(jnp.sum(lam_p[2] * lam_p[3])) + lam_init).astype(jnp.float32)
    qk_shape = (DA_HEADS, 2, DA_QK)
    q = apply_rope(aq.reshape(bsz, seq, *qk_shape), cos, sin)
    k = apply_rope(ak.reshape(bsz, seq, *qk_shape), cos, sin)
    kc = cp[0].reshape(bsz, clen, *qk_shape)
    vc = heads(cp[1], DA_V)
    k_all = jnp.concatenate([k, kc], axis=1)
    v_all = jnp.concatenate([heads(av, DA_V), vc], axis=1)
    oa = rmsnorm(diff_attention(q, k_all, v_all, lam), subln) * (1.0 - lam_init)
    ua = oa.reshape(bsz, seq, BRANCH_W) * jax.nn.silu(ag)
    ub = bb * short_conv(bc * bh, conv_w) * jax.nn.silu(bg)
    u = jnp.concatenate([ua, ub], axis=-1)
    if not ctx_out:
        return u, None
    oac = rmsnorm(diff_attention(cp[2].reshape(bsz, clen, *qk_shape), kc, vc, lam), subln) * (1.0 - lam_init)
    uac = oac.reshape(bsz, clen, BRANCH_W) * jax.nn.silu(cp[3])
    ubc = cp[5] * short_conv(cp[6] * cp[4], conv_w) * jax.nn.silu(cp[7])
    return u, jnp.concatenate([uac, ubc], axis=-1)


def odd_mixer(h, hc, w_in, rpb, gate_up, gate_bias, gnorm, ctx_out):
    bsz, seq, _ = h.shape
    clen = hc.shape[1]
    ck, cv, dk, dv, dlr, cq, dq, cg, dg = split_cols(h @ w_in, ODD_SIZES)
    csz = ODD_SIZES if ctx_out else ODD_SIZES[:ODD_CTX_N]
    cp = split_cols(hc @ w_in[:, :sum(csz)], csz)
    kc_na, vc_na = heads(cp[0], NA_DIM), heads(cp[1], NA_DIM)
    o_na = neighbourhood_attention(heads(cq, NA_DIM), heads(ck, NA_DIM), heads(cv, NA_DIM), kc_na, vc_na, rpb)
    qscale = GLA_DK ** -0.5
    s0 = jnp.zeros((bsz, GLA_HEADS, GLA_DK, GLA_DV), jnp.float32)
    gcf, gcb = gla_log_gates(cp[4], gate_up, gate_bias)
    kch, vch = to_bht(cp[2], GLA_DK), to_bht(cp[3], GLA_DV)
    qch = to_bht(cp[6], GLA_DK) * qscale if ctx_out else None
    s_f, ocf = gla_scan(qch, kch, vch, gcf, s0)
    s_b, ocb = gla_scan(flip_t(qch), flip_t(kch), flip_t(vch), flip_t(gcb), s0)
    gf, gb = gla_log_gates(dlr, gate_up, gate_bias)
    qh, kh, vh = to_bht(dq, GLA_DK) * qscale, to_bht(dk, GLA_DK), to_bht(dv, GLA_DV)
    _, of = gla_scan(qh, kh, vh, gf, s_f)
    _, ob = gla_scan(flip_t(qh), flip_t(kh), flip_t(vh), flip_t(gb), s_b)
    o_gla = gla_out(of + flip_t(ob), gnorm)
    u = jnp.concatenate([o_na.reshape(bsz, seq, BRANCH_W) * jax.nn.silu(cg), o_gla * jax.nn.silu(dg)], axis=-1)
    if not ctx_out:
        return u, None
    o_na_c = dense_attention(heads(cp[5], NA_DIM), kc_na, vc_na)
    o_gla_c = gla_out(ocf + flip_t(ocb), gnorm)
    uc = jnp.concatenate([o_na_c.reshape(bsz, clen, BRANCH_W) * jax.nn.silu(cp[7]), o_gla_c * jax.nn.silu(cp[8])], axis=-1)
    return u, uc


def setup_inputs(seed: int = 0) -> dict:
    key = jax.random.key(seed)
    ks = jax.random.split(key, 18)
    def nrm(k, shape, s):
        return jax.random.normal(k, shape, jnp.float32) * s
    ew = sum(EVEN_SIZES)
    ow = sum(ODD_SIZES)
    return {
        'x': nrm(ks[0], (BATCH, SEQ, D_MODEL), 1.0),
        'c': nrm(ks[1], (BATCH, D_MODEL), 1.0),
        'ctx': nrm(ks[2], (BATCH, CTX_LEN, D_MODEL), 1.0),
        'c_ctx': nrm(ks[3], (D_MODEL,), 1.0),
        'w_mod': nrm(ks[4], (DEPTH, D_MODEL, 3 * D_MODEL), 0.5 * D_MODEL ** -0.5),
        'b_mod': nrm(ks[5], (DEPTH, 3 * D_MODEL), 0.02),
        'g_pre': 1.0 + nrm(ks[6], (DEPTH, D_MODEL), 0.02),
        'g_post': 1.0 + nrm(ks[7], (DEPTH, D_MODEL), 0.02),
        'w_out': nrm(ks[8], (DEPTH, MIX_W, D_MODEL), MIX_W ** -0.5),
        'ev_w_in': nrm(ks[9], (N_EVEN, D_MODEL, ew), D_MODEL ** -0.5),
        'ev_lambda': nrm(ks[10], (N_EVEN, 4, DA_QK), 0.1),
        'ev_subln': 1.0 + nrm(ks[11], (N_EVEN, DA_V), 0.02),
        'ev_conv': nrm(ks[12], (N_EVEN, SC_WIDTH, BRANCH_W), SC_WIDTH ** -0.5),
        'od_w_in': nrm(ks[13], (N_ODD, D_MODEL, ow), D_MODEL ** -0.5),
        'od_rpb': nrm(ks[14], (N_ODD, NA_HEADS, 2 * WIN_ROWS - 1, 2 * WIN_COLS - 1), 0.1),
        'od_gate_up': nrm(ks[15], (N_ODD, 2, GLA_RANK, GLA_K_W), GLA_RANK ** -0.5),
        'od_gate_bias': nrm(ks[16], (N_ODD, 2, GLA_K_W), 0.5),
        'od_gnorm': 1.0 + nrm(ks[17], (N_ODD, GLA_DV), 0.02),
    }


def reference(x, c, ctx, c_ctx, w_mod, b_mod, g_pre, g_post, w_out, ev_w_in, ev_lambda, ev_subln, ev_conv,
              od_w_in, od_rpb, od_gate_up, od_gate_bias, od_gnorm):
    seq = x.shape[1]
    cos, sin = axial_rope(seq, x.dtype)
    xc = ctx
    for l in range(DEPTH):
        last = l == DEPTH - 1
        mod = jax.nn.silu(c) @ w_mod[l] + b_mod[l]
        modc = jax.nn.silu(c_ctx) @ w_mod[l] + b_mod[l]
        shift, scale, gate = jnp.split(mod[:, None, :], 3, axis=-1)
        shift_c, scale_c, gate_c = jnp.split(modc, 3, axis=-1)
        h = rmsnorm(x, g_pre[l]) * (1.0 + scale) + shift
        hc = rmsnorm(xc, g_pre[l]) * (1.0 + scale_c) + shift_c
        j = l // 2
        if l % 2 == 0:
            lam_init = 0.8 - 0.6 * math.exp(-0.3 * l)
            u, uc = even_mixer(h, hc, ev_w_in[j], ev_lambda[j], ev_subln[j], ev_conv[j], lam_init, not last, cos, sin)
        else:
            u, uc = odd_mixer(h, hc, od_w_in[j], od_rpb[j], od_gate_up[j], od_gate_bias[j], od_gnorm[j], not last)
        x = x + gate * rmsnorm(u @ w_out[l], g_post[l])
        if not last:
            xc = xc + gate_c * rmsnorm(uc @ w_out[l], g_post[l])
    return x
```

```cpp
#include <hip/hip_runtime.h>
#include <hip/hip_cooperative_groups.h>
#include <cstdio>
namespace cg = cooperative_groups;

typedef unsigned short bfr;
typedef __attribute__((ext_vector_type(8))) short bf16x8;
typedef __attribute__((ext_vector_type(4))) float f32x4;
typedef __attribute__((ext_vector_type(4))) unsigned u32x4;
typedef __attribute__((ext_vector_type(2))) unsigned u32x2;
typedef __attribute__((ext_vector_type(16))) unsigned u32x16;
#define DI __device__ __forceinline__
DI int opaque_tid() { int t = threadIdx.x; asm volatile("" : "+v"(t)); return t; }

constexpr int GB   = 4;
constexpr int NGRP = 2;
constexpr int ML   = GB * 4096;
constexpr int MC   = GB * 256;
constexpr int MR   = ML + MC;
constexpr int NEV  = 8192;
constexpr int NOD  = 7296;
constexpr int KEYS = 4352;
constexpr float L2E = 1.4426950408889634f;
constexpr float LN2 = 0.6931471805599453f;

constexpr size_t SZ_PROJ = (size_t)MR * 8192 * 2;
constexpr size_t SZ_H    = (size_t)MR * 1024 * 2;
constexpr size_t SZ_U    = (size_t)MR * 2048 * 2;
constexpr size_t SZ_VT   = (size_t)GB * 1024 * KEYS * 2;
constexpr size_t SZ_WE   = (size_t)NEV * 1024 * 2;
constexpr size_t SZ_WO   = (size_t)NOD * 1024 * 2;
constexpr size_t SZ_WOUT = (size_t)1024 * 2048 * 2;
constexpr size_t OFF_PROJ = 0;
constexpr size_t OFF_H    = OFF_PROJ + SZ_PROJ;
constexpr size_t OFF_U    = OFF_H + SZ_H;
constexpr size_t OFF_VT   = OFF_U + SZ_U;
constexpr size_t OFF_WIN  = OFF_VT + SZ_VT;
constexpr size_t OFF_WOUT = OFF_WIN + 2 * SZ_WE + 2 * SZ_WO;
constexpr size_t OFF_XC   = OFF_WOUT + 4 * SZ_WOUT;
constexpr size_t OFF_MOD  = OFF_XC + (size_t)8 * 256 * 1024 * 4;
constexpr size_t OFF_CS   = OFF_MOD + (size_t)4 * 9 * 3072 * 4;
constexpr size_t OFF_LAM  = OFF_CS + 64 * 16 * 8;
constexpr size_t OFF_CTR  = OFF_LAM + 256;
constexpr size_t WS_NEED  = OFF_CTR + 256;

constexpr int SMEM_BYTES = 80896;

struct Params {
  const float *x, *c, *ctx, *c_ctx, *w_mod, *b_mod, *g_pre, *g_post, *w_out, *ev_w_in, *ev_lambda, *ev_subln,
      *ev_conv, *od_w_in, *od_rpb, *od_gate_up, *od_gate_bias, *od_gnorm;
  float* out;
  char* ws;
};

DI size_t win_off(int l) { return OFF_WIN + (size_t)(l >> 1) * (SZ_WE + SZ_WO) + ((l & 1) ? SZ_WE : 0); }

DI float bf2f(bfr v) { return __uint_as_float(((unsigned)v) << 16); }
DI bfr f2bf(float x) { unsigned u = __float_as_uint(x); u += 0x7fffu + ((u >> 16) & 1u); return (bfr)(u >> 16); }
DI unsigned pack2(float a, float b) { return (unsigned)f2bf(a) | (((unsigned)f2bf(b)) << 16); }
DI float lo_bf(unsigned u) { return __uint_as_float(u << 16); }
DI float hi_bf(unsigned u) { return __uint_as_float(u & 0xffff0000u); }
DI float fexp2(float x) { return __builtin_amdgcn_exp2f(x); }
DI float flog2(float x) { return __builtin_amdgcn_logf(x); }
DI float silu(float x) { return x / (1.f + fexp2(-x * L2E)); }
DI float wave_sum(float v) {
#pragma unroll
  for (int o = 1; o < 64; o <<= 1) v += __shfl_xor(v, o);
  return v;
}
DI f32x4 mfma16(bf16x8 a, bf16x8 b, f32x4 c) { return __builtin_amdgcn_mfma_f32_16x16x32_bf16(a, b, c, 0, 0, 0); }
DI int sw128(int row, int chunk) { return row * 128 + ((chunk ^ ((row >> 1) & 7)) << 4); }
DI int sw256(int row, int chunk) { return row * 256 + ((chunk ^ (row & 15)) << 4); }

DI void gemm_mainloop(const bfr* __restrict__ X, int ldx, const bfr* __restrict__ Y, int ldy, int K, char* smem,
                      f32x4 (&acc)[4][4]) {
  const int tid = opaque_tid(), lane = tid & 63, wid = tid >> 6, r = lane & 15, q = lane >> 4;
  const int wx = wid >> 1, wy = wid & 1;
  const int lr = tid >> 3, lc = tid & 7;
  const bfr* xp = X + (size_t)lr * ldx + lc * 8;
  const bfr* yp = Y + (size_t)lr * ldy + lc * 8;
  u32x4 xr[4], yr[4];
#pragma unroll
  for (int i = 0; i < 4; ++i) {
    xr[i] = *(const u32x4*)(xp + (size_t)(32 * i) * ldx);
    yr[i] = *(const u32x4*)(yp + (size_t)(32 * i) * ldy);
  }
  const int nk = K >> 6;
  for (int kt = 0; kt < nk; ++kt) {
    char* sX = smem + (kt & 1) * 32768;
    char* sY = sX + 16384;
#pragma unroll
    for (int i = 0; i < 4; ++i) {
      const int row = lr + 32 * i;
      *(u32x4*)(sX + sw128(row, lc)) = xr[i];
      *(u32x4*)(sY + sw128(row, lc)) = yr[i];
    }
    __syncthreads();
    if (kt + 1 < nk) {
      const int ko = (kt + 1) * 64;
#pragma unroll
      for (int i = 0; i < 4; ++i) {
        xr[i] = *(const u32x4*)(xp + (size_t)(32 * i) * ldx + ko);
        yr[i] = *(const u32x4*)(yp + (size_t)(32 * i) * ldy + ko);
      }
    }
#pragma unroll
    for (int s = 0; s < 2; ++s) {
      bf16x8 xa[4], yb[4];
#pragma unroll
      for (int i = 0; i < 4; ++i) xa[i] = *(const bf16x8*)(sX + sw128(wx * 64 + i * 16 + r, s * 4 + q));
#pragma unroll
      for (int j = 0; j < 4; ++j) yb[j] = *(const bf16x8*)(sY + sw128(wy * 64 + j * 16 + r, s * 4 + q));
#pragma unroll
      for (int i = 0; i < 4; ++i)
#pragma unroll
        for (int j = 0; j < 4; ++j) acc[i][j] = mfma16(xa[i], yb[j], acc[i][j]);
    }
  }
  __syncthreads();
}

DI bool tile_map(int T, int MT, int NT, int& mt, int& nt) {
  const int pm_n = MT >> 3;
  const int P = (T >> 9) * 8 + (T & 7);
  const int li = (T & 511) >> 3;
  const int pm = P % pm_n, pn = P / pm_n;
  mt = pm * 8 + (li & 7);
  nt = pn * 8 + (li >> 3);
  return nt < NT;
}

DI int odd_col_src(int n) {
  if (n < 3584) return n;
  if (n < 7168) return n + 32;
  if (n < 7200) return n - 7168 + 3584;
  return -1;
}

DI void phase0(const Params& p, char* smem) {
  const int tid = opaque_tid();
  if (blockIdx.x < 384) {
    float* sc = (float*)smem;
    float* red = sc + 9 * 1024;
    for (int i = tid; i < 9 * 1024; i += 256) {
      const int b = i >> 10, k = i & 1023;
      const float v = (b < 8) ? p.c[b * 1024 + k] : p.c_ctx[k];
      sc[i] = v / (1.f + __expf(-v));
    }
    __syncthreads();
    float* modb = (float*)(p.ws + OFF_MOD);
    for (int it = blockIdx.x; it < 384; it += gridDim.x) {
      const int l = it / 96, cgp = it % 96;
      const int col = cgp * 32 + (tid & 31), ks = tid >> 5;
      float a[9];
#pragma unroll
      for (int b = 0; b < 9; ++b) a[b] = 0.f;
      const float* w = p.w_mod + ((size_t)l * 1024 + ks * 128) * 3072 + col;
#pragma unroll 4
      for (int k = 0; k < 128; ++k) {
        const float wv = w[(size_t)k * 3072];
#pragma unroll
        for (int b = 0; b < 9; ++b) a[b] += sc[b * 1024 + ks * 128 + k] * wv;
      }
#pragma unroll
      for (int b = 0; b < 9; ++b) red[(ks * 9 + b) * 32 + (tid & 31)] = a[b];
      __syncthreads();
      for (int idx = tid; idx < 288; idx += 256) {
        const int b = idx >> 5, cc = idx & 31;
        float s = p.b_mod[l * 3072 + cgp * 32 + cc];
#pragma unroll
        for (int k2 = 0; k2 < 8; ++k2) s += red[(k2 * 9 + b) * 32 + cc];
        modb[(size_t)(l * 9 + b) * 3072 + cgp * 32 + cc] = s;
      }
      __syncthreads();
    }
  }
  if (blockIdx.x == gridDim.x - 1) {
    float2* cs = (float2*)(p.ws + OFF_CS);
    for (int idx = tid; idx < 1024; idx += 256) {
      const int pos = idx >> 4, f = idx & 15;
      const float inv = 1.0f / powf(10000.f, (float)f * 0.0625f);
      const float ang = (float)pos * inv;
      const double ad = (double)ang;
      const double n = rint(ad * 0.15915494309189535);
      const float rr = (float)(ad - n * 6.283185307179586);
      cs[idx] = make_float2(__cosf(rr), __sinf(rr));
    }
    if (tid < 2) {
      const float* lp = p.ev_lambda + tid * 256;
      float s1 = 0.f, s2 = 0.f;
      for (int i = 0; i < 64; ++i) { s1 += lp[i] * lp[64 + i]; s2 += lp[128 + i] * lp[192 + i]; }
      const float li = (tid == 0) ? 0.2f : (0.8f - 0.6f * 0.5488116360940264f);
      float* lam = (float*)(p.ws + OFF_LAM);
      lam[tid] = __expf(s1) - __expf(s2) + li;
      lam[2 + tid] = li;
    }
    if (tid < 32) ((int*)(p.ws + OFF_CTR))[tid] = 0;
  }
  float* tile = (float*)smem;
  __syncthreads();
  for (int it = blockIdx.x; it < 9792; it += gridDim.x) {
    int rr = it, l, ktile, ntile, K, Nsrc;
    const float* src;
    bfr* dst;
    bool oddmap = false;
    if (rr < 7744) {
      if (rr < 2048) { l = 0; } else if (rr < 3872) { l = 1; rr -= 2048; } else if (rr < 5920) { l = 2; rr -= 3872; } else { l = 3; rr -= 5920; }
      ktile = rr & 15; ntile = rr >> 4; K = 1024;
      oddmap = (l & 1);
      Nsrc = oddmap ? 7200 : 8192;
      src = (oddmap ? p.od_w_in : p.ev_w_in) + (size_t)(l >> 1) * 1024 * Nsrc;
      dst = (bfr*)(p.ws + win_off(l));
    } else {
      rr -= 7744; l = rr >> 9; rr &= 511;
      ktile = rr & 31; ntile = rr >> 5; K = 2048; Nsrc = 1024;
      src = p.w_out + (size_t)l * 2048 * 1024;
      dst = (bfr*)(p.ws + OFF_WOUT + (size_t)l * SZ_WOUT);
    }
    const int k0 = ktile * 64, n0 = ntile * 64;
    {
      const int nn = tid & 63;
      const int nd = n0 + nn;
      const int ns = oddmap ? odd_col_src(nd) : nd;
#pragma unroll 4
      for (int i = 0; i < 16; ++i) {
        const int kk = (tid >> 6) + 4 * i;
        tile[kk * 65 + nn] = (ns >= 0) ? src[(size_t)(k0 + kk) * Nsrc + ns] : 0.f;
      }
    }
    __syncthreads();
    {
      const int kk8 = (tid & 7) * 8;
#pragma unroll
      for (int i2 = 0; i2 < 2; ++i2) {
        const int nn = (tid >> 3) + 32 * i2;
        u32x4 v;
        v.x = pack2(tile[(kk8 + 0) * 65 + nn], tile[(kk8 + 1) * 65 + nn]);
        v.y = pack2(tile[(kk8 + 2) * 65 + nn], tile[(kk8 + 3) * 65 + nn]);
        v.z = pack2(tile[(kk8 + 4) * 65 + nn], tile[(kk8 + 5) * 65 + nn]);
        v.w = pack2(tile[(kk8 + 6) * 65 + nn], tile[(kk8 + 7) * 65 + nn]);
        *(u32x4*)(dst + (size_t)(n0 + nn) * K + k0 + kk8) = v;
      }
    }
    __syncthreads();
  }
}

DI void phase_norm(const Params& p, int l, int g) {
  const int tid = opaque_tid(), lane = tid & 63, wid = tid >> 6;
  const int rows = (l == 4) ? ML : MR;
  const float* modb = (const float*)(p.ws + OFF_MOD);
  const float* ybuf = (const float*)(p.ws + OFF_PROJ);
  bfr* hbuf = (bfr*)(p.ws + OFF_H);
  float* xcb = (float*)(p.ws + OFF_XC);
  for (int row = blockIdx.x * 4 + wid; row < rows; row += gridDim.x * 4) {
    const bool lat = row < ML;
    const int mb = lat ? (g * GB + (row >> 12)) : 8;
    const size_t grow = lat ? ((size_t)g * ML + row) : ((size_t)g * MC + (row - ML));
    const float* xin;
    float* xst;
    if (lat) { xin = ((l <= 1) ? p.x : (const float*)p.out) + grow * 1024; xst = p.out + grow * 1024; }
    else     { xin = ((l <= 1) ? p.ctx : (const float*)xcb) + grow * 1024; xst = xcb + grow * 1024; }
    float4 xv[4];
#pragma unroll
    for (int i = 0; i < 4; ++i) xv[i] = *(const float4*)(xin + lane * 4 + 256 * i);
    if (l >= 1) {
      float4 yv[4];
      float ss = 0.f;
#pragma unroll
      for (int i = 0; i < 4; ++i) {
        yv[i] = *(const float4*)(ybuf + (size_t)row * 1024 + lane * 4 + 256 * i);
        ss += yv[i].x * yv[i].x + yv[i].y * yv[i].y + yv[i].z * yv[i].z + yv[i].w * yv[i].w;
      }
      ss = wave_sum(ss);
      const float rn = rsqrtf(ss * (1.f / 1024.f) + 1e-6f);
      const float* gate = modb + (size_t)((l - 1) * 9 + mb) * 3072 + 2048;
      const float* gp = p.g_post + (l - 1) * 1024;
#pragma unroll
      for (int i = 0; i < 4; ++i) {
        const int c0 = lane * 4 + 256 * i;
        const float4 gt = *(const float4*)(gate + c0);
        const float4 gg = *(const float4*)(gp + c0);
        xv[i].x += gt.x * (yv[i].x * rn * gg.x);
        xv[i].y += gt.y * (yv[i].y * rn * gg.y);
        xv[i].z += gt.z * (yv[i].z * rn * gg.z);
        xv[i].w += gt.w * (yv[i].w * rn * gg.w);
        *(float4*)(xst + c0) = xv[i];
      }
    }
    if (l < 4) {
      float ss = 0.f;
#pragma unroll
      for (int i = 0; i < 4; ++i) ss += xv[i].x * xv[i].x + xv[i].y * xv[i].y + xv[i].z * xv[i].z + xv[i].w * xv[i].w;
      ss = wave_sum(ss);
      const float rn = rsqrtf(ss * (1.f / 1024.f) + 1e-6f);
      const float* mrow = modb + (size_t)(l * 9 + mb) * 3072;
      const float* gpre = p.g_pre + l * 1024;
#pragma unroll
      for (int i = 0; i < 4; ++i) {
        const int c0 = lane * 4 + 256 * i;
        const float4 sh = *(const float4*)(mrow + c0);
        const float4 scl = *(const float4*)(mrow + 1024 + c0);
        const float4 gg = *(const float4*)(gpre + c0);
        u32x2 o;
        o.x = pack2(xv[i].x * rn * gg.x * (1.f + scl.x) + sh.x, xv[i].y * rn * gg.y * (1.f + scl.y) + sh.y);
        o.y = pack2(xv[i].z * rn * gg.z * (1.f + scl.z) + sh.z, xv[i].w * rn * gg.w * (1.f + scl.w) + sh.w);
        *(u32x2*)(hbuf + (size_t)row * 1024 + c0) = o;
      }
    }
  }
}

DI void phase_gemm_in(const Params& p, int l, char* smem) {
  const int tid = opaque_tid(), lane = tid & 63, wid = tid >> 6, r = lane & 15, q = lane >> 4;
  const int wx = wid >> 1, wy = wid & 1;
  const bool even = !(l & 1);
  const int ldp = even ? NEV : NOD;
  const int NT = ldp >> 7, MT = MR >> 7;
  const bfr* WT = (const bfr*)(p.ws + win_off(l));
  const bfr* H = (const bfr*)(p.ws + OFF_H);
  bfr* proj = (bfr*)(p.ws + OFF_PROJ);
  bfr* VT = (bfr*)(p.ws + OFF_VT);
  const float2* cs = (const float2*)(p.ws + OFF_CS);
  const int total = ((((MT >> 3) * ((NT + 7) >> 3)) + 7) >> 3) << 9;
  for (int T = blockIdx.x; T < total; T += gridDim.x) {
    int mt, nt;
    if (!tile_map(T, MT, NT, mt, nt)) continue;
    const int m0 = mt * 128, n0 = nt * 128;
    const bool vt = (n0 >= 1024 && n0 < 2048);
    f32x4 acc[4][4];
#pragma unroll
    for (int i = 0; i < 4; ++i)
#pragma unroll
      for (int j = 0; j < 4; ++j) acc[i][j] = (f32x4){0.f, 0.f, 0.f, 0.f};
    const bfr* X = vt ? (H + (size_t)m0 * 1024) : (WT + (size_t)n0 * 1024);
    const bfr* Y = vt ? (WT + (size_t)n0 * 1024) : (H + (size_t)m0 * 1024);
    gemm_mainloop(X, 1024, Y, 1024, 1024, smem, acc);
    if (vt) {
#pragma unroll
      for (int i = 0; i < 4; ++i) {
        const int mbase = m0 + wx * 64 + i * 16;
        int b, kp;
        if (mbase < ML) { b = mbase >> 12; kp = mbase & 4095; } else { const int mm = mbase - ML; b = mm >> 8; kp = 4096 + (mm & 255); }
        const int pos = (kp & ~31) + q * 8 + ((kp >> 4) & 1) * 4;
#pragma unroll
        for (int jn = 0; jn < 4; ++jn) {
          const int f = n0 - 1024 + wy * 64 + jn * 16 + r;
          u32x2 o;
          o.x = pack2(acc[i][jn][0], acc[i][jn][1]);
          o.y = pack2(acc[i][jn][2], acc[i][jn][3]);
          *(u32x2*)(VT + ((size_t)(b * 1024 + f)) * KEYS + pos) = o;
        }
      }
    } else {
      const bool rope = even && (n0 < 1024 || (n0 >= 2048 && n0 < 3072)) && (m0 < ML);
      if (rope) {
#pragma unroll
        for (int jn = 0; jn < 4; ++jn) {
          const int m = m0 + wy * 64 + jn * 16 + r;
          const int t = m & 4095;
          const int grow = t >> 6, gcol = t & 63;
#pragma unroll
          for (int j = 0; j < 4; ++j) {
            const float2 a = cs[grow * 16 + 4 * q + j];
            const float2 c = cs[gcol * 16 + 4 * q + j];
            const float x0 = acc[0][jn][j], x1 = acc[1][jn][j], x2 = acc[2][jn][j], x3 = acc[3][jn][j];
            acc[0][jn][j] = x0 * a.x - x1 * a.y;
            acc[1][jn][j] = x1 * a.x + x0 * a.y;
            acc[2][jn][j] = x2 * c.x - x3 * c.y;
            acc[3][jn][j] = x3 * c.x + x2 * c.y;
          }
        }
      }
#pragma unroll
      for (int jn = 0; jn < 4; ++jn) {
        const int m = m0 + wy * 64 + jn * 16 + r;
#pragma unroll
        for (int i = 0; i < 4; ++i) {
          const int n = n0 + wx * 64 + i * 16 + 4 * q;
          u32x2 o;
          o.x = pack2(acc[i][jn][0], acc[i][jn][1]);
          o.y = pack2(acc[i][jn][2], acc[i][jn][3]);
          *(u32x2*)(proj + (size_t)m * ldp + n) = o;
        }
      }
    }
  }
}

DI void phase_gemm_out(const Params& p, int l, char* smem) {
  const int tid = opaque_tid(), lane = tid & 63, wid = tid >> 6, r = lane & 15, q = lane >> 4;
  const int wx = wid >> 1, wy = wid & 1;
  const bfr* WT = (const bfr*)(p.ws + OFF_WOUT + (size_t)l * SZ_WOUT);
  const bfr* U = (const bfr*)(p.ws + OFF_U);
  float* ybuf = (float*)(p.ws + OFF_PROJ);
  const int MT = (l == 3) ? (ML >> 7) : (MR >> 7);
  const int total = (((MT >> 3) + 7) >> 3) << 9;
  for (int T = blockIdx.x; T < total; T += gridDim.x) {
    int mt, nt;
    if (!tile_map(T, MT, 8, mt, nt)) continue;
    const int m0 = mt * 128, n0 = nt * 128;
    f32x4 acc[4][4];
#pragma unroll
    for (int i = 0; i < 4; ++i)
#pragma unroll
      for (int j = 0; j < 4; ++j) acc[i][j] = (f32x4){0.f, 0.f, 0.f, 0.f};
    gemm_mainloop(WT + (size_t)n0 * 2048, 2048, U + (size_t)m0 * 2048, 2048, 2048, smem, acc);
#pragma unroll
    for (int jn = 0; jn < 4; ++jn) {
      const int m = m0 + wy * 64 + jn * 16 + r;
#pragma unroll
      for (int i = 0; i < 4; ++i) {
        const int n = n0 + wx * 64 + i * 16 + 4 * q;
        *(f32x4*)(ybuf + (size_t)m * 1024 + n) = acc[i][jn];
      }
    }
  }
}

template <int DV, int QT, int KT, int MODE>
DI void attn_engine(const bfr* __restrict__ qbase, int ldq, const bfr* __restrict__ kbase, int ldk,
                    const bfr* __restrict__ vt, int nloc, int loc_row0, int loc_pos0, int nctx, int ctx_row0,
                    const float* rpb_s, int roff0, char* smem, f32x4 (&O)[DV / 16][QT], float (&lsum)[QT]) {
  constexpr int STAGE = 8192 + DV * 128;
  constexpr int NVL = DV / 32;
  const int tid = opaque_tid(), lane = tid & 63, wid = tid >> 6, r = lane & 15, q = lane >> 4;
  const int lr = tid >> 3, lc = tid & 7;
  constexpr float SC = 0.125f * L2E;

  bf16x8 Qf[QT][2];
#pragma unroll
  for (int qt = 0; qt < QT; ++qt)
#pragma unroll
    for (int s = 0; s < 2; ++s)
      Qf[qt][s] = *(const bf16x8*)(qbase + (size_t)(wid * 16 * QT + qt * 16 + r) * ldq + s * 32 + q * 8);
  float mrun[QT];
#pragma unroll
  for (int qt = 0; qt < QT; ++qt) {
    mrun[qt] = -1e30f;
    lsum[qt] = 0.f;
#pragma unroll
    for (int dt = 0; dt < DV / 16; ++dt) O[dt][qt] = (f32x4){0.f, 0.f, 0.f, 0.f};
  }

  const int nch = nloc + nctx;
  u32x4 kreg0, kreg1, vreg[NVL];
  const int ksw0 = sw128(lr, lc), ksw1 = sw128(lr + 32, lc);
#define AT_LOAD(c_)                                                                                          \
  {                                                                                                          \
    const int cc_ = (c_);                                                                                    \
    const int row_ = (cc_ < nloc) ? (loc_row0 + cc_ * 64) : (ctx_row0 + (cc_ - nloc) * 64);                  \
    const int pos_ = (cc_ < nloc) ? (loc_pos0 + cc_ * 64) : (4096 + (cc_ - nloc) * 64);                      \
    kreg0 = *(const u32x4*)(kbase + (size_t)(row_ + lr) * ldk + lc * 8);                                     \
    kreg1 = *(const u32x4*)(kbase + (size_t)(row_ + lr + 32) * ldk + lc * 8);                                \
    _Pragma("unroll") for (int i_ = 0; i_ < NVL; ++i_)                                                       \
        vreg[i_] = *(const u32x4*)(vt + (size_t)(lr + 32 * i_) * KEYS + pos_ + lc * 8);                      \
  }
#define AT_STORE(c_)                                                                                         \
  {                                                                                                          \
    char* sb_ = smem + ((c_) & 1) * STAGE;                                                                   \
    *(u32x4*)(sb_ + ksw0) = kreg0;                                                                           \
    *(u32x4*)(sb_ + ksw1) = kreg1;                                                                           \
    _Pragma("unroll") for (int i_ = 0; i_ < NVL; ++i_)                                                       \
        *(u32x4*)(sb_ + 8192 + sw128(lr + 32 * i_, lc)) = vreg[i_];                                          \
  }
  if (nch > 0) { AT_LOAD(0); AT_STORE(0); }
  for (int c = 0; c < nch; ++c) {
    __syncthreads();
    const bool more = (c + 1 < nch);
    const char* sK = smem + (c & 1) * STAGE;
    const char* sV = sK + 8192;
    if (more) AT_LOAD(c + 1);
#pragma unroll
    for (int sbk = 0; sbk < 4 / KT; ++sbk) {
      f32x4 st[KT][QT];
#pragma unroll
      for (int kt = 0; kt < KT; ++kt)
#pragma unroll
        for (int qt = 0; qt < QT; ++qt) st[kt][qt] = (f32x4){0.f, 0.f, 0.f, 0.f};
#pragma unroll
      for (int s = 0; s < 2; ++s)
#pragma unroll
        for (int kt = 0; kt < KT; ++kt) {
          const bf16x8 ka = *(const bf16x8*)(sK + sw128(sbk * KT * 16 + kt * 16 + r, s * 4 + q));
#pragma unroll
          for (int qt = 0; qt < QT; ++qt) st[kt][qt] = mfma16(ka, Qf[qt][s], st[kt][qt]);
        }
#pragma unroll
      for (int kt = 0; kt < KT; ++kt)
#pragma unroll
        for (int qt = 0; qt < QT; ++qt)
#pragma unroll
          for (int j = 0; j < 4; ++j) {
            float v = st[kt][qt][j] * SC;
            if (MODE == 1) {
              if (c < nloc) {
                const int kc = sbk * KT * 16 + kt * 16 + 4 * q + j;
                const int qc = wid * 16 + r;
                int wst = qc - 8; wst = wst < 0 ? 0 : (wst > 48 ? 48 : wst);
                const bool valid = (kc >= wst) && (kc < wst + 16);
                int co = kc - qc + 15; co = co < 0 ? 0 : (co > 30 ? 30 : co);
                const float bias = rpb_s[(roff0 + c) * 31 + co] * L2E;
                v = valid ? (v + bias) : -INFINITY;
              }
            }
            st[kt][qt][j] = v;
          }
      bf16x8 pb[KT / 2][QT];
#pragma unroll
      for (int qt = 0; qt < QT; ++qt) {
        float mx = -INFINITY;
#pragma unroll
        for (int kt = 0; kt < KT; ++kt)
#pragma unroll
          for (int j = 0; j < 4; ++j) mx = fmaxf(mx, st[kt][qt][j]);
        mx = fmaxf(mx, __shfl_xor(mx, 16));
        mx = fmaxf(mx, __shfl_xor(mx, 32));
        const float mnew = fmaxf(mrun[qt], mx);
        const float alpha = fexp2(mrun[qt] - mnew);
        mrun[qt] = mnew;
        float ps = 0.f;
#pragma unroll
        for (int kt = 0; kt < KT; ++kt)
#pragma unroll
          for (int j = 0; j < 4; ++j) {
            const float pv = fexp2(st[kt][qt][j] - mnew);
            st[kt][qt][j] = pv;
            ps += pv;
          }
        lsum[qt] = lsum[qt] * alpha + ps;
        if (__any(alpha != 1.f)) {
#pragma unroll
          for (int dt = 0; dt < DV / 16; ++dt) {
            O[dt][qt][0] *= alpha; O[dt][qt][1] *= alpha; O[dt][qt][2] *= alpha; O[dt][qt][3] *= alpha;
          }
        }
#pragma unroll
        for (int ks = 0; ks < KT / 2; ++ks) {
          u32x4 pk;
          pk.x = pack2(st[2 * ks][qt][0], st[2 * ks][qt][1]);
          pk.y = pack2(st[2 * ks][qt][2], st[2 * ks][qt][3]);
          pk.z = pack2(st[2 * ks + 1][qt][0], st[2 * ks + 1][qt][1]);
          pk.w = pack2(st[2 * ks + 1][qt][2], st[2 * ks + 1][qt][3]);
          pb[ks][qt] = __builtin_bit_cast(bf16x8, pk);
        }
      }
#pragma unroll
      for (int dt = 0; dt < DV / 16; ++dt)
#pragma unroll
        for (int ks = 0; ks < KT / 2; ++ks) {
          const bf16x8 va = *(const bf16x8*)(sV + sw128(dt * 16 + r, (sbk * (KT / 2) + ks) * 4 + q));
#pragma unroll
          for (int qt = 0; qt < QT; ++qt) O[dt][qt] = mfma16(va, pb[ks][qt], O[dt][qt]);
        }
    }
    if (more) AT_STORE(c + 1);
  }
#undef AT_LOAD
#undef AT_STORE
  __syncthreads();
#pragma unroll
  for (int qt = 0; qt < QT; ++qt) {
    float L = lsum[qt];
    L += __shfl_xor(L, 16);
    L += __shfl_xor(L, 32);
    lsum[qt] = L;
  }
}

DI void diff_attn_item(const Params& p, int l, int b, int head, int qrow0, bool ctxq, char* smem) {
  const int tid = opaque_tid(), lane = tid & 63, wid = tid >> 6, r = lane & 15, q = lane >> 4;
  const bfr* proj = (const bfr*)(p.ws + OFF_PROJ);
  const bfr* VT = (const bfr*)(p.ws + OFF_VT);
  bfr* U = (bfr*)(p.ws + OFF_U);
  const float* lamv = (const float*)(p.ws + OFF_LAM);
  const float lam = lamv[l >> 1], lam_init = lamv[2 + (l >> 1)];
  u32x16 park0, park1;
  f32x4 O[8][2];
  float ls[2];
  attn_engine<128, 2, 2, 0>(proj + (size_t)qrow0 * NEV + 2048 + head * 128, NEV, proj + head * 128, NEV,
                            VT + (size_t)(b * 1024 + head * 128) * KEYS, ctxq ? 0 : 64, b * 4096, 0, 4,
                            ML + b * 256, nullptr, 0, smem, O, ls);
  {
    const float i0 = 1.f / ls[0], i1 = 1.f / ls[1];
#pragma unroll
    for (int dt = 0; dt < 8; ++dt) {
      park0[dt * 2] = pack2(O[dt][0][0] * i0, O[dt][0][1] * i0);
      park0[dt * 2 + 1] = pack2(O[dt][0][2] * i0, O[dt][0][3] * i0);
      park1[dt * 2] = pack2(O[dt][1][0] * i1, O[dt][1][1] * i1);
      park1[dt * 2 + 1] = pack2(O[dt][1][2] * i1, O[dt][1][3] * i1);
    }
  }
  attn_engine<128, 2, 2, 0>(proj + (size_t)qrow0 * NEV + 2048 + head * 128 + 64, NEV, proj + head * 128 + 64, NEV,
                            VT + (size_t)(b * 1024 + head * 128) * KEYS, ctxq ? 0 : 64, b * 4096, 0, 4,
                            ML + b * 256, nullptr, 0, smem, O, ls);
  const float* subln = p.ev_subln + (l >> 1) * 128;
#pragma unroll
  for (int qt = 0; qt < 2; ++qt) {
    const float i1 = lam / ls[qt];
    float ss = 0.f;
#pragma unroll
    for (int dt = 0; dt < 8; ++dt) {
      const unsigned pa = (qt == 0) ? park0[dt * 2] : park1[dt * 2];
      const unsigned pc = (qt == 0) ? park0[dt * 2 + 1] : park1[dt * 2 + 1];
      const float o0 = lo_bf(pa) - O[dt][qt][0] * i1;
      const float o1 = hi_bf(pa) - O[dt][qt][1] * i1;
      const float o2 = lo_bf(pc) - O[dt][qt][2] * i1;
      const float o3 = hi_bf(pc) - O[dt][qt][3] * i1;
      O[dt][qt][0] = o0; O[dt][qt][1] = o1; O[dt][qt][2] = o2; O[dt][qt][3] = o3;
      ss += o0 * o0 + o1 * o1 + o2 * o2 + o3 * o3;
    }
    ss += __shfl_xor(ss, 16);
    ss += __shfl_xor(ss, 32);
    const float rn = rsqrtf(ss * (1.f / 128.f) + 1e-6f) * (1.f - lam_init);
    const int row = qrow0 + wid * 32 + qt * 16 + r;
#pragma unroll
    for (int dt = 0; dt < 8; ++dt) {
      const int dv = dt * 16 + 4 * q;
      const u32x2 ag = *(const u32x2*)(proj + (size_t)row * NEV + 3072 + head * 128 + dv);
      const float4 sl = *(const float4*)(subln + dv);
      u32x2 o;
      o.x = pack2(O[dt][qt][0] * rn * sl.x * silu(lo_bf(ag.x)), O[dt][qt][1] * rn * sl.y * silu(hi_bf(ag.x)));
      o.y = pack2(O[dt][qt][2] * rn * sl.z * silu(lo_bf(ag.y)), O[dt][qt][3] * rn * sl.w * silu(hi_bf(ag.y)));
      *(u32x2*)(U + (size_t)row * 2048 + head * 128 + dv) = o;
    }
  }
}

DI void na_item(const Params& p, int l, int b, int head, int rho, bool ctxq, int cq0, char* smem) {
  const int tid = opaque_tid(), lane = tid & 63, wid = tid >> 6, r = lane & 15, q = lane >> 4;
  const bfr* proj = (const bfr*)(p.ws + OFF_PROJ);
  const bfr* VT = (const bfr*)(p.ws + OFF_VT);
  bfr* U = (bfr*)(p.ws + OFF_U);
  float* rpb_s = (float*)(smem + 2 * (8192 + 64 * 128));
  int rs = rho - 4; rs = rs < 0 ? 0 : (rs > 56 ? 56 : rs);
  const int qrow0 = ctxq ? (ML + b * 256 + cq0) : (b * 4096 + rho * 64);
  f32x4 O[4][1];
  float ls[1];
  if (!ctxq) {
    const float* rp = p.od_rpb + ((size_t)(l >> 1) * 16 + head) * 465;
    for (int i = tid; i < 465; i += 256) rpb_s[i] = rp[i];
    attn_engine<64, 1, 4, 1>(proj + (size_t)qrow0 * NOD + 3584 + head * 64, NOD, proj + head * 64, NOD,
                                VT + (size_t)(b * 1024 + head * 64) * KEYS, 8, b * 4096 + rs * 64, rs * 64, 4,
                                ML + b * 256, rpb_s, rs - rho + 7, smem, O, ls);
  } else {
    attn_engine<64, 1, 4, 0>(proj + (size_t)qrow0 * NOD + 3584 + head * 64, NOD, proj + head * 64, NOD,
                                VT + (size_t)(b * 1024 + head * 64) * KEYS, 0, 0, 0, 4, ML + b * 256, nullptr, 0,
                                smem, O, ls);
  }
  const float inv = 1.f / ls[0];
  const int row = qrow0 + wid * 16 + r;
#pragma unroll
  for (int dt = 0; dt < 4; ++dt) {
    const int dv = dt * 16 + 4 * q;
    const u32x2 cgv = *(const u32x2*)(proj + (size_t)row * NOD + 5120 + head * 64 + dv);
    u32x2 o;
    o.x = pack2(O[dt][0][0] * inv * silu(lo_bf(cgv.x)), O[dt][0][1] * inv * silu(hi_bf(cgv.x)));
    o.y = pack2(O[dt][0][2] * inv * silu(lo_bf(cgv.y)), O[dt][0][3] * inv * silu(hi_bf(cgv.y)));
    *(u32x2*)(U + (size_t)row * 2048 + head * 64 + dv) = o;
  }
}

DI void conv_item(const Params& p, int l, int item) {
  const int tid = opaque_tid();
  const bfr* proj = (const bfr*)(p.ws + OFF_PROJ);
  bfr* U = (bfr*)(p.ws + OFF_U);
  const float* cw = p.ev_conv + (size_t)(l >> 1) * 3 * 1024;
#pragma unroll 1
  for (int i = 0; i < 8; ++i) {
    const int v = tid + 256 * i;
    const int ri = v >> 7, ch = (v & 127) * 8;
    const int m = item * 16 + ri;
    int t, T;
    if (m < ML) { t = m & 4095; T = 4096; } else { t = (m - ML) & 255; T = 256; }
    const bfr* pr = proj + (size_t)m * NEV;
    float acc[8];
#pragma unroll
    for (int e = 0; e < 8; ++e) acc[e] = 0.f;
#pragma unroll
    for (int w = 0; w < 3; ++w) {
      const int tt = t + w - 1;
      if (tt >= 0 && tt < T) {
        const bfr* prw = pr + (ptrdiff_t)(w - 1) * NEV;
        const u32x4 bh = *(const u32x4*)(prw + 4096 + ch);
        const u32x4 bc = *(const u32x4*)(prw + 6144 + ch);
        const float4 w0 = *(const float4*)(cw + w * 1024 + ch);
        const float4 w1 = *(const float4*)(cw + w * 1024 + ch + 4);
        acc[0] += w0.x * lo_bf(bh.x) * lo_bf(bc.x); acc[1] += w0.y * hi_bf(bh.x) * hi_bf(bc.x);
        acc[2] += w0.z * lo_bf(bh.y) * lo_bf(bc.y); acc[3] += w0.w * hi_bf(bh.y) * hi_bf(bc.y);
        acc[4] += w1.x * lo_bf(bh.z) * lo_bf(bc.z); acc[5] += w1.y * hi_bf(bh.z) * hi_bf(bc.z);
        acc[6] += w1.z * lo_bf(bh.w) * lo_bf(bc.w); acc[7] += w1.w * hi_bf(bh.w) * hi_bf(bc.w);
      }
    }
    const u32x4 bb = *(const u32x4*)(pr + 5120 + ch);
    const u32x4 bg = *(const u32x4*)(pr + 7168 + ch);
    u32x4 o;
    o.x = pack2(lo_bf(bb.x) * acc[0] * silu(lo_bf(bg.x)), hi_bf(bb.x) * acc[1] * silu(hi_bf(bg.x)));
    o.y = pack2(lo_bf(bb.y) * acc[2] * silu(lo_bf(bg.y)), hi_bf(bb.y) * acc[3] * silu(hi_bf(bg.y)));
    o.z = pack2(lo_bf(bb.z) * acc[4] * silu(lo_bf(bg.z)), hi_bf(bb.z) * acc[5] * silu(hi_bf(bg.z)));
    o.w = pack2(lo_bf(bb.w) * acc[6] * silu(lo_bf(bg.w)), hi_bf(bb.w) * acc[7] * silu(hi_bf(bg.w)));
    *(u32x4*)(U + (size_t)m * 2048 + 1024 + ch) = o;
  }
}

DI void gla_item(const Params& p, int l, int item, char* smem) {
  const int tid = opaque_tid(), lane = tid & 63, wid = tid >> 6, r = lane & 15, q = lane >> 4;
  const int slice = item & 7, dir = (item >> 3) & 1, head = (item >> 4) & 3, b = item >> 6;
  const int jl = l >> 1;
  const bfr* proj = (const bfr*)(p.ws + OFF_PROJ);
  bfr* dst = dir ? (bfr*)(p.ws + OFF_H) : ((bfr*)(p.ws + OFF_U) + 1024);
  const int dld = dir ? 1024 : 2048;
  char* sQb = smem;
  char* sKc = smem + 16384;
  char* sKbT = smem + 32768;
  char* sVt = smem + 49152;
  char* sAtt = smem + 53248;
  float* sLr = (float*)sAtt;
  float* sHs = (float*)(sAtt + 4096);
  char* sST = smem + 61440;
  float* sDec = (float*)(smem + 77824);

  const int d = tid & 127, half = tid >> 7;
  float gu[16];
#pragma unroll
  for (int k = 0; k < 16; ++k) gu[k] = p.od_gate_up[(((size_t)jl * 2 + dir) * 16 + k) * 512 + head * 128 + d];
  const float gbias = p.od_gate_bias[((size_t)jl * 2 + dir) * 512 + head * 128 + d];
  const float qscale = 0.08838834764831845f;

  f32x4 S[2][2];
#pragma unroll
  for (int a = 0; a < 2; ++a)
#pragma unroll
    for (int c2 = 0; c2 < 2; ++c2) S[a][c2] = (f32x4){0.f, 0.f, 0.f, 0.f};
  __syncthreads();
  for (int i = tid; i < 512; i += 256) ((u32x4*)sST)[i] = (u32x4){0u, 0u, 0u, 0u};

  for (int ci = 0; ci < 68; ++ci) {
    int row0;
    if (ci < 4) row0 = ML + b * 256 + (dir ? (3 - ci) : ci) * 64;
    else        row0 = b * 4096 + (dir ? (67 - ci) : (ci - 4)) * 64;
    const char* stc = sST + (ci & 1) * 8192;
    char* stn = sST + ((ci + 1) & 1) * 8192;
    __syncthreads();
    {
      const int s = tid >> 2, part = tid & 3;
      const u32x2 lv = *(const u32x2*)(proj + (size_t)(row0 + s) * NOD + 7168 + dir * 16 + part * 4);
      *(float4*)(sLr + s * 16 + part * 4) = make_float4(lo_bf(lv.x), hi_bf(lv.x), lo_bf(lv.y), hi_bf(lv.y));
      const int e = tid & 31, sg = tid >> 5;
      const bfr* vp = proj + (size_t)(row0 + sg * 8) * NOD + 2560 + head * 256 + slice * 32 + e;
      u32x4 pk;
      pk.x = (unsigned)vp[0] | ((unsigned)vp[NOD] << 16);
      pk.y = (unsigned)vp[2 * NOD] | ((unsigned)vp[3 * NOD] << 16);
      pk.z = (unsigned)vp[4 * NOD] | ((unsigned)vp[5 * NOD] << 16);
      pk.w = (unsigned)vp[6 * NOD] | ((unsigned)vp[7 * NOD] << 16);
      *(u32x4*)(sVt + sw128(e, sg)) = pk;
    }
    __syncthreads();
    float gl[32];
    float tot = 0.f;
#pragma unroll
    for (int i = 0; i < 32; ++i) {
      const int s = half * 32 + i;
      float z = gbias;
#pragma unroll
      for (int k4 = 0; k4 < 4; ++k4) {
        const float4 lv = *(const float4*)(sLr + s * 16 + k4 * 4);
        z += lv.x * gu[k4 * 4] + lv.y * gu[k4 * 4 + 1] + lv.z * gu[k4 * 4 + 2] + lv.w * gu[k4 * 4 + 3];
      }
      const float tneg = fexp2(-fabsf(z) * L2E);
      const float g = (fminf(z, 0.f) - flog2(1.f + tneg) * LN2) * (1.f / 16.f);
      gl[i] = g;
      tot += g;
    }
    if (dir == 0) {
      float run = 0.f;
#pragma unroll
      for (int i = 0; i < 32; ++i) { run += gl[i]; gl[i] = run; }
    } else {
      float run = 0.f;
#pragma unroll
      for (int i = 31; i >= 0; --i) { run += gl[i]; gl[i] = run; }
    }
    sHs[half * 128 + d] = tot;
    __syncthreads();
    const float other = sHs[(1 - half) * 128 + d];
    const float bend = tot + other;
    const float offs = (dir == 0) ? (half ? other : 0.f) : (half ? 0.f : other);
    const float dec = fexp2(bend * L2E);
    if (half == 0) sDec[d] = dec;
    {
      const bfr* qp = proj + (size_t)(row0 + half * 32) * NOD + 4608 + head * 128 + d;
      const bfr* kp = proj + (size_t)(row0 + half * 32) * NOD + 2048 + head * 128 + d;
#pragma unroll
      for (int i8 = 0; i8 < 4; ++i8) {
        unsigned kb[4];
#pragma unroll
        for (int ii = 0; ii < 8; ++ii) {
          const int i = i8 * 8 + ii;
          const int s = half * 32 + i;
          const float bb = (gl[i] + offs) * L2E;
          const float E = fexp2(bb), Ei = fexp2(-bb);
          const float qv = bf2f(qp[(size_t)i * NOD]) * qscale * E;
          const float kc = bf2f(kp[(size_t)i * NOD]) * Ei;
          *(bfr*)(sQb + sw256(s, d >> 3) + (d & 7) * 2) = f2bf(qv);
          *(bfr*)(sKc + sw256(s, d >> 3) + (d & 7) * 2) = f2bf(kc);
          const unsigned kbv = f2bf(kc * dec);
          if (ii & 1) kb[ii >> 1] |= kbv << 16; else kb[ii >> 1] = kbv;
        }
        *(u32x4*)(sKbT + sw128(d, half * 4 + i8)) = (u32x4){kb[0], kb[1], kb[2], kb[3]};
      }
    }
    __syncthreads();
    {
      f32x4 at[4];
#pragma unroll
      for (int st = 0; st < 4; ++st) at[st] = (f32x4){0.f, 0.f, 0.f, 0.f};
#pragma unroll
      for (int ks = 0; ks < 4; ++ks) {
        const bf16x8 qa = *(const bf16x8*)(sQb + sw256(wid * 16 + r, ks * 4 + q));
#pragma unroll
        for (int st = 0; st < 4; ++st) {
          const bf16x8 kb2 = *(const bf16x8*)(sKc + sw256(st * 16 + r, ks * 4 + q));
          at[st] = mfma16(qa, kb2, at[st]);
        }
      }
#pragma unroll
      for (int st = 0; st < 4; ++st)
#pragma unroll
        for (int j = 0; j < 4; ++j) {
          const int t = wid * 16 + 4 * q + j, s = st * 16 + r;
          const bool keep = dir ? (s >= t) : (s <= t);
          *(bfr*)(sAtt + sw128(t, s >> 3) + (s & 7) * 2) = f2bf(keep ? at[st][j] : 0.f);
        }
    }
    __syncthreads();
    {
      f32x4 o[2];
      o[0] = (f32x4){0.f, 0.f, 0.f, 0.f};
      o[1] = (f32x4){0.f, 0.f, 0.f, 0.f};
#pragma unroll
      for (int ks = 0; ks < 4; ++ks) {
        const bf16x8 qa = *(const bf16x8*)(sQb + sw256(wid * 16 + r, ks * 4 + q));
#pragma unroll
        for (int et = 0; et < 2; ++et) {
          const bf16x8 sb2 = *(const bf16x8*)(stc + sw256(et * 16 + r, ks * 4 + q));
          o[et] = mfma16(qa, sb2, o[et]);
        }
      }
#pragma unroll
      for (int ks = 0; ks < 2; ++ks) {
        const bf16x8 aa = *(const bf16x8*)(sAtt + sw128(wid * 16 + r, ks * 4 + q));
#pragma unroll
        for (int et = 0; et < 2; ++et) {
          const bf16x8 vb = *(const bf16x8*)(sVt + sw128(et * 16 + r, ks * 4 + q));
          o[et] = mfma16(aa, vb, o[et]);
        }
      }
#pragma unroll
      for (int et = 0; et < 2; ++et)
#pragma unroll
        for (int j = 0; j < 4; ++j) {
          const int t = wid * 16 + 4 * q + j;
          dst[(size_t)(row0 + t) * dld + head * 256 + slice * 32 + et * 16 + r] = f2bf(o[et][j]);
        }
    }
    {
#pragma unroll
      for (int dti = 0; dti < 2; ++dti) {
        const float dc = sDec[(2 * wid + dti) * 16 + r];
#pragma unroll
        for (int et = 0; et < 2; ++et) {
          S[et][dti][0] *= dc; S[et][dti][1] *= dc; S[et][dti][2] *= dc; S[et][dti][3] *= dc;
        }
      }
#pragma unroll
      for (int ks = 0; ks < 2; ++ks) {
        bf16x8 va[2], kb2[2];
#pragma unroll
        for (int et = 0; et < 2; ++et) va[et] = *(const bf16x8*)(sVt + sw128(et * 16 + r, ks * 4 + q));
#pragma unroll
        for (int dti = 0; dti < 2; ++dti) kb2[dti] = *(const bf16x8*)(sKbT + sw128((2 * wid + dti) * 16 + r, ks * 4 + q));
#pragma unroll
        for (int et = 0; et < 2; ++et)
#pragma unroll
          for (int dti = 0; dti < 2; ++dti) S[et][dti] = mfma16(va[et], kb2[dti], S[et][dti]);
      }
#pragma unroll
      for (int et = 0; et < 2; ++et)
#pragma unroll
        for (int dti = 0; dti < 2; ++dti)
#pragma unroll
          for (int j = 0; j < 4; ++j) {
            const int e = et * 16 + 4 * q + j, dd = (2 * wid + dti) * 16 + r;
            *(bfr*)(stn + sw256(e, dd >> 3) + (dd & 7) * 2) = f2bf(S[et][dti][j]);
          }
    }
  }
  __syncthreads();
}

DI void phase_gla_combine(const Params& p, int l) {
  const int tid = opaque_tid(), lane = tid & 63, wid = tid >> 6;
  const bfr* proj = (const bfr*)(p.ws + OFF_PROJ);
  const bfr* OB = (const bfr*)(p.ws + OFF_H);
  bfr* U = (bfr*)(p.ws + OFF_U);
  const float* gn = p.od_gnorm + (l >> 1) * 256 + (lane & 15) * 16;
  for (int row = blockIdx.x * 4 + wid; row < MR; row += gridDim.x * 4) {
    bfr* up = U + (size_t)row * 2048 + 1024 + lane * 16;
    const u32x4 a0 = *(const u32x4*)up, a1 = *(const u32x4*)(up + 8);
    const u32x4 b0 = *(const u32x4*)(OB + (size_t)row * 1024 + lane * 16), b1 = *(const u32x4*)(OB + (size_t)row * 1024 + lane * 16 + 8);
    const u32x4 g0 = *(const u32x4*)(proj + (size_t)row * NOD + 6144 + lane * 16), g1 = *(const u32x4*)(proj + (size_t)row * NOD + 6144 + lane * 16 + 8);
    float o[16], dg[16];
    const unsigned av[8] = {a0.x, a0.y, a0.z, a0.w, a1.x, a1.y, a1.z, a1.w};
    const unsigned bv[8] = {b0.x, b0.y, b0.z, b0.w, b1.x, b1.y, b1.z, b1.w};
    const unsigned gv[8] = {g0.x, g0.y, g0.z, g0.w, g1.x, g1.y, g1.z, g1.w};
    float ss = 0.f;
#pragma unroll
    for (int i = 0; i < 8; ++i) {
      o[2 * i] = lo_bf(av[i]) + lo_bf(bv[i]);
      o[2 * i + 1] = hi_bf(av[i]) + hi_bf(bv[i]);
      dg[2 * i] = lo_bf(gv[i]);
      dg[2 * i + 1] = hi_bf(gv[i]);
      ss += o[2 * i] * o[2 * i] + o[2 * i + 1] * o[2 * i + 1];
    }
    ss += __shfl_xor(ss, 1); ss += __shfl_xor(ss, 2); ss += __shfl_xor(ss, 4); ss += __shfl_xor(ss, 8);
    const float rn = rsqrtf(ss * (1.f / 256.f) + 1e-6f);
    unsigned ov[8];
#pragma unroll
    for (int i = 0; i < 8; ++i)
      ov[i] = pack2(o[2 * i] * rn * gn[2 * i] * silu(dg[2 * i]), o[2 * i + 1] * rn * gn[2 * i + 1] * silu(dg[2 * i + 1]));
    *(u32x4*)up = (u32x4){ov[0], ov[1], ov[2], ov[3]};
    *(u32x4*)(up + 8) = (u32x4){ov[4], ov[5], ov[6], ov[7]};
  }
}

DI int next_item(int* ctr, int* slot) {
  __syncthreads();
  if (threadIdx.x == 0) *slot = atomicAdd(ctr, 1);
  __syncthreads();
  return *slot;
}

DI void phase_mix_even(const Params& p, int l, int g, char* smem) {
  int* ctr = (int*)(p.ws + OFF_CTR) + (g * 4 + l);
  int* slot = (int*)(smem + SMEM_BYTES - 16);
  const int N_LAT = GB * 8 * 32, N_CTX = GB * 8 * 2, N_CONV = MR / 16;
  const int total = N_LAT + N_CTX + N_CONV;
  for (;;) {
    int it = next_item(ctr, slot);
    if (it >= total) break;
    if (it < N_LAT) {
      const int x = it & 7, li = it >> 3;
      const int qb = li & 31, b = li >> 5;
      diff_attn_item(p, l, b, x, b * 4096 + qb * 128, false, smem);
    } else if (it < N_LAT + N_CTX) {
      it -= N_LAT;
      const int qb = it & 1, head = (it >> 1) & 7, b = it >> 4;
      diff_attn_item(p, l, b, head, ML + b * 256 + qb * 128, true, smem);
    } else {
      conv_item(p, l, it - N_LAT - N_CTX);
    }
  }
}

DI void phase_mix_odd(const Params& p, int l, int g, char* smem) {
  int* ctr = (int*)(p.ws + OFF_CTR) + (g * 4 + l);
  int* slot = (int*)(smem + SMEM_BYTES - 16);
  const int N_GLA = GB * 4 * 2 * 8, N_NA = GB * 16 * 64, N_CTX = (l == 3) ? 0 : GB * 16 * 4;
  const int total = N_GLA + N_NA + N_CTX;
  for (;;) {
    int it = next_item(ctr, slot);
    if (it >= total) break;
    if (it < N_GLA) {
      gla_item(p, l, it, smem);
    } else if (it < N_GLA + N_NA) {
      it -= N_GLA;
      const int rho = it & 63, bh = it >> 6;
      na_item(p, l, bh >> 4, bh & 15, rho, false, 0, smem);
    } else {
      it -= N_GLA + N_NA;
      const int qb = it & 3, bh = it >> 2;
      na_item(p, l, bh >> 4, bh & 15, 0, true, qb * 64, smem);
    }
  }
}


#ifdef DEBUG_CHECK
DI void dbg_flag(const Params& p, int k, float fast, float slow) {
  const float d = fabsf(fast - slow) / (fabsf(slow) + 0.1f);
  if (!(d < 0.1f)) atomicOr((int*)(p.ws + OFF_CTR) + 16, 1 << k);
}
DI int vt_perm(int k) { return (k & ~31) + ((k >> 2) & 3) * 8 + ((k >> 4) & 1) * 4 + (k & 3); }
DI void dbg_check_diff(const Params& p) {
  const int lane = threadIdx.x & 63, wid = threadIdx.x >> 6;
  const bfr* proj = (const bfr*)(p.ws + OFF_PROJ);
  const bfr* VT = (const bfr*)(p.ws + OFF_VT);
  const bfr* U = (const bfr*)(p.ws + OFF_U);
  const float* lamv = (const float*)(p.ws + OFF_LAM);
  const float lam = lamv[0], lam_init = lamv[2];
  for (int smp = blockIdx.x * 4 + wid; smp < 96; smp += gridDim.x * 4) {
    const int b = smp & 3, head = (smp >> 2) & 7;
    const bool cq = (smp >= 64);
    const int tq = cq ? ((smp * 37) & 255) : ((smp * 1237 + 11) & 4095);
    const int row = cq ? (ML + b * 256 + tq) : (b * 4096 + tq);
    float o0a = 0.f, o0b = 0.f, o1a = 0.f, o1b = 0.f, l0 = 0.f, l1 = 0.f;
    const int k0 = cq ? 4096 : 0;
    for (int k = k0; k < KEYS; ++k) {
      const int krow = (k < 4096) ? (b * 4096 + k) : (ML + b * 256 + (k - 4096));
      float s0 = 0.f, s1 = 0.f;
      for (int d = 0; d < 64; ++d) {
        s0 += bf2f(proj[(size_t)row * NEV + 2048 + head * 128 + d]) * bf2f(proj[(size_t)krow * NEV + head * 128 + d]);
        s1 += bf2f(proj[(size_t)row * NEV + 2048 + head * 128 + 64 + d]) * bf2f(proj[(size_t)krow * NEV + head * 128 + 64 + d]);
      }
      const float p0 = __expf(s0 * 0.125f), p1 = __expf(s1 * 0.125f);
      l0 += p0; l1 += p1;
      const float va = bf2f(VT[(size_t)(b * 1024 + head * 128 + lane) * KEYS + vt_perm(k)]);
      const float vb = bf2f(VT[(size_t)(b * 1024 + head * 128 + 64 + lane) * KEYS + vt_perm(k)]);
      o0a += p0 * va; o0b += p0 * vb; o1a += p1 * va; o1b += p1 * vb;
    }
    const float oa = o0a / l0 - lam * o1a / l1, ob = o0b / l0 - lam * o1b / l1;
    const float ss = wave_sum(oa * oa + ob * ob);
    const float rn = rsqrtf(ss / 128.f + 1e-6f) * (1.f - lam_init);
    const float ra = oa * rn * p.ev_subln[lane] * silu(bf2f(proj[(size_t)row * NEV + 3072 + head * 128 + lane]));
    const float rb = ob * rn * p.ev_subln[64 + lane] * silu(bf2f(proj[(size_t)row * NEV + 3072 + head * 128 + 64 + lane]));
    dbg_flag(p, 0, bf2f(U[(size_t)row * 2048 + head * 128 + lane]), ra);
    dbg_flag(p, 0, bf2f(U[(size_t)row * 2048 + head * 128 + 64 + lane]), rb);
  }
}
DI void dbg_check_gemm(const Params& p) {
  const int lane = threadIdx.x & 63, wid = threadIdx.x >> 6;
  const bfr* proj = (const bfr*)(p.ws + OFF_PROJ);
  const bfr* H = (const bfr*)(p.ws + OFF_H);
  const bfr* WT = (const bfr*)(p.ws + win_off(0));
  const float2* cs = (const float2*)(p.ws + OFF_CS);
  for (int smp = blockIdx.x * 4 + wid; smp < 256; smp += gridDim.x * 4) {
    const int m = (smp * 7919 + 13) % MR;
    int n = (smp * 104729 + 7) % NEV;
    if (n >= 1024 && n < 2048) n += 1024;
    float a = 0.f, a2 = 0.f;
    const int d = n & 63;
    const bool ropecol = (n < 1024 || (n >= 2048 && n < 3072)) && (m < ML);
    const int npair = ((d & 31) < 16) ? n + 16 : n - 16;
    for (int k = lane; k < 1024; k += 64) {
      a += bf2f(H[(size_t)m * 1024 + k]) * bf2f(WT[(size_t)n * 1024 + k]);
      a2 += bf2f(H[(size_t)m * 1024 + k]) * bf2f(WT[(size_t)npair * 1024 + k]);
    }
    a = wave_sum(a); a2 = wave_sum(a2);
    float ref = a;
    if (ropecol) {
      const int t = m & 4095;
      const int pos = (d < 32) ? (t >> 6) : (t & 63);
      const float2 c = cs[pos * 16 + (d & 15)];
      ref = ((d & 31) < 16) ? (a * c.x - a2 * c.y) : (a * c.x + a2 * c.y);
    }
    if (lane == 0) dbg_flag(p, 1, bf2f(proj[(size_t)m * NEV + n]), ref);
  }
}
DI void dbg_check_gla(const Params& p) {
  const int lane = threadIdx.x & 63, wid = threadIdx.x >> 6;
  const bfr* proj = (const bfr*)(p.ws + OFF_PROJ);
  for (int smp = blockIdx.x * 4 + wid; smp < 64; smp += gridDim.x * 4) {
    const int b = smp & 3, head = (smp >> 2) & 3, dir = (smp >> 4) & 1, e = (smp * 53 + 17) & 255;
    const bfr* dst = dir ? (const bfr*)(p.ws + OFF_H) : ((const bfr*)(p.ws + OFF_U) + 1024);
    const int dld = dir ? 1024 : 2048;
    float gu0[16], gu1[16];
    for (int k = 0; k < 16; ++k) {
      gu0[k] = p.od_gate_up[((size_t)dir * 16 + k) * 512 + head * 128 + lane];
      gu1[k] = p.od_gate_up[((size_t)dir * 16 + k) * 512 + head * 128 + 64 + lane];
    }
    const float gb0 = p.od_gate_bias[dir * 512 + head * 128 + lane], gb1 = p.od_gate_bias[dir * 512 + head * 128 + 64 + lane];
    float s0 = 0.f, s1 = 0.f;
    for (int step = 0; step < 4352; ++step) {
      int row;
      if (step < 256) row = ML + b * 256 + (dir ? (255 - step) : step);
      else row = b * 4096 + (dir ? (4095 - (step - 256)) : (step - 256));
      const bfr* pr = proj + (size_t)row * NOD;
      float z0 = gb0, z1 = gb1;
      for (int k = 0; k < 16; ++k) { const float lv = bf2f(pr[7168 + dir * 16 + k]); z0 += lv * gu0[k]; z1 += lv * gu1[k]; }
      const float g0 = (fminf(z0, 0.f) - log1pf(__expf(-fabsf(z0)))) / 16.f;
      const float g1 = (fminf(z1, 0.f) - log1pf(__expf(-fabsf(z1)))) / 16.f;
      const float v = bf2f(pr[2560 + head * 256 + e]);
      s0 = __expf(g0) * s0 + bf2f(pr[2048 + head * 128 + lane]) * v;
      s1 = __expf(g1) * s1 + bf2f(pr[2048 + head * 128 + 64 + lane]) * v;
      float o = bf2f(pr[4608 + head * 128 + lane]) * s0 + bf2f(pr[4608 + head * 128 + 64 + lane]) * s1;
      o = wave_sum(o) * 0.08838834764831845f;
      if (lane == 0 && (step % 29) == 0) dbg_flag(p, 2, bf2f(dst[(size_t)row * dld + head * 256 + e]), o);
    }
  }
}
DI void dbg_check_na(const Params& p) {
  const int lane = threadIdx.x & 63, wid = threadIdx.x >> 6;
  const bfr* proj = (const bfr*)(p.ws + OFF_PROJ);
  const bfr* VT = (const bfr*)(p.ws + OFF_VT);
  const bfr* U = (const bfr*)(p.ws + OFF_U);
  for (int smp = blockIdx.x * 4 + wid; smp < 192; smp += gridDim.x * 4) {
    const int b = smp & 3, head = (smp >> 2) & 15;
    const int t = (smp * 2741 + 5) & 4095;
    const int rho = t >> 6, qc = t & 63;
    const int row = b * 4096 + t;
    int rs = rho - 4; rs = rs < 0 ? 0 : (rs > 56 ? 56 : rs);
    int wst = qc - 8; wst = wst < 0 ? 0 : (wst > 48 ? 48 : wst);
    const float* rp = p.od_rpb + (size_t)head * 465;
    float o = 0.f, L = 0.f;
    for (int kk = 0; kk < 128 + 256; ++kk) {
      int krow, kpos; float bias = 0.f;
      if (kk < 128) {
        const int i = kk >> 4, kc = wst + (kk & 15);
        krow = b * 4096 + (rs + i) * 64 + kc; kpos = (rs + i) * 64 + kc;
        bias = rp[(rs + i - rho + 7) * 31 + (kc - qc + 15)];
      } else { krow = ML + b * 256 + (kk - 128); kpos = 4096 + (kk - 128); }
      float sdot = 0.f;
      for (int d = 0; d < 64; ++d) sdot += bf2f(proj[(size_t)row * NOD + 3584 + head * 64 + d]) * bf2f(proj[(size_t)krow * NOD + head * 64 + d]);
      const float pw = __expf(sdot * 0.125f + bias);
      L += pw;
      o += pw * bf2f(VT[(size_t)(b * 1024 + head * 64 + lane) * KEYS + vt_perm(kpos)]);
    }
    const float ref = o / L * silu(bf2f(proj[(size_t)row * NOD + 5120 + head * 64 + lane]));
    dbg_flag(p, 3, bf2f(U[(size_t)row * 2048 + head * 64 + lane]), ref);
  }
}
DI void dbg_check_conv(const Params& p) {
  const bfr* proj = (const bfr*)(p.ws + OFF_PROJ);
  const bfr* U = (const bfr*)(p.ws + OFF_U);
  for (int smp = blockIdx.x * 256 + threadIdx.x; smp < 4096; smp += gridDim.x * 256) {
    const int m = (smp * 7919 + 3) % MR, ch = (smp * 613 + 1) & 1023;
    int t, T;
    if (m < ML) { t = m & 4095; T = 4096; } else { t = (m - ML) & 255; T = 256; }
    float cv = 0.f;
    for (int w = 0; w < 3; ++w) {
      const int tt = t + w - 1;
      if (tt >= 0 && tt < T) {
        const bfr* pr = proj + (size_t)(m + w - 1) * NEV;
        cv += p.ev_conv[w * 1024 + ch] * bf2f(pr[6144 + ch]) * bf2f(pr[4096 + ch]);
      }
    }
    const bfr* pr = proj + (size_t)m * NEV;
    const float ref = bf2f(pr[5120 + ch]) * cv * silu(bf2f(pr[7168 + ch]));
    dbg_flag(p, 4, bf2f(U[(size_t)m * 2048 + 1024 + ch]), ref);
  }
}
DI void dbg_check_gemm_out(const Params& p) {
  const int lane = threadIdx.x & 63, wid = threadIdx.x >> 6;
  const bfr* U = (const bfr*)(p.ws + OFF_U);
  const bfr* WT = (const bfr*)(p.ws + OFF_WOUT);
  const float* ybuf = (const float*)(p.ws + OFF_PROJ);
  for (int smp = blockIdx.x * 4 + wid; smp < 256; smp += gridDim.x * 4) {
    const int m = (smp * 7919 + 13) % MR, n = (smp * 104729 + 7) & 1023;
    float a = 0.f;
    for (int k = lane; k < 2048; k += 64) a += bf2f(U[(size_t)m * 2048 + k]) * bf2f(WT[(size_t)n * 2048 + k]);
    a = wave_sum(a);
    if (lane == 0) dbg_flag(p, 5, ybuf[(size_t)m * 1024 + n], a);
  }
}
#endif

__global__ void __launch_bounds__(256) mega_kernel(Params p) {
  extern __shared__ __attribute__((aligned(16))) char smem[];
  cg::grid_group grid = cg::this_grid();
  phase0(p, smem);
  grid.sync();
#ifdef DEBUG_CHECK
  {
    phase_norm(p, 0, 0); grid.sync();
    phase_gemm_in(p, 0, smem); grid.sync();
    dbg_check_gemm(p);
    phase_mix_even(p, 0, 0, smem); grid.sync();
    dbg_check_diff(p); dbg_check_conv(p);
    grid.sync();
    phase_gemm_out(p, 0, smem); grid.sync();
    dbg_check_gemm_out(p);
    grid.sync();
    phase_norm(p, 1, 0); grid.sync();
    phase_gemm_in(p, 1, smem); grid.sync();
    phase_mix_odd(p, 1, 0, smem); grid.sync();
    dbg_check_gla(p); dbg_check_na(p);
    grid.sync();
    const int mask = ((int*)(p.ws + OFF_CTR))[16];
    for (size_t i = (size_t)blockIdx.x * 256 + threadIdx.x; i < (size_t)8 * 4096 * 1024; i += (size_t)gridDim.x * 256)
      p.out[i] = p.x[i] + ((i == 0) ? (100.f + 10.f * (float)mask) : 0.f);
    return;
  }
#endif
  for (int g = 0; g < NGRP; ++g) {
    for (int l = 0; l < 4; ++l) {
      phase_norm(p, l, g);
      grid.sync();
      phase_gemm_in(p, l, smem);
      grid.sync();
      if (l & 1) {
        phase_mix_odd(p, l, g, smem);
        grid.sync();
        phase_gla_combine(p, l);
      } else {
        phase_mix_even(p, l, g, smem);
      }
      grid.sync();
      phase_gemm_out(p, l, smem);
      grid.sync();
    }
    phase_norm(p, 4, g);
    grid.sync();
  }
}

extern "C" void kernel_launch(void* const* d_in, const int* in_sizes, int n_in, void* d_out, int out_size, void* d_ws,
                              size_t ws_size, hipStream_t stream) {
  static int grid_blocks = 0;
  if (!grid_blocks) {
    int dev = 0, cus = 0, per_cu = 0;
    hipGetDevice(&dev);
    hipDeviceGetAttribute(&cus, hipDeviceAttributeMultiprocessorCount, dev);
    hipFuncSetAttribute((const void*)mega_kernel, hipFuncAttributeMaxDynamicSharedMemorySize, SMEM_BYTES);
    hipOccupancyMaxActiveBlocksPerMultiprocessor(&per_cu, mega_kernel, 256, SMEM_BYTES);
    if (per_cu > 2) per_cu = 2;
    if (per_cu < 1) per_cu = 1;
    grid_blocks = cus * per_cu;
    grid_blocks &= ~7;
  }
  if (ws_size < WS_NEED) { fprintf(stderr, "workspace too small: %zu < %zu\n", ws_size, (size_t)WS_NEED); return; }
  Params p{};
  p.x = (const float*)d_in[0]; p.c = (const float*)d_in[1]; p.ctx = (const float*)d_in[2]; p.c_ctx = (const float*)d_in[3];
  p.w_mod = (const float*)d_in[4]; p.b_mod = (const float*)d_in[5]; p.g_pre = (const float*)d_in[6]; p.g_post = (const float*)d_in[7];
  p.w_out = (const float*)d_in[8]; p.ev_w_in = (const float*)d_in[9]; p.ev_lambda = (const float*)d_in[10]; p.ev_subln = (const float*)d_in[11];
  p.ev_conv = (const float*)d_in[12]; p.od_w_in = (const float*)d_in[13]; p.od_rpb = (const float*)d_in[14]; p.od_gate_up = (const float*)d_in[15];
  p.od_gate_bias = (const float*)d_in[16]; p.od_gnorm = (const float*)d_in[17];
  p.out = (float*)d_out;
  p.ws = (char*)d_ws;
  void* args[] = {&p};
  hipError_t e = hipLaunchCooperativeKernel((const void*)mega_kernel, dim3(grid_blocks), dim3(256), args, SMEM_BYTES, stream);
  if (e != hipSuccess) fprintf(stderr, "cooperative launch failed: %s (grid %d)\n", hipGetErrorString(e), grid_blocks);
}
```

```cpp
#include <hip/hip_runtime.h>
#include <hip/hip_cooperative_groups.h>
#include <cstdio>
namespace cg = cooperative_groups;

typedef unsigned short bfr;
typedef __attribute__((ext_vector_type(8))) short bf16x8;
typedef __attribute__((ext_vector_type(4))) float f32x4;
typedef __attribute__((ext_vector_type(4))) unsigned u32x4;
typedef __attribute__((ext_vector_type(2))) unsigned u32x2;
typedef __attribute__((ext_vector_type(16))) unsigned u32x16;
typedef __attribute__((ext_vector_type(2))) __bf16 bf16x2_t;
#define DI __device__ __forceinline__
DI float dot2bf(unsigned a, unsigned b, float c) { return __builtin_amdgcn_fdot2_f32_bf16(__builtin_bit_cast(bf16x2_t, a), __builtin_bit_cast(bf16x2_t, b), c, false); }
DI int opaque_tid() { int t = threadIdx.x; asm volatile("" : "+v"(t)); return t; }

constexpr int GB   = 4;
constexpr int NGRP = 2;
constexpr int ML   = GB * 4096;
constexpr int MC   = GB * 256;
constexpr int MR   = ML + MC;
constexpr int NEV  = 8192;
constexpr int NOD  = 7296;
constexpr int KEYS = 4352;
constexpr float L2E = 1.4426950408889634f;
constexpr float LN2 = 0.6931471805599453f;

constexpr size_t SZ_PROJ = (size_t)MR * 8192 * 2;
constexpr size_t SZ_H    = (size_t)MR * 1024 * 2;
constexpr size_t SZ_U    = (size_t)MR * 2048 * 2;
constexpr size_t SZ_VT   = (size_t)GB * 1024 * KEYS * 2;
constexpr size_t SZ_WE   = (size_t)NEV * 1024 * 2;
constexpr size_t SZ_WO   = (size_t)NOD * 1024 * 2;
constexpr size_t SZ_WOUT = (size_t)1024 * 2048 * 2;
constexpr size_t OFF_PROJ = 0;
constexpr size_t OFF_H    = OFF_PROJ + SZ_PROJ;
constexpr size_t OFF_U    = OFF_H + SZ_H;
constexpr size_t OFF_VT   = OFF_U + SZ_U;
constexpr size_t OFF_WIN  = OFF_VT + SZ_VT;
constexpr size_t OFF_WOUT = OFF_WIN + 2 * SZ_WE + 2 * SZ_WO;
constexpr size_t OFF_XC   = OFF_WOUT + 4 * SZ_WOUT;
constexpr size_t OFF_MOD  = OFF_XC + (size_t)8 * 256 * 1024 * 4;
constexpr size_t OFF_CS   = OFF_MOD + (size_t)4 * 9 * 3072 * 4;
constexpr size_t OFF_LAM  = OFF_CS + 64 * 16 * 8;
constexpr size_t OFF_CTR  = OFF_LAM + 256;
constexpr size_t WS_NEED  = OFF_CTR + 256;

constexpr int SMEM_BYTES = 80896;

struct Params {
  const float *x, *c, *ctx, *c_ctx, *w_mod, *b_mod, *g_pre, *g_post, *w_out, *ev_w_in, *ev_lambda, *ev_subln,
      *ev_conv, *od_w_in, *od_rpb, *od_gate_up, *od_gate_bias, *od_gnorm;
  float* out;
  char* ws;
};

DI size_t win_off(int l) { return OFF_WIN + (size_t)(l >> 1) * (SZ_WE + SZ_WO) + ((l & 1) ? SZ_WE : 0); }

DI float bf2f(bfr v) { return __uint_as_float(((unsigned)v) << 16); }
DI bfr f2bf(float x) { unsigned u = __float_as_uint(x); u += 0x7fffu + ((u >> 16) & 1u); return (bfr)(u >> 16); }
DI unsigned pack2(float a, float b) { return (unsigned)f2bf(a) | (((unsigned)f2bf(b)) << 16); }
DI float lo_bf(unsigned u) { return __uint_as_float(u << 16); }
DI float hi_bf(unsigned u) { return __uint_as_float(u & 0xffff0000u); }
DI float fexp2(float x) { return __builtin_amdgcn_exp2f(x); }
DI float flog2(float x) { return __builtin_amdgcn_logf(x); }
DI float silu(float x) { return x / (1.f + fexp2(-x * L2E)); }
template <int M>
DI float shx(float v, int lane) {
  if (M < 32) return __builtin_bit_cast(float, __builtin_amdgcn_ds_swizzle(__builtin_bit_cast(int, v), (M << 10) | 0x1f));
  return __builtin_bit_cast(float, __builtin_amdgcn_ds_bpermute((lane ^ 32) << 2, __builtin_bit_cast(int, v)));
}
DI float wave_sum(float v, int lane) {
  v += shx<1>(v, lane); v += shx<2>(v, lane); v += shx<4>(v, lane); v += shx<8>(v, lane); v += shx<16>(v, lane); v += shx<32>(v, lane);
  return v;
}
DI f32x4 mfma16(bf16x8 a, bf16x8 b, f32x4 c) { return __builtin_amdgcn_mfma_f32_16x16x32_bf16(a, b, c, 0, 0, 0); }
DI int sw128(int row, int chunk) { return row * 128 + ((chunk ^ ((row >> 1) & 7)) << 4); }
DI int sw256(int row, int chunk) { return row * 256 + ((chunk ^ (row & 15)) << 4); }

DI void gemm_mainloop(const bfr* __restrict__ X, int ldx, const bfr* __restrict__ Y, int ldy, int K, char* smem,
                      f32x4 (&acc)[4][4]) {
  const int tid = opaque_tid(), lane = tid & 63, wid = tid >> 6, r = lane & 15, q = lane >> 4;
  const int wx = wid >> 1, wy = wid & 1;
  const int lr = tid >> 3, lc = tid & 7;
  const bfr* xp = X + (size_t)lr * ldx + lc * 8;
  const bfr* yp = Y + (size_t)lr * ldy + lc * 8;
  u32x4 xr[4], yr[4];
#pragma unroll
  for (int i = 0; i < 4; ++i) {
    xr[i] = *(const u32x4*)(xp + (size_t)(32 * i) * ldx);
    yr[i] = *(const u32x4*)(yp + (size_t)(32 * i) * ldy);
  }
  const int nk = K >> 6;
  for (int kt = 0; kt < nk; ++kt) {
    char* sX = smem + (kt & 1) * 32768;
    char* sY = sX + 16384;
#pragma unroll
    for (int i = 0; i < 4; ++i) {
      const int row = lr + 32 * i;
      *(u32x4*)(sX + sw128(row, lc)) = xr[i];
      *(u32x4*)(sY + sw128(row, lc)) = yr[i];
    }
    __syncthreads();
    if (kt + 1 < nk) {
      const int ko = (kt + 1) * 64;
#pragma unroll
      for (int i = 0; i < 4; ++i) {
        xr[i] = *(const u32x4*)(xp + (size_t)(32 * i) * ldx + ko);
        yr[i] = *(const u32x4*)(yp + (size_t)(32 * i) * ldy + ko);
      }
    }
#pragma unroll
    for (int s = 0; s < 2; ++s) {
      bf16x8 xa[4], yb[4];
#pragma unroll
      for (int i = 0; i < 4; ++i) xa[i] = *(const bf16x8*)(sX + sw128(wx * 64 + i * 16 + r, s * 4 + q));
#pragma unroll
      for (int j = 0; j < 4; ++j) yb[j] = *(const bf16x8*)(sY + sw128(wy * 64 + j * 16 + r, s * 4 + q));
#pragma unroll
      for (int i = 0; i < 4; ++i)
#pragma unroll
        for (int j = 0; j < 4; ++j) acc[i][j] = mfma16(xa[i], yb[j], acc[i][j]);
    }
  }
  __syncthreads();
}

DI bool tile_map(int T, int MT, int NT, int& mt, int& nt) {
  const int pm_n = MT >> 3;
  const int P = (T >> 9) * 8 + (T & 7);
  const int li = (T & 511) >> 3;
  const int pm = P % pm_n, pn = P / pm_n;
  mt = pm * 8 + (li & 7);
  nt = pn * 8 + (li >> 3);
  return nt < NT;
}

DI int odd_col_src(int n) {
  if (n < 3584) return n;
  if (n < 7168) return n + 32;
  if (n < 7200) return n - 7168 + 3584;
  return -1;
}

DI void phase0(const Params& p, char* smem) {
  const int tid = opaque_tid();
  if (blockIdx.x < 384) {
    float* sc = (float*)smem;
    float* red = sc + 9 * 1024;
    for (int i = tid; i < 9 * 1024; i += 256) {
      const int b = i >> 10, k = i & 1023;
      const float v = (b < 8) ? p.c[b * 1024 + k] : p.c_ctx[k];
      sc[i] = v / (1.f + __expf(-v));
    }
    __syncthreads();
    float* modb = (float*)(p.ws + OFF_MOD);
    for (int it = blockIdx.x; it < 384; it += gridDim.x) {
      const int l = it / 96, cgp = it % 96;
      const int col = cgp * 32 + (tid & 31), ks = tid >> 5;
      float a[9];
#pragma unroll
      for (int b = 0; b < 9; ++b) a[b] = 0.f;
      const float* w = p.w_mod + ((size_t)l * 1024 + ks * 128) * 3072 + col;
#pragma unroll 4
      for (int k = 0; k < 128; ++k) {
        const float wv = w[(size_t)k * 3072];
#pragma unroll
        for (int b = 0; b < 9; ++b) a[b] += sc[b * 1024 + ks * 128 + k] * wv;
      }
#pragma unroll
      for (int b = 0; b < 9; ++b) red[(ks * 9 + b) * 32 + (tid & 31)] = a[b];
      __syncthreads();
      for (int idx = tid; idx < 288; idx += 256) {
        const int b = idx >> 5, cc = idx & 31;
        float s = p.b_mod[l * 3072 + cgp * 32 + cc];
#pragma unroll
        for (int k2 = 0; k2 < 8; ++k2) s += red[(k2 * 9 + b) * 32 + cc];
        modb[(size_t)(l * 9 + b) * 3072 + cgp * 32 + cc] = s;
      }
      __syncthreads();
    }
  }
  if (blockIdx.x == gridDim.x - 1) {
    float2* cs = (float2*)(p.ws + OFF_CS);
    for (int idx = tid; idx < 1024; idx += 256) {
      const int pos = idx >> 4, f = idx & 15;
      const float inv = 1.0f / powf(10000.f, (float)f * 0.0625f);
      const float ang = (float)pos * inv;
      const double ad = (double)ang;
      const double n = rint(ad * 0.15915494309189535);
      const float rr = (float)(ad - n * 6.283185307179586);
      cs[idx] = make_float2(__cosf(rr), __sinf(rr));
    }
    if (tid < 2) {
      const float* lp = p.ev_lambda + tid * 256;
      float s1 = 0.f, s2 = 0.f;
      for (int i = 0; i < 64; ++i) { s1 += lp[i] * lp[64 + i]; s2 += lp[128 + i] * lp[192 + i]; }
      const float li = (tid == 0) ? 0.2f : (0.8f - 0.6f * 0.5488116360940264f);
      float* lam = (float*)(p.ws + OFF_LAM);
      lam[tid] = __expf(s1) - __expf(s2) + li;
      lam[2 + tid] = li;
    }
    if (tid < 32) ((int*)(p.ws + OFF_CTR))[tid] = 0;
  }
  float* tile = (float*)smem;
  __syncthreads();
  for (int it = blockIdx.x; it < 9792; it += gridDim.x) {
    int rr = it, l, ktile, ntile, K, Nsrc;
    const float* src;
    bfr* dst;
    bool oddmap = false;
    if (rr < 7744) {
      if (rr < 2048) { l = 0; } else if (rr < 3872) { l = 1; rr -= 2048; } else if (rr < 5920) { l = 2; rr -= 3872; } else { l = 3; rr -= 5920; }
      ktile = rr & 15; ntile = rr >> 4; K = 1024;
      oddmap = (l & 1);
      Nsrc = oddmap ? 7200 : 8192;
      src = (oddmap ? p.od_w_in : p.ev_w_in) + (size_t)(l >> 1) * 1024 * Nsrc;
      dst = (bfr*)(p.ws + win_off(l));
    } else {
      rr -= 7744; l = rr >> 9; rr &= 511;
      ktile = rr & 31; ntile = rr >> 5; K = 2048; Nsrc = 1024;
      src = p.w_out + (size_t)l * 2048 * 1024;
      dst = (bfr*)(p.ws + OFF_WOUT + (size_t)l * SZ_WOUT);
    }
    const int k0 = ktile * 64, n0 = ntile * 64;
    {
      const int nn = tid & 63;
      const int nd = n0 + nn;
      const int ns = oddmap ? odd_col_src(nd) : nd;
#pragma unroll 4
      for (int i = 0; i < 16; ++i) {
        const int kk = (tid >> 6) + 4 * i;
        tile[kk * 65 + nn] = (ns >= 0) ? src[(size_t)(k0 + kk) * Nsrc + ns] : 0.f;
      }
    }
    __syncthreads();
    {
      const int kk8 = (tid & 7) * 8;
#pragma unroll
      for (int i2 = 0; i2 < 2; ++i2) {
        const int nn = (tid >> 3) + 32 * i2;
        u32x4 v;
        v.x = pack2(tile[(kk8 + 0) * 65 + nn], tile[(kk8 + 1) * 65 + nn]);
        v.y = pack2(tile[(kk8 + 2) * 65 + nn], tile[(kk8 + 3) * 65 + nn]);
        v.z = pack2(tile[(kk8 + 4) * 65 + nn], tile[(kk8 + 5) * 65 + nn]);
        v.w = pack2(tile[(kk8 + 6) * 65 + nn], tile[(kk8 + 7) * 65 + nn]);
        *(u32x4*)(dst + (size_t)(n0 + nn) * K + k0 + kk8) = v;
      }
    }
    __syncthreads();
  }
}

DI void phase_norm(const Params& p, int l, int g) {
  const int tid = opaque_tid(), lane = tid & 63, wid = tid >> 6;
  const int rows = (l == 4) ? ML : MR;
  const float* modb = (const float*)(p.ws + OFF_MOD);
  const float* ybuf = (const float*)(p.ws + OFF_PROJ);
  bfr* hbuf = (bfr*)(p.ws + OFF_H);
  float* xcb = (float*)(p.ws + OFF_XC);
  for (int row = blockIdx.x * 4 + wid; row < rows; row += gridDim.x * 4) {
    const bool lat = row < ML;
    const int mb = lat ? (g * GB + (row >> 12)) : 8;
    const size_t grow = lat ? ((size_t)g * ML + row) : ((size_t)g * MC + (row - ML));
    const float* xin;
    float* xst;
    if (lat) { xin = ((l <= 1) ? p.x : (const float*)p.out) + grow * 1024; xst = p.out + grow * 1024; }
    else     { xin = ((l <= 1) ? p.ctx : (const float*)xcb) + grow * 1024; xst = xcb + grow * 1024; }
    float4 xv[4];
#pragma unroll
    for (int i = 0; i < 4; ++i) xv[i] = *(const float4*)(xin + lane * 4 + 256 * i);
    if (l >= 1) {
      float4 yv[4];
      float ss = 0.f;
#pragma unroll
      for (int i = 0; i < 4; ++i) {
        yv[i] = *(const float4*)(ybuf + (size_t)row * 1024 + lane * 4 + 256 * i);
        ss += yv[i].x * yv[i].x + yv[i].y * yv[i].y + yv[i].z * yv[i].z + yv[i].w * yv[i].w;
      }
      ss = wave_sum(ss, lane);
      const float rn = rsqrtf(ss * (1.f / 1024.f) + 1e-6f);
      const float* gate = modb + (size_t)((l - 1) * 9 + mb) * 3072 + 2048;
      const float* gp = p.g_post + (l - 1) * 1024;
#pragma unroll
      for (int i = 0; i < 4; ++i) {
        const int c0 = lane * 4 + 256 * i;
        const float4 gt = *(const float4*)(gate + c0);
        const float4 gg = *(const float4*)(gp + c0);
        xv[i].x += gt.x * (yv[i].x * rn * gg.x);
        xv[i].y += gt.y * (yv[i].y * rn * gg.y);
        xv[i].z += gt.z * (yv[i].z * rn * gg.z);
        xv[i].w += gt.w * (yv[i].w * rn * gg.w);
        *(float4*)(xst + c0) = xv[i];
      }
    }
    if (l < 4) {
      float ss = 0.f;
#pragma unroll
      for (int i = 0; i < 4; ++i) ss += xv[i].x * xv[i].x + xv[i].y * xv[i].y + xv[i].z * xv[i].z + xv[i].w * xv[i].w;
      ss = wave_sum(ss, lane);
      const float rn = rsqrtf(ss * (1.f / 1024.f) + 1e-6f);
      const float* mrow = modb + (size_t)(l * 9 + mb) * 3072;
      const float* gpre = p.g_pre + l * 1024;
#pragma unroll
      for (int i = 0; i < 4; ++i) {
        const int c0 = lane * 4 + 256 * i;
        const float4 sh = *(const float4*)(mrow + c0);
        const float4 scl = *(const float4*)(mrow + 1024 + c0);
        const float4 gg = *(const float4*)(gpre + c0);
        u32x2 o;
        o.x = pack2(xv[i].x * rn * gg.x * (1.f + scl.x) + sh.x, xv[i].y * rn * gg.y * (1.f + scl.y) + sh.y);
        o.y = pack2(xv[i].z * rn * gg.z * (1.f + scl.z) + sh.z, xv[i].w * rn * gg.w * (1.f + scl.w) + sh.w);
        *(u32x2*)(hbuf + (size_t)row * 1024 + c0) = o;
      }
    }
  }
}

DI void phase_gemm_in(const Params& p, int l, char* smem) {
  const int tid = opaque_tid(), lane = tid & 63, wid = tid >> 6, r = lane & 15, q = lane >> 4;
  const int wx = wid >> 1, wy = wid & 1;
  const bool even = !(l & 1);
  const int ldp = even ? NEV : NOD;
  const int NT = ldp >> 7, MT = MR >> 7;
  const bfr* WT = (const bfr*)(p.ws + win_off(l));
  const bfr* H = (const bfr*)(p.ws + OFF_H);
  bfr* proj = (bfr*)(p.ws + OFF_PROJ);
  bfr* VT = (bfr*)(p.ws + OFF_VT);
  const float2* cs = (const float2*)(p.ws + OFF_CS);
  const int total = ((((MT >> 3) * ((NT + 7) >> 3)) + 7) >> 3) << 9;
  for (int T = blockIdx.x; T < total; T += gridDim.x) {
    int mt, nt;
    if (!tile_map(T, MT, NT, mt, nt)) continue;
    const int m0 = mt * 128, n0 = nt * 128;
    const bool vt = (n0 >= 1024 && n0 < 2048);
    f32x4 acc[4][4];
#pragma unroll
    for (int i = 0; i < 4; ++i)
#pragma unroll
      for (int j = 0; j < 4; ++j) acc[i][j] = (f32x4){0.f, 0.f, 0.f, 0.f};
    const bfr* X = vt ? (H + (size_t)m0 * 1024) : (WT + (size_t)n0 * 1024);
    const bfr* Y = vt ? (WT + (size_t)n0 * 1024) : (H + (size_t)m0 * 1024);
    gemm_mainloop(X, 1024, Y, 1024, 1024, smem, acc);
    if (vt) {
#pragma unroll
      for (int i = 0; i < 4; ++i) {
        const int mbase = m0 + wx * 64 + i * 16;
        int b, kp;
        if (mbase < ML) { b = mbase >> 12; kp = mbase & 4095; } else { const int mm = mbase - ML; b = mm >> 8; kp = 4096 + (mm & 255); }
        const int pos = (kp & ~31) + q * 8 + ((kp >> 4) & 1) * 4;
#pragma unroll
        for (int jn = 0; jn < 4; ++jn) {
          const int f = n0 - 1024 + wy * 64 + jn * 16 + r;
          u32x2 o;
          o.x = pack2(acc[i][jn][0], acc[i][jn][1]);
          o.y = pack2(acc[i][jn][2], acc[i][jn][3]);
          *(u32x2*)(VT + ((size_t)(b * 1024 + f)) * KEYS + pos) = o;
        }
      }
    } else {
      const bool rope = even && (n0 < 1024 || (n0 >= 2048 && n0 < 3072)) && (m0 < ML);
      if (rope) {
#pragma unroll
        for (int jn = 0; jn < 4; ++jn) {
          const int m = m0 + wy * 64 + jn * 16 + r;
          const int t = m & 4095;
          const int grow = t >> 6, gcol = t & 63;
#pragma unroll
          for (int j = 0; j < 4; ++j) {
            const float2 a = cs[grow * 16 + 4 * q + j];
            const float2 c = cs[gcol * 16 + 4 * q + j];
            const float x0 = acc[0][jn][j], x1 = acc[1][jn][j], x2 = acc[2][jn][j], x3 = acc[3][jn][j];
            acc[0][jn][j] = x0 * a.x - x1 * a.y;
            acc[1][jn][j] = x1 * a.x + x0 * a.y;
            acc[2][jn][j] = x2 * c.x - x3 * c.y;
            acc[3][jn][j] = x3 * c.x + x2 * c.y;
          }
        }
      }
#pragma unroll
      for (int jn = 0; jn < 4; ++jn) {
        const int m = m0 + wy * 64 + jn * 16 + r;
#pragma unroll
        for (int i = 0; i < 4; ++i) {
          const int n = n0 + wx * 64 + i * 16 + 4 * q;
          u32x2 o;
          o.x = pack2(acc[i][jn][0], acc[i][jn][1]);
          o.y = pack2(acc[i][jn][2], acc[i][jn][3]);
          *(u32x2*)(proj + (size_t)m * ldp + n) = o;
        }
      }
    }
  }
}

DI void phase_gemm_out(const Params& p, int l, char* smem) {
  const int tid = opaque_tid(), lane = tid & 63, wid = tid >> 6, r = lane & 15, q = lane >> 4;
  const int wx = wid >> 1, wy = wid & 1;
  const bfr* WT = (const bfr*)(p.ws + OFF_WOUT + (size_t)l * SZ_WOUT);
  const bfr* U = (const bfr*)(p.ws + OFF_U);
  float* ybuf = (float*)(p.ws + OFF_PROJ);
  const int MT = (l == 3) ? (ML >> 7) : (MR >> 7);
  const int total = (((MT >> 3) + 7) >> 3) << 9;
  for (int T = blockIdx.x; T < total; T += gridDim.x) {
    int mt, nt;
    if (!tile_map(T, MT, 8, mt, nt)) continue;
    const int m0 = mt * 128, n0 = nt * 128;
    f32x4 acc[4][4];
#pragma unroll
    for (int i = 0; i < 4; ++i)
#pragma unroll
      for (int j = 0; j < 4; ++j) acc[i][j] = (f32x4){0.f, 0.f, 0.f, 0.f};
    gemm_mainloop(WT + (size_t)n0 * 2048, 2048, U + (size_t)m0 * 2048, 2048, 2048, smem, acc);
#pragma unroll
    for (int jn = 0; jn < 4; ++jn) {
      const int m = m0 + wy * 64 + jn * 16 + r;
#pragma unroll
      for (int i = 0; i < 4; ++i) {
        const int n = n0 + wx * 64 + i * 16 + 4 * q;
        *(f32x4*)(ybuf + (size_t)m * 1024 + n) = acc[i][jn];
      }
    }
  }
}

template <int DV, int QT, int KT, int MODE>
DI void attn_engine(const bfr* __restrict__ qbase, int ldq, const bfr* __restrict__ kbase, int ldk,
                    const bfr* __restrict__ vt, int nloc, int loc_row0, int loc_pos0, int nctx, int ctx_row0,
                    const float* rpb_s, int roff0, char* smem, f32x4 (&O)[DV / 16][QT], float (&lsum)[QT]) {
  constexpr int STAGE = 8192 + DV * 128;
  constexpr int NVL = DV / 32;
  const int tid = opaque_tid(), lane = tid & 63, wid = tid >> 6, r = lane & 15, q = lane >> 4;
  const int lr = tid >> 3, lc = tid & 7;
  constexpr float SC = 0.125f * L2E;

  bf16x8 Qf[QT][2];
#pragma unroll
  for (int qt = 0; qt < QT; ++qt)
#pragma unroll
    for (int s = 0; s < 2; ++s)
      Qf[qt][s] = *(const bf16x8*)(qbase + (size_t)(wid * 16 * QT + qt * 16 + r) * ldq + s * 32 + q * 8);
  float mrun[QT];
#pragma unroll
  for (int qt = 0; qt < QT; ++qt) {
    mrun[qt] = -1e30f;
    lsum[qt] = 0.f;
#pragma unroll
    for (int dt = 0; dt < DV / 16; ++dt) O[dt][qt] = (f32x4){0.f, 0.f, 0.f, 0.f};
  }

  const int nch = nloc + nctx;
  u32x4 kreg0, kreg1, vreg[NVL];
  const int ksw0 = sw128(lr, lc), ksw1 = sw128(lr + 32, lc);
#define AT_LOAD(c_)                                                                                          \
  {                                                                                                          \
    const int cc_ = (c_);                                                                                    \
    const int row_ = (cc_ < nloc) ? (loc_row0 + cc_ * 64) : (ctx_row0 + (cc_ - nloc) * 64);                  \
    const int pos_ = (cc_ < nloc) ? (loc_pos0 + cc_ * 64) : (4096 + (cc_ - nloc) * 64);                      \
    kreg0 = *(const u32x4*)(kbase + (size_t)(row_ + lr) * ldk + lc * 8);                                     \
    kreg1 = *(const u32x4*)(kbase + (size_t)(row_ + lr + 32) * ldk + lc * 8);                                \
    _Pragma("unroll") for (int i_ = 0; i_ < NVL; ++i_)                                                       \
        vreg[i_] = *(const u32x4*)(vt + (size_t)(lr + 32 * i_) * KEYS + pos_ + lc * 8);                      \
  }
#define AT_STORE(c_)                                                                                         \
  {                                                                                                          \
    char* sb_ = smem + ((c_) & 1) * STAGE;                                                                   \
    *(u32x4*)(sb_ + ksw0) = kreg0;                                                                           \
    *(u32x4*)(sb_ + ksw1) = kreg1;                                                                           \
    _Pragma("unroll") for (int i_ = 0; i_ < NVL; ++i_)                                                       \
        *(u32x4*)(sb_ + 8192 + sw128(lr + 32 * i_, lc)) = vreg[i_];                                          \
  }
  if (nch > 0) { AT_LOAD(0); AT_STORE(0); }
  for (int c = 0; c < nch; ++c) {
    __syncthreads();
    const bool more = (c + 1 < nch);
    const char* sK = smem + (c & 1) * STAGE;
    const char* sV = sK + 8192;
    if (more) AT_LOAD(c + 1);
#pragma unroll
    for (int sbk = 0; sbk < 4 / KT; ++sbk) {
      f32x4 st[KT][QT];
#pragma unroll
      for (int kt = 0; kt < KT; ++kt)
#pragma unroll
        for (int qt = 0; qt < QT; ++qt) st[kt][qt] = (f32x4){0.f, 0.f, 0.f, 0.f};
#pragma unroll
      for (int s = 0; s < 2; ++s)
#pragma unroll
        for (int kt = 0; kt < KT; ++kt) {
          const bf16x8 ka = *(const bf16x8*)(sK + sw128(sbk * KT * 16 + kt * 16 + r, s * 4 + q));
#pragma unroll
          for (int qt = 0; qt < QT; ++qt) st[kt][qt] = mfma16(ka, Qf[qt][s], st[kt][qt]);
        }
#pragma unroll
      for (int kt = 0; kt < KT; ++kt)
#pragma unroll
        for (int qt = 0; qt < QT; ++qt)
#pragma unroll
          for (int j = 0; j < 4; ++j) {
            float v = st[kt][qt][j] * SC;
            if (MODE == 1) {
              if (c < nloc) {
                const int kc = sbk * KT * 16 + kt * 16 + 4 * q + j;
                const int qc = wid * 16 + r;
                int wst = qc - 8; wst = wst < 0 ? 0 : (wst > 48 ? 48 : wst);
                const bool valid = (kc >= wst) && (kc < wst + 16);
                int co = kc - qc + 15; co = co < 0 ? 0 : (co > 30 ? 30 : co);
                const float bias = rpb_s[(roff0 + c) * 31 + co] * L2E;
                v = valid ? (v + bias) : -INFINITY;
              }
            }
            st[kt][qt][j] = v;
          }
      bf16x8 pb[KT / 2][QT];
#pragma unroll
      for (int qt = 0; qt < QT; ++qt) {
        float mx = -INFINITY;
#pragma unroll
        for (int kt = 0; kt < KT; ++kt)
#pragma unroll
          for (int j = 0; j < 4; ++j) mx = fmaxf(mx, st[kt][qt][j]);
        mx = fmaxf(mx, shx<16>(mx, lane));
        mx = fmaxf(mx, shx<32>(mx, lane));
        const float mnew = fmaxf(mrun[qt], mx);
        const float alpha = fexp2(mrun[qt] - mnew);
        mrun[qt] = mnew;
        float ps = 0.f;
#pragma unroll
        for (int kt = 0; kt < KT; ++kt)
#pragma unroll
          for (int j = 0; j < 4; ++j) {
            const float pv = fexp2(st[kt][qt][j] - mnew);
            st[kt][qt][j] = pv;
            ps += pv;
          }
        lsum[qt] = lsum[qt] * alpha + ps;
        if (__any(alpha != 1.f)) {
#pragma unroll
          for (int dt = 0; dt < DV / 16; ++dt) {
            O[dt][qt][0] *= alpha; O[dt][qt][1] *= alpha; O[dt][qt][2] *= alpha; O[dt][qt][3] *= alpha;
          }
        }
#pragma unroll
        for (int ks = 0; ks < KT / 2; ++ks) {
          u32x4 pk;
          pk.x = pack2(st[2 * ks][qt][0], st[2 * ks][qt][1]);
          pk.y = pack2(st[2 * ks][qt][2], st[2 * ks][qt][3]);
          pk.z = pack2(st[2 * ks + 1][qt][0], st[2 * ks + 1][qt][1]);
          pk.w = pack2(st[2 * ks + 1][qt][2], st[2 * ks + 1][qt][3]);
          pb[ks][qt] = __builtin_bit_cast(bf16x8, pk);
        }
      }
#pragma unroll
      for (int dt = 0; dt < DV / 16; ++dt)
#pragma unroll
        for (int ks = 0; ks < KT / 2; ++ks) {
          const bf16x8 va = *(const bf16x8*)(sV + sw128(dt * 16 + r, (sbk * (KT / 2) + ks) * 4 + q));
#pragma unroll
          for (int qt = 0; qt < QT; ++qt) O[dt][qt] = mfma16(va, pb[ks][qt], O[dt][qt]);
        }
    }
    if (more) AT_STORE(c + 1);
  }
#undef AT_LOAD
#undef AT_STORE
  __syncthreads();
#pragma unroll
  for (int qt = 0; qt < QT; ++qt) {
    float L = lsum[qt];
    L += shx<16>(L, lane);
    L += shx<32>(L, lane);
    lsum[qt] = L;
  }
}

DI void diff_attn_item(const Params& p, int l, int b, int head, int qrow0, bool ctxq, char* smem) {
  const int tid = opaque_tid(), lane = tid & 63, wid = tid >> 6, r = lane & 15, q = lane >> 4;
  const bfr* proj = (const bfr*)(p.ws + OFF_PROJ);
  const bfr* VT = (const bfr*)(p.ws + OFF_VT);
  bfr* U = (bfr*)(p.ws + OFF_U);
  const float* lamv = (const float*)(p.ws + OFF_LAM);
  const float lam = lamv[l >> 1], lam_init = lamv[2 + (l >> 1)];
  f32x4 O[8][2];
  float ls[2];
  char* parkb = smem + 49152 + tid * 16;
  attn_engine<128, 2, 2, 0>(proj + (size_t)qrow0 * NEV + 2048 + head * 128, NEV, proj + head * 128, NEV,
                            VT + (size_t)(b * 1024 + head * 128) * KEYS, ctxq ? 0 : 64, b * 4096, 0, 4,
                            ML + b * 256, nullptr, 0, smem, O, ls);
  {
    const float i0 = 1.f / ls[0], i1 = 1.f / ls[1];
#pragma unroll
    for (int dt = 0; dt < 8; dt += 2) {
      u32x4 v0, v1;
      v0.x = pack2(O[dt][0][0] * i0, O[dt][0][1] * i0);
      v0.y = pack2(O[dt][0][2] * i0, O[dt][0][3] * i0);
      v0.z = pack2(O[dt + 1][0][0] * i0, O[dt + 1][0][1] * i0);
      v0.w = pack2(O[dt + 1][0][2] * i0, O[dt + 1][0][3] * i0);
      v1.x = pack2(O[dt][1][0] * i1, O[dt][1][1] * i1);
      v1.y = pack2(O[dt][1][2] * i1, O[dt][1][3] * i1);
      v1.z = pack2(O[dt + 1][1][0] * i1, O[dt + 1][1][1] * i1);
      v1.w = pack2(O[dt + 1][1][2] * i1, O[dt + 1][1][3] * i1);
      *(u32x4*)(parkb + (dt / 2) * 4096) = v0;
      *(u32x4*)(parkb + (4 + dt / 2) * 4096) = v1;
    }
  }
  attn_engine<128, 2, 2, 0>(proj + (size_t)qrow0 * NEV + 2048 + head * 128 + 64, NEV, proj + head * 128 + 64, NEV,
                            VT + (size_t)(b * 1024 + head * 128) * KEYS, ctxq ? 0 : 64, b * 4096, 0, 4,
                            ML + b * 256, nullptr, 0, smem, O, ls);
  const float* subln = p.ev_subln + (l >> 1) * 128;
#pragma unroll
  for (int qt = 0; qt < 2; ++qt) {
    const float i1 = lam / ls[qt];
    float ss = 0.f;
#pragma unroll
    for (int dt = 0; dt < 8; ++dt) {
      const u32x2 pk2 = *(const u32x2*)(parkb + (qt * 4 + dt / 2) * 4096 + (dt & 1) * 8);
      const unsigned pa = pk2.x, pc = pk2.y;
      const float o0 = lo_bf(pa) - O[dt][qt][0] * i1;
      const float o1 = hi_bf(pa) - O[dt][qt][1] * i1;
      const float o2 = lo_bf(pc) - O[dt][qt][2] * i1;
      const float o3 = hi_bf(pc) - O[dt][qt][3] * i1;
      O[dt][qt][0] = o0; O[dt][qt][1] = o1; O[dt][qt][2] = o2; O[dt][qt][3] = o3;
      ss += o0 * o0 + o1 * o1 + o2 * o2 + o3 * o3;
    }
    ss += shx<16>(ss, lane);
    ss += shx<32>(ss, lane);
    const float rn = rsqrtf(ss * (1.f / 128.f) + 1e-6f) * (1.f - lam_init);
    const int row = qrow0 + wid * 32 + qt * 16 + r;
#pragma unroll
    for (int dt = 0; dt < 8; ++dt) {
      const int dv = dt * 16 + 4 * q;
      const u32x2 ag = *(const u32x2*)(proj + (size_t)row * NEV + 3072 + head * 128 + dv);
      const float4 sl = *(const float4*)(subln + dv);
      u32x2 o;
      o.x = pack2(O[dt][qt][0] * rn * sl.x * silu(lo_bf(ag.x)), O[dt][qt][1] * rn * sl.y * silu(hi_bf(ag.x)));
      o.y = pack2(O[dt][qt][2] * rn * sl.z * silu(lo_bf(ag.y)), O[dt][qt][3] * rn * sl.w * silu(hi_bf(ag.y)));
      *(u32x2*)(U + (size_t)row * 2048 + head * 128 + dv) = o;
    }
  }
}

DI void na_item(const Params& p, int l, int b, int head, int rho, bool ctxq, int cq0, char* smem) {
  const int tid = opaque_tid(), lane = tid & 63, wid = tid >> 6, r = lane & 15, q = lane >> 4;
  const bfr* proj = (const bfr*)(p.ws + OFF_PROJ);
  const bfr* VT = (const bfr*)(p.ws + OFF_VT);
  bfr* U = (bfr*)(p.ws + OFF_U);
  float* rpb_s = (float*)(smem + 2 * (8192 + 64 * 128));
  int rs = rho - 4; rs = rs < 0 ? 0 : (rs > 56 ? 56 : rs);
  const int qrow0 = ctxq ? (ML + b * 256 + cq0) : (b * 4096 + rho * 64);
  f32x4 O[4][1];
  float ls[1];
  if (!ctxq) {
    const float* rp = p.od_rpb + ((size_t)(l >> 1) * 16 + head) * 465;
    for (int i = tid; i < 465; i += 256) rpb_s[i] = rp[i];
    attn_engine<64, 1, 4, 1>(proj + (size_t)qrow0 * NOD + 3584 + head * 64, NOD, proj + head * 64, NOD,
                                VT + (size_t)(b * 1024 + head * 64) * KEYS, 8, b * 4096 + rs * 64, rs * 64, 4,
                                ML + b * 256, rpb_s, rs - rho + 7, smem, O, ls);
  } else {
    attn_engine<64, 1, 4, 0>(proj + (size_t)qrow0 * NOD + 3584 + head * 64, NOD, proj + head * 64, NOD,
                                VT + (size_t)(b * 1024 + head * 64) * KEYS, 0, 0, 0, 4, ML + b * 256, nullptr, 0,
                                smem, O, ls);
  }
  const float inv = 1.f / ls[0];
  const int row = qrow0 + wid * 16 + r;
#pragma unroll
  for (int dt = 0; dt < 4; ++dt) {
    const int dv = dt * 16 + 4 * q;
    const u32x2 cgv = *(const u32x2*)(proj + (size_t)row * NOD + 5120 + head * 64 + dv);
    u32x2 o;
    o.x = pack2(O[dt][0][0] * inv * silu(lo_bf(cgv.x)), O[dt][0][1] * inv * silu(hi_bf(cgv.x)));
    o.y = pack2(O[dt][0][2] * inv * silu(lo_bf(cgv.y)), O[dt][0][3] * inv * silu(hi_bf(cgv.y)));
    *(u32x2*)(U + (size_t)row * 2048 + head * 64 + dv) = o;
  }
}

DI void conv_item(const Params& p, int l, int item) {
  const int tid = opaque_tid();
  const bfr* proj = (const bfr*)(p.ws + OFF_PROJ);
  bfr* U = (bfr*)(p.ws + OFF_U);
  const float* cw = p.ev_conv + (size_t)(l >> 1) * 3 * 1024;
#pragma unroll 1
  for (int i = 0; i < 8; ++i) {
    const int v = tid + 256 * i;
    const int ri = v >> 7, ch = (v & 127) * 8;
    const int m = item * 16 + ri;
    int t, T;
    if (m < ML) { t = m & 4095; T = 4096; } else { t = (m - ML) & 255; T = 256; }
    const bfr* pr = proj + (size_t)m * NEV;
    float acc[8];
#pragma unroll
    for (int e = 0; e < 8; ++e) acc[e] = 0.f;
#pragma unroll
    for (int w = 0; w < 3; ++w) {
      const int tt = t + w - 1;
      if (tt >= 0 && tt < T) {
        const bfr* prw = pr + (ptrdiff_t)(w - 1) * NEV;
        const u32x4 bh = *(const u32x4*)(prw + 4096 + ch);
        const u32x4 bc = *(const u32x4*)(prw + 6144 + ch);
        const float4 w0 = *(const float4*)(cw + w * 1024 + ch);
        const float4 w1 = *(const float4*)(cw + w * 1024 + ch + 4);
        acc[0] += w0.x * lo_bf(bh.x) * lo_bf(bc.x); acc[1] += w0.y * hi_bf(bh.x) * hi_bf(bc.x);
        acc[2] += w0.z * lo_bf(bh.y) * lo_bf(bc.y); acc[3] += w0.w * hi_bf(bh.y) * hi_bf(bc.y);
        acc[4] += w1.x * lo_bf(bh.z) * lo_bf(bc.z); acc[5] += w1.y * hi_bf(bh.z) * hi_bf(bc.z);
        acc[6] += w1.z * lo_bf(bh.w) * lo_bf(bc.w); acc[7] += w1.w * hi_bf(bh.w) * hi_bf(bc.w);
      }
    }
    const u32x4 bb = *(const u32x4*)(pr + 5120 + ch);
    const u32x4 bg = *(const u32x4*)(pr + 7168 + ch);
    u32x4 o;
    o.x = pack2(lo_bf(bb.x) * acc[0] * silu(lo_bf(bg.x)), hi_bf(bb.x) * acc[1] * silu(hi_bf(bg.x)));
    o.y = pack2(lo_bf(bb.y) * acc[2] * silu(lo_bf(bg.y)), hi_bf(bb.y) * acc[3] * silu(hi_bf(bg.y)));
    o.z = pack2(lo_bf(bb.z) * acc[4] * silu(lo_bf(bg.z)), hi_bf(bb.z) * acc[5] * silu(hi_bf(bg.z)));
    o.w = pack2(lo_bf(bb.w) * acc[6] * silu(lo_bf(bg.w)), hi_bf(bb.w) * acc[7] * silu(hi_bf(bg.w)));
    *(u32x4*)(U + (size_t)m * 2048 + 1024 + ch) = o;
  }
}

DI void gla_item(const Params& p, int l, int item, char* smem) {
  const int tid = opaque_tid(), lane = tid & 63, wid = tid >> 6, r = lane & 15, q = lane >> 4;
  const int slice = item & 7, dir = (item >> 3) & 1, head = (item >> 4) & 3, b = item >> 6;
  const int jl = l >> 1;
  const bfr* proj = (const bfr*)(p.ws + OFF_PROJ);
  bfr* dst = dir ? (bfr*)(p.ws + OFF_H) : ((bfr*)(p.ws + OFF_U) + 1024);
  const int dld = dir ? 1024 : 2048;
  char* sQb = smem;
  char* sKc = smem + 16384;
  char* sKbT = smem + 32768;
  char* sVt = smem + 49152;
  char* sAtt = smem + 53248;
  float* sLr = (float*)sAtt;
  float* sHs = (float*)(sAtt + 4096);
  char* sST = smem + 61440;
  float* sDec = (float*)(smem + 77824);

  const int d = tid & 127, half = tid >> 7;
  unsigned gu[8];
#pragma unroll
  for (int k = 0; k < 8; ++k)
    gu[k] = pack2(p.od_gate_up[(((size_t)jl * 2 + dir) * 16 + 2 * k) * 512 + head * 128 + d],
                  p.od_gate_up[(((size_t)jl * 2 + dir) * 16 + 2 * k + 1) * 512 + head * 128 + d]);
  const float gbias = p.od_gate_bias[((size_t)jl * 2 + dir) * 512 + head * 128 + d];
  const float qscale = 0.08838834764831845f;

  f32x4 S[2][2];
#pragma unroll
  for (int a = 0; a < 2; ++a)
#pragma unroll
    for (int c2 = 0; c2 < 2; ++c2) S[a][c2] = (f32x4){0.f, 0.f, 0.f, 0.f};
  __syncthreads();
  for (int i = tid; i < 512; i += 256) ((u32x4*)sST)[i] = (u32x4){0u, 0u, 0u, 0u};

  for (int ci = 0; ci < 68; ++ci) {
    int row0;
    if (ci < 4) row0 = ML + b * 256 + (dir ? (3 - ci) : ci) * 64;
    else        row0 = b * 4096 + (dir ? (67 - ci) : (ci - 4)) * 64;
    const char* stc = sST + (ci & 1) * 8192;
    char* stn = sST + ((ci + 1) & 1) * 8192;
    __syncthreads();
    {
      const int s = tid >> 2, part = tid & 3;
      const u32x2 lv = *(const u32x2*)(proj + (size_t)(row0 + s) * NOD + 7168 + dir * 16 + part * 4);
      *(u32x2*)((char*)sLr + s * 32 + part * 8) = lv;
      const int e = tid & 31, sg = tid >> 5;
      const bfr* vp = proj + (size_t)(row0 + sg * 8) * NOD + 2560 + head * 256 + slice * 32 + e;
      u32x4 pk;
      pk.x = (unsigned)vp[0] | ((unsigned)vp[NOD] << 16);
      pk.y = (unsigned)vp[2 * NOD] | ((unsigned)vp[3 * NOD] << 16);
      pk.z = (unsigned)vp[4 * NOD] | ((unsigned)vp[5 * NOD] << 16);
      pk.w = (unsigned)vp[6 * NOD] | ((unsigned)vp[7 * NOD] << 16);
      *(u32x4*)(sVt + sw128(e, sg)) = pk;
    }
    __syncthreads();
    float gl[32];
    float tot = 0.f;
#pragma unroll
    for (int i = 0; i < 32; ++i) {
      const int s = half * 32 + i;
      float z = gbias;
      {
        const u32x4 la = *(const u32x4*)((const char*)sLr + s * 32);
        const u32x4 lb = *(const u32x4*)((const char*)sLr + s * 32 + 16);
        z = dot2bf(la.x, gu[0], z); z = dot2bf(la.y, gu[1], z); z = dot2bf(la.z, gu[2], z); z = dot2bf(la.w, gu[3], z);
        z = dot2bf(lb.x, gu[4], z); z = dot2bf(lb.y, gu[5], z); z = dot2bf(lb.z, gu[6], z); z = dot2bf(lb.w, gu[7], z);
      }
      const float tneg = fexp2(-fabsf(z) * L2E);
      const float g = (fminf(z, 0.f) - flog2(1.f + tneg) * LN2) * (1.f / 16.f);
      gl[i] = g;
      tot += g;
    }
    if (dir == 0) {
      float run = 0.f;
#pragma unroll
      for (int i = 0; i < 32; ++i) { run += gl[i]; gl[i] = run; }
    } else {
      float run = 0.f;
#pragma unroll
      for (int i = 31; i >= 0; --i) { run += gl[i]; gl[i] = run; }
    }
    sHs[half * 128 + d] = tot;
    __syncthreads();
    const float other = sHs[(1 - half) * 128 + d];
    const float bend = tot + other;
    const float offs = (dir == 0) ? (half ? other : 0.f) : (half ? 0.f : other);
    const float dec = fexp2(bend * L2E);
    if (half == 0) sDec[d] = dec;
    {
      const bfr* qp = proj + (size_t)(row0 + half * 32) * NOD + 4608 + head * 128 + d;
      const bfr* kp = proj + (size_t)(row0 + half * 32) * NOD + 2048 + head * 128 + d;
#pragma unroll
      for (int i8 = 0; i8 < 4; ++i8) {
        unsigned kb[4];
#pragma unroll
        for (int ii = 0; ii < 8; ++ii) {
          const int i = i8 * 8 + ii;
          const int s = half * 32 + i;
          const float bb = (gl[i] + offs) * L2E;
          const float E = fexp2(bb), Ei = fexp2(-bb);
          const float qv = bf2f(qp[(size_t)i * NOD]) * qscale * E;
          const float kc = bf2f(kp[(size_t)i * NOD]) * Ei;
          *(bfr*)(sQb + sw256(s, d >> 3) + (d & 7) * 2) = f2bf(qv);
          *(bfr*)(sKc + sw256(s, d >> 3) + (d & 7) * 2) = f2bf(kc);
          const unsigned kbv = f2bf(kc * dec);
          if (ii & 1) kb[ii >> 1] |= kbv << 16; else kb[ii >> 1] = kbv;
        }
        *(u32x4*)(sKbT + sw128(d, half * 4 + i8)) = (u32x4){kb[0], kb[1], kb[2], kb[3]};
      }
    }
    __syncthreads();
    {
      f32x4 at[4];
#pragma unroll
      for (int st = 0; st < 4; ++st) at[st] = (f32x4){0.f, 0.f, 0.f, 0.f};
#pragma unroll
      for (int ks = 0; ks < 4; ++ks) {
        const bf16x8 qa = *(const bf16x8*)(sQb + sw256(wid * 16 + r, ks * 4 + q));
#pragma unroll
        for (int st = 0; st < 4; ++st) {
          const bf16x8 kb2 = *(const bf16x8*)(sKc + sw256(st * 16 + r, ks * 4 + q));
          at[st] = mfma16(qa, kb2, at[st]);
        }
      }
#pragma unroll
      for (int st = 0; st < 4; ++st)
#pragma unroll
        for (int j = 0; j < 4; ++j) {
          const int t = wid * 16 + 4 * q + j, s = st * 16 + r;
          const bool keep = dir ? (s >= t) : (s <= t);
          *(bfr*)(sAtt + sw128(t, s >> 3) + (s & 7) * 2) = f2bf(keep ? at[st][j] : 0.f);
        }
    }
    __syncthreads();
    {
      f32x4 o[2];
      o[0] = (f32x4){0.f, 0.f, 0.f, 0.f};
      o[1] = (f32x4){0.f, 0.f, 0.f, 0.f};
#pragma unroll
      for (int ks = 0; ks < 4; ++ks) {
        const bf16x8 qa = *(const bf16x8*)(sQb + sw256(wid * 16 + r, ks * 4 + q));
#pragma unroll
        for (int et = 0; et < 2; ++et) {
          const bf16x8 sb2 = *(const bf16x8*)(stc + sw256(et * 16 + r, ks * 4 + q));
          o[et] = mfma16(qa, sb2, o[et]);
        }
      }
#pragma unroll
      for (int ks = 0; ks < 2; ++ks) {
        const bf16x8 aa = *(const bf16x8*)(sAtt + sw128(wid * 16 + r, ks * 4 + q));
#pragma unroll
        for (int et = 0; et < 2; ++et) {
          const bf16x8 vb = *(const bf16x8*)(sVt + sw128(et * 16 + r, ks * 4 + q));
          o[et] = mfma16(aa, vb, o[et]);
        }
      }
#pragma unroll
      for (int et = 0; et < 2; ++et)
#pragma unroll
        for (int j = 0; j < 4; ++j) {
          const int t = wid * 16 + 4 * q + j;
          dst[(size_t)(row0 + t) * dld + head * 256 + slice * 32 + et * 16 + r] = f2bf(o[et][j]);
        }
    }
    {
#pragma unroll
      for (int dti = 0; dti < 2; ++dti) {
        const float dc = sDec[(2 * wid + dti) * 16 + r];
#pragma unroll
        for (int et = 0; et < 2; ++et) {
          S[et][dti][0] *= dc; S[et][dti][1] *= dc; S[et][dti][2] *= dc; S[et][dti][3] *= dc;
        }
      }
#pragma unroll
      for (int ks = 0; ks < 2; ++ks) {
        bf16x8 va[2], kb2[2];
#pragma unroll
        for (int et = 0; et < 2; ++et) va[et] = *(const bf16x8*)(sVt + sw128(et * 16 + r, ks * 4 + q));
#pragma unroll
        for (int dti = 0; dti < 2; ++dti) kb2[dti] = *(const bf16x8*)(sKbT + sw128((2 * wid + dti) * 16 + r, ks * 4 + q));
#pragma unroll
        for (int et = 0; et < 2; ++et)
#pragma unroll
          for (int dti = 0; dti < 2; ++dti) S[et][dti] = mfma16(va[et], kb2[dti], S[et][dti]);
      }
#pragma unroll
      for (int et = 0; et < 2; ++et)
#pragma unroll
        for (int dti = 0; dti < 2; ++dti)
#pragma unroll
          for (int j = 0; j < 4; ++j) {
            const int e = et * 16 + 4 * q + j, dd = (2 * wid + dti) * 16 + r;
            *(bfr*)(stn + sw256(e, dd >> 3) + (dd & 7) * 2) = f2bf(S[et][dti][j]);
          }
    }
  }
  __syncthreads();
}

DI void phase_gla_combine(const Params& p, int l) {
  const int tid = opaque_tid(), lane = tid & 63, wid = tid >> 6;
  const bfr* proj = (const bfr*)(p.ws + OFF_PROJ);
  const bfr* OB = (const bfr*)(p.ws + OFF_H);
  bfr* U = (bfr*)(p.ws + OFF_U);
  const float* gn = p.od_gnorm + (l >> 1) * 256 + (lane & 15) * 16;
  for (int row = blockIdx.x * 4 + wid; row < MR; row += gridDim.x * 4) {
    bfr* up = U + (size_t)row * 2048 + 1024 + lane * 16;
    const u32x4 a0 = *(const u32x4*)up, a1 = *(const u32x4*)(up + 8);
    const u32x4 b0 = *(const u32x4*)(OB + (size_t)row * 1024 + lane * 16), b1 = *(const u32x4*)(OB + (size_t)row * 1024 + lane * 16 + 8);
    const u32x4 g0 = *(const u32x4*)(proj + (size_t)row * NOD + 6144 + lane * 16), g1 = *(const u32x4*)(proj + (size_t)row * NOD + 6144 + lane * 16 + 8);
    float o[16], dg[16];
    const unsigned av[8] = {a0.x, a0.y, a0.z, a0.w, a1.x, a1.y, a1.z, a1.w};
    const unsigned bv[8] = {b0.x, b0.y, b0.z, b0.w, b1.x, b1.y, b1.z, b1.w};
    const unsigned gv[8] = {g0.x, g0.y, g0.z, g0.w, g1.x, g1.y, g1.z, g1.w};
    float ss = 0.f;
#pragma unroll
    for (int i = 0; i < 8; ++i) {
      o[2 * i] = lo_bf(av[i]) + lo_bf(bv[i]);
      o[2 * i + 1] = hi_bf(av[i]) + hi_bf(bv[i]);
      dg[2 * i] = lo_bf(gv[i]);
      dg[2 * i + 1] = hi_bf(gv[i]);
      ss += o[2 * i] * o[2 * i] + o[2 * i + 1] * o[2 * i + 1];
    }
    ss += shx<1>(ss, lane); ss += shx<2>(ss, lane); ss += shx<4>(ss, lane); ss += shx<8>(ss, lane);
    const float rn = rsqrtf(ss * (1.f / 256.f) + 1e-6f);
    unsigned ov[8];
#pragma unroll
    for (int i = 0; i < 8; ++i)
      ov[i] = pack2(o[2 * i] * rn * gn[2 * i] * silu(dg[2 * i]), o[2 * i + 1] * rn * gn[2 * i + 1] * silu(dg[2 * i + 1]));
    *(u32x4*)up = (u32x4){ov[0], ov[1], ov[2], ov[3]};
    *(u32x4*)(up + 8) = (u32x4){ov[4], ov[5], ov[6], ov[7]};
  }
}

DI int next_item(int* ctr, int* slot) {
  __syncthreads();
  if (threadIdx.x == 0) *slot = atomicAdd(ctr, 1);
  __syncthreads();
  return *slot;
}

DI void phase_mix_even(const Params& p, int l, int g, char* smem) {
  int* ctr = (int*)(p.ws + OFF_CTR) + (g * 4 + l);
  int* slot = (int*)(smem + SMEM_BYTES - 16);
  const int N_LAT = GB * 8 * 32, N_CTX = GB * 8 * 2, N_CONV = MR / 16;
  const int total = N_LAT + N_CTX + N_CONV;
  for (;;) {
    int it = next_item(ctr, slot);
    if (it >= total) break;
    if (it < N_LAT) {
      const int x = it & 7, li = it >> 3;
      const int qb = li & 31, b = li >> 5;
      diff_attn_item(p, l, b, x, b * 4096 + qb * 128, false, smem);
    } else if (it < N_LAT + N_CTX) {
      it -= N_LAT;
      const int qb = it & 1, head = (it >> 1) & 7, b = it >> 4;
      diff_attn_item(p, l, b, head, ML + b * 256 + qb * 128, true, smem);
    } else {
      conv_item(p, l, it - N_LAT - N_CTX);
    }
  }
}

DI void phase_mix_odd(const Params& p, int l, int g, char* smem) {
  int* ctr = (int*)(p.ws + OFF_CTR) + (g * 4 + l);
  int* slot = (int*)(smem + SMEM_BYTES - 16);
  const int N_GLA = GB * 4 * 2 * 8, N_NA = GB * 16 * 64, N_CTX = (l == 3) ? 0 : GB * 16 * 4;
  const int total = N_GLA + N_NA + N_CTX;
  for (;;) {
    int it = next_item(ctr, slot);
    if (it >= total) break;
    if (it < N_GLA) {
      gla_item(p, l, it, smem);
    } else if (it < N_GLA + N_NA) {
      it -= N_GLA;
      const int rho = it & 63, bh = it >> 6;
      na_item(p, l, bh >> 4, bh & 15, rho, false, 0, smem);
    } else {
      it -= N_GLA + N_NA;
      const int qb = it & 3, bh = it >> 2;
      na_item(p, l, bh >> 4, bh & 15, 0, true, qb * 64, smem);
    }
  }
}


typedef const __attribute__((address_space(4))) Params* KParamsPtr;
DI Params load_params() {
#if defined(__HIP_DEVICE_COMPILE__)
  KParamsPtr kp = (KParamsPtr)__builtin_amdgcn_kernarg_segment_ptr();
  asm volatile("" : "+s"(kp));
  Params r;
  __builtin_memcpy(&r, kp, sizeof(Params));
  return r;
#else
  return Params{};
#endif
}
#define PH(call) { const Params p = load_params(); call; }
__global__ void __launch_bounds__(256, 2) mega_kernel(Params p_unused) {
  extern __shared__ __attribute__((aligned(16))) char smem[];
  cg::grid_group grid = cg::this_grid();
  PH(phase0(p, smem));
  grid.sync();
#pragma unroll 1
  for (int g = 0; g < NGRP; ++g) {
#pragma unroll 1
    for (int l = 0; l < 4; ++l) {
      PH(phase_norm(p, l, g));
      grid.sync();
      PH(phase_gemm_in(p, l, smem));
      grid.sync();
      if (l & 1) {
        PH(phase_mix_odd(p, l, g, smem));
        grid.sync();
        PH(phase_gla_combine(p, l));
      } else {
        PH(phase_mix_even(p, l, g, smem));
      }
      grid.sync();
      PH(phase_gemm_out(p, l, smem));
      grid.sync();
    }
    PH(phase_norm(p, 4, g));
    grid.sync();
  }
}

extern "C" void kernel_launch(void* const* d_in, const int* in_sizes, int n_in, void* d_out, int out_size, void* d_ws,
                              size_t ws_size, hipStream_t stream) {
  static int grid_blocks = 0;
  if (!grid_blocks) {
    int dev = 0, cus = 0, per_cu = 0;
    hipGetDevice(&dev);
    hipDeviceGetAttribute(&cus, hipDeviceAttributeMultiprocessorCount, dev);
    hipFuncSetAttribute((const void*)mega_kernel, hipFuncAttributeMaxDynamicSharedMemorySize, SMEM_BYTES);
    hipOccupancyMaxActiveBlocksPerMultiprocessor(&per_cu, mega_kernel, 256, SMEM_BYTES);
    if (per_cu > 2) per_cu = 2;
    if (per_cu < 1) per_cu = 1;
    grid_blocks = cus * per_cu;
    grid_blocks &= ~7;
  }
  if (ws_size < WS_NEED) { fprintf(stderr, "workspace too small: %zu < %zu\n", ws_size, (size_t)WS_NEED); return; }
  Params p{};
  p.x = (const float*)d_in[0]; p.c = (const float*)d_in[1]; p.ctx = (const float*)d_in[2]; p.c_ctx = (const float*)d_in[3];
  p.w_mod = (const float*)d_in[4]; p.b_mod = (const float*)d_in[5]; p.g_pre = (const float*)d_in[6]; p.g_post = (const float*)d_in[7];
  p.w_out = (const float*)d_in[8]; p.ev_w_in = (const float*)d_in[9]; p.ev_lambda = (const float*)d_in[10]; p.ev_subln = (const float*)d_in[11];
  p.ev_conv = (const float*)d_in[12]; p.od_w_in = (const float*)d_in[13]; p.od_rpb = (const float*)d_in[14]; p.od_gate_up = (const float*)d_in[15];
  p.od_gate_bias = (const float*)d_in[16]; p.od_gnorm = (const float*)d_in[17];
  p.out = (float*)d_out;
  p.ws = (char*)d_ws;
  void* args[] = {&p};
  hipError_t e = hipLaunchCooperativeKernel((const void*)mega_kernel, dim3(grid_blocks), dim3(256), args, SMEM_BYTES, stream);
  if (e != hipSuccess) fprintf(stderr, "cooperative launch failed: %s (grid %d)\n", hipGetErrorString(e), grid_blocks);
}
```

```cpp
#include <hip/hip_runtime.h>
#include <hip/hip_cooperative_groups.h>
#include <cstdio>
namespace cg = cooperative_groups;

typedef unsigned short bfr;
typedef __attribute__((ext_vector_type(8))) short bf16x8;
typedef __attribute__((ext_vector_type(4))) float f32x4;
typedef __attribute__((ext_vector_type(4))) unsigned u32x4;
typedef __attribute__((ext_vector_type(2))) unsigned u32x2;
typedef __attribute__((ext_vector_type(16))) unsigned u32x16;
typedef __attribute__((ext_vector_type(2))) __bf16 bf16x2_t;
#define DI __device__ __forceinline__
DI float dot2bf(unsigned a, unsigned b, float c) { return __builtin_amdgcn_fdot2_f32_bf16(__builtin_bit_cast(bf16x2_t, a), __builtin_bit_cast(bf16x2_t, b), c, false); }
DI int opaque_tid() { int t = threadIdx.x; asm volatile("" : "+v"(t)); return t; }

constexpr int GB   = 4;
constexpr int NGRP = 2;
constexpr int ML   = GB * 4096;
constexpr int MC   = GB * 256;
constexpr int MR   = ML + MC;
constexpr int NEV  = 8192;
constexpr int NOD  = 7296;
constexpr int KEYS = 4352;
constexpr float L2E = 1.4426950408889634f;
constexpr float LN2 = 0.6931471805599453f;

constexpr size_t SZ_PROJ = (size_t)MR * 8192 * 2;
constexpr size_t SZ_H    = (size_t)MR * 1024 * 2;
constexpr size_t SZ_U    = (size_t)MR * 2048 * 2;
constexpr size_t SZ_VT   = (size_t)GB * 1024 * KEYS * 2;
constexpr size_t SZ_WE   = (size_t)NEV * 1024 * 2;
constexpr size_t SZ_WO   = (size_t)NOD * 1024 * 2;
constexpr size_t SZ_WOUT = (size_t)1024 * 2048 * 2;
constexpr size_t OFF_PROJ = 0;
constexpr size_t OFF_H    = OFF_PROJ + SZ_PROJ;
constexpr size_t OFF_U    = OFF_H + SZ_H;
constexpr size_t OFF_VT   = OFF_U + SZ_U;
constexpr size_t OFF_WIN  = OFF_VT + SZ_VT;
constexpr size_t OFF_WOUT = OFF_WIN + 2 * SZ_WE + 2 * SZ_WO;
constexpr size_t OFF_XC   = OFF_WOUT + 4 * SZ_WOUT;
constexpr size_t OFF_MOD  = OFF_XC + (size_t)8 * 256 * 1024 * 4;
constexpr size_t OFF_CS   = OFF_MOD + (size_t)4 * 9 * 3072 * 4;
constexpr size_t OFF_LAM  = OFF_CS + 64 * 16 * 8;
constexpr size_t OFF_CTR  = OFF_LAM + 256;
constexpr size_t WS_NEED  = OFF_CTR + 256;

constexpr int SMEM_BYTES = 80896;

struct Params {
  const float *x, *c, *ctx, *c_ctx, *w_mod, *b_mod, *g_pre, *g_post, *w_out, *ev_w_in, *ev_lambda, *ev_subln,
      *ev_conv, *od_w_in, *od_rpb, *od_gate_up, *od_gate_bias, *od_gnorm;
  float* out;
  char* ws;
};

DI size_t win_off(int l) { return OFF_WIN + (size_t)(l >> 1) * (SZ_WE + SZ_WO) + ((l & 1) ? SZ_WE : 0); }

DI float bf2f(bfr v) { return __uint_as_float(((unsigned)v) << 16); }
DI bfr f2bf(float x) { unsigned u = __float_as_uint(x); u += 0x7fffu + ((u >> 16) & 1u); return (bfr)(u >> 16); }
DI unsigned pack2(float a, float b) { return (unsigned)f2bf(a) | (((unsigned)f2bf(b)) << 16); }
DI float lo_bf(unsigned u) { return __uint_as_float(u << 16); }
DI float hi_bf(unsigned u) { return __uint_as_float(u & 0xffff0000u); }
DI float fexp2(float x) { return __builtin_amdgcn_exp2f(x); }
DI float flog2(float x) { return __builtin_amdgcn_logf(x); }
DI float silu(float x) { return x / (1.f + fexp2(-x * L2E)); }
template <int M>
DI float shx(float v, int lane) {
  if (M < 32) return __builtin_bit_cast(float, __builtin_amdgcn_ds_swizzle(__builtin_bit_cast(int, v), (M << 10) | 0x1f));
  return __builtin_bit_cast(float, __builtin_amdgcn_ds_bpermute((lane ^ 32) << 2, __builtin_bit_cast(int, v)));
}
DI float wave_sum(float v, int lane) {
  v += shx<1>(v, lane); v += shx<2>(v, lane); v += shx<4>(v, lane); v += shx<8>(v, lane); v += shx<16>(v, lane); v += shx<32>(v, lane);
  return v;
}
DI f32x4 mfma16(bf16x8 a, bf16x8 b, f32x4 c) { return __builtin_amdgcn_mfma_f32_16x16x32_bf16(a, b, c, 0, 0, 0); }
DI int sw128(int row, int chunk) { return row * 128 + ((chunk ^ ((row >> 1) & 7)) << 4); }
DI int sw256(int row, int chunk) { return row * 256 + ((chunk ^ (row & 15)) << 4); }

DI void gemm_mainloop(const bfr* __restrict__ X, int ldx, const bfr* __restrict__ Y, int ldy, int K, char* smem,
                      f32x4 (&acc)[4][4]) {
  const int tid = opaque_tid(), lane = tid & 63, wid = tid >> 6, r = lane & 15, q = lane >> 4;
  const int wx = wid >> 1, wy = wid & 1;
  const int lr = tid >> 3, lc = tid & 7;
  const bfr* xp = X + (size_t)lr * ldx + lc * 8;
  const bfr* yp = Y + (size_t)lr * ldy + lc * 8;
  u32x4 xr[4], yr[4];
#pragma unroll
  for (int i = 0; i < 4; ++i) {
    xr[i] = *(const u32x4*)(xp + (size_t)(32 * i) * ldx);
    yr[i] = *(const u32x4*)(yp + (size_t)(32 * i) * ldy);
  }
  const int nk = K >> 6;
  for (int kt = 0; kt < nk; ++kt) {
    char* sX = smem + (kt & 1) * 32768;
    char* sY = sX + 16384;
#pragma unroll
    for (int i = 0; i < 4; ++i) {
      const int row = lr + 32 * i;
      *(u32x4*)(sX + sw128(row, lc)) = xr[i];
      *(u32x4*)(sY + sw128(row, lc)) = yr[i];
    }
    __syncthreads();
    if (kt + 1 < nk) {
      const int ko = (kt + 1) * 64;
#pragma unroll
      for (int i = 0; i < 4; ++i) {
        xr[i] = *(const u32x4*)(xp + (size_t)(32 * i) * ldx + ko);
        yr[i] = *(const u32x4*)(yp + (size_t)(32 * i) * ldy + ko);
      }
    }
#pragma unroll
    for (int s = 0; s < 2; ++s) {
      bf16x8 xa[4], yb[4];
#pragma unroll
      for (int i = 0; i < 4; ++i) xa[i] = *(const bf16x8*)(sX + sw128(wx * 64 + i * 16 + r, s * 4 + q));
#pragma unroll
      for (int j = 0; j < 4; ++j) yb[j] = *(const bf16x8*)(sY + sw128(wy * 64 + j * 16 + r, s * 4 + q));
#pragma unroll
      for (int i = 0; i < 4; ++i)
#pragma unroll
        for (int j = 0; j < 4; ++j) acc[i][j] = mfma16(xa[i], yb[j], acc[i][j]);
    }
  }
  __syncthreads();
}

DI bool tile_map(int T, int MT, int NT, int& mt, int& nt) {
  const int pm_n = MT >> 3;
  const int P = (T >> 9) * 8 + (T & 7);
  const int li = (T & 511) >> 3;
  const int pm = P % pm_n, pn = P / pm_n;
  mt = pm * 8 + (li & 7);
  nt = pn * 8 + (li >> 3);
  return nt < NT;
}

DI int odd_col_src(int n) {
  if (n < 3584) return n;
  if (n < 7168) return n + 32;
  if (n < 7200) return n - 7168 + 3584;
  return -1;
}

DI void phase0(const Params& p, char* smem) {
  const int tid = opaque_tid();
  if (blockIdx.x < 384) {
    float* sc = (float*)smem;
    float* red = sc + 9 * 1024;
    for (int i = tid; i < 9 * 1024; i += 256) {
      const int b = i >> 10, k = i & 1023;
      const float v = (b < 8) ? p.c[b * 1024 + k] : p.c_ctx[k];
      sc[i] = v / (1.f + __expf(-v));
    }
    __syncthreads();
    float* modb = (float*)(p.ws + OFF_MOD);
    for (int it = blockIdx.x; it < 384; it += gridDim.x) {
      const int l = it / 96, cgp = it % 96;
      const int col = cgp * 32 + (tid & 31), ks = tid >> 5;
      float a[9];
#pragma unroll
      for (int b = 0; b < 9; ++b) a[b] = 0.f;
      const float* w = p.w_mod + ((size_t)l * 1024 + ks * 128) * 3072 + col;
#pragma unroll 4
      for (int k = 0; k < 128; ++k) {
        const float wv = w[(size_t)k * 3072];
#pragma unroll
        for (int b = 0; b < 9; ++b) a[b] += sc[b * 1024 + ks * 128 + k] * wv;
      }
#pragma unroll
      for (int b = 0; b < 9; ++b) red[(ks * 9 + b) * 32 + (tid & 31)] = a[b];
      __syncthreads();
      for (int idx = tid; idx < 288; idx += 256) {
        const int b = idx >> 5, cc = idx & 31;
        float s = p.b_mod[l * 3072 + cgp * 32 + cc];
#pragma unroll
        for (int k2 = 0; k2 < 8; ++k2) s += red[(k2 * 9 + b) * 32 + cc];
        modb[(size_t)(l * 9 + b) * 3072 + cgp * 32 + cc] = s;
      }
      __syncthreads();
    }
  }
  if (blockIdx.x == gridDim.x - 1) {
    float2* cs = (float2*)(p.ws + OFF_CS);
    for (int idx = tid; idx < 1024; idx += 256) {
      const int pos = idx >> 4, f = idx & 15;
      const float inv = 1.0f / powf(10000.f, (float)f * 0.0625f);
      const float ang = (float)pos * inv;
      const double ad = (double)ang;
      const double n = rint(ad * 0.15915494309189535);
      const float rr = (float)(ad - n * 6.283185307179586);
      cs[idx] = make_float2(__cosf(rr), __sinf(rr));
    }
    if (tid < 2) {
      const float* lp = p.ev_lambda + tid * 256;
      float s1 = 0.f, s2 = 0.f;
      for (int i = 0; i < 64; ++i) { s1 += lp[i] * lp[64 + i]; s2 += lp[128 + i] * lp[192 + i]; }
      const float li = (tid == 0) ? 0.2f : (0.8f - 0.6f * 0.5488116360940264f);
      float* lam = (float*)(p.ws + OFF_LAM);
      lam[tid] = __expf(s1) - __expf(s2) + li;
      lam[2 + tid] = li;
    }
    if (tid < 32) ((int*)(p.ws + OFF_CTR))[tid] = 0;
  }
  float* tile = (float*)smem;
  __syncthreads();
  for (int it = blockIdx.x; it < 9792; it += gridDim.x) {
    int rr = it, l, ktile, ntile, K, Nsrc;
    const float* src;
    bfr* dst;
    bool oddmap = false;
    if (rr < 7744) {
      if (rr < 2048) { l = 0; } else if (rr < 3872) { l = 1; rr -= 2048; } else if (rr < 5920) { l = 2; rr -= 3872; } else { l = 3; rr -= 5920; }
      ktile = rr & 15; ntile = rr >> 4; K = 1024;
      oddmap = (l & 1);
      Nsrc = oddmap ? 7200 : 8192;
      src = (oddmap ? p.od_w_in : p.ev_w_in) + (size_t)(l >> 1) * 1024 * Nsrc;
      dst = (bfr*)(p.ws + win_off(l));
    } else {
      rr -= 7744; l = rr >> 9; rr &= 511;
      ktile = rr & 31; ntile = rr >> 5; K = 2048; Nsrc = 1024;
      src = p.w_out + (size_t)l * 2048 * 1024;
      dst = (bfr*)(p.ws + OFF_WOUT + (size_t)l * SZ_WOUT);
    }
    const int k0 = ktile * 64, n0 = ntile * 64;
    {
      const int nn = tid & 63;
      const int nd = n0 + nn;
      const int ns = oddmap ? odd_col_src(nd) : nd;
#pragma unroll 4
      for (int i = 0; i < 16; ++i) {
        const int kk = (tid >> 6) + 4 * i;
        tile[kk * 65 + nn] = (ns >= 0) ? src[(size_t)(k0 + kk) * Nsrc + ns] : 0.f;
      }
    }
    __syncthreads();
    {
      const int kk8 = (tid & 7) * 8;
#pragma unroll
      for (int i2 = 0; i2 < 2; ++i2) {
        const int nn = (tid >> 3) + 32 * i2;
        u32x4 v;
        v.x = pack2(tile[(kk8 + 0) * 65 + nn], tile[(kk8 + 1) * 65 + nn]);
        v.y = pack2(tile[(kk8 + 2) * 65 + nn], tile[(kk8 + 3) * 65 + nn]);
        v.z = pack2(tile[(kk8 + 4) * 65 + nn], tile[(kk8 + 5) * 65 + nn]);
        v.w = pack2(tile[(kk8 + 6) * 65 + nn], tile[(kk8 + 7) * 65 + nn]);
        *(u32x4*)(dst + (size_t)(n0 + nn) * K + k0 + kk8) = v;
      }
    }
    __syncthreads();
  }
}

DI void phase_norm(const Params& p, int l, int g) {
  const int tid = opaque_tid(), lane = tid & 63, wid = tid >> 6;
  const int rows = (l == 4) ? ML : MR;
  const float* modb = (const float*)(p.ws + OFF_MOD);
  const float* ybuf = (const float*)(p.ws + OFF_PROJ);
  bfr* hbuf = (bfr*)(p.ws + OFF_H);
  float* xcb = (float*)(p.ws + OFF_XC);
  for (int row = blockIdx.x * 4 + wid; row < rows; row += gridDim.x * 4) {
    const bool lat = row < ML;
    const int mb = lat ? (g * GB + (row >> 12)) : 8;
    const size_t grow = lat ? ((size_t)g * ML + row) : ((size_t)g * MC + (row - ML));
    const float* xin;
    float* xst;
    if (lat) { xin = ((l <= 1) ? p.x : (const float*)p.out) + grow * 1024; xst = p.out + grow * 1024; }
    else     { xin = ((l <= 1) ? p.ctx : (const float*)xcb) + grow * 1024; xst = xcb + grow * 1024; }
    float4 xv[4];
#pragma unroll
    for (int i = 0; i < 4; ++i) xv[i] = *(const float4*)(xin + lane * 4 + 256 * i);
    if (l >= 1) {
      float4 yv[4];
      float ss = 0.f;
#pragma unroll
      for (int i = 0; i < 4; ++i) {
        yv[i] = *(const float4*)(ybuf + (size_t)row * 1024 + lane * 4 + 256 * i);
        ss += yv[i].x * yv[i].x + yv[i].y * yv[i].y + yv[i].z * yv[i].z + yv[i].w * yv[i].w;
      }
      ss = wave_sum(ss, lane);
      const float rn = rsqrtf(ss * (1.f / 1024.f) + 1e-6f);
      const float* gate = modb + (size_t)((l - 1) * 9 + mb) * 3072 + 2048;
      const float* gp = p.g_post + (l - 1) * 1024;
#pragma unroll
      for (int i = 0; i < 4; ++i) {
        const int c0 = lane * 4 + 256 * i;
        const float4 gt = *(const float4*)(gate + c0);
        const float4 gg = *(const float4*)(gp + c0);
        xv[i].x += gt.x * (yv[i].x * rn * gg.x);
        xv[i].y += gt.y * (yv[i].y * rn * gg.y);
        xv[i].z += gt.z * (yv[i].z * rn * gg.z);
        xv[i].w += gt.w * (yv[i].w * rn * gg.w);
        *(float4*)(xst + c0) = xv[i];
      }
    }
    if (l < 4) {
      float ss = 0.f;
#pragma unroll
      for (int i = 0; i < 4; ++i) ss += xv[i].x * xv[i].x + xv[i].y * xv[i].y + xv[i].z * xv[i].z + xv[i].w * xv[i].w;
      ss = wave_sum(ss, lane);
      const float rn = rsqrtf(ss * (1.f / 1024.f) + 1e-6f);
      const float* mrow = modb + (size_t)(l * 9 + mb) * 3072;
      const float* gpre = p.g_pre + l * 1024;
#pragma unroll
      for (int i = 0; i < 4; ++i) {
        const int c0 = lane * 4 + 256 * i;
        const float4 sh = *(const float4*)(mrow + c0);
        const float4 scl = *(const float4*)(mrow + 1024 + c0);
        const float4 gg = *(const float4*)(gpre + c0);
        u32x2 o;
        o.x = pack2(xv[i].x * rn * gg.x * (1.f + scl.x) + sh.x, xv[i].y * rn * gg.y * (1.f + scl.y) + sh.y);
        o.y = pack2(xv[i].z * rn * gg.z * (1.f + scl.z) + sh.z, xv[i].w * rn * gg.w * (1.f + scl.w) + sh.w);
        *(u32x2*)(hbuf + (size_t)row * 1024 + c0) = o;
      }
    }
  }
}

DI void phase_gemm_in(const Params& p, int l, char* smem) {
  const int tid = opaque_tid(), lane = tid & 63, wid = tid >> 6, r = lane & 15, q = lane >> 4;
  const int wx = wid >> 1, wy = wid & 1;
  const bool even = !(l & 1);
  const int ldp = even ? NEV : NOD;
  const int NT = ldp >> 7, MT = MR >> 7;
  const bfr* WT = (const bfr*)(p.ws + win_off(l));
  const bfr* H = (const bfr*)(p.ws + OFF_H);
  bfr* proj = (bfr*)(p.ws + OFF_PROJ);
  bfr* VT = (bfr*)(p.ws + OFF_VT);
  const float2* cs = (const float2*)(p.ws + OFF_CS);
  const int total = ((((MT >> 3) * ((NT + 7) >> 3)) + 7) >> 3) << 9;
  for (int T = blockIdx.x; T < total; T += gridDim.x) {
    int mt, nt;
    if (!tile_map(T, MT, NT, mt, nt)) continue;
    const int m0 = mt * 128, n0 = nt * 128;
    const bool vt = (n0 >= 1024 && n0 < 2048);
    f32x4 acc[4][4];
#pragma unroll
    for (int i = 0; i < 4; ++i)
#pragma unroll
      for (int j = 0; j < 4; ++j) acc[i][j] = (f32x4){0.f, 0.f, 0.f, 0.f};
    const bfr* X = vt ? (H + (size_t)m0 * 1024) : (WT + (size_t)n0 * 1024);
    const bfr* Y = vt ? (WT + (size_t)n0 * 1024) : (H + (size_t)m0 * 1024);
    gemm_mainloop(X, 1024, Y, 1024, 1024, smem, acc);
    if (vt) {
#pragma unroll
      for (int i = 0; i < 4; ++i) {
        const int mbase = m0 + wx * 64 + i * 16;
        int b, kp;
        if (mbase < ML) { b = mbase >> 12; kp = mbase & 4095; } else { const int mm = mbase - ML; b = mm >> 8; kp = 4096 + (mm & 255); }
        const int pos = (kp & ~31) + q * 8 + ((kp >> 4) & 1) * 4;
#pragma unroll
        for (int jn = 0; jn < 4; ++jn) {
          const int f = n0 - 1024 + wy * 64 + jn * 16 + r;
          u32x2 o;
          o.x = pack2(acc[i][jn][0], acc[i][jn][1]);
          o.y = pack2(acc[i][jn][2], acc[i][jn][3]);
          *(u32x2*)(VT + ((size_t)(b * 1024 + f)) * KEYS + pos) = o;
        }
      }
    } else {
      const bool rope = even && (n0 < 1024 || (n0 >= 2048 && n0 < 3072)) && (m0 < ML);
      if (rope) {
#pragma unroll
        for (int jn = 0; jn < 4; ++jn) {
          const int m = m0 + wy * 64 + jn * 16 + r;
          const int t = m & 4095;
          const int grow = t >> 6, gcol = t & 63;
#pragma unroll
          for (int j = 0; j < 4; ++j) {
            const float2 a = cs[grow * 16 + 4 * q + j];
            const float2 c = cs[gcol * 16 + 4 * q + j];
            const float x0 = acc[0][jn][j], x1 = acc[1][jn][j], x2 = acc[2][jn][j], x3 = acc[3][jn][j];
            acc[0][jn][j] = x0 * a.x - x1 * a.y;
            acc[1][jn][j] = x1 * a.x + x0 * a.y;
            acc[2][jn][j] = x2 * c.x - x3 * c.y;
            acc[3][jn][j] = x3 * c.x + x2 * c.y;
          }
        }
      }
#pragma unroll
      for (int jn = 0; jn < 4; ++jn) {
        const int m = m0 + wy * 64 + jn * 16 + r;
#pragma unroll
        for (int i = 0; i < 4; ++i) {
          const int n = n0 + wx * 64 + i * 16 + 4 * q;
          u32x2 o;
          o.x = pack2(acc[i][jn][0], acc[i][jn][1]);
          o.y = pack2(acc[i][jn][2], acc[i][jn][3]);
          *(u32x2*)(proj + (size_t)m * ldp + n) = o;
        }
      }
    }
  }
}

DI void phase_gemm_out(const Params& p, int l, char* smem) {
  const int tid = opaque_tid(), lane = tid & 63, wid = tid >> 6, r = lane & 15, q = lane >> 4;
  const int wx = wid >> 1, wy = wid & 1;
  const bfr* WT = (const bfr*)(p.ws + OFF_WOUT + (size_t)l * SZ_WOUT);
  const bfr* U = (const bfr*)(p.ws + OFF_U);
  float* ybuf = (float*)(p.ws + OFF_PROJ);
  const int MT = (l == 3) ? (ML >> 7) : (MR >> 7);
  const int total = (((MT >> 3) + 7) >> 3) << 9;
  for (int T = blockIdx.x; T < total; T += gridDim.x) {
    int mt, nt;
    if (!tile_map(T, MT, 8, mt, nt)) continue;
    const int m0 = mt * 128, n0 = nt * 128;
    f32x4 acc[4][4];
#pragma unroll
    for (int i = 0; i < 4; ++i)
#pragma unroll
      for (int j = 0; j < 4; ++j) acc[i][j] = (f32x4){0.f, 0.f, 0.f, 0.f};
    gemm_mainloop(WT + (size_t)n0 * 2048, 2048, U + (size_t)m0 * 2048, 2048, 2048, smem, acc);
#pragma unroll
    for (int jn = 0; jn < 4; ++jn) {
      const int m = m0 + wy * 64 + jn * 16 + r;
#pragma unroll
      for (int i = 0; i < 4; ++i) {
        const int n = n0 + wx * 64 + i * 16 + 4 * q;
        *(f32x4*)(ybuf + (size_t)m * 1024 + n) = acc[i][jn];
      }
    }
  }
}

template <int DV, int QT, int KT, int MODE>
DI void attn_engine(const bfr* __restrict__ qbase, int ldq, const bfr* __restrict__ kbase, int ldk,
                    const bfr* __restrict__ vt, int nloc, int loc_row0, int loc_pos0, int nctx, int ctx_row0,
                    const float* rpb_s, int roff0, char* smem, f32x4 (&O)[DV / 16][QT], float (&lsum)[QT]) {
  constexpr int STAGE = 8192 + DV * 128;
  constexpr int NVL = DV / 32;
  const int tid = opaque_tid(), lane = tid & 63, wid = tid >> 6, r = lane & 15, q = lane >> 4;
  const int lr = tid >> 3, lc = tid & 7;
  constexpr float SC = 0.125f * L2E;

  bf16x8 Qf[QT][2];
#pragma unroll
  for (int qt = 0; qt < QT; ++qt)
#pragma unroll
    for (int s = 0; s < 2; ++s)
      Qf[qt][s] = *(const bf16x8*)(qbase + (size_t)(wid * 16 * QT + qt * 16 + r) * ldq + s * 32 + q * 8);
  float mrun[QT];
#pragma unroll
  for (int qt = 0; qt < QT; ++qt) {
    mrun[qt] = -1e30f;
    lsum[qt] = 0.f;
#pragma unroll
    for (int dt = 0; dt < DV / 16; ++dt) O[dt][qt] = (f32x4){0.f, 0.f, 0.f, 0.f};
  }

  const int nch = nloc + nctx;
  u32x4 kreg0, kreg1, vreg[NVL];
  const int ksw0 = sw128(lr, lc), ksw1 = sw128(lr + 32, lc);
#define AT_LOAD(c_)                                                                                          \
  {                                                                                                          \
    const int cc_ = (c_);                                                                                    \
    const int row_ = (cc_ < nloc) ? (loc_row0 + cc_ * 64) : (ctx_row0 + (cc_ - nloc) * 64);                  \
    const int pos_ = (cc_ < nloc) ? (loc_pos0 + cc_ * 64) : (4096 + (cc_ - nloc) * 64);                      \
    kreg0 = *(const u32x4*)(kbase + (size_t)(row_ + lr) * ldk + lc * 8);                                     \
    kreg1 = *(const u32x4*)(kbase + (size_t)(row_ + lr + 32) * ldk + lc * 8);                                \
    _Pragma("unroll") for (int i_ = 0; i_ < NVL; ++i_)                                                       \
        vreg[i_] = *(const u32x4*)(vt + (size_t)(lr + 32 * i_) * KEYS + pos_ + lc * 8);                      \
  }
#define AT_STORE(c_)                                                                                         \
  {                                                                                                          \
    char* sb_ = smem + ((c_) & 1) * STAGE;                                                                   \
    *(u32x4*)(sb_ + ksw0) = kreg0;                                                                           \
    *(u32x4*)(sb_ + ksw1) = kreg1;                                                                           \
    _Pragma("unroll") for (int i_ = 0; i_ < NVL; ++i_)                                                       \
        *(u32x4*)(sb_ + 8192 + sw128(lr + 32 * i_, lc)) = vreg[i_];                                          \
  }
  if (nch > 0) { AT_LOAD(0); AT_STORE(0); }
  for (int c = 0; c < nch; ++c) {
    __syncthreads();
    const bool more = (c + 1 < nch);
    const char* sK = smem + (c & 1) * STAGE;
    const char* sV = sK + 8192;
    if (more) AT_LOAD(c + 1);
#pragma unroll
    for (int sbk = 0; sbk < 4 / KT; ++sbk) {
      f32x4 st[KT][QT];
#pragma unroll
      for (int kt = 0; kt < KT; ++kt)
#pragma unroll
        for (int qt = 0; qt < QT; ++qt) st[kt][qt] = (f32x4){0.f, 0.f, 0.f, 0.f};
#pragma unroll
      for (int s = 0; s < 2; ++s)
#pragma unroll
        for (int kt = 0; kt < KT; ++kt) {
          const bf16x8 ka = *(const bf16x8*)(sK + sw128(sbk * KT * 16 + kt * 16 + r, s * 4 + q));
#pragma unroll
          for (int qt = 0; qt < QT; ++qt) st[kt][qt] = mfma16(ka, Qf[qt][s], st[kt][qt]);
        }
#pragma unroll
      for (int kt = 0; kt < KT; ++kt)
#pragma unroll
        for (int qt = 0; qt < QT; ++qt)
#pragma unroll
          for (int j = 0; j < 4; ++j) {
            float v = st[kt][qt][j] * SC;
            if (MODE == 1) {
              if (c < nloc) {
                const int kc = sbk * KT * 16 + kt * 16 + 4 * q + j;
                const int qc = wid * 16 + r;
                int wst = qc - 8; wst = wst < 0 ? 0 : (wst > 48 ? 48 : wst);
                const bool valid = (kc >= wst) && (kc < wst + 16);
                int co = kc - qc + 15; co = co < 0 ? 0 : (co > 30 ? 30 : co);
                const float bias = rpb_s[(roff0 + c) * 31 + co] * L2E;
                v = valid ? (v + bias) : -INFINITY;
              }
            }
            st[kt][qt][j] = v;
          }
      bf16x8 pb[KT / 2][QT];
#pragma unroll
      for (int qt = 0; qt < QT; ++qt) {
        float mx = -INFINITY;
#pragma unroll
        for (int kt = 0; kt < KT; ++kt)
#pragma unroll
          for (int j = 0; j < 4; ++j) mx = fmaxf(mx, st[kt][qt][j]);
        mx = fmaxf(mx, shx<16>(mx, lane));
        mx = fmaxf(mx, shx<32>(mx, lane));
        const float mnew = fmaxf(mrun[qt], mx);
        const float alpha = fexp2(mrun[qt] - mnew);
        mrun[qt] = mnew;
        float ps = 0.f;
#pragma unroll
        for (int kt = 0; kt < KT; ++kt)
#pragma unroll
          for (int j = 0; j < 4; ++j) {
            const float pv = fexp2(st[kt][qt][j] - mnew);
            st[kt][qt][j] = pv;
            ps += pv;
          }
        lsum[qt] = lsum[qt] * alpha + ps;
        if (__any(alpha != 1.f)) {
#pragma unroll
          for (int dt = 0; dt < DV / 16; ++dt) {
            O[dt][qt][0] *= alpha; O[dt][qt][1] *= alpha; O[dt][qt][2] *= alpha; O[dt][qt][3] *= alpha;
          }
        }
#pragma unroll
        for (int ks = 0; ks < KT / 2; ++ks) {
          u32x4 pk;
          pk.x = pack2(st[2 * ks][qt][0], st[2 * ks][qt][1]);
          pk.y = pack2(st[2 * ks][qt][2], st[2 * ks][qt][3]);
          pk.z = pack2(st[2 * ks + 1][qt][0], st[2 * ks + 1][qt][1]);
          pk.w = pack2(st[2 * ks + 1][qt][2], st[2 * ks + 1][qt][3]);
          pb[ks][qt] = __builtin_bit_cast(bf16x8, pk);
        }
      }
#pragma unroll
      for (int dt = 0; dt < DV / 16; ++dt)
#pragma unroll
        for (int ks = 0; ks < KT / 2; ++ks) {
          const bf16x8 va = *(const bf16x8*)(sV + sw128(dt * 16 + r, (sbk * (KT / 2) + ks) * 4 + q));
#pragma unroll
          for (int qt = 0; qt < QT; ++qt) O[dt][qt] = mfma16(va, pb[ks][qt], O[dt][qt]);
        }
    }
    if (more) AT_STORE(c + 1);
  }
#undef AT_LOAD
#undef AT_STORE
  __syncthreads();
#pragma unroll
  for (int qt = 0; qt < QT; ++qt) {
    float L = lsum[qt];
    L += shx<16>(L, lane);
    L += shx<32>(L, lane);
    lsum[qt] = L;
  }
}

DI void diff_attn_item(const Params& p, int l, int b, int head, int qrow0, bool ctxq, char* smem) {
  const int tid = opaque_tid(), lane = tid & 63, wid = tid >> 6, r = lane & 15, q = lane >> 4;
  const bfr* proj = (const bfr*)(p.ws + OFF_PROJ);
  const bfr* VT = (const bfr*)(p.ws + OFF_VT);
  bfr* U = (bfr*)(p.ws + OFF_U);
  const float* lamv = (const float*)(p.ws + OFF_LAM);
  const float lam = lamv[l >> 1], lam_init = lamv[2 + (l >> 1)];
  f32x4 O[8][2];
  float ls[2];
  char* parkb = smem + 49152 + tid * 16;
  attn_engine<128, 2, 2, 0>(proj + (size_t)qrow0 * NEV + 2048 + head * 128, NEV, proj + head * 128, NEV,
                            VT + (size_t)(b * 1024 + head * 128) * KEYS, ctxq ? 0 : 64, b * 4096, 0, 4,
                            ML + b * 256, nullptr, 0, smem, O, ls);
  u32x4 pkr0, pkr1;
  {
    const float i0 = 1.f / ls[0], i1 = 1.f / ls[1];
#pragma unroll
    for (int dt = 0; dt < 8; dt += 2) {
      u32x4 v0, v1;
      v0.x = pack2(O[dt][0][0] * i0, O[dt][0][1] * i0);
      v0.y = pack2(O[dt][0][2] * i0, O[dt][0][3] * i0);
      v0.z = pack2(O[dt + 1][0][0] * i0, O[dt + 1][0][1] * i0);
      v0.w = pack2(O[dt + 1][0][2] * i0, O[dt + 1][0][3] * i0);
      v1.x = pack2(O[dt][1][0] * i1, O[dt][1][1] * i1);
      v1.y = pack2(O[dt][1][2] * i1, O[dt][1][3] * i1);
      v1.z = pack2(O[dt + 1][1][0] * i1, O[dt + 1][1][1] * i1);
      v1.w = pack2(O[dt + 1][1][2] * i1, O[dt + 1][1][3] * i1);
      if (dt < 6) {
        *(u32x4*)(parkb + (dt / 2) * 4096) = v0;
        *(u32x4*)(parkb + (3 + dt / 2) * 4096) = v1;
      } else { pkr0 = v0; pkr1 = v1; }
    }
  }
  attn_engine<128, 2, 2, 0>(proj + (size_t)qrow0 * NEV + 2048 + head * 128 + 64, NEV, proj + head * 128 + 64, NEV,
                            VT + (size_t)(b * 1024 + head * 128) * KEYS, ctxq ? 0 : 64, b * 4096, 0, 4,
                            ML + b * 256, nullptr, 0, smem, O, ls);
  const float* subln = p.ev_subln + (l >> 1) * 128;
#pragma unroll
  for (int qt = 0; qt < 2; ++qt) {
    const float i1 = lam / ls[qt];
    float ss = 0.f;
#pragma unroll
    for (int dt = 0; dt < 8; ++dt) {
      unsigned pa, pc;
      if (dt < 6) {
        const u32x2 pk2 = *(const u32x2*)(parkb + (qt * 3 + dt / 2) * 4096 + (dt & 1) * 8);
        pa = pk2.x; pc = pk2.y;
      } else {
        const u32x4 pr = qt ? pkr1 : pkr0;
        pa = (dt & 1) ? pr.z : pr.x; pc = (dt & 1) ? pr.w : pr.y;
      }
      const float o0 = lo_bf(pa) - O[dt][qt][0] * i1;
      const float o1 = hi_bf(pa) - O[dt][qt][1] * i1;
      const float o2 = lo_bf(pc) - O[dt][qt][2] * i1;
      const float o3 = hi_bf(pc) - O[dt][qt][3] * i1;
      O[dt][qt][0] = o0; O[dt][qt][1] = o1; O[dt][qt][2] = o2; O[dt][qt][3] = o3;
      ss += o0 * o0 + o1 * o1 + o2 * o2 + o3 * o3;
    }
    ss += shx<16>(ss, lane);
    ss += shx<32>(ss, lane);
    const float rn = rsqrtf(ss * (1.f / 128.f) + 1e-6f) * (1.f - lam_init);
    const int row = qrow0 + wid * 32 + qt * 16 + r;
#pragma unroll
    for (int dt = 0; dt < 8; ++dt) {
      const int dv = dt * 16 + 4 * q;
      const u32x2 ag = *(const u32x2*)(proj + (size_t)row * NEV + 3072 + head * 128 + dv);
      const float4 sl = *(const float4*)(subln + dv);
      u32x2 o;
      o.x = pack2(O[dt][qt][0] * rn * sl.x * silu(lo_bf(ag.x)), O[dt][qt][1] * rn * sl.y * silu(hi_bf(ag.x)));
      o.y = pack2(O[dt][qt][2] * rn * sl.z * silu(lo_bf(ag.y)), O[dt][qt][3] * rn * sl.w * silu(hi_bf(ag.y)));
      *(u32x2*)(U + (size_t)row * 2048 + head * 128 + dv) = o;
    }
  }
}

DI void na_item(const Params& p, int l, int b, int head, int rho, bool ctxq, int cq0, char* smem) {
  const int tid = opaque_tid(), lane = tid & 63, wid = tid >> 6, r = lane & 15, q = lane >> 4;
  const bfr* proj = (const bfr*)(p.ws + OFF_PROJ);
  const bfr* VT = (const bfr*)(p.ws + OFF_VT);
  bfr* U = (bfr*)(p.ws + OFF_U);
  float* rpb_s = (float*)(smem + 2 * (8192 + 64 * 128));
  int rs = rho - 4; rs = rs < 0 ? 0 : (rs > 56 ? 56 : rs);
  const int qrow0 = ctxq ? (ML + b * 256 + cq0) : (b * 4096 + rho * 64);
  f32x4 O[4][1];
  float ls[1];
  if (!ctxq) {
    const float* rp = p.od_rpb + ((size_t)(l >> 1) * 16 + head) * 465;
    for (int i = tid; i < 465; i += 256) rpb_s[i] = rp[i];
    attn_engine<64, 1, 4, 1>(proj + (size_t)qrow0 * NOD + 3584 + head * 64, NOD, proj + head * 64, NOD,
                                VT + (size_t)(b * 1024 + head * 64) * KEYS, 8, b * 4096 + rs * 64, rs * 64, 4,
                                ML + b * 256, rpb_s, rs - rho + 7, smem, O, ls);
  } else {
    attn_engine<64, 1, 4, 0>(proj + (size_t)qrow0 * NOD + 3584 + head * 64, NOD, proj + head * 64, NOD,
                                VT + (size_t)(b * 1024 + head * 64) * KEYS, 0, 0, 0, 4, ML + b * 256, nullptr, 0,
                                smem, O, ls);
  }
  const float inv = 1.f / ls[0];
  const int row = qrow0 + wid * 16 + r;
#pragma unroll
  for (int dt = 0; dt < 4; ++dt) {
    const int dv = dt * 16 + 4 * q;
    const u32x2 cgv = *(const u32x2*)(proj + (size_t)row * NOD + 5120 + head * 64 + dv);
    u32x2 o;
    o.x = pack2(O[dt][0][0] * inv * silu(lo_bf(cgv.x)), O[dt][0][1] * inv * silu(hi_bf(cgv.x)));
    o.y = pack2(O[dt][0][2] * inv * silu(lo_bf(cgv.y)), O[dt][0][3] * inv * silu(hi_bf(cgv.y)));
    *(u32x2*)(U + (size_t)row * 2048 + head * 64 + dv) = o;
  }
}

DI void conv_item(const Params& p, int l, int item) {
  const int tid = opaque_tid();
  const bfr* proj = (const bfr*)(p.ws + OFF_PROJ);
  bfr* U = (bfr*)(p.ws + OFF_U);
  const float* cw = p.ev_conv + (size_t)(l >> 1) * 3 * 1024;
#pragma unroll 1
  for (int i = 0; i < 8; ++i) {
    const int v = tid + 256 * i;
    const int ri = v >> 7, ch = (v & 127) * 8;
    const int m = item * 16 + ri;
    int t, T;
    if (m < ML) { t = m & 4095; T = 4096; } else { t = (m - ML) & 255; T = 256; }
    const bfr* pr = proj + (size_t)m * NEV;
    float acc[8];
#pragma unroll
    for (int e = 0; e < 8; ++e) acc[e] = 0.f;
#pragma unroll
    for (int w = 0; w < 3; ++w) {
      const int tt = t + w - 1;
      if (tt >= 0 && tt < T) {
        const bfr* prw = pr + (ptrdiff_t)(w - 1) * NEV;
        const u32x4 bh = *(const u32x4*)(prw + 4096 + ch);
        const u32x4 bc = *(const u32x4*)(prw + 6144 + ch);
        const float4 w0 = *(const float4*)(cw + w * 1024 + ch);
        const float4 w1 = *(const float4*)(cw + w * 1024 + ch + 4);
        acc[0] += w0.x * lo_bf(bh.x) * lo_bf(bc.x); acc[1] += w0.y * hi_bf(bh.x) * hi_bf(bc.x);
        acc[2] += w0.z * lo_bf(bh.y) * lo_bf(bc.y); acc[3] += w0.w * hi_bf(bh.y) * hi_bf(bc.y);
        acc[4] += w1.x * lo_bf(bh.z) * lo_bf(bc.z); acc[5] += w1.y * hi_bf(bh.z) * hi_bf(bc.z);
        acc[6] += w1.z * lo_bf(bh.w) * lo_bf(bc.w); acc[7] += w1.w * hi_bf(bh.w) * hi_bf(bc.w);
      }
    }
    const u32x4 bb = *(const u32x4*)(pr + 5120 + ch);
    const u32x4 bg = *(const u32x4*)(pr + 7168 + ch);
    u32x4 o;
    o.x = pack2(lo_bf(bb.x) * acc[0] * silu(lo_bf(bg.x)), hi_bf(bb.x) * acc[1] * silu(hi_bf(bg.x)));
    o.y = pack2(lo_bf(bb.y) * acc[2] * silu(lo_bf(bg.y)), hi_bf(bb.y) * acc[3] * silu(hi_bf(bg.y)));
    o.z = pack2(lo_bf(bb.z) * acc[4] * silu(lo_bf(bg.z)), hi_bf(bb.z) * acc[5] * silu(hi_bf(bg.z)));
    o.w = pack2(lo_bf(bb.w) * acc[6] * silu(lo_bf(bg.w)), hi_bf(bb.w) * acc[7] * silu(hi_bf(bg.w)));
    *(u32x4*)(U + (size_t)m * 2048 + 1024 + ch) = o;
  }
}

DI void gla_item(const Params& p, int l, int item, char* smem) {
  const int tid0 = opaque_tid();
  const int slice = item & 7, dir = (item >> 3) & 1, head = (item >> 4) & 3, b = item >> 6;
  const int jl = l >> 1;
  const bfr* proj = (const bfr*)(p.ws + OFF_PROJ);
  char* sQb = smem;
  char* sKc = smem + 16384;
  char* sKbT = smem + 32768;
  char* sVt = smem + 49152;
  char* sAtt = smem + 53248;
  float* sLr = (float*)sAtt;
  float* sHs = (float*)(sAtt + 4096);
  char* sST = smem + 61440;
  float* sDec = (float*)(smem + 77824);

  unsigned gu[8];
  {
  const int d = tid0 & 127;
#pragma unroll
  for (int k = 0; k < 8; ++k)
    gu[k] = pack2(p.od_gate_up[(((size_t)jl * 2 + dir) * 16 + 2 * k) * 512 + head * 128 + d],
                  p.od_gate_up[(((size_t)jl * 2 + dir) * 16 + 2 * k + 1) * 512 + head * 128 + d]);
  }
  const float gbias = p.od_gate_bias[((size_t)jl * 2 + dir) * 512 + head * 128 + (tid0 & 127)];
  const float qscale = 0.08838834764831845f;

  f32x4 S[2][2];
#pragma unroll
  for (int a = 0; a < 2; ++a)
#pragma unroll
    for (int c2 = 0; c2 < 2; ++c2) S[a][c2] = (f32x4){0.f, 0.f, 0.f, 0.f};
  __syncthreads();
  for (int i = tid0; i < 512; i += 256) ((u32x4*)sST)[i] = (u32x4){0u, 0u, 0u, 0u};

  u32x4 pq0, pq1, pq2, pq3, pk0, pk1, pk2, pk3, pv;
  u32x2 plr;
#define GLA_ROW0(ci_) (((ci_) < 4) ? (ML + b * 256 + (dir ? (3 - (ci_)) : (ci_)) * 64) : (b * 4096 + (dir ? (67 - (ci_)) : ((ci_) - 4)) * 64))
#define GLA_LOAD(ci_)                                                                                         \
  {                                                                                                           \
    const int prow = tid >> 4, pch = tid & 15, vs = tid >> 2, vpart = tid & 3;                                \
    const bfr* pr_ = proj + (size_t)(GLA_ROW0(ci_) + prow) * NOD + head * 128 + pch * 8;                      \
    pq0 = *(const u32x4*)(pr_ + 4608);                     pk0 = *(const u32x4*)(pr_ + 2048);                 \
    pq1 = *(const u32x4*)(pr_ + 4608 + (size_t)16 * NOD);  pk1 = *(const u32x4*)(pr_ + 2048 + (size_t)16 * NOD); \
    pq2 = *(const u32x4*)(pr_ + 4608 + (size_t)32 * NOD);  pk2 = *(const u32x4*)(pr_ + 2048 + (size_t)32 * NOD); \
    pq3 = *(const u32x4*)(pr_ + 4608 + (size_t)48 * NOD);  pk3 = *(const u32x4*)(pr_ + 2048 + (size_t)48 * NOD); \
    const bfr* pv_ = proj + (size_t)(GLA_ROW0(ci_) + vs) * NOD;                                               \
    pv = *(const u32x4*)(pv_ + 2560 + head * 256 + slice * 32 + vpart * 8);                                   \
    plr = *(const u32x2*)(pv_ + 7168 + dir * 16 + vpart * 4);                                                 \
  }
  { const int tid = tid0; GLA_LOAD(0); }
  for (int ci = 0; ci < 68; ++ci) {
    int tid = tid0; asm volatile("" : "+v"(tid));
    const int lane = tid & 63, wid = tid >> 6, r = lane & 15, q = lane >> 4;
    const int d = tid & 127, half = tid >> 7;
    const int prow = tid >> 4, pch = tid & 15, vs = tid >> 2, vpart = tid & 3;
    const int row0 = GLA_ROW0(ci);
    const char* stc = sST + (ci & 1) * 8192;
    char* stn = sST + ((ci + 1) & 1) * 8192;
    __syncthreads();
    {
      *(u32x4*)(sQb + sw256(prow, pch)) = pq0;       *(u32x4*)(sKc + sw256(prow, pch)) = pk0;
      *(u32x4*)(sQb + sw256(prow + 16, pch)) = pq1;  *(u32x4*)(sKc + sw256(prow + 16, pch)) = pk1;
      *(u32x4*)(sQb + sw256(prow + 32, pch)) = pq2;  *(u32x4*)(sKc + sw256(prow + 32, pch)) = pk2;
      *(u32x4*)(sQb + sw256(prow + 48, pch)) = pq3;  *(u32x4*)(sKc + sw256(prow + 48, pch)) = pk3;
      *(u32x2*)((char*)sLr + vs * 32 + vpart * 8) = plr;
      const unsigned vv[4] = {pv.x, pv.y, pv.z, pv.w};
#pragma unroll
      for (int j = 0; j < 4; ++j) {
        const int e0 = vpart * 8 + 2 * j;
        *(bfr*)(sVt + sw128(e0, vs >> 3) + (vs & 7) * 2) = (bfr)(vv[j] & 0xffffu);
        *(bfr*)(sVt + sw128(e0 + 1, vs >> 3) + (vs & 7) * 2) = (bfr)(vv[j] >> 16);
      }
    }
    __syncthreads();
    float gl[32];
    float tot = 0.f;
#pragma unroll
    for (int i = 0; i < 32; ++i) {
      const int s = half * 32 + i;
      float z = gbias;
      {
        const u32x4 la = *(const u32x4*)((const char*)sLr + s * 32);
        const u32x4 lb = *(const u32x4*)((const char*)sLr + s * 32 + 16);
        z = dot2bf(la.x, gu[0], z); z = dot2bf(la.y, gu[1], z); z = dot2bf(la.z, gu[2], z); z = dot2bf(la.w, gu[3], z);
        z = dot2bf(lb.x, gu[4], z); z = dot2bf(lb.y, gu[5], z); z = dot2bf(lb.z, gu[6], z); z = dot2bf(lb.w, gu[7], z);
      }
      const float tneg = fexp2(-fabsf(z) * L2E);
      const float g = (fminf(z, 0.f) - flog2(1.f + tneg) * LN2) * (1.f / 16.f);
      gl[i] = g;
      tot += g;
    }
    if (dir == 0) {
      float run = 0.f;
#pragma unroll
      for (int i = 0; i < 32; ++i) { run += gl[i]; gl[i] = run; }
    } else {
      float run = 0.f;
#pragma unroll
      for (int i = 31; i >= 0; --i) { run += gl[i]; gl[i] = run; }
    }
    sHs[half * 128 + d] = tot;
    __syncthreads();
    const float other = sHs[(1 - half) * 128 + d];
    const float bend = tot + other;
    const float offs = (dir == 0) ? (half ? other : 0.f) : (half ? 0.f : other);
    const float dec = fexp2(bend * L2E);
    if (half == 0) sDec[d] = dec;
    {
#pragma unroll
      for (int i8 = 0; i8 < 4; ++i8) {
        unsigned kb[4];
#pragma unroll
        for (int ii = 0; ii < 8; ++ii) {
          const int i = i8 * 8 + ii;
          const int s = half * 32 + i;
          const float bb = (gl[i] + offs) * L2E;
          const float E = fexp2(bb), Ei = fexp2(-bb);
          bfr* qa_ = (bfr*)(sQb + sw256(s, d >> 3) + (d & 7) * 2);
          bfr* ka_ = (bfr*)(sKc + sw256(s, d >> 3) + (d & 7) * 2);
          const float qv = bf2f(*qa_) * qscale * E;
          const float kc = bf2f(*ka_) * Ei;
          *qa_ = f2bf(qv);
          *ka_ = f2bf(kc);
          const unsigned kbv = f2bf(kc * dec);
          if (ii & 1) kb[ii >> 1] |= kbv << 16; else kb[ii >> 1] = kbv;
        }
        *(u32x4*)(sKbT + sw128(d, half * 4 + i8)) = (u32x4){kb[0], kb[1], kb[2], kb[3]};
      }
    }
    __syncthreads();
    if (ci + 1 < 68) GLA_LOAD(ci + 1);
    {
      f32x4 at[4];
#pragma unroll
      for (int st = 0; st < 4; ++st) at[st] = (f32x4){0.f, 0.f, 0.f, 0.f};
#pragma unroll
      for (int ks = 0; ks < 4; ++ks) {
        const bf16x8 qa = *(const bf16x8*)(sQb + sw256(wid * 16 + r, ks * 4 + q));
#pragma unroll
        for (int st = 0; st < 4; ++st) {
          const bf16x8 kb2 = *(const bf16x8*)(sKc + sw256(st * 16 + r, ks * 4 + q));
          at[st] = mfma16(qa, kb2, at[st]);
        }
      }
#pragma unroll
      for (int st = 0; st < 4; ++st)
#pragma unroll
        for (int j = 0; j < 4; ++j) {
          const int t = wid * 16 + 4 * q + j, s = st * 16 + r;
          const bool keep = dir ? (s >= t) : (s <= t);
          *(bfr*)(sAtt + sw128(t, s >> 3) + (s & 7) * 2) = f2bf(keep ? at[st][j] : 0.f);
        }
    }
    __syncthreads();
    {
      f32x4 o[2];
      o[0] = (f32x4){0.f, 0.f, 0.f, 0.f};
      o[1] = (f32x4){0.f, 0.f, 0.f, 0.f};
#pragma unroll
      for (int ks = 0; ks < 4; ++ks) {
        const bf16x8 qa = *(const bf16x8*)(sQb + sw256(wid * 16 + r, ks * 4 + q));
#pragma unroll
        for (int et = 0; et < 2; ++et) {
          const bf16x8 sb2 = *(const bf16x8*)(stc + sw256(et * 16 + r, ks * 4 + q));
          o[et] = mfma16(qa, sb2, o[et]);
        }
      }
#pragma unroll
      for (int ks = 0; ks < 2; ++ks) {
        const bf16x8 aa = *(const bf16x8*)(sAtt + sw128(wid * 16 + r, ks * 4 + q));
#pragma unroll
        for (int et = 0; et < 2; ++et) {
          const bf16x8 vb = *(const bf16x8*)(sVt + sw128(et * 16 + r, ks * 4 + q));
          o[et] = mfma16(aa, vb, o[et]);
        }
      }
      {
        const int lam = head * 8 + slice;
#pragma unroll
        for (int j = 0; j < 4; ++j) {
          const int row = row0 + wid * 16 + 4 * q + j;
          const int m2 = row >> 1, par = row & 1;
          bfr* lp = dir ? ((bfr*)(p.ws + OFF_H) + ((size_t)m2 * 32 + lam) * 64)
                        : ((bfr*)(p.ws + OFF_U) + (size_t)(2 * m2 + (lam >> 4)) * 2048 + 1024 + (lam & 15) * 64);
#pragma unroll
          for (int et = 0; et < 2; ++et) lp[par * 32 + et * 16 + r] = f2bf(o[et][j]);
        }
      }
    }
    {
#pragma unroll
      for (int dti = 0; dti < 2; ++dti) {
        const float dc = sDec[(2 * wid + dti) * 16 + r];
#pragma unroll
        for (int et = 0; et < 2; ++et) {
          S[et][dti][0] *= dc; S[et][dti][1] *= dc; S[et][dti][2] *= dc; S[et][dti][3] *= dc;
        }
      }
#pragma unroll
      for (int ks = 0; ks < 2; ++ks) {
        bf16x8 va[2], kb2[2];
#pragma unroll
        for (int et = 0; et < 2; ++et) va[et] = *(const bf16x8*)(sVt + sw128(et * 16 + r, ks * 4 + q));
#pragma unroll
        for (int dti = 0; dti < 2; ++dti) kb2[dti] = *(const bf16x8*)(sKbT + sw128((2 * wid + dti) * 16 + r, ks * 4 + q));
#pragma unroll
        for (int et = 0; et < 2; ++et)
#pragma unroll
          for (int dti = 0; dti < 2; ++dti) S[et][dti] = mfma16(va[et], kb2[dti], S[et][dti]);
      }
#pragma unroll
      for (int et = 0; et < 2; ++et)
#pragma unroll
        for (int dti = 0; dti < 2; ++dti)
#pragma unroll
          for (int j = 0; j < 4; ++j) {
            const int e = et * 16 + 4 * q + j, dd = (2 * wid + dti) * 16 + r;
            *(bfr*)(stn + sw256(e, dd >> 3) + (dd & 7) * 2) = f2bf(S[et][dti][j]);
          }
    }
  }
#undef GLA_LOAD
#undef GLA_ROW0
  __syncthreads();
}

DI void phase_gla_combine(const Params& p, int l) {
  const int tid = opaque_tid(), lane = tid & 63, wid = tid >> 6;
  const bfr* proj = (const bfr*)(p.ws + OFF_PROJ);
  const bfr* OB = (const bfr*)(p.ws + OFF_H);
  bfr* U = (bfr*)(p.ws + OFF_U);
  const int h = lane >> 4, e16 = (lane & 15) * 16;
  const int lam = h * 8 + ((lane & 15) >> 1), ein = (lane & 1) * 16;
  const float* gn = p.od_gnorm + (l >> 1) * 256 + e16;
  for (int m2 = blockIdx.x * 4 + wid; m2 < MR / 2; m2 += gridDim.x * 4) {
    const bfr* ofl = U + (size_t)(2 * m2 + (lam >> 4)) * 2048 + 1024 + (lam & 15) * 64 + ein;
    const bfr* obl = OB + ((size_t)m2 * 32 + lam) * 64 + ein;
    u32x4 a[2][2], bq[2][2], g[2][2];
#pragma unroll
    for (int par = 0; par < 2; ++par) {
      a[par][0] = *(const u32x4*)(ofl + par * 32);  a[par][1] = *(const u32x4*)(ofl + par * 32 + 8);
      bq[par][0] = *(const u32x4*)(obl + par * 32); bq[par][1] = *(const u32x4*)(obl + par * 32 + 8);
      const bfr* gp = proj + (size_t)(2 * m2 + par) * NOD + 6144 + h * 256 + e16;
      g[par][0] = *(const u32x4*)gp; g[par][1] = *(const u32x4*)(gp + 8);
    }
    u32x4 res[2][2];
#pragma unroll
    for (int par = 0; par < 2; ++par) {
      float o[16], dg[16];
      float ss = 0.f;
#pragma unroll
      for (int hv = 0; hv < 2; ++hv)
#pragma unroll
        for (int i = 0; i < 4; ++i) {
          const unsigned av = a[par][hv][i], bv = bq[par][hv][i], gv = g[par][hv][i];
          const int k = hv * 8 + i * 2;
          o[k] = lo_bf(av) + lo_bf(bv); o[k + 1] = hi_bf(av) + hi_bf(bv);
          dg[k] = lo_bf(gv); dg[k + 1] = hi_bf(gv);
          ss += o[k] * o[k] + o[k + 1] * o[k + 1];
        }
      ss += shx<1>(ss, lane); ss += shx<2>(ss, lane); ss += shx<4>(ss, lane); ss += shx<8>(ss, lane);
      const float rn = rsqrtf(ss * (1.f / 256.f) + 1e-6f);
#pragma unroll
      for (int hv = 0; hv < 2; ++hv)
#pragma unroll
        for (int i = 0; i < 4; ++i) {
          const int k = hv * 8 + i * 2;
          res[par][hv][i] = pack2(o[k] * rn * gn[k] * silu(dg[k]), o[k + 1] * rn * gn[k + 1] * silu(dg[k + 1]));
        }
    }
#pragma unroll
    for (int par = 0; par < 2; ++par) {
      bfr* up = U + (size_t)(2 * m2 + par) * 2048 + 1024 + h * 256 + e16;
      *(u32x4*)up = res[par][0];
      *(u32x4*)(up + 8) = res[par][1];
    }
  }
}

DI int next_item(int* ctr, int* slot) {
  __syncthreads();
  if (threadIdx.x == 0) *slot = atomicAdd(ctr, 1);
  __syncthreads();
  return *slot;
}

DI void phase_mix_even(const Params& p, int l, int g, char* smem) {
  int* ctr = (int*)(p.ws + OFF_CTR) + (g * 4 + l);
  int* slot = (int*)(smem + SMEM_BYTES - 16);
  const int N_LAT = GB * 8 * 32, N_CTX = GB * 8 * 2, N_CONV = MR / 16;
  const int total = N_LAT + N_CTX + N_CONV;
  for (;;) {
    int it = next_item(ctr, slot);
    if (it >= total) break;
    if (it < N_LAT) {
      const int x = it & 7, li = it >> 3;
      const int qb = li & 31, b = li >> 5;
      diff_attn_item(p, l, b, x, b * 4096 + qb * 128, false, smem);
    } else if (it < N_LAT + N_CTX) {
      it -= N_LAT;
      const int qb = it & 1, head = (it >> 1) & 7, b = it >> 4;
      diff_attn_item(p, l, b, head, ML + b * 256 + qb * 128, true, smem);
    } else {
      conv_item(p, l, it - N_LAT - N_CTX);
    }
  }
}

DI void phase_mix_odd(const Params& p, int l, int g, char* smem) {
  int* ctr = (int*)(p.ws + OFF_CTR) + (g * 4 + l);
  int* slot = (int*)(smem + SMEM_BYTES - 16);
  const int N_GLA = GB * 4 * 2 * 8, N_NA = GB * 16 * 64, N_CTX = (l == 3) ? 0 : GB * 16 * 4;
  const int total = N_GLA + N_NA + N_CTX;
  (void)ctr; (void)slot;
  for (int it0 = blockIdx.x; it0 < total; it0 += gridDim.x) {
    int it = it0;
    __syncthreads();
    if (it < N_GLA) {
      gla_item(p, l, it, smem);
    } else if (it < N_GLA + N_NA) {
      it -= N_GLA;
      const int rho = it & 63, bh = it >> 6;
      na_item(p, l, bh >> 4, bh & 15, rho, false, 0, smem);
    } else {
      it -= N_GLA + N_NA;
      const int qb = it & 3, bh = it >> 2;
      na_item(p, l, bh >> 4, bh & 15, 0, true, qb * 64, smem);
    }
  }
}


typedef const __attribute__((address_space(4))) Params* KParamsPtr;
DI Params load_params() {
#if defined(__HIP_DEVICE_COMPILE__)
  KParamsPtr kp = (KParamsPtr)__builtin_amdgcn_kernarg_segment_ptr();
  asm volatile("" : "+s"(kp));
  Params r;
  __builtin_memcpy(&r, kp, sizeof(Params));
  return r;
#else
  return Params{};
#endif
}
#define PH(call) { const Params p = load_params(); call; }
__global__ void __launch_bounds__(256, 2) mega_kernel(Params p_unused) {
  extern __shared__ __attribute__((aligned(16))) char smem[];
  cg::grid_group grid = cg::this_grid();
  PH(phase0(p, smem));
  grid.sync();
#pragma unroll 1
  for (int g = 0; g < NGRP; ++g) {
#pragma unroll 1
    for (int l = 0; l < 4; ++l) {
      PH(phase_norm(p, l, g));
      grid.sync();
      PH(phase_gemm_in(p, l, smem));
      grid.sync();
      if (l & 1) {
        PH(phase_mix_odd(p, l, g, smem));
        grid.sync();
        PH(phase_gla_combine(p, l));
      } else {
        PH(phase_mix_even(p, l, g, smem));
      }
      grid.sync();
      PH(phase_gemm_out(p, l, smem));
      grid.sync();
    }
    PH(phase_norm(p, 4, g));
    grid.sync();
  }
}

extern "C" void kernel_launch(void* const* d_in, const int* in_sizes, int n_in, void* d_out, int out_size, void* d_ws,
                              size_t ws_size, hipStream_t stream) {
  static int grid_blocks = 0;
  if (!grid_blocks) {
    int dev = 0, cus = 0, per_cu = 0;
    hipGetDevice(&dev);
    hipDeviceGetAttribute(&cus, hipDeviceAttributeMultiprocessorCount, dev);
    hipFuncSetAttribute((const void*)mega_kernel, hipFuncAttributeMaxDynamicSharedMemorySize, SMEM_BYTES);
    hipOccupancyMaxActiveBlocksPerMultiprocessor(&per_cu, mega_kernel, 256, SMEM_BYTES);
    if (per_cu > 2) per_cu = 2;
    if (per_cu < 1) per_cu = 1;
    grid_blocks = cus * per_cu;
    grid_blocks &= ~7;
  }
  if (ws_size < WS_NEED) { fprintf(stderr, "workspace too small: %zu < %zu\n", ws_size, (size_t)WS_NEED); return; }
  Params p{};
  p.x = (const float*)d_in[0]; p.c = (const float*)d_in[1]; p.ctx = (const float*)d_in[2]; p.c_ctx = (const float*)d_in[3];
  p.w_mod = (const float*)d_in[4]; p.b_mod = (const float*)d_in[5]; p.g_pre = (const float*)d_in[6]; p.g_post = (const float*)d_in[7];
  p.w_out = (const float*)d_in[8]; p.ev_w_in = (const float*)d_in[9]; p.ev_lambda = (const float*)d_in[10]; p.ev_subln = (const float*)d_in[11];
  p.ev_conv = (const float*)d_in[12]; p.od_w_in = (const float*)d_in[13]; p.od_rpb = (const float*)d_in[14]; p.od_gate_up = (const float*)d_in[15];
  p.od_gate_bias = (const float*)d_in[16]; p.od_gnorm = (const float*)d_in[17];
  p.out = (float*)d_out;
  p.ws = (char*)d_ws;
  void* args[] = {&p};
  hipError_t e = hipLaunchCooperativeKernel((const void*)mega_kernel, dim3(grid_blocks), dim3(256), args, SMEM_BYTES, stream);
  if (e != hipSuccess) fprintf(stderr, "cooperative launch failed: %s (grid %d)\n", hipGetErrorString(e), grid_blocks);
}
```

```cpp
#include <hip/hip_runtime.h>
#include <hip/hip_cooperative_groups.h>
#include <cstdio>
namespace cg = cooperative_groups;

typedef unsigned short bfr;
typedef __attribute__((ext_vector_type(8))) short bf16x8;
typedef __attribute__((ext_vector_type(4))) float f32x4;
typedef __attribute__((ext_vector_type(4))) unsigned u32x4;
typedef __attribute__((ext_vector_type(2))) unsigned u32x2;
typedef __attribute__((ext_vector_type(16))) unsigned u32x16;
typedef __attribute__((ext_vector_type(2))) __bf16 bf16x2_t;
#define DI __device__ __forceinline__
DI float dot2bf(unsigned a, unsigned b, float c) { return __builtin_amdgcn_fdot2_f32_bf16(__builtin_bit_cast(bf16x2_t, a), __builtin_bit_cast(bf16x2_t, b), c, false); }
DI int opaque_tid() { int t = threadIdx.x; asm volatile("" : "+v"(t)); return t; }

constexpr int GB   = 4;
constexpr int NGRP = 2;
constexpr int ML   = GB * 4096;
constexpr int MC   = GB * 256;
constexpr int MR   = ML + MC;
constexpr int NEV  = 8192;
constexpr int NOD  = 7296;
constexpr int KEYS = 4352;
constexpr float L2E = 1.4426950408889634f;
constexpr float LN2 = 0.6931471805599453f;

constexpr size_t SZ_PROJ = (size_t)MR * 8192 * 2;
constexpr size_t SZ_H    = (size_t)MR * 1024 * 2;
constexpr size_t SZ_U    = (size_t)MR * 2048 * 2;
constexpr size_t SZ_VT   = (size_t)GB * 1024 * KEYS * 2;
constexpr size_t SZ_WE   = (size_t)NEV * 1024 * 2;
constexpr size_t SZ_WO   = (size_t)NOD * 1024 * 2;
constexpr size_t SZ_WOUT = (size_t)1024 * 2048 * 2;
constexpr size_t OFF_PROJ = 0;
constexpr size_t OFF_H    = OFF_PROJ + SZ_PROJ;
constexpr size_t OFF_U    = OFF_H + SZ_H;
constexpr size_t OFF_VT   = OFF_U + SZ_U;
constexpr size_t OFF_WIN  = OFF_VT + SZ_VT;
constexpr size_t OFF_WOUT = OFF_WIN + 2 * SZ_WE + 2 * SZ_WO;
constexpr size_t OFF_XC   = OFF_WOUT + 4 * SZ_WOUT;
constexpr size_t OFF_MOD  = OFF_XC + (size_t)8 * 256 * 1024 * 4;
constexpr size_t OFF_CS   = OFF_MOD + (size_t)4 * 9 * 3072 * 4;
constexpr size_t OFF_LAM  = OFF_CS + 64 * 16 * 8;
constexpr size_t OFF_CTR  = OFF_LAM + 256;
constexpr size_t OFF_BAR  = OFF_CTR + 256;
constexpr size_t BAR_BYTES = 34 * 256;
constexpr size_t WS_NEED  = OFF_BAR + BAR_BYTES;

constexpr int SMEM_BYTES = 80896;

struct Params {
  const float *x, *c, *ctx, *c_ctx, *w_mod, *b_mod, *g_pre, *g_post, *w_out, *ev_w_in, *ev_lambda, *ev_subln,
      *ev_conv, *od_w_in, *od_rpb, *od_gate_up, *od_gate_bias, *od_gnorm;
  float* out;
  char* ws;
};

DI size_t win_off(int l) { return OFF_WIN + (size_t)(l >> 1) * (SZ_WE + SZ_WO) + ((l & 1) ? SZ_WE : 0); }

DI float bf2f(bfr v) { return __uint_as_float(((unsigned)v) << 16); }
typedef __attribute__((ext_vector_type(2))) float f32x2_t;
DI bfr f2bf(float x) { return __builtin_bit_cast(bfr, (__bf16)x); }
DI unsigned pack2(float a, float b) { f32x2_t v = {a, b}; return __builtin_bit_cast(unsigned, __builtin_convertvector(v, bf16x2_t)); }
DI float lo_bf(unsigned u) { return __uint_as_float(u << 16); }
DI float hi_bf(unsigned u) { return __uint_as_float(u & 0xffff0000u); }
DI float fexp2(float x) { return __builtin_amdgcn_exp2f(x); }
DI float flog2(float x) { return __builtin_amdgcn_logf(x); }
DI float silu(float x) { return x / (1.f + fexp2(-x * L2E)); }
template <int M>
DI float shx(float v, int lane) {
  if (M < 32) return __builtin_bit_cast(float, __builtin_amdgcn_ds_swizzle(__builtin_bit_cast(int, v), (M << 10) | 0x1f));
  return __builtin_bit_cast(float, __builtin_amdgcn_ds_bpermute((lane ^ 32) << 2, __builtin_bit_cast(int, v)));
}
DI float wave_sum(float v, int lane) {
  v += shx<1>(v, lane); v += shx<2>(v, lane); v += shx<4>(v, lane); v += shx<8>(v, lane); v += shx<16>(v, lane); v += shx<32>(v, lane);
  return v;
}
DI f32x4 mfma16(bf16x8 a, bf16x8 b, f32x4 c) { return __builtin_amdgcn_mfma_f32_16x16x32_bf16(a, b, c, 0, 0, 0); }
DI int sw128(int row, int chunk) { return row * 128 + ((chunk ^ ((row >> 1) & 7)) << 4); }
DI int sw256(int row, int chunk) { return row * 256 + ((chunk ^ (row & 15)) << 4); }

DI void gemm_mainloop(const bfr* __restrict__ X, int ldx, const bfr* __restrict__ Y, int ldy, int K, char* smem,
                      f32x4 (&acc)[4][4]) {
  const int tid = opaque_tid(), lane = tid & 63, wid = tid >> 6, r = lane & 15, q = lane >> 4;
  const int wx = wid >> 1, wy = wid & 1;
  const int lr = tid >> 3, lc = tid & 7;
  const bfr* xp = X + (size_t)lr * ldx + lc * 8;
  const bfr* yp = Y + (size_t)lr * ldy + lc * 8;
  u32x4 xa0[4], ya0[4], xa1[4], ya1[4];
#pragma unroll
  for (int i = 0; i < 4; ++i) {
    xa0[i] = *(const u32x4*)(xp + (size_t)(32 * i) * ldx);
    ya0[i] = *(const u32x4*)(yp + (size_t)(32 * i) * ldy);
  }
#pragma unroll
  for (int i = 0; i < 4; ++i) {
    xa1[i] = *(const u32x4*)(xp + (size_t)(32 * i) * ldx + 64);
    ya1[i] = *(const u32x4*)(yp + (size_t)(32 * i) * ldy + 64);
  }
  const int nk = K >> 6;
#define GEMM_STEP(XR, YR, BUF, KT)                                                                       \
  {                                                                                                      \
    char* sX = smem + (BUF) * 32768;                                                                     \
    char* sY = sX + 16384;                                                                               \
    _Pragma("unroll") for (int i = 0; i < 4; ++i) {                                                      \
      *(u32x4*)(sX + sw128(lr + 32 * i, lc)) = XR[i];                                                    \
      *(u32x4*)(sY + sw128(lr + 32 * i, lc)) = YR[i];                                                    \
    }                                                                                                    \
    __syncthreads();                                                                                     \
    if ((KT) + 2 < nk) {                                                                                 \
      const int ko = ((KT) + 2) * 64;                                                                    \
      _Pragma("unroll") for (int i = 0; i < 4; ++i) {                                                    \
        XR[i] = *(const u32x4*)(xp + (size_t)(32 * i) * ldx + ko);                                       \
        YR[i] = *(const u32x4*)(yp + (size_t)(32 * i) * ldy + ko);                                       \
      }                                                                                                  \
    }                                                                                                    \
    _Pragma("unroll") for (int s = 0; s < 2; ++s) {                                                      \
      bf16x8 xf[4], yf[4];                                                                               \
      _Pragma("unroll") for (int i = 0; i < 4; ++i)                                                      \
          xf[i] = *(const bf16x8*)(sX + sw128(wx * 64 + i * 16 + r, s * 4 + q));                         \
      _Pragma("unroll") for (int j = 0; j < 4; ++j)                                                      \
          yf[j] = *(const bf16x8*)(sY + sw128(wy * 64 + j * 16 + r, s * 4 + q));                         \
      _Pragma("unroll") for (int i = 0; i < 4; ++i)                                                      \
          _Pragma("unroll") for (int j = 0; j < 4; ++j) acc[i][j] = mfma16(xf[i], yf[j], acc[i][j]);     \
    }                                                                                                    \
  }
  for (int kt = 0; kt < nk; kt += 2) {
    GEMM_STEP(xa0, ya0, 0, kt);
    GEMM_STEP(xa1, ya1, 1, kt + 1);
  }
#undef GEMM_STEP
  __syncthreads();
}

DI bool tile_map(int T, int MT, int NT, int& mt, int& nt) {
  const int pm_n = MT >> 3;
  const int P = (T >> 9) * 8 + (T & 7);
  const int li = (T & 511) >> 3;
  const int pm = P % pm_n, pn = P / pm_n;
  mt = pm * 8 + (li & 7);
  nt = pn * 8 + (li >> 3);
  return nt < NT;
}

DI int odd_col_src(int n) {
  if (n < 3584) return n;
  if (n < 7168) return n + 32;
  if (n < 7200) return n - 7168 + 3584;
  return -1;
}

DI void phase0(const Params& p, char* smem) {
  const int tid = opaque_tid();
  if (blockIdx.x < 384) {
    float* sc = (float*)smem;
    float* red = sc + 9 * 1024;
    for (int i = tid; i < 9 * 1024; i += 256) {
      const int b = i >> 10, k = i & 1023;
      const float v = (b < 8) ? p.c[b * 1024 + k] : p.c_ctx[k];
      sc[i] = v / (1.f + __expf(-v));
    }
    __syncthreads();
    float* modb = (float*)(p.ws + OFF_MOD);
    for (int it = blockIdx.x; it < 384; it += gridDim.x) {
      const int l = it / 96, cgp = it % 96;
      const int col = cgp * 32 + (tid & 31), ks = tid >> 5;
      float a[9];
#pragma unroll
      for (int b = 0; b < 9; ++b) a[b] = 0.f;
      const float* w = p.w_mod + ((size_t)l * 1024 + ks * 128) * 3072 + col;
#pragma unroll 4
      for (int k = 0; k < 128; ++k) {
        const float wv = w[(size_t)k * 3072];
#pragma unroll
        for (int b = 0; b < 9; ++b) a[b] += sc[b * 1024 + ks * 128 + k] * wv;
      }
#pragma unroll
      for (int b = 0; b < 9; ++b) red[(ks * 9 + b) * 32 + (tid & 31)] = a[b];
      __syncthreads();
      for (int idx = tid; idx < 288; idx += 256) {
        const int b = idx >> 5, cc = idx & 31;
        float s = p.b_mod[l * 3072 + cgp * 32 + cc];
#pragma unroll
        for (int k2 = 0; k2 < 8; ++k2) s += red[(k2 * 9 + b) * 32 + cc];
        modb[(size_t)(l * 9 + b) * 3072 + cgp * 32 + cc] = s;
      }
      __syncthreads();
    }
  }
  if (blockIdx.x == gridDim.x - 1) {
    float2* cs = (float2*)(p.ws + OFF_CS);
    for (int idx = tid; idx < 1024; idx += 256) {
      const int pos = idx >> 4, f = idx & 15;
      const float inv = 1.0f / powf(10000.f, (float)f * 0.0625f);
      const float ang = (float)pos * inv;
      const double ad = (double)ang;
      const double n = rint(ad * 0.15915494309189535);
      const float rr = (float)(ad - n * 6.283185307179586);
      cs[idx] = make_float2(__cosf(rr), __sinf(rr));
    }
    if (tid < 2) {
      const float* lp = p.ev_lambda + tid * 256;
      float s1 = 0.f, s2 = 0.f;
      for (int i = 0; i < 64; ++i) { s1 += lp[i] * lp[64 + i]; s2 += lp[128 + i] * lp[192 + i]; }
      const float li = (tid == 0) ? 0.2f : (0.8f - 0.6f * 0.5488116360940264f);
      float* lam = (float*)(p.ws + OFF_LAM);
      lam[tid] = __expf(s1) - __expf(s2) + li;
      lam[2 + tid] = li;
    }
    if (tid < 32) ((int*)(p.ws + OFF_CTR))[tid] = 0;
  }
  float* tile = (float*)smem;
  __syncthreads();
  for (int it = blockIdx.x; it < 9792; it += gridDim.x) {
    int rr = it, l, ktile, ntile, K, Nsrc;
    const float* src;
    bfr* dst;
    bool oddmap = false;
    if (rr < 7744) {
      if (rr < 2048) { l = 0; } else if (rr < 3872) { l = 1; rr -= 2048; } else if (rr < 5920) { l = 2; rr -= 3872; } else { l = 3; rr -= 5920; }
      ktile = rr & 15; ntile = rr >> 4; K = 1024;
      oddmap = (l & 1);
      Nsrc = oddmap ? 7200 : 8192;
      src = (oddmap ? p.od_w_in : p.ev_w_in) + (size_t)(l >> 1) * 1024 * Nsrc;
      dst = (bfr*)(p.ws + win_off(l));
    } else {
      rr -= 7744; l = rr >> 9; rr &= 511;
      ktile = rr & 31; ntile = rr >> 5; K = 2048; Nsrc = 1024;
      src = p.w_out + (size_t)l * 2048 * 1024;
      dst = (bfr*)(p.ws + OFF_WOUT + (size_t)l * SZ_WOUT);
    }
    const int k0 = ktile * 64, n0 = ntile * 64;
    {
      const int nn = tid & 63;
      const int nd = n0 + nn;
      const int ns = oddmap ? odd_col_src(nd) : nd;
#pragma unroll 4
      for (int i = 0; i < 16; ++i) {
        const int kk = (tid >> 6) + 4 * i;
        tile[kk * 65 + nn] = (ns >= 0) ? src[(size_t)(k0 + kk) * Nsrc + ns] : 0.f;
      }
    }
    __syncthreads();
    {
      const int kk8 = (tid & 7) * 8;
#pragma unroll
      for (int i2 = 0; i2 < 2; ++i2) {
        const int nn = (tid >> 3) + 32 * i2;
        u32x4 v;
        v.x = pack2(tile[(kk8 + 0) * 65 + nn], tile[(kk8 + 1) * 65 + nn]);
        v.y = pack2(tile[(kk8 + 2) * 65 + nn], tile[(kk8 + 3) * 65 + nn]);
        v.z = pack2(tile[(kk8 + 4) * 65 + nn], tile[(kk8 + 5) * 65 + nn]);
        v.w = pack2(tile[(kk8 + 6) * 65 + nn], tile[(kk8 + 7) * 65 + nn]);
        *(u32x4*)(dst + (size_t)(n0 + nn) * K + k0 + kk8) = v;
      }
    }
    __syncthreads();
  }
}

DI void phase_norm(const Params& p, int l, int g) {
  const int tid = opaque_tid(), lane = tid & 63, wid = tid >> 6;
  const int rows = (l == 4) ? ML : MR;
  const float* modb = (const float*)(p.ws + OFF_MOD);
  const bfr* ybuf = (const bfr*)(p.ws + OFF_PROJ);
  bfr* hbuf = (bfr*)(p.ws + OFF_H);
  float* xcb = (float*)(p.ws + OFF_XC);
  for (int row = blockIdx.x * 4 + wid; row < rows; row += gridDim.x * 4) {
    const bool lat = row < ML;
    const int mb = lat ? (g * GB + (row >> 12)) : 8;
    const size_t grow = lat ? ((size_t)g * ML + row) : ((size_t)g * MC + (row - ML));
    const float* xin;
    float* xst;
    if (lat) { xin = ((l <= 1) ? p.x : (const float*)p.out) + grow * 1024; xst = p.out + grow * 1024; }
    else     { xin = ((l <= 1) ? p.ctx : (const float*)xcb) + grow * 1024; xst = xcb + grow * 1024; }
    float4 xv[4];
#pragma unroll
    for (int i = 0; i < 4; ++i) xv[i] = *(const float4*)(xin + lane * 4 + 256 * i);
    if (l >= 1) {
      float4 yv[4];
      float ss = 0.f;
#pragma unroll
      for (int i = 0; i < 4; ++i) {
        const u32x2 yr = *(const u32x2*)(ybuf + (size_t)row * 1024 + lane * 4 + 256 * i);
        yv[i] = make_float4(lo_bf(yr.x), hi_bf(yr.x), lo_bf(yr.y), hi_bf(yr.y));
        ss += yv[i].x * yv[i].x + yv[i].y * yv[i].y + yv[i].z * yv[i].z + yv[i].w * yv[i].w;
      }
      ss = wave_sum(ss, lane);
      const float rn = rsqrtf(ss * (1.f / 1024.f) + 1e-6f);
      const float* gate = modb + (size_t)((l - 1) * 9 + mb) * 3072 + 2048;
      const float* gp = p.g_post + (l - 1) * 1024;
#pragma unroll
      for (int i = 0; i < 4; ++i) {
        const int c0 = lane * 4 + 256 * i;
        const float4 gt = *(const float4*)(gate + c0);
        const float4 gg = *(const float4*)(gp + c0);
        xv[i].x += gt.x * (yv[i].x * rn * gg.x);
        xv[i].y += gt.y * (yv[i].y * rn * gg.y);
        xv[i].z += gt.z * (yv[i].z * rn * gg.z);
        xv[i].w += gt.w * (yv[i].w * rn * gg.w);
        *(float4*)(xst + c0) = xv[i];
      }
    }
    if (l < 4) {
      float ss = 0.f;
#pragma unroll
      for (int i = 0; i < 4; ++i) ss += xv[i].x * xv[i].x + xv[i].y * xv[i].y + xv[i].z * xv[i].z + xv[i].w * xv[i].w;
      ss = wave_sum(ss, lane);
      const float rn = rsqrtf(ss * (1.f / 1024.f) + 1e-6f);
      const float* mrow = modb + (size_t)(l * 9 + mb) * 3072;
      const float* gpre = p.g_pre + l * 1024;
#pragma unroll
      for (int i = 0; i < 4; ++i) {
        const int c0 = lane * 4 + 256 * i;
        const float4 sh = *(const float4*)(mrow + c0);
        const float4 scl = *(const float4*)(mrow + 1024 + c0);
        const float4 gg = *(const float4*)(gpre + c0);
        u32x2 o;
        o.x = pack2(xv[i].x * rn * gg.x * (1.f + scl.x) + sh.x, xv[i].y * rn * gg.y * (1.f + scl.y) + sh.y);
        o.y = pack2(xv[i].z * rn * gg.z * (1.f + scl.z) + sh.z, xv[i].w * rn * gg.w * (1.f + scl.w) + sh.w);
        *(u32x2*)(hbuf + (size_t)row * 1024 + c0) = o;
      }
    }
  }
}

DI void phase_gemm_in(const Params& p, int l, char* smem) {
  const int tid = opaque_tid(), lane = tid & 63, wid = tid >> 6, r = lane & 15, q = lane >> 4;
  const int wx = wid >> 1, wy = wid & 1;
  const bool even = !(l & 1);
  const int ldp = even ? NEV : NOD;
  const int NT = ldp >> 7, MT = MR >> 7;
  const bfr* WT = (const bfr*)(p.ws + win_off(l));
  const bfr* H = (const bfr*)(p.ws + OFF_H);
  bfr* proj = (bfr*)(p.ws + OFF_PROJ);
  bfr* VT = (bfr*)(p.ws + OFF_VT);
  const float2* cs = (const float2*)(p.ws + OFF_CS);
  const int total = ((((MT >> 3) * ((NT + 7) >> 3)) + 7) >> 3) << 9;
  for (int T = blockIdx.x; T < total; T += gridDim.x) {
    int mt, nt;
    if (!tile_map(T, MT, NT, mt, nt)) continue;
    const int m0 = mt * 128, n0 = nt * 128;
    const bool vt = (n0 >= 1024 && n0 < 2048);
    f32x4 acc[4][4];
#pragma unroll
    for (int i = 0; i < 4; ++i)
#pragma unroll
      for (int j = 0; j < 4; ++j) acc[i][j] = (f32x4){0.f, 0.f, 0.f, 0.f};
    const bfr* X = vt ? (H + (size_t)m0 * 1024) : (WT + (size_t)n0 * 1024);
    const bfr* Y = vt ? (WT + (size_t)n0 * 1024) : (H + (size_t)m0 * 1024);
    gemm_mainloop(X, 1024, Y, 1024, 1024, smem, acc);
    if (vt) {
#pragma unroll
      for (int i = 0; i < 4; ++i) {
        const int mbase = m0 + wx * 64 + i * 16;
        int b, kp;
        if (mbase < ML) { b = mbase >> 12; kp = mbase & 4095; } else { const int mm = mbase - ML; b = mm >> 8; kp = 4096 + (mm & 255); }
        const int pos = (kp & ~31) + q * 8 + ((kp >> 4) & 1) * 4;
#pragma unroll
        for (int jn = 0; jn < 4; ++jn) {
          const int f = n0 - 1024 + wy * 64 + jn * 16 + r;
          u32x2 o;
          o.x = pack2(acc[i][jn][0], acc[i][jn][1]);
          o.y = pack2(acc[i][jn][2], acc[i][jn][3]);
          *(u32x2*)(VT + ((size_t)(b * 1024 + f)) * KEYS + pos) = o;
        }
      }
    } else {
      const bool rope = even && (n0 < 1024 || (n0 >= 2048 && n0 < 3072)) && (m0 < ML);
      if (rope) {
#pragma unroll
        for (int jn = 0; jn < 4; ++jn) {
          const int m = m0 + wy * 64 + jn * 16 + r;
          const int t = m & 4095;
          const int grow = t >> 6, gcol = t & 63;
#pragma unroll
          for (int j = 0; j < 4; ++j) {
            const float2 a = cs[grow * 16 + 4 * q + j];
            const float2 c = cs[gcol * 16 + 4 * q + j];
            const float x0 = acc[0][jn][j], x1 = acc[1][jn][j], x2 = acc[2][jn][j], x3 = acc[3][jn][j];
            acc[0][jn][j] = x0 * a.x - x1 * a.y;
            acc[1][jn][j] = x1 * a.x + x0 * a.y;
            acc[2][jn][j] = x2 * c.x - x3 * c.y;
            acc[3][jn][j] = x3 * c.x + x2 * c.y;
          }
        }
      }
#pragma unroll
      for (int jn = 0; jn < 4; ++jn) {
        const int m = m0 + wy * 64 + jn * 16 + r;
#pragma unroll
        for (int i = 0; i < 4; ++i) {
          const int n = n0 + wx * 64 + i * 16 + 4 * q;
          u32x2 o;
          o.x = pack2(acc[i][jn][0], acc[i][jn][1]);
          o.y = pack2(acc[i][jn][2], acc[i][jn][3]);
          *(u32x2*)(proj + (size_t)m * ldp + n) = o;
        }
      }
    }
  }
}

DI void phase_gemm_out(const Params& p, int l, char* smem) {
  const int tid = opaque_tid(), lane = tid & 63, wid = tid >> 6, r = lane & 15, q = lane >> 4;
  const int wx = wid >> 1, wy = wid & 1;
  const bfr* WT = (const bfr*)(p.ws + OFF_WOUT + (size_t)l * SZ_WOUT);
  const bfr* U = (const bfr*)(p.ws + OFF_U);
  bfr* ybuf = (bfr*)(p.ws + OFF_PROJ);
  const int MT = (l == 3) ? (ML >> 7) : (MR >> 7);
  const int total = (((MT >> 3) + 7) >> 3) << 9;
  for (int T = blockIdx.x; T < total; T += gridDim.x) {
    int mt, nt;
    if (!tile_map(T, MT, 8, mt, nt)) continue;
    const int m0 = mt * 128, n0 = nt * 128;
    f32x4 acc[4][4];
#pragma unroll
    for (int i = 0; i < 4; ++i)
#pragma unroll
      for (int j = 0; j < 4; ++j) acc[i][j] = (f32x4){0.f, 0.f, 0.f, 0.f};
    gemm_mainloop(WT + (size_t)n0 * 2048, 2048, U + (size_t)m0 * 2048, 2048, 2048, smem, acc);
#pragma unroll
    for (int jn = 0; jn < 4; ++jn) {
      const int m = m0 + wy * 64 + jn * 16 + r;
#pragma unroll
      for (int i = 0; i < 4; ++i) {
        const int n = n0 + wx * 64 + i * 16 + 4 * q;
        u32x2 o;
        o.x = pack2(acc[i][jn][0], acc[i][jn][1]);
        o.y = pack2(acc[i][jn][2], acc[i][jn][3]);
        *(u32x2*)(ybuf + (size_t)m * 1024 + n) = o;
      }
    }
  }
}

template <int DV, int QT, int KT, int MODE>
DI void attn_engine(const bfr* __restrict__ qbase, int ldq, const bfr* __restrict__ kbase, int ldk,
                    const bfr* __restrict__ vt, int nloc, int loc_row0, int loc_pos0, int nctx, int ctx_row0,
                    const float* rpb_s, int roff0, char* smem, f32x4 (&O)[DV / 16][QT], float (&lsum)[QT]) {
  constexpr int STAGE = 8192 + DV * 128;
  constexpr int NVL = DV / 32;
  const int tid = opaque_tid(), lane = tid & 63, wid = tid >> 6, r = lane & 15, q = lane >> 4;
  const int lr = tid >> 3, lc = tid & 7;
  constexpr float SC = 0.125f * L2E;

  bf16x8 Qf[QT][2];
#pragma unroll
  for (int qt = 0; qt < QT; ++qt)
#pragma unroll
    for (int s = 0; s < 2; ++s)
      Qf[qt][s] = *(const bf16x8*)(qbase + (size_t)(wid * 16 * QT + qt * 16 + r) * ldq + s * 32 + q * 8);
  float mrun[QT];
#pragma unroll
  for (int qt = 0; qt < QT; ++qt) {
    mrun[qt] = -1e30f;
    lsum[qt] = 0.f;
#pragma unroll
    for (int dt = 0; dt < DV / 16; ++dt) O[dt][qt] = (f32x4){0.f, 0.f, 0.f, 0.f};
  }

  const int nch = nloc + nctx;
  u32x4 kreg0, kreg1, vreg[NVL];
  const int ksw0 = sw128(lr, lc), ksw1 = sw128(lr + 32, lc);
#define AT_LOAD(c_)                                                                                          \
  {                                                                                                          \
    const int cc_ = (c_);                                                                                    \
    const int row_ = (cc_ < nloc) ? (loc_row0 + cc_ * 64) : (ctx_row0 + (cc_ - nloc) * 64);                  \
    const int pos_ = (cc_ < nloc) ? (loc_pos0 + cc_ * 64) : (4096 + (cc_ - nloc) * 64);                      \
    kreg0 = *(const u32x4*)(kbase + (size_t)(row_ + lr) * ldk + lc * 8);                                     \
    kreg1 = *(const u32x4*)(kbase + (size_t)(row_ + lr + 32) * ldk + lc * 8);                                \
    _Pragma("unroll") for (int i_ = 0; i_ < NVL; ++i_)                                                       \
        vreg[i_] = *(const u32x4*)(vt + (size_t)(lr + 32 * i_) * KEYS + pos_ + lc * 8);                      \
  }
#define AT_STORE(c_)                                                                                         \
  {                                                                                                          \
    char* sb_ = smem + ((c_) & 1) * STAGE;                                                                   \
    *(u32x4*)(sb_ + ksw0) = kreg0;                                                                           \
    *(u32x4*)(sb_ + ksw1) = kreg1;                                                                           \
    _Pragma("unroll") for (int i_ = 0; i_ < NVL; ++i_)                                                       \
        *(u32x4*)(sb_ + 8192 + sw128(lr + 32 * i_, lc)) = vreg[i_];                                          \
  }
  if (nch > 0) { AT_LOAD(0); AT_STORE(0); }
  for (int c = 0; c < nch; ++c) {
    __syncthreads();
    const bool more = (c + 1 < nch);
    const char* sK = smem + (c & 1) * STAGE;
    const char* sV = sK + 8192;
    if (more) AT_LOAD(c + 1);
#pragma unroll
    for (int sbk = 0; sbk < 4 / KT; ++sbk) {
      f32x4 st[KT][QT];
#pragma unroll
      for (int kt = 0; kt < KT; ++kt)
#pragma unroll
        for (int qt = 0; qt < QT; ++qt) st[kt][qt] = (f32x4){0.f, 0.f, 0.f, 0.f};
#pragma unroll
      for (int s = 0; s < 2; ++s)
#pragma unroll
        for (int kt = 0; kt < KT; ++kt) {
          const bf16x8 ka = *(const bf16x8*)(sK + sw128(sbk * KT * 16 + kt * 16 + r, s * 4 + q));
#pragma unroll
          for (int qt = 0; qt < QT; ++qt) st[kt][qt] = mfma16(ka, Qf[qt][s], st[kt][qt]);
        }
#pragma unroll
      for (int kt = 0; kt < KT; ++kt)
#pragma unroll
        for (int qt = 0; qt < QT; ++qt)
#pragma unroll
          for (int j = 0; j < 4; ++j) {
            float v = st[kt][qt][j] * SC;
            if (MODE == 1) {
              if (c < nloc) {
                const int kc = sbk * KT * 16 + kt * 16 + 4 * q + j;
                const int qc = wid * 16 + r;
                int wst = qc - 8; wst = wst < 0 ? 0 : (wst > 48 ? 48 : wst);
                const bool valid = (kc >= wst) && (kc < wst + 16);
                int co = kc - qc + 15; co = co < 0 ? 0 : (co > 30 ? 30 : co);
                const float bias = rpb_s[(roff0 + c) * 31 + co] * L2E;
                v = valid ? (v + bias) : -INFINITY;
              }
            }
            st[kt][qt][j] = v;
          }
      bf16x8 pb[KT / 2][QT];
#pragma unroll
      for (int qt = 0; qt < QT; ++qt) {
        float mx = -INFINITY;
#pragma unroll
        for (int kt = 0; kt < KT; ++kt)
#pragma unroll
          for (int j = 0; j < 4; ++j) mx = fmaxf(mx, st[kt][qt][j]);
        mx = fmaxf(mx, shx<16>(mx, lane));
        mx = fmaxf(mx, shx<32>(mx, lane));
        const float mnew = fmaxf(mrun[qt], mx);
        const float alpha = fexp2(mrun[qt] - mnew);
        mrun[qt] = mnew;
        float ps = 0.f;
#pragma unroll
        for (int kt = 0; kt < KT; ++kt)
#pragma unroll
          for (int j = 0; j < 4; ++j) {
            const float pv = fexp2(st[kt][qt][j] - mnew);
            st[kt][qt][j] = pv;
            ps += pv;
          }
        lsum[qt] = lsum[qt] * alpha + ps;
        if (__any(alpha != 1.f)) {
#pragma unroll
          for (int dt = 0; dt < DV / 16; ++dt) {
            O[dt][qt][0] *= alpha; O[dt][qt][1] *= alpha; O[dt][qt][2] *= alpha; O[dt][qt][3] *= alpha;
          }
        }
#pragma unroll
        for (int ks = 0; ks < KT / 2; ++ks) {
          u32x4 pk;
          pk.x = pack2(st[2 * ks][qt][0], st[2 * ks][qt][1]);
          pk.y = pack2(st[2 * ks][qt][2], st[2 * ks][qt][3]);
          pk.z = pack2(st[2 * ks + 1][qt][0], st[2 * ks + 1][qt][1]);
          pk.w = pack2(st[2 * ks + 1][qt][2], st[2 * ks + 1][qt][3]);
          pb[ks][qt] = __builtin_bit_cast(bf16x8, pk);
        }
      }
#pragma unroll
      for (int dt = 0; dt < DV / 16; ++dt)
#pragma unroll
        for (int ks = 0; ks < KT / 2; ++ks) {
          const bf16x8 va = *(const bf16x8*)(sV + sw128(dt * 16 + r, (sbk * (KT / 2) + ks) * 4 + q));
#pragma unroll
          for (int qt = 0; qt < QT; ++qt) O[dt][qt] = mfma16(va, pb[ks][qt], O[dt][qt]);
        }
    }
    if (more) AT_STORE(c + 1);
  }
#undef AT_LOAD
#undef AT_STORE
  __syncthreads();
#pragma unroll
  for (int qt = 0; qt < QT; ++qt) {
    float L = lsum[qt];
    L += shx<16>(L, lane);
    L += shx<32>(L, lane);
    lsum[qt] = L;
  }
}

DI void diff_attn_item(const Params& p, int l, int b, int head, int qrow0, bool ctxq, char* smem) {
  const int tid = opaque_tid(), lane = tid & 63, wid = tid >> 6, r = lane & 15, q = lane >> 4;
  const bfr* proj = (const bfr*)(p.ws + OFF_PROJ);
  const bfr* VT = (const bfr*)(p.ws + OFF_VT);
  bfr* U = (bfr*)(p.ws + OFF_U);
  const float* lamv = (const float*)(p.ws + OFF_LAM);
  const float lam = lamv[l >> 1], lam_init = lamv[2 + (l >> 1)];
  f32x4 O[8][2];
  float ls[2];
  char* parkb = smem + 49152 + tid * 16;
  attn_engine<128, 2, 2, 0>(proj + (size_t)qrow0 * NEV + 2048 + head * 128, NEV, proj + head * 128, NEV,
                            VT + (size_t)(b * 1024 + head * 128) * KEYS, ctxq ? 0 : 64, b * 4096, 0, 4,
                            ML + b * 256, nullptr, 0, smem, O, ls);
  u32x4 pkr0, pkr1;
  {
    const float i0 = 1.f / ls[0], i1 = 1.f / ls[1];
#pragma unroll
    for (int dt = 0; dt < 8; dt += 2) {
      u32x4 v0, v1;
      v0.x = pack2(O[dt][0][0] * i0, O[dt][0][1] * i0);
      v0.y = pack2(O[dt][0][2] * i0, O[dt][0][3] * i0);
      v0.z = pack2(O[dt + 1][0][0] * i0, O[dt + 1][0][1] * i0);
      v0.w = pack2(O[dt + 1][0][2] * i0, O[dt + 1][0][3] * i0);
      v1.x = pack2(O[dt][1][0] * i1, O[dt][1][1] * i1);
      v1.y = pack2(O[dt][1][2] * i1, O[dt][1][3] * i1);
      v1.z = pack2(O[dt + 1][1][0] * i1, O[dt + 1][1][1] * i1);
      v1.w = pack2(O[dt + 1][1][2] * i1, O[dt + 1][1][3] * i1);
      if (dt < 6) {
        *(u32x4*)(parkb + (dt / 2) * 4096) = v0;
        *(u32x4*)(parkb + (3 + dt / 2) * 4096) = v1;
      } else { pkr0 = v0; pkr1 = v1; }
    }
  }
  attn_engine<128, 2, 2, 0>(proj + (size_t)qrow0 * NEV + 2048 + head * 128 + 64, NEV, proj + head * 128 + 64, NEV,
                            VT + (size_t)(b * 1024 + head * 128) * KEYS, ctxq ? 0 : 64, b * 4096, 0, 4,
                            ML + b * 256, nullptr, 0, smem, O, ls);
  const float* subln = p.ev_subln + (l >> 1) * 128;
#pragma unroll
  for (int qt = 0; qt < 2; ++qt) {
    const float i1 = lam / ls[qt];
    float ss = 0.f;
#pragma unroll
    for (int dt = 0; dt < 8; ++dt) {
      unsigned pa, pc;
      if (dt < 6) {
        const u32x2 pk2 = *(const u32x2*)(parkb + (qt * 3 + dt / 2) * 4096 + (dt & 1) * 8);
        pa = pk2.x; pc = pk2.y;
      } else {
        const u32x4 pr = qt ? pkr1 : pkr0;
        pa = (dt & 1) ? pr.z : pr.x; pc = (dt & 1) ? pr.w : pr.y;
      }
      const float o0 = lo_bf(pa) - O[dt][qt][0] * i1;
      const float o1 = hi_bf(pa) - O[dt][qt][1] * i1;
      const float o2 = lo_bf(pc) - O[dt][qt][2] * i1;
      const float o3 = hi_bf(pc) - O[dt][qt][3] * i1;
      O[dt][qt][0] = o0; O[dt][qt][1] = o1; O[dt][qt][2] = o2; O[dt][qt][3] = o3;
      ss += o0 * o0 + o1 * o1 + o2 * o2 + o3 * o3;
    }
    ss += shx<16>(ss, lane);
    ss += shx<32>(ss, lane);
    const float rn = rsqrtf(ss * (1.f / 128.f) + 1e-6f) * (1.f - lam_init);
    const int row = qrow0 + wid * 32 + qt * 16 + r;
#pragma unroll
    for (int dt = 0; dt < 8; ++dt) {
      const int dv = dt * 16 + 4 * q;
      const u32x2 ag = *(const u32x2*)(proj + (size_t)row * NEV + 3072 + head * 128 + dv);
      const float4 sl = *(const float4*)(subln + dv);
      u32x2 o;
      o.x = pack2(O[dt][qt][0] * rn * sl.x * silu(lo_bf(ag.x)), O[dt][qt][1] * rn * sl.y * silu(hi_bf(ag.x)));
      o.y = pack2(O[dt][qt][2] * rn * sl.z * silu(lo_bf(ag.y)), O[dt][qt][3] * rn * sl.w * silu(hi_bf(ag.y)));
      *(u32x2*)(U + (size_t)row * 2048 + head * 128 + dv) = o;
    }
  }
}

DI void na_item(const Params& p, int l, int b, int head, int rho, bool ctxq, int cq0, char* smem) {
  const int tid = opaque_tid(), lane = tid & 63, wid = tid >> 6, r = lane & 15, q = lane >> 4;
  const bfr* proj = (const bfr*)(p.ws + OFF_PROJ);
  const bfr* VT = (const bfr*)(p.ws + OFF_VT);
  bfr* U = (bfr*)(p.ws + OFF_U);
  float* rpb_s = (float*)(smem + 2 * (8192 + 64 * 128));
  int rs = rho - 4; rs = rs < 0 ? 0 : (rs > 56 ? 56 : rs);
  const int qrow0 = ctxq ? (ML + b * 256 + cq0) : (b * 4096 + rho * 64);
  f32x4 O[4][1];
  float ls[1];
  if (!ctxq) {
    const float* rp = p.od_rpb + ((size_t)(l >> 1) * 16 + head) * 465;
    for (int i = tid; i < 465; i += 256) rpb_s[i] = rp[i];
    attn_engine<64, 1, 4, 1>(proj + (size_t)qrow0 * NOD + 3584 + head * 64, NOD, proj + head * 64, NOD,
                                VT + (size_t)(b * 1024 + head * 64) * KEYS, 8, b * 4096 + rs * 64, rs * 64, 4,
                                ML + b * 256, rpb_s, rs - rho + 7, smem, O, ls);
  } else {
    attn_engine<64, 1, 4, 0>(proj + (size_t)qrow0 * NOD + 3584 + head * 64, NOD, proj + head * 64, NOD,
                                VT + (size_t)(b * 1024 + head * 64) * KEYS, 0, 0, 0, 4, ML + b * 256, nullptr, 0,
                                smem, O, ls);
  }
  const float inv = 1.f / ls[0];
  const int row = qrow0 + wid * 16 + r;
#pragma unroll
  for (int dt = 0; dt < 4; ++dt) {
    const int dv = dt * 16 + 4 * q;
    const u32x2 cgv = *(const u32x2*)(proj + (size_t)row * NOD + 5120 + head * 64 + dv);
    u32x2 o;
    o.x = pack2(O[dt][0][0] * inv * silu(lo_bf(cgv.x)), O[dt][0][1] * inv * silu(hi_bf(cgv.x)));
    o.y = pack2(O[dt][0][2] * inv * silu(lo_bf(cgv.y)), O[dt][0][3] * inv * silu(hi_bf(cgv.y)));
    *(u32x2*)(U + (size_t)row * 2048 + head * 64 + dv) = o;
  }
}

DI void conv_item(const Params& p, int l, int item) {
  const int tid = opaque_tid();
  const bfr* proj = (const bfr*)(p.ws + OFF_PROJ);
  bfr* U = (bfr*)(p.ws + OFF_U);
  const float* cw = p.ev_conv + (size_t)(l >> 1) * 3 * 1024;
#pragma unroll 1
  for (int i = 0; i < 8; ++i) {
    const int v = tid + 256 * i;
    const int ri = v >> 7, ch = (v & 127) * 8;
    const int m = item * 16 + ri;
    int t, T;
    if (m < ML) { t = m & 4095; T = 4096; } else { t = (m - ML) & 255; T = 256; }
    const bfr* pr = proj + (size_t)m * NEV;
    float acc[8];
#pragma unroll
    for (int e = 0; e < 8; ++e) acc[e] = 0.f;
#pragma unroll
    for (int w = 0; w < 3; ++w) {
      const int tt = t + w - 1;
      if (tt >= 0 && tt < T) {
        const bfr* prw = pr + (ptrdiff_t)(w - 1) * NEV;
        const u32x4 bh = *(const u32x4*)(prw + 4096 + ch);
        const u32x4 bc = *(const u32x4*)(prw + 6144 + ch);
        const float4 w0 = *(const float4*)(cw + w * 1024 + ch);
        const float4 w1 = *(const float4*)(cw + w * 1024 + ch + 4);
        acc[0] += w0.x * lo_bf(bh.x) * lo_bf(bc.x); acc[1] += w0.y * hi_bf(bh.x) * hi_bf(bc.x);
        acc[2] += w0.z * lo_bf(bh.y) * lo_bf(bc.y); acc[3] += w0.w * hi_bf(bh.y) * hi_bf(bc.y);
        acc[4] += w1.x * lo_bf(bh.z) * lo_bf(bc.z); acc[5] += w1.y * hi_bf(bh.z) * hi_bf(bc.z);
        acc[6] += w1.z * lo_bf(bh.w) * lo_bf(bc.w); acc[7] += w1.w * hi_bf(bh.w) * hi_bf(bc.w);
      }
    }
    const u32x4 bb = *(const u32x4*)(pr + 5120 + ch);
    const u32x4 bg = *(const u32x4*)(pr + 7168 + ch);
    u32x4 o;
    o.x = pack2(lo_bf(bb.x) * acc[0] * silu(lo_bf(bg.x)), hi_bf(bb.x) * acc[1] * silu(hi_bf(bg.x)));
    o.y = pack2(lo_bf(bb.y) * acc[2] * silu(lo_bf(bg.y)), hi_bf(bb.y) * acc[3] * silu(hi_bf(bg.y)));
    o.z = pack2(lo_bf(bb.z) * acc[4] * silu(lo_bf(bg.z)), hi_bf(bb.z) * acc[5] * silu(hi_bf(bg.z)));
    o.w = pack2(lo_bf(bb.w) * acc[6] * silu(lo_bf(bg.w)), hi_bf(bb.w) * acc[7] * silu(hi_bf(bg.w)));
    *(u32x4*)(U + (size_t)m * 2048 + 1024 + ch) = o;
  }
}

DI void gla_item(const Params& p, int l, int item, char* smem) {
  const int tid0 = opaque_tid();
  const int slice = item & 7, dir = (item >> 3) & 1, head = (item >> 4) & 3, b = item >> 6;
  const int jl = l >> 1;
  const bfr* proj = (const bfr*)(p.ws + OFF_PROJ);
  char* sQb = smem;
  char* sKc = smem + 16384;
  char* sKbT = smem + 32768;
  char* sVt = smem + 49152;
  char* sAtt = smem + 53248;
  float* sLr = (float*)sAtt;
  float* sHs = (float*)(sAtt + 4096);
  char* sST = smem + 61440;
  float* sDec = (float*)(smem + 77824);

  unsigned gu[8];
  {
  const int d = tid0 & 127;
#pragma unroll
  for (int k = 0; k < 8; ++k)
    gu[k] = pack2(p.od_gate_up[(((size_t)jl * 2 + dir) * 16 + 2 * k) * 512 + head * 128 + d],
                  p.od_gate_up[(((size_t)jl * 2 + dir) * 16 + 2 * k + 1) * 512 + head * 128 + d]);
  }
  const float gbias = p.od_gate_bias[((size_t)jl * 2 + dir) * 512 + head * 128 + (tid0 & 127)];
  const float qscale = 0.08838834764831845f;

  f32x4 S[2][2];
#pragma unroll
  for (int a = 0; a < 2; ++a)
#pragma unroll
    for (int c2 = 0; c2 < 2; ++c2) S[a][c2] = (f32x4){0.f, 0.f, 0.f, 0.f};
  __syncthreads();
  for (int i = tid0; i < 512; i += 256) ((u32x4*)sST)[i] = (u32x4){0u, 0u, 0u, 0u};

  u32x4 pq0, pq1, pq2, pq3, pk0, pk1, pk2, pk3, pv;
  u32x2 plr;
#define GLA_ROW0(ci_) (((ci_) < 4) ? (ML + b * 256 + (dir ? (3 - (ci_)) : (ci_)) * 64) : (b * 4096 + (dir ? (67 - (ci_)) : ((ci_) - 4)) * 64))
#define GLA_LOAD(ci_)                                                                                         \
  {                                                                                                           \
    const int prow = tid >> 4, pch = tid & 15, vs = tid >> 2, vpart = tid & 3;                                \
    const bfr* pr_ = proj + (size_t)(GLA_ROW0(ci_) + prow) * NOD + head * 128 + pch * 8;                      \
    pq0 = *(const u32x4*)(pr_ + 4608);                     pk0 = *(const u32x4*)(pr_ + 2048);                 \
    pq1 = *(const u32x4*)(pr_ + 4608 + (size_t)16 * NOD);  pk1 = *(const u32x4*)(pr_ + 2048 + (size_t)16 * NOD); \
    pq2 = *(const u32x4*)(pr_ + 4608 + (size_t)32 * NOD);  pk2 = *(const u32x4*)(pr_ + 2048 + (size_t)32 * NOD); \
    pq3 = *(const u32x4*)(pr_ + 4608 + (size_t)48 * NOD);  pk3 = *(const u32x4*)(pr_ + 2048 + (size_t)48 * NOD); \
    const bfr* pv_ = proj + (size_t)(GLA_ROW0(ci_) + vs) * NOD;                                               \
    pv = *(const u32x4*)(pv_ + 2560 + head * 256 + slice * 32 + vpart * 8);                                   \
    plr = *(const u32x2*)(pv_ + 7168 + dir * 16 + vpart * 4);                                                 \
  }
  { const int tid = tid0; GLA_LOAD(0); }
  for (int ci = 0; ci < 68; ++ci) {
    int tid = tid0; asm volatile("" : "+v"(tid));
    const int lane = tid & 63, wid = tid >> 6, r = lane & 15, q = lane >> 4;
    const int d = tid & 127, half = tid >> 7;
    const int prow = tid >> 4, pch = tid & 15, vs = tid >> 2, vpart = tid & 3;
    const int row0 = GLA_ROW0(ci);
    const char* stc = sST + (ci & 1) * 8192;
    char* stn = sST + ((ci + 1) & 1) * 8192;
    __syncthreads();
    {
      *(u32x4*)(sQb + sw256(prow, pch)) = pq0;       *(u32x4*)(sKc + sw256(prow, pch)) = pk0;
      *(u32x4*)(sQb + sw256(prow + 16, pch)) = pq1;  *(u32x4*)(sKc + sw256(prow + 16, pch)) = pk1;
      *(u32x4*)(sQb + sw256(prow + 32, pch)) = pq2;  *(u32x4*)(sKc + sw256(prow + 32, pch)) = pk2;
      *(u32x4*)(sQb + sw256(prow + 48, pch)) = pq3;  *(u32x4*)(sKc + sw256(prow + 48, pch)) = pk3;
      *(u32x2*)((char*)sLr + vs * 32 + vpart * 8) = plr;
      const unsigned vv[4] = {pv.x, pv.y, pv.z, pv.w};
#pragma unroll
      for (int j = 0; j < 4; ++j) {
        const int e0 = vpart * 8 + 2 * j;
        *(bfr*)(sVt + sw128(e0, vs >> 3) + (vs & 7) * 2) = (bfr)(vv[j] & 0xffffu);
        *(bfr*)(sVt + sw128(e0 + 1, vs >> 3) + (vs & 7) * 2) = (bfr)(vv[j] >> 16);
      }
    }
    __syncthreads();
    float gl[32];
    float tot = 0.f;
#pragma unroll
    for (int i = 0; i < 32; ++i) {
      const int s = half * 32 + i;
      float z = gbias;
      {
        const u32x4 la = *(const u32x4*)((const char*)sLr + s * 32);
        const u32x4 lb = *(const u32x4*)((const char*)sLr + s * 32 + 16);
        z = dot2bf(la.x, gu[0], z); z = dot2bf(la.y, gu[1], z); z = dot2bf(la.z, gu[2], z); z = dot2bf(la.w, gu[3], z);
        z = dot2bf(lb.x, gu[4], z); z = dot2bf(lb.y, gu[5], z); z = dot2bf(lb.z, gu[6], z); z = dot2bf(lb.w, gu[7], z);
      }
      const float tneg = fexp2(-fabsf(z) * L2E);
      const float g = (fminf(z, 0.f) - flog2(1.f + tneg) * LN2) * (1.f / 16.f);
      gl[i] = g;
      tot += g;
    }
    if (dir == 0) {
      float run = 0.f;
#pragma unroll
      for (int i = 0; i < 32; ++i) { run += gl[i]; gl[i] = run; }
    } else {
      float run = 0.f;
#pragma unroll
      for (int i = 31; i >= 0; --i) { run += gl[i]; gl[i] = run; }
    }
    sHs[half * 128 + d] = tot;
    __syncthreads();
    const float other = sHs[(1 - half) * 128 + d];
    const float bend = tot + other;
    const float offs = (dir == 0) ? (half ? other : 0.f) : (half ? 0.f : other);
    const float dec = fexp2(bend * L2E);
    if (half == 0) sDec[d] = dec;
    {
#pragma unroll
      for (int i8 = 0; i8 < 4; ++i8) {
        unsigned kb[4];
#pragma unroll
        for (int ii = 0; ii < 8; ++ii) {
          const int i = i8 * 8 + ii;
          const int s = half * 32 + i;
          const float bb = (gl[i] + offs) * L2E;
          const float E = fexp2(bb), Ei = fexp2(-bb);
          bfr* qa_ = (bfr*)(sQb + sw256(s, d >> 3) + (d & 7) * 2);
          bfr* ka_ = (bfr*)(sKc + sw256(s, d >> 3) + (d & 7) * 2);
          const float qv = bf2f(*qa_) * qscale * E;
          const float kc = bf2f(*ka_) * Ei;
          *qa_ = f2bf(qv);
          *ka_ = f2bf(kc);
          const unsigned kbv = f2bf(kc * dec);
          if (ii & 1) kb[ii >> 1] |= kbv << 16; else kb[ii >> 1] = kbv;
        }
        *(u32x4*)(sKbT + sw128(d, half * 4 + i8)) = (u32x4){kb[0], kb[1], kb[2], kb[3]};
      }
    }
    __syncthreads();
    if (ci + 1 < 68) GLA_LOAD(ci + 1);
    {
      f32x4 at[4];
#pragma unroll
      for (int st = 0; st < 4; ++st) at[st] = (f32x4){0.f, 0.f, 0.f, 0.f};
#pragma unroll
      for (int ks = 0; ks < 4; ++ks) {
        const bf16x8 qa = *(const bf16x8*)(sQb + sw256(wid * 16 + r, ks * 4 + q));
#pragma unroll
        for (int st = 0; st < 4; ++st) {
          const bf16x8 kb2 = *(const bf16x8*)(sKc + sw256(st * 16 + r, ks * 4 + q));
          at[st] = mfma16(qa, kb2, at[st]);
        }
      }
#pragma unroll
      for (int st = 0; st < 4; ++st)
#pragma unroll
        for (int j = 0; j < 4; ++j) {
          const int t = wid * 16 + 4 * q + j, s = st * 16 + r;
          const bool keep = dir ? (s >= t) : (s <= t);
          *(bfr*)(sAtt + sw128(t, s >> 3) + (s & 7) * 2) = f2bf(keep ? at[st][j] : 0.f);
        }
    }
    __syncthreads();
    {
      f32x4 o[2];
      o[0] = (f32x4){0.f, 0.f, 0.f, 0.f};
      o[1] = (f32x4){0.f, 0.f, 0.f, 0.f};
#pragma unroll
      for (int ks = 0; ks < 4; ++ks) {
        const bf16x8 qa = *(const bf16x8*)(sQb + sw256(wid * 16 + r, ks * 4 + q));
#pragma unroll
        for (int et = 0; et < 2; ++et) {
          const bf16x8 sb2 = *(const bf16x8*)(stc + sw256(et * 16 + r, ks * 4 + q));
          o[et] = mfma16(qa, sb2, o[et]);
        }
      }
#pragma unroll
      for (int ks = 0; ks < 2; ++ks) {
        const bf16x8 aa = *(const bf16x8*)(sAtt + sw128(wid * 16 + r, ks * 4 + q));
#pragma unroll
        for (int et = 0; et < 2; ++et) {
          const bf16x8 vb = *(const bf16x8*)(sVt + sw128(et * 16 + r, ks * 4 + q));
          o[et] = mfma16(aa, vb, o[et]);
        }
      }
      {
        const int lam = head * 8 + slice;
#pragma unroll
        for (int j = 0; j < 4; ++j) {
          const int row = row0 + wid * 16 + 4 * q + j;
          const int m2 = row >> 1, par = row & 1;
          bfr* lp = dir ? ((bfr*)(p.ws + OFF_H) + ((size_t)m2 * 32 + lam) * 64)
                        : ((bfr*)(p.ws + OFF_U) + (size_t)(2 * m2 + (lam >> 4)) * 2048 + 1024 + (lam & 15) * 64);
#pragma unroll
          for (int et = 0; et < 2; ++et) lp[par * 32 + et * 16 + r] = f2bf(o[et][j]);
        }
      }
    }
    {
#pragma unroll
      for (int dti = 0; dti < 2; ++dti) {
        const float dc = sDec[(2 * wid + dti) * 16 + r];
#pragma unroll
        for (int et = 0; et < 2; ++et) {
          S[et][dti][0] *= dc; S[et][dti][1] *= dc; S[et][dti][2] *= dc; S[et][dti][3] *= dc;
        }
      }
#pragma unroll
      for (int ks = 0; ks < 2; ++ks) {
        bf16x8 va[2], kb2[2];
#pragma unroll
        for (int et = 0; et < 2; ++et) va[et] = *(const bf16x8*)(sVt + sw128(et * 16 + r, ks * 4 + q));
#pragma unroll
        for (int dti = 0; dti < 2; ++dti) kb2[dti] = *(const bf16x8*)(sKbT + sw128((2 * wid + dti) * 16 + r, ks * 4 + q));
#pragma unroll
        for (int et = 0; et < 2; ++et)
#pragma unroll
          for (int dti = 0; dti < 2; ++dti) S[et][dti] = mfma16(va[et], kb2[dti], S[et][dti]);
      }
#pragma unroll
      for (int et = 0; et < 2; ++et)
#pragma unroll
        for (int dti = 0; dti < 2; ++dti)
#pragma unroll
          for (int j = 0; j < 4; ++j) {
            const int e = et * 16 + 4 * q + j, dd = (2 * wid + dti) * 16 + r;
            *(bfr*)(stn + sw256(e, dd >> 3) + (dd & 7) * 2) = f2bf(S[et][dti][j]);
          }
    }
  }
#undef GLA_LOAD
#undef GLA_ROW0
  __syncthreads();
}

DI void phase_gla_combine(const Params& p, int l) {
  const int tid = opaque_tid(), lane = tid & 63, wid = tid >> 6;
  const bfr* proj = (const bfr*)(p.ws + OFF_PROJ);
  const bfr* OB = (const bfr*)(p.ws + OFF_H);
  bfr* U = (bfr*)(p.ws + OFF_U);
  const int h = lane >> 4, e16 = (lane & 15) * 16;
  const int lam = h * 8 + ((lane & 15) >> 1), ein = (lane & 1) * 16;
  const float* gn = p.od_gnorm + (l >> 1) * 256 + e16;
  for (int m2 = blockIdx.x * 4 + wid; m2 < MR / 2; m2 += gridDim.x * 4) {
    const bfr* ofl = U + (size_t)(2 * m2 + (lam >> 4)) * 2048 + 1024 + (lam & 15) * 64 + ein;
    const bfr* obl = OB + ((size_t)m2 * 32 + lam) * 64 + ein;
    u32x4 a[2][2], bq[2][2], g[2][2];
#pragma unroll
    for (int par = 0; par < 2; ++par) {
      a[par][0] = *(const u32x4*)(ofl + par * 32);  a[par][1] = *(const u32x4*)(ofl + par * 32 + 8);
      bq[par][0] = *(const u32x4*)(obl + par * 32); bq[par][1] = *(const u32x4*)(obl + par * 32 + 8);
      const bfr* gp = proj + (size_t)(2 * m2 + par) * NOD + 6144 + h * 256 + e16;
      g[par][0] = *(const u32x4*)gp; g[par][1] = *(const u32x4*)(gp + 8);
    }
    u32x4 res[2][2];
#pragma unroll
    for (int par = 0; par < 2; ++par) {
      float o[16], dg[16];
      float ss = 0.f;
#pragma unroll
      for (int hv = 0; hv < 2; ++hv)
#pragma unroll
        for (int i = 0; i < 4; ++i) {
          const unsigned av = a[par][hv][i], bv = bq[par][hv][i], gv = g[par][hv][i];
          const int k = hv * 8 + i * 2;
          o[k] = lo_bf(av) + lo_bf(bv); o[k + 1] = hi_bf(av) + hi_bf(bv);
          dg[k] = lo_bf(gv); dg[k + 1] = hi_bf(gv);
          ss += o[k] * o[k] + o[k + 1] * o[k + 1];
        }
      ss += shx<1>(ss, lane); ss += shx<2>(ss, lane); ss += shx<4>(ss, lane); ss += shx<8>(ss, lane);
      const float rn = rsqrtf(ss * (1.f / 256.f) + 1e-6f);
#pragma unroll
      for (int hv = 0; hv < 2; ++hv)
#pragma unroll
        for (int i = 0; i < 4; ++i) {
          const int k = hv * 8 + i * 2;
          res[par][hv][i] = pack2(o[k] * rn * gn[k] * silu(dg[k]), o[k + 1] * rn * gn[k + 1] * silu(dg[k + 1]));
        }
    }
#pragma unroll
    for (int par = 0; par < 2; ++par) {
      bfr* up = U + (size_t)(2 * m2 + par) * 2048 + 1024 + h * 256 + e16;
      *(u32x4*)up = res[par][0];
      *(u32x4*)(up + 8) = res[par][1];
    }
  }
}

DI int next_item(int* ctr, int* slot) {
  __syncthreads();
  if (threadIdx.x == 0) *slot = atomicAdd(ctr, 1);
  __syncthreads();
  return *slot;
}

DI void phase_mix_even(const Params& p, int l, int g, char* smem, int coff = 0) {
  int* ctr0 = (int*)(p.ws + OFF_CTR) + ((g * 2 + (l >> 1)) * 8) + coff;
  int* slot = (int*)(smem + SMEM_BYTES - 16);
  const int PER_LAT = GB * 32, PER_CTX = GB * 2, PER_CONV = MR / 16 / 8;
  const int per_q = PER_LAT + PER_CTX + PER_CONV;
  const int myq = (int)(__builtin_amdgcn_s_getreg((3 << 11) | 20) & 7u);
  for (int dq = 0; dq < 8; ++dq) {
    const int x = (myq + dq) & 7;
    for (;;) {
      int it = next_item(ctr0 + x, slot);
      if (it >= per_q) break;
      if (it < PER_LAT) {
        const int qb = it & 31, b = it >> 5;
        diff_attn_item(p, l, b, x, b * 4096 + qb * 128, false, smem);
      } else if (it < PER_LAT + PER_CTX) {
        it -= PER_LAT;
        const int qb = it & 1, b = it >> 1;
        diff_attn_item(p, l, b, x, ML + b * 256 + qb * 128, true, smem);
      } else {
        conv_item(p, l, (it - PER_LAT - PER_CTX) * 8 + x);
      }
    }
  }
}

DI void phase_mix_odd(const Params& p, int l, int g, char* smem) {
  int* ctr = (int*)(p.ws + OFF_CTR) + (g * 4 + l);
  int* slot = (int*)(smem + SMEM_BYTES - 16);
  const int N_GLA = GB * 4 * 2 * 8, N_NA = GB * 16 * 64, N_CTX = (l == 3) ? 0 : GB * 16 * 4;
  const int total = N_GLA + N_NA + N_CTX;
  (void)ctr; (void)slot; (void)total;
  const int nb = gridDim.x, bx = blockIdx.x;
  const int nup = (nb > N_GLA) ? (nb - N_GLA) : 0;
  for (int k = 0;; ++k) {
    int it;
    if (nup == 0) { it = bx + k * nb; if (it >= total) break; }
    else if (bx < N_GLA) {
      if (k == 0) it = bx;
      else { it = N_GLA + N_NA + bx + (k - 1) * N_GLA; if (it >= total) break; }
    } else {
      it = N_GLA + (bx - N_GLA) + k * nup;
      if (it >= N_GLA + N_NA) break;
    }
    __syncthreads();
    if (it < N_GLA) {
      gla_item(p, l, it, smem);
    } else if (it < N_GLA + N_NA) {
      it -= N_GLA;
      const int rho = it & 63, bh = it >> 6;
      na_item(p, l, bh >> 4, bh & 15, rho, false, 0, smem);
    } else {
      it -= N_GLA + N_NA;
      const int qb = it & 3, bh = it >> 2;
      na_item(p, l, bh >> 4, bh & 15, 0, true, qb * 64, smem);
    }
  }
}


DI void grid_barrier(unsigned* bar, unsigned& bgen, unsigned xcc, unsigned nxcc, unsigned nx) {
  asm volatile("s_waitcnt vmcnt(0)" ::: "memory");
  __syncthreads();
  const unsigned target = bgen + 1;
  if (threadIdx.x == 0) {
    const unsigned old = __hip_atomic_fetch_add(bar + xcc * 64, 1u, __ATOMIC_RELAXED, __HIP_MEMORY_SCOPE_AGENT);
    if (old == target * nxcc - 1) {
      __builtin_amdgcn_fence(__ATOMIC_RELEASE, "agent");
      asm volatile("s_waitcnt vmcnt(0)" ::: "memory");
      const unsigned o2 = __hip_atomic_fetch_add(bar + 16 * 64, 1u, __ATOMIC_RELAXED, __HIP_MEMORY_SCOPE_AGENT);
      if (o2 == target * nx - 1) __hip_atomic_store(bar + 17 * 64, target, __ATOMIC_RELAXED, __HIP_MEMORY_SCOPE_AGENT);
    }
    while (__hip_atomic_load(bar + 17 * 64, __ATOMIC_RELAXED, __HIP_MEMORY_SCOPE_AGENT) < target) __builtin_amdgcn_s_sleep(1);
    __builtin_amdgcn_fence(__ATOMIC_ACQUIRE, "agent");
    asm volatile("s_waitcnt vmcnt(0)" ::: "memory");
  }
  bgen = target;
  __syncthreads();
}
typedef const __attribute__((address_space(4))) Params* KParamsPtr;
DI Params load_params() {
#if defined(__HIP_DEVICE_COMPILE__)
  KParamsPtr kp = (KParamsPtr)__builtin_amdgcn_kernarg_segment_ptr();
  asm volatile("" : "+s"(kp));
  Params r;
  __builtin_memcpy(&r, kp, sizeof(Params));
  return r;
#else
  return Params{};
#endif
}
#define PH(call) { const Params p = load_params(); call; }
__global__ void __launch_bounds__(256, 2) mega_kernel(Params p_unused) {
  extern __shared__ __attribute__((aligned(16))) char smem[];
  cg::grid_group grid = cg::this_grid();
  unsigned bgen = 0;
  const unsigned xcc = (unsigned)__builtin_amdgcn_s_getreg((3 << 11) | 20) & 15u;
  if (threadIdx.x == 0) {
    const Params pb = load_params();
    __hip_atomic_fetch_add((unsigned*)(pb.ws + OFF_BAR) + (18 + xcc) * 64, 1u, __ATOMIC_RELAXED, __HIP_MEMORY_SCOPE_AGENT);
  }
  PH(phase0(p, smem));
  grid.sync();
  unsigned nxcc = 0, nx = 0;
  {
    const Params pb = load_params();
    const unsigned* cen = (const unsigned*)(pb.ws + OFF_BAR) + 18 * 64;
    for (unsigned j = 0; j < 16; ++j) {
      const unsigned cj = __hip_atomic_load(cen + j * 64, __ATOMIC_RELAXED, __HIP_MEMORY_SCOPE_AGENT);
      nx += (cj != 0);
      if (j == xcc) nxcc = cj;
    }
  }
#define GBAR() { const Params pb = load_params(); grid_barrier((unsigned*)(pb.ws + OFF_BAR), bgen, xcc, nxcc, nx); }
#pragma unroll 1
  for (int g = 0; g < NGRP; ++g) {
#pragma unroll 1
    for (int l = 0; l < 4; ++l) {
      PH(phase_norm(p, l, g));
      GBAR();
      PH(phase_gemm_in(p, l, smem));
      GBAR();
      if (l & 1) {
        PH(phase_mix_odd(p, l, g, smem));
        GBAR();
        PH(phase_gla_combine(p, l));
      } else {
        PH(phase_mix_even(p, l, g, smem));
      }
      GBAR();
      PH(phase_gemm_out(p, l, smem));
      GBAR();
    }
    PH(phase_norm(p, 4, g));
    GBAR();
  }
}

extern "C" void kernel_launch(void* const* d_in, const int* in_sizes, int n_in, void* d_out, int out_size, void* d_ws,
                              size_t ws_size, hipStream_t stream) {
  static int grid_blocks = 0;
  if (!grid_blocks) {
    int dev = 0, cus = 0, per_cu = 0;
    hipGetDevice(&dev);
    hipDeviceGetAttribute(&cus, hipDeviceAttributeMultiprocessorCount, dev);
    hipFuncSetAttribute((const void*)mega_kernel, hipFuncAttributeMaxDynamicSharedMemorySize, SMEM_BYTES);
    hipOccupancyMaxActiveBlocksPerMultiprocessor(&per_cu, mega_kernel, 256, SMEM_BYTES);
    if (per_cu > 2) per_cu = 2;
    if (per_cu < 1) per_cu = 1;
    grid_blocks = cus * per_cu;
    grid_blocks &= ~15;
  }
  if (ws_size < WS_NEED) { fprintf(stderr, "workspace too small: %zu < %zu\n", ws_size, (size_t)WS_NEED); return; }
  Params p{};
  p.x = (const float*)d_in[0]; p.c = (const float*)d_in[1]; p.ctx = (const float*)d_in[2]; p.c_ctx = (const float*)d_in[3];
  p.w_mod = (const float*)d_in[4]; p.b_mod = (const float*)d_in[5]; p.g_pre = (const float*)d_in[6]; p.g_post = (const float*)d_in[7];
  p.w_out = (const float*)d_in[8]; p.ev_w_in = (const float*)d_in[9]; p.ev_lambda = (const float*)d_in[10]; p.ev_subln = (const float*)d_in[11];
  p.ev_conv = (const float*)d_in[12]; p.od_w_in = (const float*)d_in[13]; p.od_rpb = (const float*)d_in[14]; p.od_gate_up = (const float*)d_in[15];
  p.od_gate_bias = (const float*)d_in[16]; p.od_gnorm = (const float*)d_in[17];
  p.out = (float*)d_out;
  p.ws = (char*)d_ws;
  (void)hipMemsetAsync((char*)d_ws + OFF_BAR, 0, BAR_BYTES, stream);
  void* args[] = {&p};
  hipError_t e = hipLaunchCooperativeKernel((const void*)mega_kernel, dim3(grid_blocks), dim3(256), args, SMEM_BYTES, stream);
  if (e != hipSuccess) fprintf(stderr, "cooperative launch failed: %s (grid %d)\n", hipGetErrorString(e), grid_blocks);
}
```

```cpp
#include <hip/hip_runtime.h>
#include <hip/hip_cooperative_groups.h>
#include <cstdio>
namespace cg = cooperative_groups;

typedef unsigned short bfr;
typedef __attribute__((ext_vector_type(8))) short bf16x8;
typedef __attribute__((ext_vector_type(4))) float f32x4;
typedef __attribute__((ext_vector_type(4))) unsigned u32x4;
typedef __attribute__((ext_vector_type(2))) unsigned u32x2;
typedef __attribute__((ext_vector_type(16))) unsigned u32x16;
typedef __attribute__((ext_vector_type(2))) __bf16 bf16x2_t;
#define DI __device__ __forceinline__
DI float dot2bf(unsigned a, unsigned b, float c) { return __builtin_amdgcn_fdot2_f32_bf16(__builtin_bit_cast(bf16x2_t, a), __builtin_bit_cast(bf16x2_t, b), c, false); }
DI int opaque_tid() { int t = threadIdx.x; asm volatile("" : "+v"(t)); return t; }

constexpr int GB   = 4;
constexpr int NGRP = 2;
constexpr int ML   = GB * 4096;
constexpr int MC   = GB * 256;
constexpr int MR   = ML + MC;
constexpr int NEV  = 8192;
constexpr int NOD  = 7296;
constexpr int KEYS = 4352;
constexpr float L2E = 1.4426950408889634f;
constexpr float LN2 = 0.6931471805599453f;

constexpr size_t SZ_PROJ = (size_t)MR * 8192 * 2;
constexpr size_t SZ_H    = (size_t)MR * 1024 * 2;
constexpr size_t SZ_U    = (size_t)MR * 2048 * 2;
constexpr size_t SZ_VT   = (size_t)GB * 1024 * KEYS * 2;
constexpr size_t SZ_WE   = (size_t)NEV * 1024 * 2;
constexpr size_t SZ_WO   = (size_t)NOD * 1024 * 2;
constexpr size_t SZ_WOUT = (size_t)1024 * 2048 * 2;
constexpr size_t OFF_PROJ = 0;
constexpr size_t OFF_H    = OFF_PROJ + SZ_PROJ;
constexpr size_t OFF_U    = OFF_H + SZ_H;
constexpr size_t OFF_VT   = OFF_U + SZ_U;
constexpr size_t OFF_WIN  = OFF_VT + SZ_VT;
constexpr size_t OFF_WOUT = OFF_WIN + 2 * SZ_WE + 2 * SZ_WO;
constexpr size_t OFF_XC   = OFF_WOUT + 4 * SZ_WOUT;
constexpr size_t OFF_MOD  = OFF_XC + (size_t)8 * 256 * 1024 * 4;
constexpr size_t OFF_CS   = OFF_MOD + (size_t)4 * 9 * 3072 * 4;
constexpr size_t OFF_LAM  = OFF_CS + 64 * 16 * 8;
constexpr size_t OFF_CTR  = OFF_LAM + 256;
constexpr size_t OFF_BAR  = OFF_CTR + 256;
constexpr size_t BAR_BYTES = 34 * 256;
constexpr size_t WS_NEED  = OFF_BAR + BAR_BYTES;

constexpr int SMEM_BYTES = 80896;

struct Params {
  const float *x, *c, *ctx, *c_ctx, *w_mod, *b_mod, *g_pre, *g_post, *w_out, *ev_w_in, *ev_lambda, *ev_subln,
      *ev_conv, *od_w_in, *od_rpb, *od_gate_up, *od_gate_bias, *od_gnorm;
  float* out;
  char* ws;
};

DI size_t win_off(int l) { return OFF_WIN + (size_t)(l >> 1) * (SZ_WE + SZ_WO) + ((l & 1) ? SZ_WE : 0); }

DI float bf2f(bfr v) { return __uint_as_float(((unsigned)v) << 16); }
typedef __attribute__((ext_vector_type(2))) float f32x2_t;
DI bfr f2bf(float x) { return __builtin_bit_cast(bfr, (__bf16)x); }
DI unsigned pack2(float a, float b) { f32x2_t v = {a, b}; return __builtin_bit_cast(unsigned, __builtin_convertvector(v, bf16x2_t)); }
DI float lo_bf(unsigned u) { return __uint_as_float(u << 16); }
DI float hi_bf(unsigned u) { return __uint_as_float(u & 0xffff0000u); }
DI float fexp2(float x) { return __builtin_amdgcn_exp2f(x); }
DI float flog2(float x) { return __builtin_amdgcn_logf(x); }
DI float silu(float x) { return x / (1.f + fexp2(-x * L2E)); }
template <int M>
DI float shx(float v, int lane) {
  if (M < 32) return __builtin_bit_cast(float, __builtin_amdgcn_ds_swizzle(__builtin_bit_cast(int, v), (M << 10) | 0x1f));
  return __builtin_bit_cast(float, __builtin_amdgcn_ds_bpermute((lane ^ 32) << 2, __builtin_bit_cast(int, v)));
}
DI float wave_sum(float v, int lane) {
  v += shx<1>(v, lane); v += shx<2>(v, lane); v += shx<4>(v, lane); v += shx<8>(v, lane); v += shx<16>(v, lane); v += shx<32>(v, lane);
  return v;
}
DI f32x4 mfma16(bf16x8 a, bf16x8 b, f32x4 c) { return __builtin_amdgcn_mfma_f32_16x16x32_bf16(a, b, c, 0, 0, 0); }
DI int sw128(int row, int chunk) { return row * 128 + ((chunk ^ ((row >> 1) & 7)) << 4); }
DI int sw256(int row, int chunk) { return row * 256 + ((chunk ^ (row & 15)) << 4); }

DI void gemm_mainloop(const bfr* __restrict__ X, int ldx, const bfr* __restrict__ Y, int ldy, int K, char* smem,
                      f32x4 (&acc)[4][4]) {
  const int tid = opaque_tid(), lane = tid & 63, wid = tid >> 6, r = lane & 15, q = lane >> 4;
  const int wx = wid >> 1, wy = wid & 1;
  const int lr = tid >> 3, lc = tid & 7;
  const bfr* xp = X + (size_t)lr * ldx + lc * 8;
  const bfr* yp = Y + (size_t)lr * ldy + lc * 8;
  u32x4 xa0[4], ya0[4], xa1[4], ya1[4];
#pragma unroll
  for (int i = 0; i < 4; ++i) {
    xa0[i] = *(const u32x4*)(xp + (size_t)(32 * i) * ldx);
    ya0[i] = *(const u32x4*)(yp + (size_t)(32 * i) * ldy);
  }
#pragma unroll
  for (int i = 0; i < 4; ++i) {
    xa1[i] = *(const u32x4*)(xp + (size_t)(32 * i) * ldx + 64);
    ya1[i] = *(const u32x4*)(yp + (size_t)(32 * i) * ldy + 64);
  }
  const int nk = K >> 6;
#define GEMM_STEP(XR, YR, BUF, KT)                                                                       \
  {                                                                                                      \
    char* sX = smem + (BUF) * 32768;                                                                     \
    char* sY = sX + 16384;                                                                               \
    _Pragma("unroll") for (int i = 0; i < 4; ++i) {                                                      \
      *(u32x4*)(sX + sw128(lr + 32 * i, lc)) = XR[i];                                                    \
      *(u32x4*)(sY + sw128(lr + 32 * i, lc)) = YR[i];                                                    \
    }                                                                                                    \
    __syncthreads();                                                                                     \
    if ((KT) + 2 < nk) {                                                                                 \
      const int ko = ((KT) + 2) * 64;                                                                    \
      _Pragma("unroll") for (int i = 0; i < 4; ++i) {                                                    \
        XR[i] = *(const u32x4*)(xp + (size_t)(32 * i) * ldx + ko);                                       \
        YR[i] = *(const u32x4*)(yp + (size_t)(32 * i) * ldy + ko);                                       \
      }                                                                                                  \
    }                                                                                                    \
    _Pragma("unroll") for (int s = 0; s < 2; ++s) {                                                      \
      bf16x8 xf[4], yf[4];                                                                               \
      _Pragma("unroll") for (int i = 0; i < 4; ++i)                                                      \
          xf[i] = *(const bf16x8*)(sX + sw128(wx * 64 + i * 16 + r, s * 4 + q));                         \
      _Pragma("unroll") for (int j = 0; j < 4; ++j)                                                      \
          yf[j] = *(const bf16x8*)(sY + sw128(wy * 64 + j * 16 + r, s * 4 + q));                         \
      _Pragma("unroll") for (int i = 0; i < 4; ++i)                                                      \
          _Pragma("unroll") for (int j = 0; j < 4; ++j) acc[i][j] = mfma16(xf[i], yf[j], acc[i][j]);     \
    }                                                                                                    \
  }
  for (int kt = 0; kt < nk; kt += 2) {
    GEMM_STEP(xa0, ya0, 0, kt);
    GEMM_STEP(xa1, ya1, 1, kt + 1);
  }
#undef GEMM_STEP
  __syncthreads();
}

DI bool tile_map(int T, int MT, int NT, int& mt, int& nt) {
  const int pm_n = MT >> 3;
  const int P = (T >> 9) * 8 + (T & 7);
  const int li = (T & 511) >> 3;
  const int pm = P % pm_n, pn = P / pm_n;
  mt = pm * 8 + (li & 7);
  nt = pn * 8 + (li >> 3);
  return nt < NT;
}

DI int odd_col_src(int n) {
  if (n < 3584) return n;
  if (n < 7168) return n + 32;
  if (n < 7200) return n - 7168 + 3584;
  return -1;
}

DI void phase0(const Params& p, char* smem) {
  const int tid = opaque_tid();
  if (blockIdx.x < 384) {
    float* sc = (float*)smem;
    float* red = sc + 9 * 1024;
    for (int i = tid; i < 9 * 1024; i += 256) {
      const int b = i >> 10, k = i & 1023;
      const float v = (b < 8) ? p.c[b * 1024 + k] : p.c_ctx[k];
      sc[i] = v / (1.f + __expf(-v));
    }
    __syncthreads();
    float* modb = (float*)(p.ws + OFF_MOD);
    for (int it = blockIdx.x; it < 384; it += gridDim.x) {
      const int l = it / 96, cgp = it % 96;
      const int col = cgp * 32 + (tid & 31), ks = tid >> 5;
      float a[9];
#pragma unroll
      for (int b = 0; b < 9; ++b) a[b] = 0.f;
      const float* w = p.w_mod + ((size_t)l * 1024 + ks * 128) * 3072 + col;
#pragma unroll 4
      for (int k = 0; k < 128; ++k) {
        const float wv = w[(size_t)k * 3072];
#pragma unroll
        for (int b = 0; b < 9; ++b) a[b] += sc[b * 1024 + ks * 128 + k] * wv;
      }
#pragma unroll
      for (int b = 0; b < 9; ++b) red[(ks * 9 + b) * 32 + (tid & 31)] = a[b];
      __syncthreads();
      for (int idx = tid; idx < 288; idx += 256) {
        const int b = idx >> 5, cc = idx & 31;
        float s = p.b_mod[l * 3072 + cgp * 32 + cc];
#pragma unroll
        for (int k2 = 0; k2 < 8; ++k2) s += red[(k2 * 9 + b) * 32 + cc];
        modb[(size_t)(l * 9 + b) * 3072 + cgp * 32 + cc] = s;
      }
      __syncthreads();
    }
  }
  if (blockIdx.x == gridDim.x - 1) {
    float2* cs = (float2*)(p.ws + OFF_CS);
    for (int idx = tid; idx < 1024; idx += 256) {
      const int pos = idx >> 4, f = idx & 15;
      const float inv = 1.0f / powf(10000.f, (float)f * 0.0625f);
      const float ang = (float)pos * inv;
      const double ad = (double)ang;
      const double n = rint(ad * 0.15915494309189535);
      const float rr = (float)(ad - n * 6.283185307179586);
      cs[idx] = make_float2(__cosf(rr), __sinf(rr));
    }
    if (tid < 2) {
      const float* lp = p.ev_lambda + tid * 256;
      float s1 = 0.f, s2 = 0.f;
      for (int i = 0; i < 64; ++i) { s1 += lp[i] * lp[64 + i]; s2 += lp[128 + i] * lp[192 + i]; }
      const float li = (tid == 0) ? 0.2f : (0.8f - 0.6f * 0.5488116360940264f);
      float* lam = (float*)(p.ws + OFF_LAM);
      lam[tid] = __expf(s1) - __expf(s2) + li;
      lam[2 + tid] = li;
    }
    if (tid < 32) ((int*)(p.ws + OFF_CTR))[tid] = 0;
  }
  float* tile = (float*)smem;
  __syncthreads();
  for (int it = blockIdx.x; it < 9792; it += gridDim.x) {
    int rr = it, l, ktile, ntile, K, Nsrc;
    const float* src;
    bfr* dst;
    bool oddmap = false;
    if (rr < 7744) {
      if (rr < 2048) { l = 0; } else if (rr < 3872) { l = 1; rr -= 2048; } else if (rr < 5920) { l = 2; rr -= 3872; } else { l = 3; rr -= 5920; }
      ktile = rr & 15; ntile = rr >> 4; K = 1024;
      oddmap = (l & 1);
      Nsrc = oddmap ? 7200 : 8192;
      src = (oddmap ? p.od_w_in : p.ev_w_in) + (size_t)(l >> 1) * 1024 * Nsrc;
      dst = (bfr*)(p.ws + win_off(l));
    } else {
      rr -= 7744; l = rr >> 9; rr &= 511;
      ktile = rr & 31; ntile = rr >> 5; K = 2048; Nsrc = 1024;
      src = p.w_out + (size_t)l * 2048 * 1024;
      dst = (bfr*)(p.ws + OFF_WOUT + (size_t)l * SZ_WOUT);
    }
    const int k0 = ktile * 64, n0 = ntile * 64;
    {
      const int nn = tid & 63;
      const int nd = n0 + nn;
      const int ns = oddmap ? odd_col_src(nd) : nd;
#pragma unroll 4
      for (int i = 0; i < 16; ++i) {
        const int kk = (tid >> 6) + 4 * i;
        tile[kk * 65 + nn] = (ns >= 0) ? src[(size_t)(k0 + kk) * Nsrc + ns] : 0.f;
      }
    }
    __syncthreads();
    {
      const int kk8 = (tid & 7) * 8;
#pragma unroll
      for (int i2 = 0; i2 < 2; ++i2) {
        const int nn = (tid >> 3) + 32 * i2;
        u32x4 v;
        v.x = pack2(tile[(kk8 + 0) * 65 + nn], tile[(kk8 + 1) * 65 + nn]);
        v.y = pack2(tile[(kk8 + 2) * 65 + nn], tile[(kk8 + 3) * 65 + nn]);
        v.z = pack2(tile[(kk8 + 4) * 65 + nn], tile[(kk8 + 5) * 65 + nn]);
        v.w = pack2(tile[(kk8 + 6) * 65 + nn], tile[(kk8 + 7) * 65 + nn]);
        *(u32x4*)(dst + (size_t)(n0 + nn) * K + k0 + kk8) = v;
      }
    }
    __syncthreads();
  }
}

DI void phase_norm(const Params& p, int l, int g) {
  const int tid = opaque_tid(), lane = tid & 63, wid = tid >> 6;
  const int rows = (l == 4) ? ML : MR;
  const float* modb = (const float*)(p.ws + OFF_MOD);
  const bfr* ybuf = (const bfr*)(p.ws + OFF_PROJ);
  bfr* hbuf = (bfr*)(p.ws + OFF_H);
  float* xcb = (float*)(p.ws + OFF_XC);
  for (int row = blockIdx.x * 4 + wid; row < rows; row += gridDim.x * 4) {
    const bool lat = row < ML;
    const int mb = lat ? (g * GB + (row >> 12)) : 8;
    const size_t grow = lat ? ((size_t)g * ML + row) : ((size_t)g * MC + (row - ML));
    const float* xin;
    float* xst;
    if (lat) { xin = ((l <= 1) ? p.x : (const float*)p.out) + grow * 1024; xst = p.out + grow * 1024; }
    else     { xin = ((l <= 1) ? p.ctx : (const float*)xcb) + grow * 1024; xst = xcb + grow * 1024; }
    float4 xv[4];
#pragma unroll
    for (int i = 0; i < 4; ++i) xv[i] = *(const float4*)(xin + lane * 4 + 256 * i);
    if (l >= 1) {
      float4 yv[4];
      float ss = 0.f;
#pragma unroll
      for (int i = 0; i < 4; ++i) {
        const u32x2 yr = *(const u32x2*)(ybuf + (size_t)row * 1024 + lane * 4 + 256 * i);
        yv[i] = make_float4(lo_bf(yr.x), hi_bf(yr.x), lo_bf(yr.y), hi_bf(yr.y));
        ss += yv[i].x * yv[i].x + yv[i].y * yv[i].y + yv[i].z * yv[i].z + yv[i].w * yv[i].w;
      }
      ss = wave_sum(ss, lane);
      const float rn = rsqrtf(ss * (1.f / 1024.f) + 1e-6f);
      const float* gate = modb + (size_t)((l - 1) * 9 + mb) * 3072 + 2048;
      const float* gp = p.g_post + (l - 1) * 1024;
#pragma unroll
      for (int i = 0; i < 4; ++i) {
        const int c0 = lane * 4 + 256 * i;
        const float4 gt = *(const float4*)(gate + c0);
        const float4 gg = *(const float4*)(gp + c0);
        xv[i].x += gt.x * (yv[i].x * rn * gg.x);
        xv[i].y += gt.y * (yv[i].y * rn * gg.y);
        xv[i].z += gt.z * (yv[i].z * rn * gg.z);
        xv[i].w += gt.w * (yv[i].w * rn * gg.w);
        *(float4*)(xst + c0) = xv[i];
      }
    }
    if (l < 4) {
      float ss = 0.f;
#pragma unroll
      for (int i = 0; i < 4; ++i) ss += xv[i].x * xv[i].x + xv[i].y * xv[i].y + xv[i].z * xv[i].z + xv[i].w * xv[i].w;
      ss = wave_sum(ss, lane);
      const float rn = rsqrtf(ss * (1.f / 1024.f) + 1e-6f);
      const float* mrow = modb + (size_t)(l * 9 + mb) * 3072;
      const float* gpre = p.g_pre + l * 1024;
#pragma unroll
      for (int i = 0; i < 4; ++i) {
        const int c0 = lane * 4 + 256 * i;
        const float4 sh = *(const float4*)(mrow + c0);
        const float4 scl = *(const float4*)(mrow + 1024 + c0);
        const float4 gg = *(const float4*)(gpre + c0);
        u32x2 o;
        o.x = pack2(xv[i].x * rn * gg.x * (1.f + scl.x) + sh.x, xv[i].y * rn * gg.y * (1.f + scl.y) + sh.y);
        o.y = pack2(xv[i].z * rn * gg.z * (1.f + scl.z) + sh.z, xv[i].w * rn * gg.w * (1.f + scl.w) + sh.w);
        *(u32x2*)(hbuf + (size_t)row * 1024 + c0) = o;
      }
    }
  }
}

DI void phase_gemm_in(const Params& p, int l, char* smem) {
  const int tid = opaque_tid(), lane = tid & 63, wid = tid >> 6, r = lane & 15, q = lane >> 4;
  const int wx = wid >> 1, wy = wid & 1;
  const bool even = !(l & 1);
  const int ldp = even ? NEV : NOD;
  const int NT = ldp >> 7, MT = MR >> 7;
  const bfr* WT = (const bfr*)(p.ws + win_off(l));
  const bfr* H = (const bfr*)(p.ws + OFF_H);
  bfr* proj = (bfr*)(p.ws + OFF_PROJ);
  bfr* VT = (bfr*)(p.ws + OFF_VT);
  const float2* cs = (const float2*)(p.ws + OFF_CS);
  const int total = ((((MT >> 3) * ((NT + 7) >> 3)) + 7) >> 3) << 9;
  for (int T = blockIdx.x; T < total; T += gridDim.x) {
    int mt, nt;
    if (!tile_map(T, MT, NT, mt, nt)) continue;
    const int m0 = mt * 128, n0 = nt * 128;
    const bool vt = (n0 >= 1024 && n0 < 2048);
    f32x4 acc[4][4];
#pragma unroll
    for (int i = 0; i < 4; ++i)
#pragma unroll
      for (int j = 0; j < 4; ++j) acc[i][j] = (f32x4){0.f, 0.f, 0.f, 0.f};
    const bfr* X = vt ? (H + (size_t)m0 * 1024) : (WT + (size_t)n0 * 1024);
    const bfr* Y = vt ? (WT + (size_t)n0 * 1024) : (H + (size_t)m0 * 1024);
    gemm_mainloop(X, 1024, Y, 1024, 1024, smem, acc);
    if (vt) {
#pragma unroll
      for (int i = 0; i < 4; ++i) {
        const int mbase = m0 + wx * 64 + i * 16;
        int b, kp;
        if (mbase < ML) { b = mbase >> 12; kp = mbase & 4095; } else { const int mm = mbase - ML; b = mm >> 8; kp = 4096 + (mm & 255); }
        const int pos = (kp & ~31) + q * 8 + ((kp >> 4) & 1) * 4;
#pragma unroll
        for (int jn = 0; jn < 4; ++jn) {
          const int f = n0 - 1024 + wy * 64 + jn * 16 + r;
          u32x2 o;
          o.x = pack2(acc[i][jn][0], acc[i][jn][1]);
          o.y = pack2(acc[i][jn][2], acc[i][jn][3]);
          *(u32x2*)(VT + ((size_t)(b * 1024 + f)) * KEYS + pos) = o;
        }
      }
    } else {
      const bool rope = even && (n0 < 1024 || (n0 >= 2048 && n0 < 3072)) && (m0 < ML);
      if (rope) {
#pragma unroll
        for (int jn = 0; jn < 4; ++jn) {
          const int m = m0 + wy * 64 + jn * 16 + r;
          const int t = m & 4095;
          const int grow = t >> 6, gcol = t & 63;
#pragma unroll
          for (int j = 0; j < 4; ++j) {
            const float2 a = cs[grow * 16 + 4 * q + j];
            const float2 c = cs[gcol * 16 + 4 * q + j];
            const float x0 = acc[0][jn][j], x1 = acc[1][jn][j], x2 = acc[2][jn][j], x3 = acc[3][jn][j];
            acc[0][jn][j] = x0 * a.x - x1 * a.y;
            acc[1][jn][j] = x1 * a.x + x0 * a.y;
            acc[2][jn][j] = x2 * c.x - x3 * c.y;
            acc[3][jn][j] = x3 * c.x + x2 * c.y;
          }
        }
      }
#pragma unroll
      for (int jn = 0; jn < 4; ++jn) {
        const int m = m0 + wy * 64 + jn * 16 + r;
#pragma unroll
        for (int i = 0; i < 4; ++i) {
          const int n = n0 + wx * 64 + i * 16 + 4 * q;
          u32x2 o;
          o.x = pack2(acc[i][jn][0], acc[i][jn][1]);
          o.y = pack2(acc[i][jn][2], acc[i][jn][3]);
          *(u32x2*)(proj + (size_t)m * ldp + n) = o;
        }
      }
    }
  }
}

DI void phase_gemm_out(const Params& p, int l, char* smem) {
  const int tid = opaque_tid(), lane = tid & 63, wid = tid >> 6, r = lane & 15, q = lane >> 4;
  const int wx = wid >> 1, wy = wid & 1;
  const bfr* WT = (const bfr*)(p.ws + OFF_WOUT + (size_t)l * SZ_WOUT);
  const bfr* U = (const bfr*)(p.ws + OFF_U);
  bfr* ybuf = (bfr*)(p.ws + OFF_PROJ);
  const int MT = (l == 3) ? (ML >> 7) : (MR >> 7);
  const int total = (((MT >> 3) + 7) >> 3) << 9;
  for (int T = blockIdx.x; T < total; T += gridDim.x) {
    int mt, nt;
    if (!tile_map(T, MT, 8, mt, nt)) continue;
    const int m0 = mt * 128, n0 = nt * 128;
    f32x4 acc[4][4];
#pragma unroll
    for (int i = 0; i < 4; ++i)
#pragma unroll
      for (int j = 0; j < 4; ++j) acc[i][j] = (f32x4){0.f, 0.f, 0.f, 0.f};
    gemm_mainloop(WT + (size_t)n0 * 2048, 2048, U + (size_t)m0 * 2048, 2048, 2048, smem, acc);
#pragma unroll
    for (int jn = 0; jn < 4; ++jn) {
      const int m = m0 + wy * 64 + jn * 16 + r;
#pragma unroll
      for (int i = 0; i < 4; ++i) {
        const int n = n0 + wx * 64 + i * 16 + 4 * q;
        u32x2 o;
        o.x = pack2(acc[i][jn][0], acc[i][jn][1]);
        o.y = pack2(acc[i][jn][2], acc[i][jn][3]);
        *(u32x2*)(ybuf + (size_t)m * 1024 + n) = o;
      }
    }
  }
}

template <int DV, int QT, int KT, int MODE>
DI void attn_engine(const bfr* __restrict__ qbase, int ldq, const bfr* __restrict__ kbase, int ldk,
                    const bfr* __restrict__ vt, int nloc, int loc_row0, int loc_pos0, int nctx, int ctx_row0,
                    const float* rpb_s, int roff0, char* smem, f32x4 (&O)[DV / 16][QT], float (&lsum)[QT]) {
  constexpr int STAGE = 8192 + DV * 128;
  constexpr int NVL = DV / 32;
  const int tid = opaque_tid(), lane = tid & 63, wid = tid >> 6, r = lane & 15, q = lane >> 4;
  const int lr = tid >> 3, lc = tid & 7;
  constexpr float SC = 0.125f * L2E;

  bf16x8 Qf[QT][2];
#pragma unroll
  for (int qt = 0; qt < QT; ++qt)
#pragma unroll
    for (int s = 0; s < 2; ++s)
      Qf[qt][s] = *(const bf16x8*)(qbase + (size_t)(wid * 16 * QT + qt * 16 + r) * ldq + s * 32 + q * 8);
  float mrun[QT];
#pragma unroll
  for (int qt = 0; qt < QT; ++qt) {
    mrun[qt] = -1e30f;
    lsum[qt] = 0.f;
#pragma unroll
    for (int dt = 0; dt < DV / 16; ++dt) O[dt][qt] = (f32x4){0.f, 0.f, 0.f, 0.f};
  }

  const int nch = nloc + nctx;
  u32x4 kreg0, kreg1, vreg[NVL];
  const int ksw0 = sw128(lr, lc), ksw1 = sw128(lr + 32, lc);
#define AT_LOAD(c_)                                                                                          \
  {                                                                                                          \
    const int cc_ = (c_);                                                                                    \
    const int row_ = (cc_ < nloc) ? (loc_row0 + cc_ * 64) : (ctx_row0 + (cc_ - nloc) * 64);                  \
    const int pos_ = (cc_ < nloc) ? (loc_pos0 + cc_ * 64) : (4096 + (cc_ - nloc) * 64);                      \
    kreg0 = *(const u32x4*)(kbase + (size_t)(row_ + lr) * ldk + lc * 8);                                     \
    kreg1 = *(const u32x4*)(kbase + (size_t)(row_ + lr + 32) * ldk + lc * 8);                                \
    _Pragma("unroll") for (int i_ = 0; i_ < NVL; ++i_)                                                       \
        vreg[i_] = *(const u32x4*)(vt + (size_t)(lr + 32 * i_) * KEYS + pos_ + lc * 8);                      \
  }
#define AT_STORE(c_)                                                                                         \
  {                                                                                                          \
    char* sb_ = smem + ((c_) & 1) * STAGE;                                                                   \
    *(u32x4*)(sb_ + ksw0) = kreg0;                                                                           \
    *(u32x4*)(sb_ + ksw1) = kreg1;                                                                           \
    _Pragma("unroll") for (int i_ = 0; i_ < NVL; ++i_)                                                       \
        *(u32x4*)(sb_ + 8192 + sw128(lr + 32 * i_, lc)) = vreg[i_];                                          \
  }
  if (nch > 0) { AT_LOAD(0); AT_STORE(0); }
  for (int c = 0; c < nch; ++c) {
    __syncthreads();
    const bool more = (c + 1 < nch);
    const char* sK = smem + (c & 1) * STAGE;
    const char* sV = sK + 8192;
    if (more) AT_LOAD(c + 1);
    f32x4 stall[4 / KT][KT][QT];
#pragma unroll
    for (int sbk = 0; sbk < 4 / KT; ++sbk) {
#pragma unroll
      for (int kt = 0; kt < KT; ++kt)
#pragma unroll
        for (int qt = 0; qt < QT; ++qt) stall[sbk][kt][qt] = (f32x4){0.f, 0.f, 0.f, 0.f};
#pragma unroll
      for (int s = 0; s < 2; ++s)
#pragma unroll
        for (int kt = 0; kt < KT; ++kt) {
          const bf16x8 ka = *(const bf16x8*)(sK + sw128(sbk * KT * 16 + kt * 16 + r, s * 4 + q));
#pragma unroll
          for (int qt = 0; qt < QT; ++qt) stall[sbk][kt][qt] = mfma16(ka, Qf[qt][s], stall[sbk][kt][qt]);
        }
    }
#pragma unroll
    for (int sbk = 0; sbk < 4 / KT; ++sbk) {
      f32x4 (&st)[KT][QT] = stall[sbk];
      bf16x8 pb[KT / 2][QT];
      if (MODE == 1) {
#pragma unroll
        for (int kt = 0; kt < KT; ++kt)
#pragma unroll
          for (int qt = 0; qt < QT; ++qt)
#pragma unroll
            for (int j = 0; j < 4; ++j) {
              float v = st[kt][qt][j] * SC;
              if (c < nloc) {
                const int kc = sbk * KT * 16 + kt * 16 + 4 * q + j;
                const int qc = wid * 16 + r;
                int wst = qc - 8; wst = wst < 0 ? 0 : (wst > 48 ? 48 : wst);
                const bool valid = (kc >= wst) && (kc < wst + 16);
                int co = kc - qc + 15; co = co < 0 ? 0 : (co > 30 ? 30 : co);
                const float bias = rpb_s[(roff0 + c) * 31 + co] * L2E;
                v = valid ? (v + bias) : -INFINITY;
              }
              st[kt][qt][j] = v;
            }
      }
#pragma unroll
      for (int qt = 0; qt < QT; ++qt) {
        float mx = fmaxf(fmaxf(st[0][qt][0], st[0][qt][1]), fmaxf(st[0][qt][2], st[0][qt][3]));
#pragma unroll
        for (int kt = 1; kt < KT; ++kt) {
          mx = __builtin_fmaxf(mx, __builtin_fmaxf(st[kt][qt][0], st[kt][qt][1]));
          mx = __builtin_fmaxf(mx, __builtin_fmaxf(st[kt][qt][2], st[kt][qt][3]));
        }
        if (MODE != 1) mx *= SC;
        if (__any(mx > mrun[qt] + 8.f)) {
          mx = fmaxf(mx, shx<16>(mx, lane));
          mx = fmaxf(mx, shx<32>(mx, lane));
          const float mnew2 = fmaxf(mrun[qt], mx);
          const float alpha = fexp2(mrun[qt] - mnew2);
          mrun[qt] = mnew2;
          lsum[qt] *= alpha;
#pragma unroll
          for (int dt = 0; dt < DV / 16; ++dt) {
            O[dt][qt][0] *= alpha; O[dt][qt][1] *= alpha; O[dt][qt][2] *= alpha; O[dt][qt][3] *= alpha;
          }
        }
        const float mnew = mrun[qt];
        f32x2_t ps2 = {0.f, 0.f};
#pragma unroll
        for (int kt = 0; kt < KT; ++kt) {
          float e0, e1, e2, e3;
          if (MODE == 1) {
            e0 = fexp2(st[kt][qt][0] - mnew); e1 = fexp2(st[kt][qt][1] - mnew);
            e2 = fexp2(st[kt][qt][2] - mnew); e3 = fexp2(st[kt][qt][3] - mnew);
          } else {
            e0 = fexp2(__builtin_fmaf(st[kt][qt][0], SC, -mnew)); e1 = fexp2(__builtin_fmaf(st[kt][qt][1], SC, -mnew));
            e2 = fexp2(__builtin_fmaf(st[kt][qt][2], SC, -mnew)); e3 = fexp2(__builtin_fmaf(st[kt][qt][3], SC, -mnew));
          }
          st[kt][qt][0] = e0; st[kt][qt][1] = e1; st[kt][qt][2] = e2; st[kt][qt][3] = e3;
          const f32x2_t a01 = {e0, e1}, a23 = {e2, e3};
          ps2 = ps2 + a01;
          ps2 = ps2 + a23;
        }
        lsum[qt] += ps2.x + ps2.y;
#pragma unroll
        for (int ks = 0; ks < KT / 2; ++ks) {
          u32x4 pk;
          pk.x = pack2(st[2 * ks][qt][0], st[2 * ks][qt][1]);
          pk.y = pack2(st[2 * ks][qt][2], st[2 * ks][qt][3]);
          pk.z = pack2(st[2 * ks + 1][qt][0], st[2 * ks + 1][qt][1]);
          pk.w = pack2(st[2 * ks + 1][qt][2], st[2 * ks + 1][qt][3]);
          pb[ks][qt] = __builtin_bit_cast(bf16x8, pk);
        }
      }
#pragma unroll
      for (int dt = 0; dt < DV / 16; ++dt)
#pragma unroll
        for (int ks = 0; ks < KT / 2; ++ks) {
          const bf16x8 va = *(const bf16x8*)(sV + sw128(dt * 16 + r, (sbk * (KT / 2) + ks) * 4 + q));
#pragma unroll
          for (int qt = 0; qt < QT; ++qt) O[dt][qt] = mfma16(va, pb[ks][qt], O[dt][qt]);
        }
    }
    if (more) AT_STORE(c + 1);
  }
#undef AT_LOAD
#undef AT_STORE
  __syncthreads();
#pragma unroll
  for (int qt = 0; qt < QT; ++qt) {
    float L = lsum[qt];
    L += shx<16>(L, lane);
    L += shx<32>(L, lane);
    lsum[qt] = L;
  }
}

DI void diff_attn_item(const Params& p, int l, int b, int head, int qrow0, bool ctxq, char* smem) {
  const int tid = opaque_tid(), lane = tid & 63, wid = tid >> 6, r = lane & 15, q = lane >> 4;
  const bfr* proj = (const bfr*)(p.ws + OFF_PROJ);
  const bfr* VT = (const bfr*)(p.ws + OFF_VT);
  bfr* U = (bfr*)(p.ws + OFF_U);
  const float* lamv = (const float*)(p.ws + OFF_LAM);
  const float lam = lamv[l >> 1], lam_init = lamv[2 + (l >> 1)];
  f32x4 O[8][2];
  float ls[2];
  char* parkb = smem + 49152 + tid * 16;
  attn_engine<128, 2, 2, 0>(proj + (size_t)qrow0 * NEV + 2048 + head * 128, NEV, proj + head * 128, NEV,
                            VT + (size_t)(b * 1024 + head * 128) * KEYS, ctxq ? 0 : 64, b * 4096, 0, 4,
                            ML + b * 256, nullptr, 0, smem, O, ls);
  u32x4 pkr0, pkr1;
  {
    const float i0 = 1.f / ls[0], i1 = 1.f / ls[1];
#pragma unroll
    for (int dt = 0; dt < 8; dt += 2) {
      u32x4 v0, v1;
      v0.x = pack2(O[dt][0][0] * i0, O[dt][0][1] * i0);
      v0.y = pack2(O[dt][0][2] * i0, O[dt][0][3] * i0);
      v0.z = pack2(O[dt + 1][0][0] * i0, O[dt + 1][0][1] * i0);
      v0.w = pack2(O[dt + 1][0][2] * i0, O[dt + 1][0][3] * i0);
      v1.x = pack2(O[dt][1][0] * i1, O[dt][1][1] * i1);
      v1.y = pack2(O[dt][1][2] * i1, O[dt][1][3] * i1);
      v1.z = pack2(O[dt + 1][1][0] * i1, O[dt + 1][1][1] * i1);
      v1.w = pack2(O[dt + 1][1][2] * i1, O[dt + 1][1][3] * i1);
      if (dt < 6) {
        *(u32x4*)(parkb + (dt / 2) * 4096) = v0;
        *(u32x4*)(parkb + (3 + dt / 2) * 4096) = v1;
      } else { pkr0 = v0; pkr1 = v1; }
    }
  }
  attn_engine<128, 2, 2, 0>(proj + (size_t)qrow0 * NEV + 2048 + head * 128 + 64, NEV, proj + head * 128 + 64, NEV,
                            VT + (size_t)(b * 1024 + head * 128) * KEYS, ctxq ? 0 : 64, b * 4096, 0, 4,
                            ML + b * 256, nullptr, 0, smem, O, ls);
  const float* subln = p.ev_subln + (l >> 1) * 128;
#pragma unroll
  for (int qt = 0; qt < 2; ++qt) {
    const float i1 = lam / ls[qt];
    float ss = 0.f;
#pragma unroll
    for (int dt = 0; dt < 8; ++dt) {
      unsigned pa, pc;
      if (dt < 6) {
        const u32x2 pk2 = *(const u32x2*)(parkb + (qt * 3 + dt / 2) * 4096 + (dt & 1) * 8);
        pa = pk2.x; pc = pk2.y;
      } else {
        const u32x4 pr = qt ? pkr1 : pkr0;
        pa = (dt & 1) ? pr.z : pr.x; pc = (dt & 1) ? pr.w : pr.y;
      }
      const float o0 = lo_bf(pa) - O[dt][qt][0] * i1;
      const float o1 = hi_bf(pa) - O[dt][qt][1] * i1;
      const float o2 = lo_bf(pc) - O[dt][qt][2] * i1;
      const float o3 = hi_bf(pc) - O[dt][qt][3] * i1;
      O[dt][qt][0] = o0; O[dt][qt][1] = o1; O[dt][qt][2] = o2; O[dt][qt][3] = o3;
      ss += o0 * o0 + o1 * o1 + o2 * o2 + o3 * o3;
    }
    ss += shx<16>(ss, lane);
    ss += shx<32>(ss, lane);
    const float rn = rsqrtf(ss * (1.f / 128.f) + 1e-6f) * (1.f - lam_init);
    const int row = qrow0 + wid * 32 + qt * 16 + r;
#pragma unroll
    for (int dt = 0; dt < 8; ++dt) {
      const int dv = dt * 16 + 4 * q;
      const u32x2 ag = *(const u32x2*)(proj + (size_t)row * NEV + 3072 + head * 128 + dv);
      const float4 sl = *(const float4*)(subln + dv);
      u32x2 o;
      o.x = pack2(O[dt][qt][0] * rn * sl.x * silu(lo_bf(ag.x)), O[dt][qt][1] * rn * sl.y * silu(hi_bf(ag.x)));
      o.y = pack2(O[dt][qt][2] * rn * sl.z * silu(lo_bf(ag.y)), O[dt][qt][3] * rn * sl.w * silu(hi_bf(ag.y)));
      *(u32x2*)(U + (size_t)row * 2048 + head * 128 + dv) = o;
    }
  }
}

DI void na_item(const Params& p, int l, int b, int head, int rho, bool ctxq, int cq0, char* smem) {
  const int tid = opaque_tid(), lane = tid & 63, wid = tid >> 6, r = lane & 15, q = lane >> 4;
  const bfr* proj = (const bfr*)(p.ws + OFF_PROJ);
  const bfr* VT = (const bfr*)(p.ws + OFF_VT);
  bfr* U = (bfr*)(p.ws + OFF_U);
  float* rpb_s = (float*)(smem + 2 * (8192 + 64 * 128));
  int rs = rho - 4; rs = rs < 0 ? 0 : (rs > 56 ? 56 : rs);
  const int qrow0 = ctxq ? (ML + b * 256 + cq0) : (b * 4096 + rho * 64);
  f32x4 O[4][1];
  float ls[1];
  if (!ctxq) {
    const float* rp = p.od_rpb + ((size_t)(l >> 1) * 16 + head) * 465;
    for (int i = tid; i < 465; i += 256) rpb_s[i] = rp[i];
    attn_engine<64, 1, 4, 1>(proj + (size_t)qrow0 * NOD + 3584 + head * 64, NOD, proj + head * 64, NOD,
                                VT + (size_t)(b * 1024 + head * 64) * KEYS, 8, b * 4096 + rs * 64, rs * 64, 4,
                                ML + b * 256, rpb_s, rs - rho + 7, smem, O, ls);
  } else {
    attn_engine<64, 1, 4, 0>(proj + (size_t)qrow0 * NOD + 3584 + head * 64, NOD, proj + head * 64, NOD,
                                VT + (size_t)(b * 1024 + head * 64) * KEYS, 0, 0, 0, 4, ML + b * 256, nullptr, 0,
                                smem, O, ls);
  }
  const float inv = 1.f / ls[0];
  const int row = qrow0 + wid * 16 + r;
#pragma unroll
  for (int dt = 0; dt < 4; ++dt) {
    const int dv = dt * 16 + 4 * q;
    const u32x2 cgv = *(const u32x2*)(proj + (size_t)row * NOD + 5120 + head * 64 + dv);
    u32x2 o;
    o.x = pack2(O[dt][0][0] * inv * silu(lo_bf(cgv.x)), O[dt][0][1] * inv * silu(hi_bf(cgv.x)));
    o.y = pack2(O[dt][0][2] * inv * silu(lo_bf(cgv.y)), O[dt][0][3] * inv * silu(hi_bf(cgv.y)));
    *(u32x2*)(U + (size_t)row * 2048 + head * 64 + dv) = o;
  }
}

DI void conv_item(const Params& p, int l, int item) {
  const int tid = opaque_tid();
  const bfr* proj = (const bfr*)(p.ws + OFF_PROJ);
  bfr* U = (bfr*)(p.ws + OFF_U);
  const float* cw = p.ev_conv + (size_t)(l >> 1) * 3 * 1024;
#pragma unroll 1
  for (int i = 0; i < 8; ++i) {
    const int v = tid + 256 * i;
    const int ri = v >> 7, ch = (v & 127) * 8;
    const int m = item * 16 + ri;
    int t, T;
    if (m < ML) { t = m & 4095; T = 4096; } else { t = (m - ML) & 255; T = 256; }
    const bfr* pr = proj + (size_t)m * NEV;
    float acc[8];
#pragma unroll
    for (int e = 0; e < 8; ++e) acc[e] = 0.f;
#pragma unroll
    for (int w = 0; w < 3; ++w) {
      const int tt = t + w - 1;
      if (tt >= 0 && tt < T) {
        const bfr* prw = pr + (ptrdiff_t)(w - 1) * NEV;
        const u32x4 bh = *(const u32x4*)(prw + 4096 + ch);
        const u32x4 bc = *(const u32x4*)(prw + 6144 + ch);
        const float4 w0 = *(const float4*)(cw + w * 1024 + ch);
        const float4 w1 = *(const float4*)(cw + w * 1024 + ch + 4);
        acc[0] += w0.x * lo_bf(bh.x) * lo_bf(bc.x); acc[1] += w0.y * hi_bf(bh.x) * hi_bf(bc.x);
        acc[2] += w0.z * lo_bf(bh.y) * lo_bf(bc.y); acc[3] += w0.w * hi_bf(bh.y) * hi_bf(bc.y);
        acc[4] += w1.x * lo_bf(bh.z) * lo_bf(bc.z); acc[5] += w1.y * hi_bf(bh.z) * hi_bf(bc.z);
        acc[6] += w1.z * lo_bf(bh.w) * lo_bf(bc.w); acc[7] += w1.w * hi_bf(bh.w) * hi_bf(bc.w);
      }
    }
    const u32x4 bb = *(const u32x4*)(pr + 5120 + ch);
    const u32x4 bg = *(const u32x4*)(pr + 7168 + ch);
    u32x4 o;
    o.x = pack2(lo_bf(bb.x) * acc[0] * silu(lo_bf(bg.x)), hi_bf(bb.x) * acc[1] * silu(hi_bf(bg.x)));
    o.y = pack2(lo_bf(bb.y) * acc[2] * silu(lo_bf(bg.y)), hi_bf(bb.y) * acc[3] * silu(hi_bf(bg.y)));
    o.z = pack2(lo_bf(bb.z) * acc[4] * silu(lo_bf(bg.z)), hi_bf(bb.z) * acc[5] * silu(hi_bf(bg.z)));
    o.w = pack2(lo_bf(bb.w) * acc[6] * silu(lo_bf(bg.w)), hi_bf(bb.w) * acc[7] * silu(hi_bf(bg.w)));
    *(u32x4*)(U + (size_t)m * 2048 + 1024 + ch) = o;
  }
}

DI void gla_item(const Params& p, int l, int item, char* smem) {
  const int tid0 = opaque_tid();
  const int slice = item & 7, dir = (item >> 3) & 1, head = (item >> 4) & 3, b = item >> 6;
  const int jl = l >> 1;
  const bfr* proj = (const bfr*)(p.ws + OFF_PROJ);
  char* sQb = smem;
  char* sKc = smem + 16384;
  char* sKbT = smem + 32768;
  char* sVt = smem + 49152;
  char* sAtt = smem + 53248;
  float* sLr = (float*)sAtt;
  float* sHs = (float*)(sAtt + 4096);
  char* sST = smem + 61440;
  float* sDec = (float*)(smem + 77824);

  unsigned gu[8];
  {
  const int d = tid0 & 127;
#pragma unroll
  for (int k = 0; k < 8; ++k)
    gu[k] = pack2(p.od_gate_up[(((size_t)jl * 2 + dir) * 16 + 2 * k) * 512 + head * 128 + d],
                  p.od_gate_up[(((size_t)jl * 2 + dir) * 16 + 2 * k + 1) * 512 + head * 128 + d]);
  }
  const float gbias = p.od_gate_bias[((size_t)jl * 2 + dir) * 512 + head * 128 + (tid0 & 127)];
  const float qscale = 0.08838834764831845f;

  f32x4 S[2][2];
#pragma unroll
  for (int a = 0; a < 2; ++a)
#pragma unroll
    for (int c2 = 0; c2 < 2; ++c2) S[a][c2] = (f32x4){0.f, 0.f, 0.f, 0.f};
  __syncthreads();
  for (int i = tid0; i < 512; i += 256) ((u32x4*)sST)[i] = (u32x4){0u, 0u, 0u, 0u};

  u32x4 pq0, pq1, pq2, pq3, pk0, pk1, pk2, pk3, pv;
  u32x2 plr;
#define GLA_ROW0(ci_) (((ci_) < 4) ? (ML + b * 256 + (dir ? (3 - (ci_)) : (ci_)) * 64) : (b * 4096 + (dir ? (67 - (ci_)) : ((ci_) - 4)) * 64))
#define GLA_LOAD(ci_)                                                                                         \
  {                                                                                                           \
    const int prow = tid >> 4, pch = tid & 15, vs = tid >> 2, vpart = tid & 3;                                \
    const bfr* pr_ = proj + (size_t)(GLA_ROW0(ci_) + prow) * NOD + head * 128 + pch * 8;                      \
    pq0 = *(const u32x4*)(pr_ + 4608);                     pk0 = *(const u32x4*)(pr_ + 2048);                 \
    pq1 = *(const u32x4*)(pr_ + 4608 + (size_t)16 * NOD);  pk1 = *(const u32x4*)(pr_ + 2048 + (size_t)16 * NOD); \
    pq2 = *(const u32x4*)(pr_ + 4608 + (size_t)32 * NOD);  pk2 = *(const u32x4*)(pr_ + 2048 + (size_t)32 * NOD); \
    pq3 = *(const u32x4*)(pr_ + 4608 + (size_t)48 * NOD);  pk3 = *(const u32x4*)(pr_ + 2048 + (size_t)48 * NOD); \
    const bfr* pv_ = proj + (size_t)(GLA_ROW0(ci_) + vs) * NOD;                                               \
    pv = *(const u32x4*)(pv_ + 2560 + head * 256 + slice * 32 + vpart * 8);                                   \
    plr = *(const u32x2*)(pv_ + 7168 + dir * 16 + vpart * 4);                                                 \
  }
  { const int tid = tid0; GLA_LOAD(0); }
  for (int ci = 0; ci < 68; ++ci) {
    int tid = tid0; asm volatile("" : "+v"(tid));
    const int lane = tid & 63, wid = tid >> 6, r = lane & 15, q = lane >> 4;
    const int d = tid & 127, half = tid >> 7;
    const int prow = tid >> 4, pch = tid & 15, vs = tid >> 2, vpart = tid & 3;
    const int row0 = GLA_ROW0(ci);
    const char* stc = sST + (ci & 1) * 8192;
    char* stn = sST + ((ci + 1) & 1) * 8192;
    __syncthreads();
    {
      *(u32x4*)(sQb + sw256(prow, pch)) = pq0;       *(u32x4*)(sKc + sw256(prow, pch)) = pk0;
      *(u32x4*)(sQb + sw256(prow + 16, pch)) = pq1;  *(u32x4*)(sKc + sw256(prow + 16, pch)) = pk1;
      *(u32x4*)(sQb + sw256(prow + 32, pch)) = pq2;  *(u32x4*)(sKc + sw256(prow + 32, pch)) = pk2;
      *(u32x4*)(sQb + sw256(prow + 48, pch)) = pq3;  *(u32x4*)(sKc + sw256(prow + 48, pch)) = pk3;
      *(u32x2*)((char*)sLr + vs * 32 + vpart * 8) = plr;
      const unsigned vv[4] = {pv.x, pv.y, pv.z, pv.w};
#pragma unroll
      for (int j = 0; j < 4; ++j) {
        const int e0 = vpart * 8 + 2 * j;
        *(bfr*)(sVt + sw128(e0, vs >> 3) + (vs & 7) * 2) = (bfr)(vv[j] & 0xffffu);
        *(bfr*)(sVt + sw128(e0 + 1, vs >> 3) + (vs & 7) * 2) = (bfr)(vv[j] >> 16);
      }
    }
    __syncthreads();
    float gl[32];
    float tot = 0.f;
#pragma unroll
    for (int i = 0; i < 32; ++i) {
      const int s = half * 32 + i;
      float z = gbias;
      {
        const u32x4 la = *(const u32x4*)((const char*)sLr + s * 32);
        const u32x4 lb = *(const u32x4*)((const char*)sLr + s * 32 + 16);
        z = dot2bf(la.x, gu[0], z); z = dot2bf(la.y, gu[1], z); z = dot2bf(la.z, gu[2], z); z = dot2bf(la.w, gu[3], z);
        z = dot2bf(lb.x, gu[4], z); z = dot2bf(lb.y, gu[5], z); z = dot2bf(lb.z, gu[6], z); z = dot2bf(lb.w, gu[7], z);
      }
      const float tneg = fexp2(-fabsf(z) * L2E);
      const float g = (fminf(z, 0.f) - flog2(1.f + tneg) * LN2) * (1.f / 16.f);
      gl[i] = g;
      tot += g;
    }
    if (dir == 0) {
      float run = 0.f;
#pragma unroll
      for (int i = 0; i < 32; ++i) { run += gl[i]; gl[i] = run; }
    } else {
      float run = 0.f;
#pragma unroll
      for (int i = 31; i >= 0; --i) { run += gl[i]; gl[i] = run; }
    }
    sHs[half * 128 + d] = tot;
    __syncthreads();
    const float other = sHs[(1 - half) * 128 + d];
    const float bend = tot + other;
    const float offs = (dir == 0) ? (half ? other : 0.f) : (half ? 0.f : other);
    const float dec = fexp2(bend * L2E);
    if (half == 0) sDec[d] = dec;
    {
#pragma unroll
      for (int i8 = 0; i8 < 4; ++i8) {
        unsigned kb[4];
#pragma unroll
        for (int ii = 0; ii < 8; ++ii) {
          const int i = i8 * 8 + ii;
          const int s = half * 32 + i;
          const float bb = (gl[i] + offs) * L2E;
          const float E = fexp2(bb), Ei = fexp2(-bb);
          bfr* qa_ = (bfr*)(sQb + sw256(s, d >> 3) + (d & 7) * 2);
          bfr* ka_ = (bfr*)(sKc + sw256(s, d >> 3) + (d & 7) * 2);
          const float qv = bf2f(*qa_) * qscale * E;
          const float kc = bf2f(*ka_) * Ei;
          *qa_ = f2bf(qv);
          *ka_ = f2bf(kc);
          const unsigned kbv = f2bf(kc * dec);
          if (ii & 1) kb[ii >> 1] |= kbv << 16; else kb[ii >> 1] = kbv;
        }
        *(u32x4*)(sKbT + sw128(d, half * 4 + i8)) = (u32x4){kb[0], kb[1], kb[2], kb[3]};
      }
    }
    __syncthreads();
    if (ci + 1 < 68) GLA_LOAD(ci + 1);
    {
      f32x4 at[4];
#pragma unroll
      for (int st = 0; st < 4; ++st) at[st] = (f32x4){0.f, 0.f, 0.f, 0.f};
#pragma unroll
      for (int ks = 0; ks < 4; ++ks) {
        const bf16x8 qa = *(const bf16x8*)(sQb + sw256(wid * 16 + r, ks * 4 + q));
#pragma unroll
        for (int st = 0; st < 4; ++st) {
          const bf16x8 kb2 = *(const bf16x8*)(sKc + sw256(st * 16 + r, ks * 4 + q));
          at[st] = mfma16(qa, kb2, at[st]);
        }
      }
#pragma unroll
      for (int st = 0; st < 4; ++st)
#pragma unroll
        for (int j = 0; j < 4; ++j) {
          const int t = wid * 16 + 4 * q + j, s = st * 16 + r;
          const bool keep = dir ? (s >= t) : (s <= t);
          *(bfr*)(sAtt + sw128(t, s >> 3) + (s & 7) * 2) = f2bf(keep ? at[st][j] : 0.f);
        }
    }
    __syncthreads();
    {
      f32x4 o[2];
      o[0] = (f32x4){0.f, 0.f, 0.f, 0.f};
      o[1] = (f32x4){0.f, 0.f, 0.f, 0.f};
#pragma unroll
      for (int ks = 0; ks < 4; ++ks) {
        const bf16x8 qa = *(const bf16x8*)(sQb + sw256(wid * 16 + r, ks * 4 + q));
#pragma unroll
        for (int et = 0; et < 2; ++et) {
          const bf16x8 sb2 = *(const bf16x8*)(stc + sw256(et * 16 + r, ks * 4 + q));
          o[et] = mfma16(qa, sb2, o[et]);
        }
      }
#pragma unroll
      for (int ks = 0; ks < 2; ++ks) {
        const bf16x8 aa = *(const bf16x8*)(sAtt + sw128(wid * 16 + r, ks * 4 + q));
#pragma unroll
        for (int et = 0; et < 2; ++et) {
          const bf16x8 vb = *(const bf16x8*)(sVt + sw128(et * 16 + r, ks * 4 + q));
          o[et] = mfma16(aa, vb, o[et]);
        }
      }
      {
        const int lam = head * 8 + slice;
#pragma unroll
        for (int j = 0; j < 4; ++j) {
          const int row = row0 + wid * 16 + 4 * q + j;
          const int m2 = row >> 1, par = row & 1;
          bfr* lp = dir ? ((bfr*)(p.ws + OFF_H) + ((size_t)m2 * 32 + lam) * 64)
                        : ((bfr*)(p.ws + OFF_U) + (size_t)(2 * m2 + (lam >> 4)) * 2048 + 1024 + (lam & 15) * 64);
#pragma unroll
          for (int et = 0; et < 2; ++et) lp[par * 32 + et * 16 + r] = f2bf(o[et][j]);
        }
      }
    }
    {
#pragma unroll
      for (int dti = 0; dti < 2; ++dti) {
        const float dc = sDec[(2 * wid + dti) * 16 + r];
#pragma unroll
        for (int et = 0; et < 2; ++et) {
          S[et][dti][0] *= dc; S[et][dti][1] *= dc; S[et][dti][2] *= dc; S[et][dti][3] *= dc;
        }
      }
#pragma unroll
      for (int ks = 0; ks < 2; ++ks) {
        bf16x8 va[2], kb2[2];
#pragma unroll
        for (int et = 0; et < 2; ++et) va[et] = *(const bf16x8*)(sVt + sw128(et * 16 + r, ks * 4 + q));
#pragma unroll
        for (int dti = 0; dti < 2; ++dti) kb2[dti] = *(const bf16x8*)(sKbT + sw128((2 * wid + dti) * 16 + r, ks * 4 + q));
#pragma unroll
        for (int et = 0; et < 2; ++et)
#pragma unroll
          for (int dti = 0; dti < 2; ++dti) S[et][dti] = mfma16(va[et], kb2[dti], S[et][dti]);
      }
#pragma unroll
      for (int et = 0; et < 2; ++et)
#pragma unroll
        for (int dti = 0; dti < 2; ++dti)
#pragma unroll
          for (int j = 0; j < 4; ++j) {
            const int e = et * 16 + 4 * q + j, dd = (2 * wid + dti) * 16 + r;
            *(bfr*)(stn + sw256(e, dd >> 3) + (dd & 7) * 2) = f2bf(S[et][dti][j]);
          }
    }
  }
#undef GLA_LOAD
#undef GLA_ROW0
  __syncthreads();
}

DI void phase_gla_combine(const Params& p, int l) {
  const int tid = opaque_tid(), lane = tid & 63, wid = tid >> 6;
  const bfr* proj = (const bfr*)(p.ws + OFF_PROJ);
  const bfr* OB = (const bfr*)(p.ws + OFF_H);
  bfr* U = (bfr*)(p.ws + OFF_U);
  const int h = lane >> 4, e16 = (lane & 15) * 16;
  const int lam = h * 8 + ((lane & 15) >> 1), ein = (lane & 1) * 16;
  const float* gn = p.od_gnorm + (l >> 1) * 256 + e16;
  for (int m2 = blockIdx.x * 4 + wid; m2 < MR / 2; m2 += gridDim.x * 4) {
    const bfr* ofl = U + (size_t)(2 * m2 + (lam >> 4)) * 2048 + 1024 + (lam & 15) * 64 + ein;
    const bfr* obl = OB + ((size_t)m2 * 32 + lam) * 64 + ein;
    u32x4 a[2][2], bq[2][2], g[2][2];
#pragma unroll
    for (int par = 0; par < 2; ++par) {
      a[par][0] = *(const u32x4*)(ofl + par * 32);  a[par][1] = *(const u32x4*)(ofl + par * 32 + 8);
      bq[par][0] = *(const u32x4*)(obl + par * 32); bq[par][1] = *(const u32x4*)(obl + par * 32 + 8);
      const bfr* gp = proj + (size_t)(2 * m2 + par) * NOD + 6144 + h * 256 + e16;
      g[par][0] = *(const u32x4*)gp; g[par][1] = *(const u32x4*)(gp + 8);
    }
    u32x4 res[2][2];
#pragma unroll
    for (int par = 0; par < 2; ++par) {
      float o[16], dg[16];
      float ss = 0.f;
#pragma unroll
      for (int hv = 0; hv < 2; ++hv)
#pragma unroll
        for (int i = 0; i < 4; ++i) {
          const unsigned av = a[par][hv][i], bv = bq[par][hv][i], gv = g[par][hv][i];
          const int k = hv * 8 + i * 2;
          o[k] = lo_bf(av) + lo_bf(bv); o[k + 1] = hi_bf(av) + hi_bf(bv);
          dg[k] = lo_bf(gv); dg[k + 1] = hi_bf(gv);
          ss += o[k] * o[k] + o[k + 1] * o[k + 1];
        }
      ss += shx<1>(ss, lane); ss += shx<2>(ss, lane); ss += shx<4>(ss, lane); ss += shx<8>(ss, lane);
      const float rn = rsqrtf(ss * (1.f / 256.f) + 1e-6f);
#pragma unroll
      for (int hv = 0; hv < 2; ++hv)
#pragma unroll
        for (int i = 0; i < 4; ++i) {
          const int k = hv * 8 + i * 2;
          res[par][hv][i] = pack2(o[k] * rn * gn[k] * silu(dg[k]), o[k + 1] * rn * gn[k + 1] * silu(dg[k + 1]));
        }
    }
#pragma unroll
    for (int par = 0; par < 2; ++par) {
      bfr* up = U + (size_t)(2 * m2 + par) * 2048 + 1024 + h * 256 + e16;
      *(u32x4*)up = res[par][0];
      *(u32x4*)(up + 8) = res[par][1];
    }
  }
}

DI int next_item(int* ctr, int* slot) {
  __syncthreads();
  if (threadIdx.x == 0) *slot = atomicAdd(ctr, 1);
  __syncthreads();
  return *slot;
}

DI void phase_mix_even(const Params& p, int l, int g, char* smem, int coff = 0) {
  int* ctr0 = (int*)(p.ws + OFF_CTR) + ((g * 2 + (l >> 1)) * 8) + coff;
  int* slot = (int*)(smem + SMEM_BYTES - 16);
  const int PER_LAT = GB * 32, PER_CTX = GB * 2, PER_CONV = MR / 16 / 8;
  const int per_q = PER_LAT + PER_CTX + PER_CONV;
  const int myq = (int)(__builtin_amdgcn_s_getreg((3 << 11) | 20) & 7u);
  for (int dq = 0; dq < 8; ++dq) {
    const int x = (myq + dq) & 7;
    for (;;) {
      int it = next_item(ctr0 + x, slot);
      if (it >= per_q) break;
      if (it < PER_LAT) {
        const int qb = it & 31, b = it >> 5;
        diff_attn_item(p, l, b, x, b * 4096 + qb * 128, false, smem);
      } else if (it < PER_LAT + PER_CTX) {
        it -= PER_LAT;
        const int qb = it & 1, b = it >> 1;
        diff_attn_item(p, l, b, x, ML + b * 256 + qb * 128, true, smem);
      } else {
        conv_item(p, l, (it - PER_LAT - PER_CTX) * 8 + x);
      }
    }
  }
}

DI void phase_mix_odd(const Params& p, int l, int g, char* smem) {
  int* ctr = (int*)(p.ws + OFF_CTR) + (g * 4 + l);
  int* slot = (int*)(smem + SMEM_BYTES - 16);
  const int N_GLA = GB * 4 * 2 * 8, N_NA = GB * 16 * 64, N_CTX = (l == 3) ? 0 : GB * 16 * 4;
  const int total = N_GLA + N_NA + N_CTX;
  (void)ctr; (void)slot; (void)total;
  const int nb = gridDim.x, bx = blockIdx.x;
  const int nup = (nb > N_GLA) ? (nb - N_GLA) : 0;
  for (int k = 0;; ++k) {
    int it;
    if (nup == 0) { it = bx + k * nb; if (it >= total) break; }
    else if (bx < N_GLA) {
      if (k == 0) it = bx;
      else { it = N_GLA + N_NA + bx + (k - 1) * N_GLA; if (it >= total) break; }
    } else {
      it = N_GLA + (bx - N_GLA) + k * nup;
      if (it >= N_GLA + N_NA) break;
    }
    __syncthreads();
    if (it < N_GLA) {
      __builtin_amdgcn_s_setprio(3);
      gla_item(p, l, it, smem);
      __builtin_amdgcn_s_setprio(0);
    } else if (it < N_GLA + N_NA) {
      it -= N_GLA;
      const int rho = it & 63, bh = it >> 6;
      na_item(p, l, bh >> 4, bh & 15, rho, false, 0, smem);
    } else {
      it -= N_GLA + N_NA;
      const int qb = it & 3, bh = it >> 2;
      na_item(p, l, bh >> 4, bh & 15, 0, true, qb * 64, smem);
    }
  }
}


DI void grid_barrier(unsigned* bar, unsigned& bgen, unsigned xcc, unsigned nxcc, unsigned nx) {
  asm volatile("s_waitcnt vmcnt(0)" ::: "memory");
  __syncthreads();
  const unsigned target = bgen + 1;
  if (threadIdx.x == 0) {
    const unsigned old = __hip_atomic_fetch_add(bar + xcc * 64, 1u, __ATOMIC_RELAXED, __HIP_MEMORY_SCOPE_AGENT);
    if (old == target * nxcc - 1) {
      __builtin_amdgcn_fence(__ATOMIC_RELEASE, "agent");
      asm volatile("s_waitcnt vmcnt(0)" ::: "memory");
      const unsigned o2 = __hip_atomic_fetch_add(bar + 16 * 64, 1u, __ATOMIC_RELAXED, __HIP_MEMORY_SCOPE_AGENT);
      if (o2 == target * nx - 1) __hip_atomic_store(bar + 17 * 64, target, __ATOMIC_RELAXED, __HIP_MEMORY_SCOPE_AGENT);
    }
    while (__hip_atomic_load(bar + 17 * 64, __ATOMIC_RELAXED, __HIP_MEMORY_SCOPE_AGENT) < target) __builtin_amdgcn_s_sleep(1);
    __builtin_amdgcn_fence(__ATOMIC_ACQUIRE, "agent");
    asm volatile("s_waitcnt vmcnt(0)" ::: "memory");
  }
  bgen = target;
  __syncthreads();
}
typedef const __attribute__((address_space(4))) Params* KParamsPtr;
DI Params load_params() {
#if defined(__HIP_DEVICE_COMPILE__)
  KParamsPtr kp = (KParamsPtr)__builtin_amdgcn_kernarg_segment_ptr();
  asm volatile("" : "+s"(kp));
  Params r;
  __builtin_memcpy(&r, kp, sizeof(Params));
  return r;
#else
  return Params{};
#endif
}
#define PH(call) { const Params p = load_params(); call; }
__global__ void __launch_bounds__(256, 2) mega_kernel(Params p_unused) {
  extern __shared__ __attribute__((aligned(16))) char smem[];
  cg::grid_group grid = cg::this_grid();
  unsigned bgen = 0;
  const unsigned xcc = (unsigned)__builtin_amdgcn_s_getreg((3 << 11) | 20) & 15u;
  if (threadIdx.x == 0) {
    const Params pb = load_params();
    __hip_atomic_fetch_add((unsigned*)(pb.ws + OFF_BAR) + (18 + xcc) * 64, 1u, __ATOMIC_RELAXED, __HIP_MEMORY_SCOPE_AGENT);
  }
  PH(phase0(p, smem));
  grid.sync();
  unsigned nxcc = 0, nx = 0;
  {
    const Params pb = load_params();
    const unsigned* cen = (const unsigned*)(pb.ws + OFF_BAR) + 18 * 64;
    for (unsigned j = 0; j < 16; ++j) {
      const unsigned cj = __hip_atomic_load(cen + j * 64, __ATOMIC_RELAXED, __HIP_MEMORY_SCOPE_AGENT);
      nx += (cj != 0);
      if (j == xcc) nxcc = cj;
    }
  }
#define GBAR() { const Params pb = load_params(); grid_barrier((unsigned*)(pb.ws + OFF_BAR), bgen, xcc, nxcc, nx); }
#pragma unroll 1
  for (int g = 0; g < NGRP; ++g) {
#pragma unroll 1
    for (int l = 0; l < 4; ++l) {
      PH(phase_norm(p, l, g));
      GBAR();
      PH(phase_gemm_in(p, l, smem));
      GBAR();
      if (l & 1) {
        PH(phase_mix_odd(p, l, g, smem));
        GBAR();
        PH(phase_gla_combine(p, l));
      } else {
        PH(phase_mix_even(p, l, g, smem));
      }
      GBAR();
      PH(phase_gemm_out(p, l, smem));
      GBAR();
    }
    PH(phase_norm(p, 4, g));
    GBAR();
  }
}

extern "C" void kernel_launch(void* const* d_in, const int* in_sizes, int n_in, void* d_out, int out_size, void* d_ws,
                              size_t ws_size, hipStream_t stream) {
  static int grid_blocks = 0;
  if (!grid_blocks) {
    int dev = 0, cus = 0, per_cu = 0;
    hipGetDevice(&dev);
    hipDeviceGetAttribute(&cus, hipDeviceAttributeMultiprocessorCount, dev);
    hipFuncSetAttribute((const void*)mega_kernel, hipFuncAttributeMaxDynamicSharedMemorySize, SMEM_BYTES);
    hipOccupancyMaxActiveBlocksPerMultiprocessor(&per_cu, mega_kernel, 256, SMEM_BYTES);
    if (per_cu > 2) per_cu = 2;
    if (per_cu < 1) per_cu = 1;
    grid_blocks = cus * per_cu;
    grid_blocks &= ~15;
  }
  if (ws_size < WS_NEED) { fprintf(stderr, "workspace too small: %zu < %zu\n", ws_size, (size_t)WS_NEED); return; }
  Params p{};
  p.x = (const float*)d_in[0]; p.c = (const float*)d_in[1]; p.ctx = (const float*)d_in[2]; p.c_ctx = (const float*)d_in[3];
  p.w_mod = (const float*)d_in[4]; p.b_mod = (const float*)d_in[5]; p.g_pre = (const float*)d_in[6]; p.g_post = (const float*)d_in[7];
  p.w_out = (const float*)d_in[8]; p.ev_w_in = (const float*)d_in[9]; p.ev_lambda = (const float*)d_in[10]; p.ev_subln = (const float*)d_in[11];
  p.ev_conv = (const float*)d_in[12]; p.od_w_in = (const float*)d_in[13]; p.od_rpb = (const float*)d_in[14]; p.od_gate_up = (const float*)d_in[15];
  p.od_gate_bias = (const float*)d_in[16]; p.od_gnorm = (const float*)d_in[17];
  p.out = (float*)d_out;
  p.ws = (char*)d_ws;
  (void)hipMemsetAsync((char*)d_ws + OFF_BAR, 0, BAR_BYTES, stream);
  void* args[] = {&p};
  hipError_t e = hipLaunchCooperativeKernel((const void*)mega_kernel, dim3(grid_blocks), dim3(256), args, SMEM_BYTES, stream);
  if (e != hipSuccess) fprintf(stderr, "cooperative launch failed: %s (grid %d)\n", hipGetErrorString(e), grid_blocks);
}
```

```cpp
#include <hip/hip_runtime.h>
#include <hip/hip_cooperative_groups.h>
#include <cstdio>
namespace cg = cooperative_groups;

typedef unsigned short bfr;
typedef __attribute__((ext_vector_type(8))) short bf16x8;
typedef __attribute__((ext_vector_type(4))) float f32x4;
typedef __attribute__((ext_vector_type(4))) unsigned u32x4;
typedef __attribute__((ext_vector_type(2))) unsigned u32x2;
typedef __attribute__((ext_vector_type(16))) unsigned u32x16;
typedef __attribute__((ext_vector_type(2))) __bf16 bf16x2_t;
#define DI __device__ __forceinline__
DI float dot2bf(unsigned a, unsigned b, float c) { return __builtin_amdgcn_fdot2_f32_bf16(__builtin_bit_cast(bf16x2_t, a), __builtin_bit_cast(bf16x2_t, b), c, false); }
DI int opaque_tid() { int t = threadIdx.x; asm volatile("" : "+v"(t)); return t; }

constexpr int GB   = 4;
constexpr int NGRP = 2;
constexpr int ML   = GB * 4096;
constexpr int MC   = GB * 256;
constexpr int MR   = ML + MC;
constexpr int NEV  = 8192;
constexpr int NOD  = 7296;
constexpr int KEYS = 4352;
constexpr float L2E = 1.4426950408889634f;
constexpr float LN2 = 0.6931471805599453f;

constexpr size_t SZ_PROJ = (size_t)MR * 8192 * 2;
constexpr size_t SZ_H    = (size_t)MR * 1024 * 2;
constexpr size_t SZ_U    = (size_t)MR * 2048 * 2;
constexpr size_t SZ_VT   = (size_t)GB * 1024 * KEYS * 2;
constexpr size_t SZ_WE   = (size_t)NEV * 1024 * 2;
constexpr size_t SZ_WO   = (size_t)NOD * 1024 * 2;
constexpr size_t SZ_WOUT = (size_t)1024 * 2048 * 2;
constexpr size_t OFF_PROJ = 0;
constexpr size_t OFF_H    = OFF_PROJ + SZ_PROJ;
constexpr size_t OFF_U    = OFF_H + SZ_H;
constexpr size_t OFF_VT   = OFF_U + SZ_U;
constexpr size_t OFF_WIN  = OFF_VT + SZ_VT;
constexpr size_t OFF_WOUT = OFF_WIN + 2 * SZ_WE + 2 * SZ_WO;
constexpr size_t OFF_XC   = OFF_WOUT + 4 * SZ_WOUT;
constexpr size_t OFF_MOD  = OFF_XC + (size_t)8 * 256 * 1024 * 4;
constexpr size_t OFF_CS   = OFF_MOD + (size_t)4 * 9 * 3072 * 4;
constexpr size_t OFF_LAM  = OFF_CS + 64 * 16 * 8;
constexpr size_t OFF_CTR  = OFF_LAM + 256;
constexpr size_t OFF_BAR  = OFF_CTR + 256;
constexpr size_t BAR_BYTES = 34 * 256 + 128 * 64;
constexpr size_t SZ_ET    = (size_t)(MR / 64) * 4 * 16384;
constexpr size_t OFF_ETF  = OFF_PROJ + (size_t)MR * NOD * 2;
constexpr size_t OFF_ETB  = (OFF_BAR + BAR_BYTES + 255) & ~(size_t)255;
constexpr size_t OFF_DEC  = OFF_ETB + SZ_ET;
constexpr size_t WS_NEED  = OFF_DEC + (size_t)2 * (MR / 64) * 4 * 128 * 4;
static_assert(OFF_ETF + SZ_ET <= OFF_H, "E^T forward tiles must fit behind the odd proj rows");

constexpr int SMEM_BYTES = 80896;

struct Params {
  const float *x, *c, *ctx, *c_ctx, *w_mod, *b_mod, *g_pre, *g_post, *w_out, *ev_w_in, *ev_lambda, *ev_subln,
      *ev_conv, *od_w_in, *od_rpb, *od_gate_up, *od_gate_bias, *od_gnorm;
  float* out;
  char* ws;
};

DI size_t win_off(int l) { return OFF_WIN + (size_t)(l >> 1) * (SZ_WE + SZ_WO) + ((l & 1) ? SZ_WE : 0); }

DI float bf2f(bfr v) { return __uint_as_float(((unsigned)v) << 16); }
typedef __attribute__((ext_vector_type(2))) float f32x2_t;
DI bfr f2bf(float x) { return __builtin_bit_cast(bfr, (__bf16)x); }
DI unsigned pack2(float a, float b) { f32x2_t v = {a, b}; return __builtin_bit_cast(unsigned, __builtin_convertvector(v, bf16x2_t)); }
DI float lo_bf(unsigned u) { return __uint_as_float(u << 16); }
DI float hi_bf(unsigned u) { return __uint_as_float(u & 0xffff0000u); }
DI float fexp2(float x) { return __builtin_amdgcn_exp2f(x); }
DI float flog2(float x) { return __builtin_amdgcn_logf(x); }
DI float silu(float x) { return x / (1.f + fexp2(-x * L2E)); }
template <int M>
DI float shx(float v, int lane) {
  if (M < 32) return __builtin_bit_cast(float, __builtin_amdgcn_ds_swizzle(__builtin_bit_cast(int, v), (M << 10) | 0x1f));
  return __builtin_bit_cast(float, __builtin_amdgcn_ds_bpermute((lane ^ 32) << 2, __builtin_bit_cast(int, v)));
}
DI float wave_sum(float v, int lane) {
  v += shx<1>(v, lane); v += shx<2>(v, lane); v += shx<4>(v, lane); v += shx<8>(v, lane); v += shx<16>(v, lane); v += shx<32>(v, lane);
  return v;
}
DI f32x4 mfma16(bf16x8 a, bf16x8 b, f32x4 c) { return __builtin_amdgcn_mfma_f32_16x16x32_bf16(a, b, c, 0, 0, 0); }
DI int sw128(int row, int chunk) { return row * 128 + ((chunk ^ ((row >> 1) & 7)) << 4); }
DI int sw256(int row, int chunk) { return row * 256 + ((chunk ^ (row & 15)) << 4); }

DI void gemm_mainloop(const bfr* __restrict__ X, int ldx, const bfr* __restrict__ Y, int ldy, int K, char* smem,
                      f32x4 (&acc)[4][4]) {
  const int tid = opaque_tid(), lane = tid & 63, wid = tid >> 6, r = lane & 15, q = lane >> 4;
  const int wx = wid >> 1, wy = wid & 1;
  const int lr = tid >> 3, lc = tid & 7;
  const bfr* xp = X + (size_t)lr * ldx + lc * 8;
  const bfr* yp = Y + (size_t)lr * ldy + lc * 8;
  u32x4 xa0[4], ya0[4], xa1[4], ya1[4];
#pragma unroll
  for (int i = 0; i < 4; ++i) {
    xa0[i] = *(const u32x4*)(xp + (size_t)(32 * i) * ldx);
    ya0[i] = *(const u32x4*)(yp + (size_t)(32 * i) * ldy);
  }
#pragma unroll
  for (int i = 0; i < 4; ++i) {
    xa1[i] = *(const u32x4*)(xp + (size_t)(32 * i) * ldx + 64);
    ya1[i] = *(const u32x4*)(yp + (size_t)(32 * i) * ldy + 64);
  }
  const int nk = K >> 6;
#define GEMM_STEP(XR, YR, BUF, KT)                                                                       \
  {                                                                                                      \
    char* sX = smem + (BUF) * 32768;                                                                     \
    char* sY = sX + 16384;                                                                               \
    _Pragma("unroll") for (int i = 0; i < 4; ++i) {                                                      \
      *(u32x4*)(sX + sw128(lr + 32 * i, lc)) = XR[i];                                                    \
      *(u32x4*)(sY + sw128(lr + 32 * i, lc)) = YR[i];                                                    \
    }                                                                                                    \
    __syncthreads();                                                                                     \
    if ((KT) + 2 < nk) {                                                                                 \
      const int ko = ((KT) + 2) * 64;                                                                    \
      _Pragma("unroll") for (int i = 0; i < 4; ++i) {                                                    \
        XR[i] = *(const u32x4*)(xp + (size_t)(32 * i) * ldx + ko);                                       \
        YR[i] = *(const u32x4*)(yp + (size_t)(32 * i) * ldy + ko);                                       \
      }                                                                                                  \
    }                                                                                                    \
    _Pragma("unroll") for (int s = 0; s < 2; ++s) {                                                      \
      bf16x8 xf[4], yf[4];                                                                               \
      _Pragma("unroll") for (int i = 0; i < 4; ++i)                                                      \
          xf[i] = *(const bf16x8*)(sX + sw128(wx * 64 + i * 16 + r, s * 4 + q));                         \
      _Pragma("unroll") for (int j = 0; j < 4; ++j)                                                      \
          yf[j] = *(const bf16x8*)(sY + sw128(wy * 64 + j * 16 + r, s * 4 + q));                         \
      _Pragma("unroll") for (int i = 0; i < 4; ++i)                                                      \
          _Pragma("unroll") for (int j = 0; j < 4; ++j) acc[i][j] = mfma16(xf[i], yf[j], acc[i][j]);     \
    }                                                                                                    \
  }
  for (int kt = 0; kt < nk; kt += 2) {
    GEMM_STEP(xa0, ya0, 0, kt);
    GEMM_STEP(xa1, ya1, 1, kt + 1);
  }
#undef GEMM_STEP
  __syncthreads();
}

DI bool tile_map(int T, int MT, int NT, int& mt, int& nt) {
  const int pm_n = MT >> 3;
  const int P = (T >> 9) * 8 + (T & 7);
  const int li = (T & 511) >> 3;
  const int pm = P % pm_n, pn = P / pm_n;
  mt = pm * 8 + (li & 7);
  nt = pn * 8 + (li >> 3);
  return nt < NT;
}

DI int odd_col_src(int n) {
  if (n < 3584) return n;
  if (n < 7168) return n + 32;
  if (n < 7200) return n - 7168 + 3584;
  return -1;
}

DI void phase0(const Params& p, char* smem) {
  const int tid = opaque_tid();
  if (blockIdx.x < 384) {
    float* sc = (float*)smem;
    float* red = sc + 9 * 1024;
    for (int i = tid; i < 9 * 1024; i += 256) {
      const int b = i >> 10, k = i & 1023;
      const float v = (b < 8) ? p.c[b * 1024 + k] : p.c_ctx[k];
      sc[i] = v / (1.f + __expf(-v));
    }
    __syncthreads();
    float* modb = (float*)(p.ws + OFF_MOD);
    for (int it = blockIdx.x; it < 384; it += gridDim.x) {
      const int l = it / 96, cgp = it % 96;
      const int col = cgp * 32 + (tid & 31), ks = tid >> 5;
      float a[9];
#pragma unroll
      for (int b = 0; b < 9; ++b) a[b] = 0.f;
      const float* w = p.w_mod + ((size_t)l * 1024 + ks * 128) * 3072 + col;
#pragma unroll 4
      for (int k = 0; k < 128; ++k) {
        const float wv = w[(size_t)k * 3072];
#pragma unroll
        for (int b = 0; b < 9; ++b) a[b] += sc[b * 1024 + ks * 128 + k] * wv;
      }
#pragma unroll
      for (int b = 0; b < 9; ++b) red[(ks * 9 + b) * 32 + (tid & 31)] = a[b];
      __syncthreads();
      for (int idx = tid; idx < 288; idx += 256) {
        const int b = idx >> 5, cc = idx & 31;
        float s = p.b_mod[l * 3072 + cgp * 32 + cc];
#pragma unroll
        for (int k2 = 0; k2 < 8; ++k2) s += red[(k2 * 9 + b) * 32 + cc];
        modb[(size_t)(l * 9 + b) * 3072 + cgp * 32 + cc] = s;
      }
      __syncthreads();
    }
  }
  if (blockIdx.x == gridDim.x - 1) {
    float2* cs = (float2*)(p.ws + OFF_CS);
    for (int idx = tid; idx < 1024; idx += 256) {
      const int pos = idx >> 4, f = idx & 15;
      const float inv = 1.0f / powf(10000.f, (float)f * 0.0625f);
      const float ang = (float)pos * inv;
      const double ad = (double)ang;
      const double n = rint(ad * 0.15915494309189535);
      const float rr = (float)(ad - n * 6.283185307179586);
      cs[idx] = make_float2(__cosf(rr), __sinf(rr));
    }
    if (tid < 2) {
      const float* lp = p.ev_lambda + tid * 256;
      float s1 = 0.f, s2 = 0.f;
      for (int i = 0; i < 64; ++i) { s1 += lp[i] * lp[64 + i]; s2 += lp[128 + i] * lp[192 + i]; }
      const float li = (tid == 0) ? 0.2f : (0.8f - 0.6f * 0.5488116360940264f);
      float* lam = (float*)(p.ws + OFF_LAM);
      lam[tid] = __expf(s1) - __expf(s2) + li;
      lam[2 + tid] = li;
    }
    if (tid < 32) ((int*)(p.ws + OFF_CTR))[tid] = 0;
  }
  float* tile = (float*)smem;
  __syncthreads();
  for (int it = blockIdx.x; it < 9792; it += gridDim.x) {
    int rr = it, l, ktile, ntile, K, Nsrc;
    const float* src;
    bfr* dst;
    bool oddmap = false;
    if (rr < 7744) {
      if (rr < 2048) { l = 0; } else if (rr < 3872) { l = 1; rr -= 2048; } else if (rr < 5920) { l = 2; rr -= 3872; } else { l = 3; rr -= 5920; }
      ktile = rr & 15; ntile = rr >> 4; K = 1024;
      oddmap = (l & 1);
      Nsrc = oddmap ? 7200 : 8192;
      src = (oddmap ? p.od_w_in : p.ev_w_in) + (size_t)(l >> 1) * 1024 * Nsrc;
      dst = (bfr*)(p.ws + win_off(l));
    } else {
      rr -= 7744; l = rr >> 9; rr &= 511;
      ktile = rr & 31; ntile = rr >> 5; K = 2048; Nsrc = 1024;
      src = p.w_out + (size_t)l * 2048 * 1024;
      dst = (bfr*)(p.ws + OFF_WOUT + (size_t)l * SZ_WOUT);
    }
    const int k0 = ktile * 64, n0 = ntile * 64;
    {
      const int nn = tid & 63;
      const int nd = n0 + nn;
      const int ns = oddmap ? odd_col_src(nd) : nd;
#pragma unroll 4
      for (int i = 0; i < 16; ++i) {
        const int kk = (tid >> 6) + 4 * i;
        tile[kk * 65 + nn] = (ns >= 0) ? src[(size_t)(k0 + kk) * Nsrc + ns] : 0.f;
      }
    }
    __syncthreads();
    {
      const int kk8 = (tid & 7) * 8;
#pragma unroll
      for (int i2 = 0; i2 < 2; ++i2) {
        const int nn = (tid >> 3) + 32 * i2;
        u32x4 v;
        v.x = pack2(tile[(kk8 + 0) * 65 + nn], tile[(kk8 + 1) * 65 + nn]);
        v.y = pack2(tile[(kk8 + 2) * 65 + nn], tile[(kk8 + 3) * 65 + nn]);
        v.z = pack2(tile[(kk8 + 4) * 65 + nn], tile[(kk8 + 5) * 65 + nn]);
        v.w = pack2(tile[(kk8 + 6) * 65 + nn], tile[(kk8 + 7) * 65 + nn]);
        *(u32x4*)(dst + (size_t)(n0 + nn) * K + k0 + kk8) = v;
      }
    }
    __syncthreads();
  }
}

DI void phase_norm(const Params& p, int l, int g) {
  const int tid = opaque_tid(), lane = tid & 63, wid = tid >> 6;
  const int rows = (l == 4) ? ML : MR;
  const float* modb = (const float*)(p.ws + OFF_MOD);
  const bfr* ybuf = (const bfr*)(p.ws + OFF_PROJ);
  bfr* hbuf = (bfr*)(p.ws + OFF_H);
  float* xcb = (float*)(p.ws + OFF_XC);
  for (int row = blockIdx.x * 4 + wid; row < rows; row += gridDim.x * 4) {
    const bool lat = row < ML;
    const int mb = lat ? (g * GB + (row >> 12)) : 8;
    const size_t grow = lat ? ((size_t)g * ML + row) : ((size_t)g * MC + (row - ML));
    const float* xin;
    float* xst;
    if (lat) { xin = ((l <= 1) ? p.x : (const float*)p.out) + grow * 1024; xst = p.out + grow * 1024; }
    else     { xin = ((l <= 1) ? p.ctx : (const float*)xcb) + grow * 1024; xst = xcb + grow * 1024; }
    float4 xv[4];
#pragma unroll
    for (int i = 0; i < 4; ++i) xv[i] = *(const float4*)(xin + lane * 4 + 256 * i);
    if (l >= 1) {
      float4 yv[4];
      float ss = 0.f;
#pragma unroll
      for (int i = 0; i < 4; ++i) {
        const u32x2 yr = *(const u32x2*)(ybuf + (size_t)row * 1024 + lane * 4 + 256 * i);
        yv[i] = make_float4(lo_bf(yr.x), hi_bf(yr.x), lo_bf(yr.y), hi_bf(yr.y));
        ss += yv[i].x * yv[i].x + yv[i].y * yv[i].y + yv[i].z * yv[i].z + yv[i].w * yv[i].w;
      }
      ss = wave_sum(ss, lane);
      const float rn = rsqrtf(ss * (1.f / 1024.f) + 1e-6f);
      const float* gate = modb + (size_t)((l - 1) * 9 + mb) * 3072 + 2048;
      const float* gp = p.g_post + (l - 1) * 1024;
#pragma unroll
      for (int i = 0; i < 4; ++i) {
        const int c0 = lane * 4 + 256 * i;
        const float4 gt = *(const float4*)(gate + c0);
        const float4 gg = *(const float4*)(gp + c0);
        xv[i].x += gt.x * (yv[i].x * rn * gg.x);
        xv[i].y += gt.y * (yv[i].y * rn * gg.y);
        xv[i].z += gt.z * (yv[i].z * rn * gg.z);
        xv[i].w += gt.w * (yv[i].w * rn * gg.w);
        *(float4*)(xst + c0) = xv[i];
      }
    }
    if (l < 4) {
      float ss = 0.f;
#pragma unroll
      for (int i = 0; i < 4; ++i) ss += xv[i].x * xv[i].x + xv[i].y * xv[i].y + xv[i].z * xv[i].z + xv[i].w * xv[i].w;
      ss = wave_sum(ss, lane);
      const float rn = rsqrtf(ss * (1.f / 1024.f) + 1e-6f);
      const float* mrow = modb + (size_t)(l * 9 + mb) * 3072;
      const float* gpre = p.g_pre + l * 1024;
#pragma unroll
      for (int i = 0; i < 4; ++i) {
        const int c0 = lane * 4 + 256 * i;
        const float4 sh = *(const float4*)(mrow + c0);
        const float4 scl = *(const float4*)(mrow + 1024 + c0);
        const float4 gg = *(const float4*)(gpre + c0);
        u32x2 o;
        o.x = pack2(xv[i].x * rn * gg.x * (1.f + scl.x) + sh.x, xv[i].y * rn * gg.y * (1.f + scl.y) + sh.y);
        o.y = pack2(xv[i].z * rn * gg.z * (1.f + scl.z) + sh.z, xv[i].w * rn * gg.w * (1.f + scl.w) + sh.w);
        *(u32x2*)(hbuf + (size_t)row * 1024 + c0) = o;
      }
    }
  }
}

DI void gla_gate_precompute(const Params& p, int l, int m0, const char* sLr, float* sHs) {
  const int tid = opaque_tid();
  const int d = tid & 127, half = tid >> 7;
  const int jl = l >> 1;
#pragma unroll 1
  for (int unit = 0; unit < 16; ++unit) {
    const int cc = unit & 1, dir = (unit >> 1) & 1, head = unit >> 2;
    unsigned gu[8];
#pragma unroll
    for (int k = 0; k < 8; ++k)
      gu[k] = pack2(p.od_gate_up[(((size_t)jl * 2 + dir) * 16 + 2 * k) * 512 + head * 128 + d],
                    p.od_gate_up[(((size_t)jl * 2 + dir) * 16 + 2 * k + 1) * 512 + head * 128 + d]);
    const float gbias = p.od_gate_bias[((size_t)jl * 2 + dir) * 512 + head * 128 + d];
    float gl[32];
    float tot = 0.f;
#pragma unroll
    for (int i = 0; i < 32; ++i) {
      const int tk = cc * 64 + half * 32 + i;
      const u32x4 la = *(const u32x4*)(sLr + tk * 64 + dir * 32);
      const u32x4 lb = *(const u32x4*)(sLr + tk * 64 + dir * 32 + 16);
      float z = gbias;
      z = dot2bf(la.x, gu[0], z); z = dot2bf(la.y, gu[1], z); z = dot2bf(la.z, gu[2], z); z = dot2bf(la.w, gu[3], z);
      z = dot2bf(lb.x, gu[4], z); z = dot2bf(lb.y, gu[5], z); z = dot2bf(lb.z, gu[6], z); z = dot2bf(lb.w, gu[7], z);
      const float tneg = fexp2(-fabsf(z) * L2E);
      const float g = (fminf(z, 0.f) - flog2(1.f + tneg) * LN2) * (L2E / 16.f);
      gl[i] = g;
      tot += g;
    }
    if (dir == 0) {
      float run = 0.f;
#pragma unroll
      for (int i = 0; i < 32; ++i) { run += gl[i]; gl[i] = run; }
    } else {
      float run = 0.f;
#pragma unroll
      for (int i = 31; i >= 0; --i) { run += gl[i]; gl[i] = run; }
    }
    __syncthreads();
    sHs[half * 128 + d] = tot;
    __syncthreads();
    const float other = sHs[(1 - half) * 128 + d];
    const float offs = (dir == 0) ? (half ? other : 0.f) : (half ? 0.f : other);
    const int chunk = (m0 >> 6) + cc;
    char* et = p.ws + (dir ? OFF_ETB : OFF_ETF) + ((size_t)chunk * 4 + head) * 16384;
#pragma unroll
    for (int i8 = 0; i8 < 4; ++i8) {
      u32x4 v;
      v.x = pack2(fexp2(gl[i8 * 8 + 0] + offs), fexp2(gl[i8 * 8 + 1] + offs));
      v.y = pack2(fexp2(gl[i8 * 8 + 2] + offs), fexp2(gl[i8 * 8 + 3] + offs));
      v.z = pack2(fexp2(gl[i8 * 8 + 4] + offs), fexp2(gl[i8 * 8 + 5] + offs));
      v.w = pack2(fexp2(gl[i8 * 8 + 6] + offs), fexp2(gl[i8 * 8 + 7] + offs));
      *(u32x4*)(et + sw128(d, half * 4 + i8)) = v;
    }
    if (half == 0)
      ((float*)(p.ws + OFF_DEC))[(((size_t)dir * (MR / 64) + chunk) * 4 + head) * 128 + d] = fexp2(tot + other);
  }
}

struct TileQ {
  unsigned* base;
  int* slot;
  int x, dq, pend;
  bool has_pend;
};
DI int tileq_fetch(TileQ& tq) {
  __syncthreads();
  if (threadIdx.x == 0) {
    int j = tq.has_pend ? tq.pend : (int)__hip_atomic_fetch_add(tq.base + tq.x * 16, 1u, __ATOMIC_RELAXED, __HIP_MEMORY_SCOPE_AGENT);
    *tq.slot = j;
  }
  tq.has_pend = false;
  __syncthreads();
  return *tq.slot;
}
DI void tileq_prefetch(TileQ& tq) {
  if (threadIdx.x == 0) {
    tq.pend = (int)__hip_atomic_fetch_add(tq.base + tq.x * 16, 1u, __ATOMIC_RELAXED, __HIP_MEMORY_SCOPE_AGENT);
  }
  tq.has_pend = true;
}

DI void phase_gemm_in(const Params& p, int l, char* smem, int inst) {
  const int tid = opaque_tid(), lane = tid & 63, wid = tid >> 6, r = lane & 15, q = lane >> 4;
  const int wx = wid >> 1, wy = wid & 1;
  const bool even = !(l & 1);
  const int ldp = even ? NEV : NOD;
  const int NT = ldp >> 7, MT = MR >> 7;
  const bfr* WT = (const bfr*)(p.ws + win_off(l));
  const bfr* H = (const bfr*)(p.ws + OFF_H);
  bfr* proj = (bfr*)(p.ws + OFF_PROJ);
  bfr* VT = (bfr*)(p.ws + OFF_VT);
  const float2* cs = (const float2*)(p.ws + OFF_CS);
  const int pm_n = MT >> 3, NP = pm_n * ((NT + 7) >> 3);
  TileQ tq;
  tq.base = (unsigned*)(p.ws + OFF_BAR) + 34 * 64 + inst * 128;
  tq.slot = (int*)(smem + SMEM_BYTES - 16);
  tq.has_pend = false; tq.pend = 0;
  const int xcc0 = (int)(__builtin_amdgcn_s_getreg((3 << 11) | 20) & 7u);
  for (tq.dq = 0; tq.dq < 8; ++tq.dq) {
   tq.x = (xcc0 + tq.dq) & 7;
   tq.has_pend = false;
   for (;;) {
    const int j = tileq_fetch(tq);
    const int P = (j >> 6) * 8 + tq.x;
    if (P >= NP) break;
    const int li = j & 63;
    const int mt = (P % pm_n) * 8 + (li & 7), nt = (P / pm_n) * 8 + (li >> 3);
    if (nt >= NT) continue;
    tileq_prefetch(tq);
    const int m0 = mt * 128, n0 = nt * 128;
    const bool vt = (n0 >= 1024 && n0 < 2048);
    f32x4 acc[4][4];
#pragma unroll
    for (int i = 0; i < 4; ++i)
#pragma unroll
      for (int j = 0; j < 4; ++j) acc[i][j] = (f32x4){0.f, 0.f, 0.f, 0.f};
    const bfr* X = vt ? (H + (size_t)m0 * 1024) : (WT + (size_t)n0 * 1024);
    const bfr* Y = vt ? (WT + (size_t)n0 * 1024) : (H + (size_t)m0 * 1024);
    gemm_mainloop(X, 1024, Y, 1024, 1024, smem, acc);
    if (vt) {
#pragma unroll
      for (int i = 0; i < 4; ++i) {
        const int mbase = m0 + wx * 64 + i * 16;
        int b, kp;
        if (mbase < ML) { b = mbase >> 12; kp = mbase & 4095; } else { const int mm = mbase - ML; b = mm >> 8; kp = 4096 + (mm & 255); }
        const int pos = (kp & ~31) + q * 8 + ((kp >> 4) & 1) * 4;
#pragma unroll
        for (int jn = 0; jn < 4; ++jn) {
          const int f = n0 - 1024 + wy * 64 + jn * 16 + r;
          u32x2 o;
          o.x = pack2(acc[i][jn][0], acc[i][jn][1]);
          o.y = pack2(acc[i][jn][2], acc[i][jn][3]);
          *(u32x2*)(VT + ((size_t)(b * 1024 + f)) * KEYS + pos) = o;
        }
      }
    } else {
      const bool rope = even && (n0 < 1024 || (n0 >= 2048 && n0 < 3072)) && (m0 < ML);
      if (rope) {
#pragma unroll
        for (int jn = 0; jn < 4; ++jn) {
          const int m = m0 + wy * 64 + jn * 16 + r;
          const int t = m & 4095;
          const int grow = t >> 6, gcol = t & 63;
#pragma unroll
          for (int j = 0; j < 4; ++j) {
            const float2 a = cs[grow * 16 + 4 * q + j];
            const float2 c = cs[gcol * 16 + 4 * q + j];
            const float x0 = acc[0][jn][j], x1 = acc[1][jn][j], x2 = acc[2][jn][j], x3 = acc[3][jn][j];
            acc[0][jn][j] = x0 * a.x - x1 * a.y;
            acc[1][jn][j] = x1 * a.x + x0 * a.y;
            acc[2][jn][j] = x2 * c.x - x3 * c.y;
            acc[3][jn][j] = x3 * c.x + x2 * c.y;
          }
        }
      }
#pragma unroll
      for (int jn = 0; jn < 4; ++jn) {
        const int m = m0 + wy * 64 + jn * 16 + r;
#pragma unroll
        for (int i = 0; i < 4; ++i) {
          const int n = n0 + wx * 64 + i * 16 + 4 * q;
          u32x2 o;
          o.x = pack2(acc[i][jn][0], acc[i][jn][1]);
          o.y = pack2(acc[i][jn][2], acc[i][jn][3]);
          *(u32x2*)(proj + (size_t)m * ldp + n) = o;
        }
      }
      if (!even && n0 == 7168) {
        char* sLr = smem;
        float* sHs = (float*)(smem + 8192);
        if (wx == 0) {
#pragma unroll
          for (int jn = 0; jn < 4; ++jn)
#pragma unroll
            for (int i = 0; i < 2; ++i) {
              u32x2 o;
              o.x = pack2(acc[i][jn][0], acc[i][jn][1]);
              o.y = pack2(acc[i][jn][2], acc[i][jn][3]);
              *(u32x2*)(sLr + (wy * 64 + jn * 16 + r) * 64 + (i * 16 + 4 * q) * 2) = o;
            }
        }
        __syncthreads();
        gla_gate_precompute(p, l, m0, sLr, sHs);
        __syncthreads();
      }
    }
  }
 }
}

DI void phase_gemm_out(const Params& p, int l, char* smem, int inst) {
  const int tid = opaque_tid(), lane = tid & 63, wid = tid >> 6, r = lane & 15, q = lane >> 4;
  const int wx = wid >> 1, wy = wid & 1;
  const bfr* WT = (const bfr*)(p.ws + OFF_WOUT + (size_t)l * SZ_WOUT);
  const bfr* U = (const bfr*)(p.ws + OFF_U);
  bfr* ybuf = (bfr*)(p.ws + OFF_PROJ);
  const int MT = (l == 3) ? (ML >> 7) : (MR >> 7);
  const int pm_n = MT >> 3, NP = pm_n;
  TileQ tq;
  tq.base = (unsigned*)(p.ws + OFF_BAR) + 34 * 64 + inst * 128;
  tq.slot = (int*)(smem + SMEM_BYTES - 16);
  tq.has_pend = false; tq.pend = 0;
  const int xcc0 = (int)(__builtin_amdgcn_s_getreg((3 << 11) | 20) & 7u);
  for (tq.dq = 0; tq.dq < 8; ++tq.dq) {
   tq.x = (xcc0 + tq.dq) & 7;
   tq.has_pend = false;
   for (;;) {
    const int j = tileq_fetch(tq);
    const int P = (j >> 6) * 8 + tq.x;
    if (P >= NP) break;
    const int li = j & 63;
    const int mt = P * 8 + (li & 7), nt = (li >> 3);
    tileq_prefetch(tq);
    const int m0 = mt * 128, n0 = nt * 128;
    f32x4 acc[4][4];
#pragma unroll
    for (int i = 0; i < 4; ++i)
#pragma unroll
      for (int j = 0; j < 4; ++j) acc[i][j] = (f32x4){0.f, 0.f, 0.f, 0.f};
    gemm_mainloop(WT + (size_t)n0 * 2048, 2048, U + (size_t)m0 * 2048, 2048, 2048, smem, acc);
#pragma unroll
    for (int jn = 0; jn < 4; ++jn) {
      const int m = m0 + wy * 64 + jn * 16 + r;
#pragma unroll
      for (int i = 0; i < 4; ++i) {
        const int n = n0 + wx * 64 + i * 16 + 4 * q;
        u32x2 o;
        o.x = pack2(acc[i][jn][0], acc[i][jn][1]);
        o.y = pack2(acc[i][jn][2], acc[i][jn][3]);
        *(u32x2*)(ybuf + (size_t)m * 1024 + n) = o;
      }
    }
  }
 }
}

template <int DV, int QT, int KT, int MODE>
DI void attn_engine(const bfr* __restrict__ qbase, int ldq, const bfr* __restrict__ kbase, int ldk,
                    const bfr* __restrict__ vt, int nloc, int loc_row0, int loc_pos0, int nctx, int ctx_row0,
                    const float* rpb_s, int roff0, char* smem, f32x4 (&O)[DV / 16][QT], float (&lsum)[QT]) {
  constexpr int STAGE = 8192 + DV * 128;
  constexpr int NVL = DV / 32;
  const int tid = opaque_tid(), lane = tid & 63, wid = tid >> 6, r = lane & 15, q = lane >> 4;
  const int lr = tid >> 3, lc = tid & 7;
  constexpr float SC = 0.125f * L2E;

  bf16x8 Qf[QT][2];
#pragma unroll
  for (int qt = 0; qt < QT; ++qt)
#pragma unroll
    for (int s = 0; s < 2; ++s)
      Qf[qt][s] = *(const bf16x8*)(qbase + (size_t)(wid * 16 * QT + qt * 16 + r) * ldq + s * 32 + q * 8);
  float mrun[QT];
#pragma unroll
  for (int qt = 0; qt < QT; ++qt) {
    mrun[qt] = -1e30f;
    lsum[qt] = 0.f;
#pragma unroll
    for (int dt = 0; dt < DV / 16; ++dt) O[dt][qt] = (f32x4){0.f, 0.f, 0.f, 0.f};
  }

  const int nch = nloc + nctx;
  u32x4 kreg0, kreg1, vreg[NVL];
  const int ksw0 = sw128(lr, lc), ksw1 = sw128(lr + 32, lc);
#define AT_LOAD(c_)                                                                                          \
  {                                                                                                          \
    const int cc_ = (c_);                                                                                    \
    const int row_ = (cc_ < nloc) ? (loc_row0 + cc_ * 64) : (ctx_row0 + (cc_ - nloc) * 64);                  \
    const int pos_ = (cc_ < nloc) ? (loc_pos0 + cc_ * 64) : (4096 + (cc_ - nloc) * 64);                      \
    kreg0 = *(const u32x4*)(kbase + (size_t)(row_ + lr) * ldk + lc * 8);                                     \
    kreg1 = *(const u32x4*)(kbase + (size_t)(row_ + lr + 32) * ldk + lc * 8);                                \
    _Pragma("unroll") for (int i_ = 0; i_ < NVL; ++i_)                                                       \
        vreg[i_] = *(const u32x4*)(vt + (size_t)(lr + 32 * i_) * KEYS + pos_ + lc * 8);                      \
  }
#define AT_STORE(c_)                                                                                         \
  {                                                                                                          \
    char* sb_ = smem + ((c_) & 1) * STAGE;                                                                   \
    *(u32x4*)(sb_ + ksw0) = kreg0;                                                                           \
    *(u32x4*)(sb_ + ksw1) = kreg1;                                                                           \
    _Pragma("unroll") for (int i_ = 0; i_ < NVL; ++i_)                                                       \
        *(u32x4*)(sb_ + 8192 + sw128(lr + 32 * i_, lc)) = vreg[i_];                                          \
  }
  if (nch > 0) { AT_LOAD(0); AT_STORE(0); }
  for (int c = 0; c < nch; ++c) {
    __syncthreads();
    const bool more = (c + 1 < nch);
    const char* sK = smem + (c & 1) * STAGE;
    const char* sV = sK + 8192;
    if (more) AT_LOAD(c + 1);
    f32x4 stall[4 / KT][KT][QT];
#pragma unroll
    for (int sbk = 0; sbk < 4 / KT; ++sbk) {
#pragma unroll
      for (int kt = 0; kt < KT; ++kt)
#pragma unroll
        for (int qt = 0; qt < QT; ++qt) stall[sbk][kt][qt] = (f32x4){0.f, 0.f, 0.f, 0.f};
#pragma unroll
      for (int s = 0; s < 2; ++s)
#pragma unroll
        for (int kt = 0; kt < KT; ++kt) {
          const bf16x8 ka = *(const bf16x8*)(sK + sw128(sbk * KT * 16 + kt * 16 + r, s * 4 + q));
#pragma unroll
          for (int qt = 0; qt < QT; ++qt) stall[sbk][kt][qt] = mfma16(ka, Qf[qt][s], stall[sbk][kt][qt]);
        }
    }
#pragma unroll
    for (int sbk = 0; sbk < 4 / KT; ++sbk) {
      f32x4 (&st)[KT][QT] = stall[sbk];
      bf16x8 pb[KT / 2][QT];
      if (MODE == 1) {
#pragma unroll
        for (int kt = 0; kt < KT; ++kt)
#pragma unroll
          for (int qt = 0; qt < QT; ++qt)
#pragma unroll
            for (int j = 0; j < 4; ++j) {
              float v = st[kt][qt][j] * SC;
              if (c < nloc) {
                const int kc = sbk * KT * 16 + kt * 16 + 4 * q + j;
                const int qc = wid * 16 + r;
                int wst = qc - 8; wst = wst < 0 ? 0 : (wst > 48 ? 48 : wst);
                const bool valid = (kc >= wst) && (kc < wst + 16);
                int co = kc - qc + 15; co = co < 0 ? 0 : (co > 30 ? 30 : co);
                const float bias = rpb_s[(roff0 + c) * 31 + co] * L2E;
                v = valid ? (v + bias) : -INFINITY;
              }
              st[kt][qt][j] = v;
            }
      }
#pragma unroll
      for (int qt = 0; qt < QT; ++qt) {
        float mx = fmaxf(fmaxf(st[0][qt][0], st[0][qt][1]), fmaxf(st[0][qt][2], st[0][qt][3]));
#pragma unroll
        for (int kt = 1; kt < KT; ++kt) {
          mx = __builtin_fmaxf(mx, __builtin_fmaxf(st[kt][qt][0], st[kt][qt][1]));
          mx = __builtin_fmaxf(mx, __builtin_fmaxf(st[kt][qt][2], st[kt][qt][3]));
        }
        if (MODE != 1) mx *= SC;
        if (__any(mx > mrun[qt] + 8.f)) {
          mx = fmaxf(mx, shx<16>(mx, lane));
          mx = fmaxf(mx, shx<32>(mx, lane));
          const float mnew2 = fmaxf(mrun[qt], mx);
          const float alpha = fexp2(mrun[qt] - mnew2);
          mrun[qt] = mnew2;
          lsum[qt] *= alpha;
#pragma unroll
          for (int dt = 0; dt < DV / 16; ++dt) {
            O[dt][qt][0] *= alpha; O[dt][qt][1] *= alpha; O[dt][qt][2] *= alpha; O[dt][qt][3] *= alpha;
          }
        }
        const float mnew = mrun[qt];
        f32x2_t ps2 = {0.f, 0.f};
#pragma unroll
        for (int kt = 0; kt < KT; ++kt) {
          float e0, e1, e2, e3;
          if (MODE == 1) {
            e0 = fexp2(st[kt][qt][0] - mnew); e1 = fexp2(st[kt][qt][1] - mnew);
            e2 = fexp2(st[kt][qt][2] - mnew); e3 = fexp2(st[kt][qt][3] - mnew);
          } else {
            e0 = fexp2(__builtin_fmaf(st[kt][qt][0], SC, -mnew)); e1 = fexp2(__builtin_fmaf(st[kt][qt][1], SC, -mnew));
            e2 = fexp2(__builtin_fmaf(st[kt][qt][2], SC, -mnew)); e3 = fexp2(__builtin_fmaf(st[kt][qt][3], SC, -mnew));
          }
          st[kt][qt][0] = e0; st[kt][qt][1] = e1; st[kt][qt][2] = e2; st[kt][qt][3] = e3;
          const f32x2_t a01 = {e0, e1}, a23 = {e2, e3};
          ps2 = ps2 + a01;
          ps2 = ps2 + a23;
        }
        lsum[qt] += ps2.x + ps2.y;
#pragma unroll
        for (int ks = 0; ks < KT / 2; ++ks) {
          u32x4 pk;
          pk.x = pack2(st[2 * ks][qt][0], st[2 * ks][qt][1]);
          pk.y = pack2(st[2 * ks][qt][2], st[2 * ks][qt][3]);
          pk.z = pack2(st[2 * ks + 1][qt][0], st[2 * ks + 1][qt][1]);
          pk.w = pack2(st[2 * ks + 1][qt][2], st[2 * ks + 1][qt][3]);
          pb[ks][qt] = __builtin_bit_cast(bf16x8, pk);
        }
      }
#pragma unroll
      for (int dt = 0; dt < DV / 16; ++dt)
#pragma unroll
        for (int ks = 0; ks < KT / 2; ++ks) {
          const bf16x8 va = *(const bf16x8*)(sV + sw128(dt * 16 + r, (sbk * (KT / 2) + ks) * 4 + q));
#pragma unroll
          for (int qt = 0; qt < QT; ++qt) O[dt][qt] = mfma16(va, pb[ks][qt], O[dt][qt]);
        }
    }
    if (more) AT_STORE(c + 1);
  }
#undef AT_LOAD
#undef AT_STORE
  __syncthreads();
#pragma unroll
  for (int qt = 0; qt < QT; ++qt) {
    float L = lsum[qt];
    L += shx<16>(L, lane);
    L += shx<32>(L, lane);
    lsum[qt] = L;
  }
}

DI void diff_attn_item(const Params& p, int l, int b, int head, int qrow0, bool ctxq, char* smem) {
  const int tid = opaque_tid(), lane = tid & 63, wid = tid >> 6, r = lane & 15, q = lane >> 4;
  const bfr* proj = (const bfr*)(p.ws + OFF_PROJ);
  const bfr* VT = (const bfr*)(p.ws + OFF_VT);
  bfr* U = (bfr*)(p.ws + OFF_U);
  const float* lamv = (const float*)(p.ws + OFF_LAM);
  const float lam = lamv[l >> 1], lam_init = lamv[2 + (l >> 1)];
  f32x4 O[8][2];
  float ls[2];
  char* parkb = smem + 49152 + tid * 16;
  attn_engine<128, 2, 2, 0>(proj + (size_t)qrow0 * NEV + 2048 + head * 128, NEV, proj + head * 128, NEV,
                            VT + (size_t)(b * 1024 + head * 128) * KEYS, ctxq ? 0 : 64, b * 4096, 0, 4,
                            ML + b * 256, nullptr, 0, smem, O, ls);
  u32x4 pkr0, pkr1;
  {
    const float i0 = 1.f / ls[0], i1 = 1.f / ls[1];
#pragma unroll
    for (int dt = 0; dt < 8; dt += 2) {
      u32x4 v0, v1;
      v0.x = pack2(O[dt][0][0] * i0, O[dt][0][1] * i0);
      v0.y = pack2(O[dt][0][2] * i0, O[dt][0][3] * i0);
      v0.z = pack2(O[dt + 1][0][0] * i0, O[dt + 1][0][1] * i0);
      v0.w = pack2(O[dt + 1][0][2] * i0, O[dt + 1][0][3] * i0);
      v1.x = pack2(O[dt][1][0] * i1, O[dt][1][1] * i1);
      v1.y = pack2(O[dt][1][2] * i1, O[dt][1][3] * i1);
      v1.z = pack2(O[dt + 1][1][0] * i1, O[dt + 1][1][1] * i1);
      v1.w = pack2(O[dt + 1][1][2] * i1, O[dt + 1][1][3] * i1);
      if (dt < 6) {
        *(u32x4*)(parkb + (dt / 2) * 4096) = v0;
        *(u32x4*)(parkb + (3 + dt / 2) * 4096) = v1;
      } else { pkr0 = v0; pkr1 = v1; }
    }
  }
  attn_engine<128, 2, 2, 0>(proj + (size_t)qrow0 * NEV + 2048 + head * 128 + 64, NEV, proj + head * 128 + 64, NEV,
                            VT + (size_t)(b * 1024 + head * 128) * KEYS, ctxq ? 0 : 64, b * 4096, 0, 4,
                            ML + b * 256, nullptr, 0, smem, O, ls);
  const float* subln = p.ev_subln + (l >> 1) * 128;
#pragma unroll
  for (int qt = 0; qt < 2; ++qt) {
    const float i1 = lam / ls[qt];
    float ss = 0.f;
#pragma unroll
    for (int dt = 0; dt < 8; ++dt) {
      unsigned pa, pc;
      if (dt < 6) {
        const u32x2 pk2 = *(const u32x2*)(parkb + (qt * 3 + dt / 2) * 4096 + (dt & 1) * 8);
        pa = pk2.x; pc = pk2.y;
      } else {
        const u32x4 pr = qt ? pkr1 : pkr0;
        pa = (dt & 1) ? pr.z : pr.x; pc = (dt & 1) ? pr.w : pr.y;
      }
      const float o0 = lo_bf(pa) - O[dt][qt][0] * i1;
      const float o1 = hi_bf(pa) - O[dt][qt][1] * i1;
      const float o2 = lo_bf(pc) - O[dt][qt][2] * i1;
      const float o3 = hi_bf(pc) - O[dt][qt][3] * i1;
      O[dt][qt][0] = o0; O[dt][qt][1] = o1; O[dt][qt][2] = o2; O[dt][qt][3] = o3;
      ss += o0 * o0 + o1 * o1 + o2 * o2 + o3 * o3;
    }
    ss += shx<16>(ss, lane);
    ss += shx<32>(ss, lane);
    const float rn = rsqrtf(ss * (1.f / 128.f) + 1e-6f) * (1.f - lam_init);
    const int row = qrow0 + wid * 32 + qt * 16 + r;
#pragma unroll
    for (int dt = 0; dt < 8; ++dt) {
      const int dv = dt * 16 + 4 * q;
      const u32x2 ag = *(const u32x2*)(proj + (size_t)row * NEV + 3072 + head * 128 + dv);
      const float4 sl = *(const float4*)(subln + dv);
      u32x2 o;
      o.x = pack2(O[dt][qt][0] * rn * sl.x * silu(lo_bf(ag.x)), O[dt][qt][1] * rn * sl.y * silu(hi_bf(ag.x)));
      o.y = pack2(O[dt][qt][2] * rn * sl.z * silu(lo_bf(ag.y)), O[dt][qt][3] * rn * sl.w * silu(hi_bf(ag.y)));
      *(u32x2*)(U + (size_t)row * 2048 + head * 128 + dv) = o;
    }
  }
}

DI void na_item(const Params& p, int l, int b, int head, int rho, bool ctxq, int cq0, char* smem) {
  const int tid = opaque_tid(), lane = tid & 63, wid = tid >> 6, r = lane & 15, q = lane >> 4;
  const bfr* proj = (const bfr*)(p.ws + OFF_PROJ);
  const bfr* VT = (const bfr*)(p.ws + OFF_VT);
  bfr* U = (bfr*)(p.ws + OFF_U);
  float* rpb_s = (float*)(smem + 2 * (8192 + 64 * 128));
  int rs = rho - 4; rs = rs < 0 ? 0 : (rs > 56 ? 56 : rs);
  const int qrow0 = ctxq ? (ML + b * 256 + cq0) : (b * 4096 + rho * 64);
  f32x4 O[4][1];
  float ls[1];
  if (!ctxq) {
    const float* rp = p.od_rpb + ((size_t)(l >> 1) * 16 + head) * 465;
    for (int i = tid; i < 465; i += 256) rpb_s[i] = rp[i];
    attn_engine<64, 1, 4, 1>(proj + (size_t)qrow0 * NOD + 3584 + head * 64, NOD, proj + head * 64, NOD,
                                VT + (size_t)(b * 1024 + head * 64) * KEYS, 8, b * 4096 + rs * 64, rs * 64, 4,
                                ML + b * 256, rpb_s, rs - rho + 7, smem, O, ls);
  } else {
    attn_engine<64, 1, 4, 0>(proj + (size_t)qrow0 * NOD + 3584 + head * 64, NOD, proj + head * 64, NOD,
                                VT + (size_t)(b * 1024 + head * 64) * KEYS, 0, 0, 0, 4, ML + b * 256, nullptr, 0,
                                smem, O, ls);
  }
  const float inv = 1.f / ls[0];
  const int row = qrow0 + wid * 16 + r;
#pragma unroll
  for (int dt = 0; dt < 4; ++dt) {
    const int dv = dt * 16 + 4 * q;
    const u32x2 cgv = *(const u32x2*)(proj + (size_t)row * NOD + 5120 + head * 64 + dv);
    u32x2 o;
    o.x = pack2(O[dt][0][0] * inv * silu(lo_bf(cgv.x)), O[dt][0][1] * inv * silu(hi_bf(cgv.x)));
    o.y = pack2(O[dt][0][2] * inv * silu(lo_bf(cgv.y)), O[dt][0][3] * inv * silu(hi_bf(cgv.y)));
    *(u32x2*)(U + (size_t)row * 2048 + head * 64 + dv) = o;
  }
}

DI void conv_item(const Params& p, int l, int item) {
  const int tid = opaque_tid();
  const bfr* proj = (const bfr*)(p.ws + OFF_PROJ);
  bfr* U = (bfr*)(p.ws + OFF_U);
  const float* cw = p.ev_conv + (size_t)(l >> 1) * 3 * 1024;
#pragma unroll 1
  for (int i = 0; i < 8; ++i) {
    const int v = tid + 256 * i;
    const int ri = v >> 7, ch = (v & 127) * 8;
    const int m = item * 16 + ri;
    int t, T;
    if (m < ML) { t = m & 4095; T = 4096; } else { t = (m - ML) & 255; T = 256; }
    const bfr* pr = proj + (size_t)m * NEV;
    float acc[8];
#pragma unroll
    for (int e = 0; e < 8; ++e) acc[e] = 0.f;
#pragma unroll
    for (int w = 0; w < 3; ++w) {
      const int tt = t + w - 1;
      if (tt >= 0 && tt < T) {
        const bfr* prw = pr + (ptrdiff_t)(w - 1) * NEV;
        const u32x4 bh = *(const u32x4*)(prw + 4096 + ch);
        const u32x4 bc = *(const u32x4*)(prw + 6144 + ch);
        const float4 w0 = *(const float4*)(cw + w * 1024 + ch);
        const float4 w1 = *(const float4*)(cw + w * 1024 + ch + 4);
        acc[0] += w0.x * lo_bf(bh.x) * lo_bf(bc.x); acc[1] += w0.y * hi_bf(bh.x) * hi_bf(bc.x);
        acc[2] += w0.z * lo_bf(bh.y) * lo_bf(bc.y); acc[3] += w0.w * hi_bf(bh.y) * hi_bf(bc.y);
        acc[4] += w1.x * lo_bf(bh.z) * lo_bf(bc.z); acc[5] += w1.y * hi_bf(bh.z) * hi_bf(bc.z);
        acc[6] += w1.z * lo_bf(bh.w) * lo_bf(bc.w); acc[7] += w1.w * hi_bf(bh.w) * hi_bf(bc.w);
      }
    }
    const u32x4 bb = *(const u32x4*)(pr + 5120 + ch);
    const u32x4 bg = *(const u32x4*)(pr + 7168 + ch);
    u32x4 o;
    o.x = pack2(lo_bf(bb.x) * acc[0] * silu(lo_bf(bg.x)), hi_bf(bb.x) * acc[1] * silu(hi_bf(bg.x)));
    o.y = pack2(lo_bf(bb.y) * acc[2] * silu(lo_bf(bg.y)), hi_bf(bb.y) * acc[3] * silu(hi_bf(bg.y)));
    o.z = pack2(lo_bf(bb.z) * acc[4] * silu(lo_bf(bg.z)), hi_bf(bb.z) * acc[5] * silu(hi_bf(bg.z)));
    o.w = pack2(lo_bf(bb.w) * acc[6] * silu(lo_bf(bg.w)), hi_bf(bb.w) * acc[7] * silu(hi_bf(bg.w)));
    *(u32x4*)(U + (size_t)m * 2048 + 1024 + ch) = o;
  }
}

DI void gla_item(const Params& p, int l, int item, char* smem) {
  const int tid0 = opaque_tid();
  const int slice = item & 7, dir = (item >> 3) & 1, head = (item >> 4) & 3, b = item >> 6;
  const bfr* proj = (const bfr*)(p.ws + OFF_PROJ);
  const char* etb = p.ws + (dir ? OFF_ETB : OFF_ETF) + (size_t)head * 16384;
  const float* decb = (const float*)(p.ws + OFF_DEC) + ((size_t)dir * (MR / 64) * 4 + head) * 128;
  char* sQb = smem;
  char* sKc = smem + 16384;
  char* sKbT = smem + 32768;
  char* sVt = smem + 49152;
  char* sAtt = smem + 53248;
  char* sST = smem + 61440;
  float* sDec = (float*)(smem + 77824);
  const float qscale = 0.08838834764831845f;

  f32x4 S[2][2];
#pragma unroll
  for (int a = 0; a < 2; ++a)
#pragma unroll
    for (int c2 = 0; c2 < 2; ++c2) S[a][c2] = (f32x4){0.f, 0.f, 0.f, 0.f};
  __syncthreads();
  for (int i = tid0; i < 512; i += 256) ((u32x4*)sST)[i] = (u32x4){0u, 0u, 0u, 0u};

  u32x4 pq0, pq1, pq2, pq3, pk0, pk1, pk2, pk3, pv, pe0, pe1, pe2, pe3, pdec;
#define GLA_ROW0(ci_) (((ci_) < 4) ? (ML + b * 256 + (dir ? (3 - (ci_)) : (ci_)) * 64) : (b * 4096 + (dir ? (67 - (ci_)) : ((ci_) - 4)) * 64))
#define GLA_LOAD(ci_)                                                                                         \
  {                                                                                                           \
    const int prow = tid >> 4, pch = tid & 15, vs = tid >> 2, vpart = tid & 3;                                \
    const int r0_ = GLA_ROW0(ci_);                                                                            \
    const bfr* pr_ = proj + (size_t)(r0_ + prow) * NOD + head * 128 + pch * 8;                                \
    pq0 = *(const u32x4*)(pr_ + 4608);                     pk0 = *(const u32x4*)(pr_ + 2048);                 \
    pq1 = *(const u32x4*)(pr_ + 4608 + (size_t)16 * NOD);  pk1 = *(const u32x4*)(pr_ + 2048 + (size_t)16 * NOD); \
    pq2 = *(const u32x4*)(pr_ + 4608 + (size_t)32 * NOD);  pk2 = *(const u32x4*)(pr_ + 2048 + (size_t)32 * NOD); \
    pq3 = *(const u32x4*)(pr_ + 4608 + (size_t)48 * NOD);  pk3 = *(const u32x4*)(pr_ + 2048 + (size_t)48 * NOD); \
    pv = *(const u32x4*)(proj + (size_t)(r0_ + vs) * NOD + 2560 + head * 256 + slice * 32 + vpart * 8);       \
    const char* et_ = etb + (size_t)(r0_ >> 6) * 65536 + tid * 16;                                            \
    pe0 = *(const u32x4*)(et_);         pe1 = *(const u32x4*)(et_ + 4096);                                    \
    pe2 = *(const u32x4*)(et_ + 8192);  pe3 = *(const u32x4*)(et_ + 12288);                                   \
    if (tid < 32) pdec = *(const u32x4*)(decb + (size_t)(r0_ >> 6) * 512 + tid * 4);                          \
  }
  { const int tid = tid0; GLA_LOAD(0); }
  for (int ci = 0; ci < 68; ++ci) {
    int tid = tid0; asm volatile("" : "+v"(tid));
    const int lane = tid & 63, wid = tid >> 6, r = lane & 15, q = lane >> 4;
    const int d = tid & 127, half = tid >> 7;
    const int prow = tid >> 4, pch = tid & 15, vs = tid >> 2, vpart = tid & 3;
    const int row0 = GLA_ROW0(ci);
    const char* stc = sST + (ci & 1) * 8192;
    char* stn = sST + ((ci + 1) & 1) * 8192;
    __syncthreads();
    {
      *(u32x4*)(sQb + sw256(prow, pch)) = pq0;       *(u32x4*)(sKc + sw256(prow, pch)) = pk0;
      *(u32x4*)(sQb + sw256(prow + 16, pch)) = pq1;  *(u32x4*)(sKc + sw256(prow + 16, pch)) = pk1;
      *(u32x4*)(sQb + sw256(prow + 32, pch)) = pq2;  *(u32x4*)(sKc + sw256(prow + 32, pch)) = pk2;
      *(u32x4*)(sQb + sw256(prow + 48, pch)) = pq3;  *(u32x4*)(sKc + sw256(prow + 48, pch)) = pk3;
      *(u32x4*)(sKbT + tid * 16) = pe0;              *(u32x4*)(sKbT + tid * 16 + 4096) = pe1;
      *(u32x4*)(sKbT + tid * 16 + 8192) = pe2;       *(u32x4*)(sKbT + tid * 16 + 12288) = pe3;
      if (tid < 32) *(u32x4*)((char*)sDec + tid * 16) = pdec;
      const unsigned vv[4] = {pv.x, pv.y, pv.z, pv.w};
#pragma unroll
      for (int j = 0; j < 4; ++j) {
        const int e0 = vpart * 8 + 2 * j;
        *(bfr*)(sVt + sw128(e0, vs >> 3) + (vs & 7) * 2) = (bfr)(vv[j] & 0xffffu);
        *(bfr*)(sVt + sw128(e0 + 1, vs >> 3) + (vs & 7) * 2) = (bfr)(vv[j] >> 16);
      }
    }
    __syncthreads();
    {
      const float dec = sDec[d];
#pragma unroll
      for (int i8 = 0; i8 < 4; ++i8) {
        const u32x4 ev = *(const u32x4*)(sKbT + sw128(d, half * 4 + i8));
        const unsigned ew[4] = {ev.x, ev.y, ev.z, ev.w};
        unsigned kb[4];
#pragma unroll
        for (int ii = 0; ii < 8; ++ii) {
          const int s = half * 32 + i8 * 8 + ii;
          const float E = (ii & 1) ? hi_bf(ew[ii >> 1]) : lo_bf(ew[ii >> 1]);
          const float Ei = __builtin_amdgcn_rcpf(E);
          bfr* qa_ = (bfr*)(sQb + sw256(s, d >> 3) + (d & 7) * 2);
          bfr* ka_ = (bfr*)(sKc + sw256(s, d >> 3) + (d & 7) * 2);
          const float qv = bf2f(*qa_) * qscale * E;
          const float kc = bf2f(*ka_) * Ei;
          *qa_ = f2bf(qv);
          *ka_ = f2bf(kc);
          const unsigned kbv = f2bf(kc * dec);
          if (ii & 1) kb[ii >> 1] |= kbv << 16; else kb[ii >> 1] = kbv;
        }
        *(u32x4*)(sKbT + sw128(d, half * 4 + i8)) = (u32x4){kb[0], kb[1], kb[2], kb[3]};
      }
    }
    __syncthreads();
    if (ci + 1 < 68) GLA_LOAD(ci + 1);
    {
      f32x4 at[4];
#pragma unroll
      for (int st = 0; st < 4; ++st) at[st] = (f32x4){0.f, 0.f, 0.f, 0.f};
#pragma unroll
      for (int ks = 0; ks < 4; ++ks) {
        const bf16x8 qa = *(const bf16x8*)(sQb + sw256(wid * 16 + r, ks * 4 + q));
#pragma unroll
        for (int st = 0; st < 4; ++st) {
          const bf16x8 kb2 = *(const bf16x8*)(sKc + sw256(st * 16 + r, ks * 4 + q));
          at[st] = mfma16(qa, kb2, at[st]);
        }
      }
#pragma unroll
      for (int st = 0; st < 4; ++st)
#pragma unroll
        for (int j = 0; j < 4; ++j) {
          const int t = wid * 16 + 4 * q + j, s = st * 16 + r;
          const bool keep = dir ? (s >= t) : (s <= t);
          *(bfr*)(sAtt + sw128(t, s >> 3) + (s & 7) * 2) = f2bf(keep ? at[st][j] : 0.f);
        }
    }
    __syncthreads();
    {
      f32x4 o[2];
      o[0] = (f32x4){0.f, 0.f, 0.f, 0.f};
      o[1] = (f32x4){0.f, 0.f, 0.f, 0.f};
#pragma unroll
      for (int ks = 0; ks < 4; ++ks) {
        const bf16x8 qa = *(const bf16x8*)(sQb + sw256(wid * 16 + r, ks * 4 + q));
#pragma unroll
        for (int et = 0; et < 2; ++et) {
          const bf16x8 sb2 = *(const bf16x8*)(stc + sw256(et * 16 + r, ks * 4 + q));
          o[et] = mfma16(qa, sb2, o[et]);
        }
      }
#pragma unroll
      for (int ks = 0; ks < 2; ++ks) {
        const bf16x8 aa = *(const bf16x8*)(sAtt + sw128(wid * 16 + r, ks * 4 + q));
#pragma unroll
        for (int et = 0; et < 2; ++et) {
          const bf16x8 vb = *(const bf16x8*)(sVt + sw128(et * 16 + r, ks * 4 + q));
          o[et] = mfma16(aa, vb, o[et]);
        }
      }
      {
        const int lam = head * 8 + slice;
#pragma unroll
        for (int j = 0; j < 4; ++j) {
          const int row = row0 + wid * 16 + 4 * q + j;
          const int m2 = row >> 1, par = row & 1;
          bfr* lp = dir ? ((bfr*)(p.ws + OFF_H) + ((size_t)m2 * 32 + lam) * 64)
                        : ((bfr*)(p.ws + OFF_U) + (size_t)(2 * m2 + (lam >> 4)) * 2048 + 1024 + (lam & 15) * 64);
#pragma unroll
          for (int et = 0; et < 2; ++et) lp[par * 32 + et * 16 + r] = f2bf(o[et][j]);
        }
      }
    }
    {
#pragma unroll
      for (int dti = 0; dti < 2; ++dti) {
        const float dc = sDec[(2 * wid + dti) * 16 + r];
#pragma unroll
        for (int et = 0; et < 2; ++et) {
          S[et][dti][0] *= dc; S[et][dti][1] *= dc; S[et][dti][2] *= dc; S[et][dti][3] *= dc;
        }
      }
#pragma unroll
      for (int ks = 0; ks < 2; ++ks) {
        bf16x8 va[2], kb2[2];
#pragma unroll
        for (int et = 0; et < 2; ++et) va[et] = *(const bf16x8*)(sVt + sw128(et * 16 + r, ks * 4 + q));
#pragma unroll
        for (int dti = 0; dti < 2; ++dti) kb2[dti] = *(const bf16x8*)(sKbT + sw128((2 * wid + dti) * 16 + r, ks * 4 + q));
#pragma unroll
        for (int et = 0; et < 2; ++et)
#pragma unroll
          for (int dti = 0; dti < 2; ++dti) S[et][dti] = mfma16(va[et], kb2[dti], S[et][dti]);
      }
#pragma unroll
      for (int et = 0; et < 2; ++et)
#pragma unroll
        for (int dti = 0; dti < 2; ++dti)
#pragma unroll
          for (int j = 0; j < 4; ++j) {
            const int e = et * 16 + 4 * q + j, dd = (2 * wid + dti) * 16 + r;
            *(bfr*)(stn + sw256(e, dd >> 3) + (dd & 7) * 2) = f2bf(S[et][dti][j]);
          }
    }
  }
#undef GLA_LOAD
#undef GLA_ROW0
  __syncthreads();
}

DI void phase_gla_combine(const Params& p, int l) {
  const int tid = opaque_tid(), lane = tid & 63, wid = tid >> 6;
  const bfr* proj = (const bfr*)(p.ws + OFF_PROJ);
  const bfr* OB = (const bfr*)(p.ws + OFF_H);
  bfr* U = (bfr*)(p.ws + OFF_U);
  const int h = lane >> 4, e16 = (lane & 15) * 16;
  const int lam = h * 8 + ((lane & 15) >> 1), ein = (lane & 1) * 16;
  const float* gn = p.od_gnorm + (l >> 1) * 256 + e16;
  for (int m2 = blockIdx.x * 4 + wid; m2 < MR / 2; m2 += gridDim.x * 4) {
    const bfr* ofl = U + (size_t)(2 * m2 + (lam >> 4)) * 2048 + 1024 + (lam & 15) * 64 + ein;
    const bfr* obl = OB + ((size_t)m2 * 32 + lam) * 64 + ein;
    u32x4 a[2][2], bq[2][2], g[2][2];
#pragma unroll
    for (int par = 0; par < 2; ++par) {
      a[par][0] = *(const u32x4*)(ofl + par * 32);  a[par][1] = *(const u32x4*)(ofl + par * 32 + 8);
      bq[par][0] = *(const u32x4*)(obl + par * 32); bq[par][1] = *(const u32x4*)(obl + par * 32 + 8);
      const bfr* gp = proj + (size_t)(2 * m2 + par) * NOD + 6144 + h * 256 + e16;
      g[par][0] = *(const u32x4*)gp; g[par][1] = *(const u32x4*)(gp + 8);
    }
    u32x4 res[2][2];
#pragma unroll
    for (int par = 0; par < 2; ++par) {
      float o[16], dg[16];
      float ss = 0.f;
#pragma unroll
      for (int hv = 0; hv < 2; ++hv)
#pragma unroll
        for (int i = 0; i < 4; ++i) {
          const unsigned av = a[par][hv][i], bv = bq[par][hv][i], gv = g[par][hv][i];
          const int k = hv * 8 + i * 2;
          o[k] = lo_bf(av) + lo_bf(bv); o[k + 1] = hi_bf(av) + hi_bf(bv);
          dg[k] = lo_bf(gv); dg[k + 1] = hi_bf(gv);
          ss += o[k] * o[k] + o[k + 1] * o[k + 1];
        }
      ss += shx<1>(ss, lane); ss += shx<2>(ss, lane); ss += shx<4>(ss, lane); ss += shx<8>(ss, lane);
      const float rn = rsqrtf(ss * (1.f / 256.f) + 1e-6f);
#pragma unroll
      for (int hv = 0; hv < 2; ++hv)
#pragma unroll
        for (int i = 0; i < 4; ++i) {
          const int k = hv * 8 + i * 2;
          res[par][hv][i] = pack2(o[k] * rn * gn[k] * silu(dg[k]), o[k + 1] * rn * gn[k + 1] * silu(dg[k + 1]));
        }
    }
#pragma unroll
    for (int par = 0; par < 2; ++par) {
      bfr* up = U + (size_t)(2 * m2 + par) * 2048 + 1024 + h * 256 + e16;
      *(u32x4*)up = res[par][0];
      *(u32x4*)(up + 8) = res[par][1];
    }
  }
}

DI int next_item(int* ctr, int* slot) {
  __syncthreads();
  if (threadIdx.x == 0) *slot = atomicAdd(ctr, 1);
  __syncthreads();
  return *slot;
}

DI void phase_mix_even(const Params& p, int l, int g, char* smem, int coff = 0) {
  int* ctr0 = (int*)(p.ws + OFF_CTR) + ((g * 2 + (l >> 1)) * 8) + coff;
  int* slot = (int*)(smem + SMEM_BYTES - 16);
  const int PER_LAT = GB * 32, PER_CTX = GB * 2, PER_CONV = MR / 16 / 8;
  const int per_q = PER_LAT + PER_CTX + PER_CONV;
  const int myq = (int)(__builtin_amdgcn_s_getreg((3 << 11) | 20) & 7u);
  for (int dq = 0; dq < 8; ++dq) {
    const int x = (myq + dq) & 7;
    for (;;) {
      int it = next_item(ctr0 + x, slot);
      if (it >= per_q) break;
      if (it < PER_LAT) {
        const int qb = it & 31, b = it >> 5;
        diff_attn_item(p, l, b, x, b * 4096 + qb * 128, false, smem);
      } else if (it < PER_LAT + PER_CTX) {
        it -= PER_LAT;
        const int qb = it & 1, b = it >> 1;
        diff_attn_item(p, l, b, x, ML + b * 256 + qb * 128, true, smem);
      } else {
        conv_item(p, l, (it - PER_LAT - PER_CTX) * 8 + x);
      }
    }
  }
}

DI void phase_mix_odd(const Params& p, int l, int g, char* smem) {
  int* ctr = (int*)(p.ws + OFF_CTR) + (g * 4 + l);
  int* slot = (int*)(smem + SMEM_BYTES - 16);
  const int N_GLA = GB * 4 * 2 * 8, N_NA = GB * 16 * 64, N_CTX = (l == 3) ? 0 : GB * 16 * 4;
  const int total = N_GLA + N_NA + N_CTX;
  (void)ctr; (void)slot; (void)total;
  const int nb = gridDim.x, bx = blockIdx.x;
  const int nup = (nb > N_GLA) ? (nb - N_GLA) : 0;
  for (int k = 0;; ++k) {
    int it;
    if (nup == 0) { it = bx + k * nb; if (it >= total) break; }
    else if (bx < N_GLA) {
      if (k == 0) it = bx;
      else { it = N_GLA + N_NA + bx + (k - 1) * N_GLA; if (it >= total) break; }
    } else {
      it = N_GLA + (bx - N_GLA) + k * nup;
      if (it >= N_GLA + N_NA) break;
    }
    __syncthreads();
    if (it < N_GLA) {
      __builtin_amdgcn_s_setprio(3);
      gla_item(p, l, it, smem);
      __builtin_amdgcn_s_setprio(0);
    } else if (it < N_GLA + N_NA) {
      it -= N_GLA;
      const int rho = it & 63, bh = it >> 6;
      na_item(p, l, bh >> 4, bh & 15, rho, false, 0, smem);
    } else {
      it -= N_GLA + N_NA;
      const int qb = it & 3, bh = it >> 2;
      na_item(p, l, bh >> 4, bh & 15, 0, true, qb * 64, smem);
    }
  }
}


DI void grid_barrier(unsigned* bar, unsigned& bgen, unsigned xcc, unsigned nxcc, unsigned nx) {
  asm volatile("s_waitcnt vmcnt(0)" ::: "memory");
  __syncthreads();
  const unsigned target = bgen + 1;
  if (threadIdx.x == 0) {
    const unsigned old = __hip_atomic_fetch_add(bar + xcc * 64, 1u, __ATOMIC_RELAXED, __HIP_MEMORY_SCOPE_AGENT);
    if (old == target * nxcc - 1) {
      __builtin_amdgcn_fence(__ATOMIC_RELEASE, "agent");
      asm volatile("s_waitcnt vmcnt(0)" ::: "memory");
      const unsigned o2 = __hip_atomic_fetch_add(bar + 16 * 64, 1u, __ATOMIC_RELAXED, __HIP_MEMORY_SCOPE_AGENT);
      if (o2 == target * nx - 1) __hip_atomic_store(bar + 17 * 64, target, __ATOMIC_RELAXED, __HIP_MEMORY_SCOPE_AGENT);
    }
    while (__hip_atomic_load(bar + 17 * 64, __ATOMIC_RELAXED, __HIP_MEMORY_SCOPE_AGENT) < target) __builtin_amdgcn_s_sleep(1);
    __builtin_amdgcn_fence(__ATOMIC_ACQUIRE, "agent");
    asm volatile("s_waitcnt vmcnt(0)" ::: "memory");
  }
  bgen = target;
  __syncthreads();
}
typedef const __attribute__((address_space(4))) Params* KParamsPtr;
DI Params load_params() {
#if defined(__HIP_DEVICE_COMPILE__)
  KParamsPtr kp = (KParamsPtr)__builtin_amdgcn_kernarg_segment_ptr();
  asm volatile("" : "+s"(kp));
  Params r;
  __builtin_memcpy(&r, kp, sizeof(Params));
  return r;
#else
  return Params{};
#endif
}
#define PH(call) { const Params p = load_params(); call; }
__global__ void __launch_bounds__(256, 2) mega_kernel(Params p_unused) {
  extern __shared__ __attribute__((aligned(16))) char smem[];
  cg::grid_group grid = cg::this_grid();
  unsigned bgen = 0;
  const unsigned xcc = (unsigned)__builtin_amdgcn_s_getreg((3 << 11) | 20) & 15u;
  if (threadIdx.x == 0) {
    const Params pb = load_params();
    __hip_atomic_fetch_add((unsigned*)(pb.ws + OFF_BAR) + (18 + xcc) * 64, 1u, __ATOMIC_RELAXED, __HIP_MEMORY_SCOPE_AGENT);
  }
  PH(phase0(p, smem));
  grid.sync();
  unsigned nxcc = 0, nx = 0;
  {
    const Params pb = load_params();
    const unsigned* cen = (const unsigned*)(pb.ws + OFF_BAR) + 18 * 64;
    for (unsigned j = 0; j < 16; ++j) {
      const unsigned cj = __hip_atomic_load(cen + j * 64, __ATOMIC_RELAXED, __HIP_MEMORY_SCOPE_AGENT);
      nx += (cj != 0);
      if (j == xcc) nxcc = cj;
    }
  }
#define GBAR() { const Params pb = load_params(); grid_barrier((unsigned*)(pb.ws + OFF_BAR), bgen, xcc, nxcc, nx); }
#pragma unroll 1
  for (int g = 0; g < NGRP; ++g) {
#pragma unroll 1
    for (int l = 0; l < 4; ++l) {
      PH(phase_norm(p, l, g));
      GBAR();
      PH(phase_gemm_in(p, l, smem, g * 4 + l));
      GBAR();
      if (l & 1) {
        PH(phase_mix_odd(p, l, g, smem));
        GBAR();
        PH(phase_gla_combine(p, l));
      } else {
        PH(phase_mix_even(p, l, g, smem));
      }
      GBAR();
      PH(phase_gemm_out(p, l, smem, 8 + g * 4 + l));
      GBAR();
    }
    PH(phase_norm(p, 4, g));
    GBAR();
  }
}

extern "C" void kernel_launch(void* const* d_in, const int* in_sizes, int n_in, void* d_out, int out_size, void* d_ws,
                              size_t ws_size, hipStream_t stream) {
  static int grid_blocks = 0;
  if (!grid_blocks) {
    int dev = 0, cus = 0, per_cu = 0;
    hipGetDevice(&dev);
    hipDeviceGetAttribute(&cus, hipDeviceAttributeMultiprocessorCount, dev);
    hipFuncSetAttribute((const void*)mega_kernel, hipFuncAttributeMaxDynamicSharedMemorySize, SMEM_BYTES);
    hipOccupancyMaxActiveBlocksPerMultiprocessor(&per_cu, mega_kernel, 256, SMEM_BYTES);
    if (per_cu > 2) per_cu = 2;
    if (per_cu < 1) per_cu = 1;
    grid_blocks = cus * per_cu;
    grid_blocks &= ~15;
  }
  if (ws_size < WS_NEED) { fprintf(stderr, "workspace too small: %zu < %zu\n", ws_size, (size_t)WS_NEED); return; }
  Params p{};
  p.x = (const float*)d_in[0]; p.c = (const float*)d_in[1]; p.ctx = (const float*)d_in[2]; p.c_ctx = (const float*)d_in[3];
  p.w_mod = (const float*)d_in[4]; p.b_mod = (const float*)d_in[5]; p.g_pre = (const float*)d_in[6]; p.g_post = (const float*)d_in[7];
  p.w_out = (const float*)d_in[8]; p.ev_w_in = (const float*)d_in[9]; p.ev_lambda = (const float*)d_in[10]; p.ev_subln = (const float*)d_in[11];
  p.ev_conv = (const float*)d_in[12]; p.od_w_in = (const float*)d_in[13]; p.od_rpb = (const float*)d_in[14]; p.od_gate_up = (const float*)d_in[15];
  p.od_gate_bias = (const float*)d_in[16]; p.od_gnorm = (const float*)d_in[17];
  p.out = (float*)d_out;
  p.ws = (char*)d_ws;
  (void)hipMemsetAsync((char*)d_ws + OFF_BAR, 0, BAR_BYTES, stream);
  void* args[] = {&p};
  hipError_t e = hipLaunchCooperativeKernel((const void*)mega_kernel, dim3(grid_blocks), dim3(256), args, SMEM_BYTES, stream);
  if (e != hipSuccess) fprintf(stderr, "cooperative launch failed: %s (grid %d)\n", hipGetErrorString(e), grid_blocks);
}
```

```cpp
#include <hip/hip_runtime.h>
#include <hip/hip_cooperative_groups.h>
#include <cstdio>
namespace cg = cooperative_groups;

typedef unsigned short bfr;
typedef __attribute__((ext_vector_type(8))) short bf16x8;
typedef __attribute__((ext_vector_type(4))) float f32x4;
typedef __attribute__((ext_vector_type(4))) unsigned u32x4;
typedef __attribute__((ext_vector_type(2))) unsigned u32x2;
typedef __attribute__((ext_vector_type(16))) unsigned u32x16;
typedef __attribute__((ext_vector_type(2))) __bf16 bf16x2_t;
#define DI __device__ __forceinline__
DI float dot2bf(unsigned a, unsigned b, float c) { return __builtin_amdgcn_fdot2_f32_bf16(__builtin_bit_cast(bf16x2_t, a), __builtin_bit_cast(bf16x2_t, b), c, false); }
DI int opaque_tid() { int t = threadIdx.x; asm volatile("" : "+v"(t)); return t; }

constexpr int GB   = 4;
constexpr int NGRP = 2;
constexpr int ML   = GB * 4096;
constexpr int MC   = GB * 256;
constexpr int MR   = ML + MC;
constexpr int NEV  = 8192;
constexpr int NOD  = 7296;
constexpr int KEYS = 4352;
constexpr float L2E = 1.4426950408889634f;
constexpr float LN2 = 0.6931471805599453f;

constexpr size_t SZ_PROJ = (size_t)MR * 8192 * 2;
constexpr size_t SZ_H    = (size_t)MR * 1024 * 2;
constexpr size_t SZ_U    = (size_t)MR * 2048 * 2;
constexpr size_t SZ_VT   = (size_t)GB * 1024 * KEYS * 2;
constexpr size_t SZ_WE   = (size_t)NEV * 1024 * 2;
constexpr size_t SZ_WO   = (size_t)NOD * 1024 * 2;
constexpr size_t SZ_WOUT = (size_t)1024 * 2048 * 2;
constexpr size_t OFF_PROJ = 0;
constexpr size_t OFF_H    = OFF_PROJ + SZ_PROJ;
constexpr size_t OFF_U    = OFF_H + SZ_H;
constexpr size_t OFF_VT   = OFF_U + SZ_U;
constexpr size_t OFF_WIN  = OFF_VT + SZ_VT;
constexpr size_t OFF_WOUT = OFF_WIN + 2 * SZ_WE + 2 * SZ_WO;
constexpr size_t OFF_XC   = OFF_WOUT + 4 * SZ_WOUT;
constexpr size_t OFF_MOD  = OFF_XC + (size_t)8 * 256 * 1024 * 4;
constexpr size_t OFF_CS   = OFF_MOD + (size_t)4 * 9 * 3072 * 4;
constexpr size_t OFF_LAM  = OFF_CS + 64 * 16 * 8;
constexpr size_t OFF_CTR  = OFF_LAM + 256;
constexpr size_t OFF_BAR  = OFF_CTR + 256;
constexpr size_t BAR_BYTES = 34 * 256 + 192 * 64;
constexpr size_t SZ_ET    = (size_t)(MR / 64) * 4 * 16384;
constexpr size_t OFF_ETF  = OFF_PROJ + (size_t)MR * NOD * 2;
constexpr size_t OFF_ETB  = (OFF_BAR + BAR_BYTES + 255) & ~(size_t)255;
constexpr size_t OFF_DEC  = OFF_ETB + SZ_ET;
constexpr size_t WS_NEED  = OFF_DEC + (size_t)2 * (MR / 64) * 4 * 128 * 4;
static_assert(OFF_ETF + SZ_ET <= OFF_H, "E^T forward tiles must fit behind the odd proj rows");

constexpr int SMEM_BYTES = 80896;

struct Params {
  const float *x, *c, *ctx, *c_ctx, *w_mod, *b_mod, *g_pre, *g_post, *w_out, *ev_w_in, *ev_lambda, *ev_subln,
      *ev_conv, *od_w_in, *od_rpb, *od_gate_up, *od_gate_bias, *od_gnorm;
  float* out;
  char* ws;
};

DI size_t win_off(int l) { return OFF_WIN + (size_t)(l >> 1) * (SZ_WE + SZ_WO) + ((l & 1) ? SZ_WE : 0); }

DI float bf2f(bfr v) { return __uint_as_float(((unsigned)v) << 16); }
typedef __attribute__((ext_vector_type(2))) float f32x2_t;
DI bfr f2bf(float x) { return __builtin_bit_cast(bfr, (__bf16)x); }
DI unsigned pack2(float a, float b) { f32x2_t v = {a, b}; return __builtin_bit_cast(unsigned, __builtin_convertvector(v, bf16x2_t)); }
DI float lo_bf(unsigned u) { return __uint_as_float(u << 16); }
DI float hi_bf(unsigned u) { return __uint_as_float(u & 0xffff0000u); }
DI float fexp2(float x) { return __builtin_amdgcn_exp2f(x); }
DI float flog2(float x) { return __builtin_amdgcn_logf(x); }
DI float silu(float x) { return x / (1.f + fexp2(-x * L2E)); }
template <int M>
DI float shx(float v, int lane) {
  if (M < 32) return __builtin_bit_cast(float, __builtin_amdgcn_ds_swizzle(__builtin_bit_cast(int, v), (M << 10) | 0x1f));
  return __builtin_bit_cast(float, __builtin_amdgcn_ds_bpermute((lane ^ 32) << 2, __builtin_bit_cast(int, v)));
}
DI float wave_sum(float v, int lane) {
  v += shx<1>(v, lane); v += shx<2>(v, lane); v += shx<4>(v, lane); v += shx<8>(v, lane); v += shx<16>(v, lane); v += shx<32>(v, lane);
  return v;
}
DI f32x4 mfma16(bf16x8 a, bf16x8 b, f32x4 c) { return __builtin_amdgcn_mfma_f32_16x16x32_bf16(a, b, c, 0, 0, 0); }
DI int sw128(int row, int chunk) { return row * 128 + ((chunk ^ ((row >> 1) & 7)) << 4); }
DI int sw256(int row, int chunk) { return row * 256 + ((chunk ^ (row & 15)) << 4); }

struct GemmStage { u32x4 xa0[4], ya0[4], xa1[4], ya1[4]; };
DI void gemm_prologue(const bfr* __restrict__ X, int ldx, const bfr* __restrict__ Y, int ldy, GemmStage& st) {
  const int tid = opaque_tid();
  const int lr = tid >> 3, lc = tid & 7;
  const bfr* xp = X + (size_t)lr * ldx + lc * 8;
  const bfr* yp = Y + (size_t)lr * ldy + lc * 8;
#pragma unroll
  for (int i = 0; i < 4; ++i) {
    st.xa0[i] = *(const u32x4*)(xp + (size_t)(32 * i) * ldx);
    st.ya0[i] = *(const u32x4*)(yp + (size_t)(32 * i) * ldy);
    st.xa1[i] = *(const u32x4*)(xp + (size_t)(32 * i) * ldx + 64);
    st.ya1[i] = *(const u32x4*)(yp + (size_t)(32 * i) * ldy + 64);
  }
}
DI void gemm_mainloop(const bfr* __restrict__ X, int ldx, const bfr* __restrict__ Y, int ldy, int K,
                      const bfr* __restrict__ Xn, const bfr* __restrict__ Yn, bool hasnext, char* smem,
                      f32x4 (&acc)[4][4], GemmStage& st) {
  const int tid = opaque_tid(), lane = tid & 63, wid = tid >> 6, r = lane & 15, q = lane >> 4;
  const int wx = wid >> 1, wy = wid & 1;
  const int lr = tid >> 3, lc = tid & 7;
  const bfr* xp = X + (size_t)lr * ldx + lc * 8;
  const bfr* yp = Y + (size_t)lr * ldy + lc * 8;
  const bfr* xpn = Xn + (size_t)lr * ldx + lc * 8;
  const bfr* ypn = Yn + (size_t)lr * ldy + lc * 8;
  const int nk = K >> 6;
#define GEMM_STEP(XR, YR, BUF, KT)                                                                       \
  {                                                                                                      \
    char* sX = smem + (BUF) * 32768;                                                                     \
    char* sY = sX + 16384;                                                                               \
    _Pragma("unroll") for (int i = 0; i < 4; ++i) {                                                      \
      *(u32x4*)(sX + sw128(lr + 32 * i, lc)) = XR[i];                                                    \
      *(u32x4*)(sY + sw128(lr + 32 * i, lc)) = YR[i];                                                    \
    }                                                                                                    \
    __syncthreads();                                                                                     \
    if ((KT) + 2 < nk) {                                                                                 \
      const int ko = ((KT) + 2) * 64;                                                                    \
      _Pragma("unroll") for (int i = 0; i < 4; ++i) {                                                    \
        XR[i] = *(const u32x4*)(xp + (size_t)(32 * i) * ldx + ko);                                       \
        YR[i] = *(const u32x4*)(yp + (size_t)(32 * i) * ldy + ko);                                       \
      }                                                                                                  \
    } else if (hasnext) {                                                                                \
      const int ko = ((KT) + 2 - nk) * 64;                                                               \
      _Pragma("unroll") for (int i = 0; i < 4; ++i) {                                                    \
        XR[i] = *(const u32x4*)(xpn + (size_t)(32 * i) * ldx + ko);                                      \
        YR[i] = *(const u32x4*)(ypn + (size_t)(32 * i) * ldy + ko);                                      \
      }                                                                                                  \
    }                                                                                                    \
    _Pragma("unroll") for (int s = 0; s < 2; ++s) {                                                      \
      bf16x8 xf[4], yf[4];                                                                               \
      _Pragma("unroll") for (int i = 0; i < 4; ++i)                                                      \
          xf[i] = *(const bf16x8*)(sX + sw128(wx * 64 + i * 16 + r, s * 4 + q));                         \
      _Pragma("unroll") for (int j = 0; j < 4; ++j)                                                      \
          yf[j] = *(const bf16x8*)(sY + sw128(wy * 64 + j * 16 + r, s * 4 + q));                         \
      __builtin_amdgcn_s_setprio(1);                                                                     \
      _Pragma("unroll") for (int i = 0; i < 4; ++i)                                                      \
          _Pragma("unroll") for (int j = 0; j < 4; ++j) acc[i][j] = mfma16(xf[i], yf[j], acc[i][j]);     \
      __builtin_amdgcn_s_setprio(0);                                                                     \
    }                                                                                                    \
  }
  for (int kt = 0; kt < nk; kt += 2) {
    GEMM_STEP(st.xa0, st.ya0, 0, kt);
    GEMM_STEP(st.xa1, st.ya1, 1, kt + 1);
  }
#undef GEMM_STEP
  __syncthreads();
}

DI bool tile_map(int T, int MT, int NT, int& mt, int& nt) {
  const int pm_n = MT >> 3;
  const int P = (T >> 9) * 8 + (T & 7);
  const int li = (T & 511) >> 3;
  const int pm = P % pm_n, pn = P / pm_n;
  mt = pm * 8 + (li & 7);
  nt = pn * 8 + (li >> 3);
  return nt < NT;
}

DI int odd_col_src(int n) {
  if (n < 3584) return n;
  if (n < 7168) return n + 32;
  if (n < 7200) return n - 7168 + 3584;
  return -1;
}

DI void phase0(const Params& p, char* smem) {
  const int tid = opaque_tid();
  if (blockIdx.x < 384) {
    float* sc = (float*)smem;
    float* red = sc + 9 * 1024;
    for (int i = tid; i < 9 * 1024; i += 256) {
      const int b = i >> 10, k = i & 1023;
      const float v = (b < 8) ? p.c[b * 1024 + k] : p.c_ctx[k];
      sc[i] = v / (1.f + __expf(-v));
    }
    __syncthreads();
    float* modb = (float*)(p.ws + OFF_MOD);
    for (int it = blockIdx.x; it < 384; it += gridDim.x) {
      const int l = it / 96, cgp = it % 96;
      const int col = cgp * 32 + (tid & 31), ks = tid >> 5;
      float a[9];
#pragma unroll
      for (int b = 0; b < 9; ++b) a[b] = 0.f;
      const float* w = p.w_mod + ((size_t)l * 1024 + ks * 128) * 3072 + col;
#pragma unroll 4
      for (int k = 0; k < 128; ++k) {
        const float wv = w[(size_t)k * 3072];
#pragma unroll
        for (int b = 0; b < 9; ++b) a[b] += sc[b * 1024 + ks * 128 + k] * wv;
      }
#pragma unroll
      for (int b = 0; b < 9; ++b) red[(ks * 9 + b) * 32 + (tid & 31)] = a[b];
      __syncthreads();
      for (int idx = tid; idx < 288; idx += 256) {
        const int b = idx >> 5, cc = idx & 31;
        float s = p.b_mod[l * 3072 + cgp * 32 + cc];
#pragma unroll
        for (int k2 = 0; k2 < 8; ++k2) s += red[(k2 * 9 + b) * 32 + cc];
        modb[(size_t)(l * 9 + b) * 3072 + cgp * 32 + cc] = s;
      }
      __syncthreads();
    }
  }
  if (blockIdx.x == gridDim.x - 1) {
    float2* cs = (float2*)(p.ws + OFF_CS);
    for (int idx = tid; idx < 1024; idx += 256) {
      const int pos = idx >> 4, f = idx & 15;
      const float inv = 1.0f / powf(10000.f, (float)f * 0.0625f);
      const float ang = (float)pos * inv;
      const double ad = (double)ang;
      const double n = rint(ad * 0.15915494309189535);
      const float rr = (float)(ad - n * 6.283185307179586);
      cs[idx] = make_float2(__cosf(rr), __sinf(rr));
    }
    if (tid < 2) {
      const float* lp = p.ev_lambda + tid * 256;
      float s1 = 0.f, s2 = 0.f;
      for (int i = 0; i < 64; ++i) { s1 += lp[i] * lp[64 + i]; s2 += lp[128 + i] * lp[192 + i]; }
      const float li = (tid == 0) ? 0.2f : (0.8f - 0.6f * 0.5488116360940264f);
      float* lam = (float*)(p.ws + OFF_LAM);
      lam[tid] = __expf(s1) - __expf(s2) + li;
      lam[2 + tid] = li;
    }
    if (tid < 32) ((int*)(p.ws + OFF_CTR))[tid] = 0;
  }
  float* tile = (float*)smem;
  __syncthreads();
  for (int it = blockIdx.x; it < 9792; it += gridDim.x) {
    int rr = it, l, ktile, ntile, K, Nsrc;
    const float* src;
    bfr* dst;
    bool oddmap = false;
    if (rr < 7744) {
      if (rr < 2048) { l = 0; } else if (rr < 3872) { l = 1; rr -= 2048; } else if (rr < 5920) { l = 2; rr -= 3872; } else { l = 3; rr -= 5920; }
      ktile = rr & 15; ntile = rr >> 4; K = 1024;
      oddmap = (l & 1);
      Nsrc = oddmap ? 7200 : 8192;
      src = (oddmap ? p.od_w_in : p.ev_w_in) + (size_t)(l >> 1) * 1024 * Nsrc;
      dst = (bfr*)(p.ws + win_off(l));
    } else {
      rr -= 7744; l = rr >> 9; rr &= 511;
      ktile = rr & 31; ntile = rr >> 5; K = 2048; Nsrc = 1024;
      src = p.w_out + (size_t)l * 2048 * 1024;
      dst = (bfr*)(p.ws + OFF_WOUT + (size_t)l * SZ_WOUT);
    }
    const int k0 = ktile * 64, n0 = ntile * 64;
    {
      const int nn = tid & 63;
      const int nd = n0 + nn;
      const int ns = oddmap ? odd_col_src(nd) : nd;
#pragma unroll 4
      for (int i = 0; i < 16; ++i) {
        const int kk = (tid >> 6) + 4 * i;
        tile[kk * 65 + nn] = (ns >= 0) ? src[(size_t)(k0 + kk) * Nsrc + ns] : 0.f;
      }
    }
    __syncthreads();
    {
      const int kk8 = (tid & 7) * 8;
#pragma unroll
      for (int i2 = 0; i2 < 2; ++i2) {
        const int nn = (tid >> 3) + 32 * i2;
        u32x4 v;
        v.x = pack2(tile[(kk8 + 0) * 65 + nn], tile[(kk8 + 1) * 65 + nn]);
        v.y = pack2(tile[(kk8 + 2) * 65 + nn], tile[(kk8 + 3) * 65 + nn]);
        v.z = pack2(tile[(kk8 + 4) * 65 + nn], tile[(kk8 + 5) * 65 + nn]);
        v.w = pack2(tile[(kk8 + 6) * 65 + nn], tile[(kk8 + 7) * 65 + nn]);
        *(u32x4*)(dst + (size_t)(n0 + nn) * K + k0 + kk8) = v;
      }
    }
    __syncthreads();
  }
}

DI void phase_norm(const Params& p, int l, int g) {
  const int tid = opaque_tid(), lane = tid & 63, wid = tid >> 6;
  const int rows = (l == 4) ? ML : MR;
  const float* modb = (const float*)(p.ws + OFF_MOD);
  const bfr* ybuf = (const bfr*)(p.ws + OFF_PROJ);
  bfr* hbuf = (bfr*)(p.ws + OFF_H);
  float* xcb = (float*)(p.ws + OFF_XC);
  for (int row = blockIdx.x * 4 + wid; row < rows; row += gridDim.x * 4) {
    const bool lat = row < ML;
    const int mb = lat ? (g * GB + (row >> 12)) : 8;
    const size_t grow = lat ? ((size_t)g * ML + row) : ((size_t)g * MC + (row - ML));
    const float* xin;
    float* xst;
    if (lat) { xin = ((l <= 1) ? p.x : (const float*)p.out) + grow * 1024; xst = p.out + grow * 1024; }
    else     { xin = ((l <= 1) ? p.ctx : (const float*)xcb) + grow * 1024; xst = xcb + grow * 1024; }
    float4 xv[4];
#pragma unroll
    for (int i = 0; i < 4; ++i) xv[i] = *(const float4*)(xin + lane * 4 + 256 * i);
    if (l >= 1) {
      float4 yv[4];
      float ss = 0.f;
#pragma unroll
      for (int i = 0; i < 4; ++i) {
        const u32x2 yr = *(const u32x2*)(ybuf + (size_t)row * 1024 + lane * 4 + 256 * i);
        yv[i] = make_float4(lo_bf(yr.x), hi_bf(yr.x), lo_bf(yr.y), hi_bf(yr.y));
        ss += yv[i].x * yv[i].x + yv[i].y * yv[i].y + yv[i].z * yv[i].z + yv[i].w * yv[i].w;
      }
      ss = wave_sum(ss, lane);
      const float rn = rsqrtf(ss * (1.f / 1024.f) + 1e-6f);
      const float* gate = modb + (size_t)((l - 1) * 9 + mb) * 3072 + 2048;
      const float* gp = p.g_post + (l - 1) * 1024;
#pragma unroll
      for (int i = 0; i < 4; ++i) {
        const int c0 = lane * 4 + 256 * i;
        const float4 gt = *(const float4*)(gate + c0);
        const float4 gg = *(const float4*)(gp + c0);
        xv[i].x += gt.x * (yv[i].x * rn * gg.x);
        xv[i].y += gt.y * (yv[i].y * rn * gg.y);
        xv[i].z += gt.z * (yv[i].z * rn * gg.z);
        xv[i].w += gt.w * (yv[i].w * rn * gg.w);
        *(float4*)(xst + c0) = xv[i];
      }
    }
    if (l < 4) {
      float ss = 0.f;
#pragma unroll
      for (int i = 0; i < 4; ++i) ss += xv[i].x * xv[i].x + xv[i].y * xv[i].y + xv[i].z * xv[i].z + xv[i].w * xv[i].w;
      ss = wave_sum(ss, lane);
      const float rn = rsqrtf(ss * (1.f / 1024.f) + 1e-6f);
      const float* mrow = modb + (size_t)(l * 9 + mb) * 3072;
      const float* gpre = p.g_pre + l * 1024;
#pragma unroll
      for (int i = 0; i < 4; ++i) {
        const int c0 = lane * 4 + 256 * i;
        const float4 sh = *(const float4*)(mrow + c0);
        const float4 scl = *(const float4*)(mrow + 1024 + c0);
        const float4 gg = *(const float4*)(gpre + c0);
        u32x2 o;
        o.x = pack2(xv[i].x * rn * gg.x * (1.f + scl.x) + sh.x, xv[i].y * rn * gg.y * (1.f + scl.y) + sh.y);
        o.y = pack2(xv[i].z * rn * gg.z * (1.f + scl.z) + sh.z, xv[i].w * rn * gg.w * (1.f + scl.w) + sh.w);
        *(u32x2*)(hbuf + (size_t)row * 1024 + c0) = o;
      }
    }
  }
}

DI void gla_gate_precompute(const Params& p, int l, int m0, const char* sLr, float* sHs) {
  const int tid = opaque_tid();
  const int d = tid & 127, half = tid >> 7;
  const int jl = l >> 1;
#pragma unroll 1
  for (int unit = 0; unit < 16; ++unit) {
    const int cc = unit & 1, dir = (unit >> 1) & 1, head = unit >> 2;
    unsigned gu[8];
#pragma unroll
    for (int k = 0; k < 8; ++k)
      gu[k] = pack2(p.od_gate_up[(((size_t)jl * 2 + dir) * 16 + 2 * k) * 512 + head * 128 + d],
                    p.od_gate_up[(((size_t)jl * 2 + dir) * 16 + 2 * k + 1) * 512 + head * 128 + d]);
    const float gbias = p.od_gate_bias[((size_t)jl * 2 + dir) * 512 + head * 128 + d];
    float gl[32];
    float tot = 0.f;
#pragma unroll
    for (int i = 0; i < 32; ++i) {
      const int tk = cc * 64 + half * 32 + i;
      const u32x4 la = *(const u32x4*)(sLr + tk * 64 + dir * 32);
      const u32x4 lb = *(const u32x4*)(sLr + tk * 64 + dir * 32 + 16);
      float z = gbias;
      z = dot2bf(la.x, gu[0], z); z = dot2bf(la.y, gu[1], z); z = dot2bf(la.z, gu[2], z); z = dot2bf(la.w, gu[3], z);
      z = dot2bf(lb.x, gu[4], z); z = dot2bf(lb.y, gu[5], z); z = dot2bf(lb.z, gu[6], z); z = dot2bf(lb.w, gu[7], z);
      const float tneg = fexp2(-fabsf(z) * L2E);
      const float g = (fminf(z, 0.f) - flog2(1.f + tneg) * LN2) * (L2E / 16.f);
      gl[i] = g;
      tot += g;
    }
    if (dir == 0) {
      float run = 0.f;
#pragma unroll
      for (int i = 0; i < 32; ++i) { run += gl[i]; gl[i] = run; }
    } else {
      float run = 0.f;
#pragma unroll
      for (int i = 31; i >= 0; --i) { run += gl[i]; gl[i] = run; }
    }
    __syncthreads();
    sHs[half * 128 + d] = tot;
    __syncthreads();
    const float other = sHs[(1 - half) * 128 + d];
    const float offs = (dir == 0) ? (half ? other : 0.f) : (half ? 0.f : other);
    const int chunk = (m0 >> 6) + cc;
    char* et = p.ws + (dir ? OFF_ETB : OFF_ETF) + ((size_t)chunk * 4 + head) * 16384;
#pragma unroll
    for (int i8 = 0; i8 < 4; ++i8) {
      u32x4 v;
      v.x = pack2(fexp2(gl[i8 * 8 + 0] + offs), fexp2(gl[i8 * 8 + 1] + offs));
      v.y = pack2(fexp2(gl[i8 * 8 + 2] + offs), fexp2(gl[i8 * 8 + 3] + offs));
      v.z = pack2(fexp2(gl[i8 * 8 + 4] + offs), fexp2(gl[i8 * 8 + 5] + offs));
      v.w = pack2(fexp2(gl[i8 * 8 + 6] + offs), fexp2(gl[i8 * 8 + 7] + offs));
      *(u32x4*)(et + sw128(d, half * 4 + i8)) = v;
    }
    if (half == 0)
      ((float*)(p.ws + OFF_DEC))[(((size_t)dir * (MR / 64) + chunk) * 4 + head) * 128 + d] = fexp2(tot + other);
  }
}

struct TileQ {
  unsigned* base;
  int* slot;
  int x, dq, pend;
  bool has_pend;
};
DI int tileq_fetch(TileQ& tq) {
  __syncthreads();
  if (threadIdx.x == 0) {
    int j = tq.has_pend ? tq.pend : (int)__hip_atomic_fetch_add(tq.base + tq.x * 16, 1u, __ATOMIC_RELAXED, __HIP_MEMORY_SCOPE_AGENT);
    *tq.slot = j;
  }
  tq.has_pend = false;
  __syncthreads();
  return *tq.slot;
}
DI void tileq_prefetch(TileQ& tq) {
  if (threadIdx.x == 0) {
    tq.pend = (int)__hip_atomic_fetch_add(tq.base + tq.x * 16, 1u, __ATOMIC_RELAXED, __HIP_MEMORY_SCOPE_AGENT);
  }
  tq.has_pend = true;
}

DI bool tileq_next(TileQ& tq, int pm_n, int NP, int NT, int xcc0, int& mt, int& nt) {
  for (;;) {
    if (tq.dq >= 8) return false;
    const int j = tileq_fetch(tq);
    const int P = (j >> 6) * 8 + tq.x;
    if (P >= NP) { ++tq.dq; tq.x = (xcc0 + tq.dq) & 7; tq.has_pend = false; continue; }
    const int li = j & 63;
    mt = (P % pm_n) * 8 + (li & 7);
    nt = (P / pm_n) * 8 + (li >> 3);
    if (nt >= NT) continue;
    tileq_prefetch(tq);
    return true;
  }
}

DI void phase_gemm_in(const Params& p, int l, char* smem, int inst) {
  const int tid = opaque_tid(), lane = tid & 63, wid = tid >> 6, r = lane & 15, q = lane >> 4;
  const int wx = wid >> 1, wy = wid & 1;
  const bool even = !(l & 1);
  const int ldp = even ? NEV : NOD;
  const int NT = even ? 64 : 56, MT = MR >> 7;
  const bfr* WT = (const bfr*)(p.ws + win_off(l));
  const bfr* H = (const bfr*)(p.ws + OFF_H);
  bfr* proj = (bfr*)(p.ws + OFF_PROJ);
  bfr* VT = (bfr*)(p.ws + OFF_VT);
  const float2* cs = (const float2*)(p.ws + OFF_CS);
  const int pm_n = MT >> 3, NP = pm_n * ((NT + 7) >> 3);
  TileQ tq;
  tq.base = (unsigned*)(p.ws + OFF_BAR) + 34 * 64 + inst * 128;
  tq.slot = (int*)(smem + SMEM_BYTES - 16);
  tq.has_pend = false; tq.pend = 0;
  const int xcc0 = (int)(__builtin_amdgcn_s_getreg((3 << 11) | 20) & 7u);
  if (!even) {
    TileQ lq;
    lq.base = (unsigned*)(p.ws + OFF_BAR) + 34 * 64 + (16 + inst) * 128;
    lq.slot = tq.slot; lq.has_pend = false; lq.pend = 0; lq.x = 0; lq.dq = 0;
    for (;;) {
      const int j = tileq_fetch(lq);
      if (j >= MT) break;
      const int m0 = j * 128, n0 = 7168;
      GemmStage g2;
      gemm_prologue(WT + (size_t)n0 * 1024, 1024, H + (size_t)m0 * 1024, 1024, g2);
      f32x4 acc[4][4];
#pragma unroll
      for (int i = 0; i < 4; ++i)
#pragma unroll
        for (int jj = 0; jj < 4; ++jj) acc[i][jj] = (f32x4){0.f, 0.f, 0.f, 0.f};
      gemm_mainloop(WT + (size_t)n0 * 1024, 1024, H + (size_t)m0 * 1024, 1024, 1024, WT, H, false, smem, acc, g2);
#pragma unroll
      for (int jn = 0; jn < 4; ++jn) {
        const int m = m0 + wy * 64 + jn * 16 + r;
#pragma unroll
        for (int i = 0; i < 4; ++i) {
          const int n = n0 + wx * 64 + i * 16 + 4 * q;
          u32x2 o;
          o.x = pack2(acc[i][jn][0], acc[i][jn][1]);
          o.y = pack2(acc[i][jn][2], acc[i][jn][3]);
          *(u32x2*)(proj + (size_t)m * ldp + n) = o;
        }
      }
      char* sLr = smem;
      float* sHs = (float*)(smem + 8192);
      if (wx == 0) {
#pragma unroll
        for (int jn = 0; jn < 4; ++jn)
#pragma unroll
          for (int i = 0; i < 2; ++i) {
            u32x2 o;
            o.x = pack2(acc[i][jn][0], acc[i][jn][1]);
            o.y = pack2(acc[i][jn][2], acc[i][jn][3]);
            *(u32x2*)(sLr + (wy * 64 + jn * 16 + r) * 64 + (i * 16 + 4 * q) * 2) = o;
          }
      }
      __syncthreads();
      gla_gate_precompute(p, l, m0, sLr, sHs);
      __syncthreads();
    }
  }
  tq.dq = 0; tq.x = xcc0;
  GemmStage gst;
  int mt = 0, nt = 0;
  bool have = tileq_next(tq, pm_n, NP, NT, xcc0, mt, nt);
  bool loaded = false;
  {
   while (have) {
    const int m0 = mt * 128, n0 = nt * 128;
    const bool vt = (n0 >= 1024 && n0 < 2048);
    const bfr* X = vt ? (H + (size_t)m0 * 1024) : (WT + (size_t)n0 * 1024);
    const bfr* Y = vt ? (WT + (size_t)n0 * 1024) : (H + (size_t)m0 * 1024);
    if (!loaded) gemm_prologue(X, 1024, Y, 1024, gst);
    int mtn = 0, ntn = 0;
    const bool haven = tileq_next(tq, pm_n, NP, NT, xcc0, mtn, ntn);
    const bool stream = haven;
    const int m0n = mtn * 128, n0n = ntn * 128;
    const bool vtn = (n0n >= 1024 && n0n < 2048);
    const bfr* Xn = vtn ? (H + (size_t)m0n * 1024) : (WT + (size_t)n0n * 1024);
    const bfr* Yn = vtn ? (WT + (size_t)n0n * 1024) : (H + (size_t)m0n * 1024);
    f32x4 acc[4][4];
#pragma unroll
    for (int i = 0; i < 4; ++i)
#pragma unroll
      for (int j = 0; j < 4; ++j) acc[i][j] = (f32x4){0.f, 0.f, 0.f, 0.f};
    gemm_mainloop(X, 1024, Y, 1024, 1024, Xn, Yn, stream, smem, acc, gst);
    loaded = stream;
    if (vt) {
#pragma unroll
      for (int i = 0; i < 4; ++i) {
        const int mbase = m0 + wx * 64 + i * 16;
        int b, kp;
        if (mbase < ML) { b = mbase >> 12; kp = mbase & 4095; } else { const int mm = mbase - ML; b = mm >> 8; kp = 4096 + (mm & 255); }
        const int pos = (kp & ~31) + q * 8 + ((kp >> 4) & 1) * 4;
#pragma unroll
        for (int jn = 0; jn < 4; ++jn) {
          const int f = n0 - 1024 + wy * 64 + jn * 16 + r;
          u32x2 o;
          o.x = pack2(acc[i][jn][0], acc[i][jn][1]);
          o.y = pack2(acc[i][jn][2], acc[i][jn][3]);
          *(u32x2*)(VT + ((size_t)(b * 1024 + f)) * KEYS + pos) = o;
        }
      }
    } else {
      const bool rope = even && (n0 < 1024 || (n0 >= 2048 && n0 < 3072)) && (m0 < ML);
      if (rope) {
#pragma unroll
        for (int jn = 0; jn < 4; ++jn) {
          asm volatile("" ::: "memory");
          const int m = m0 + wy * 64 + jn * 16 + r;
          const int t = m & 4095;
          const int grow = t >> 6, gcol = t & 63;
#pragma unroll
          for (int j = 0; j < 4; ++j) {
            const float2 a = cs[grow * 16 + 4 * q + j];
            const float2 c = cs[gcol * 16 + 4 * q + j];
            const float x0 = acc[0][jn][j], x1 = acc[1][jn][j], x2 = acc[2][jn][j], x3 = acc[3][jn][j];
            acc[0][jn][j] = x0 * a.x - x1 * a.y;
            acc[1][jn][j] = x1 * a.x + x0 * a.y;
            acc[2][jn][j] = x2 * c.x - x3 * c.y;
            acc[3][jn][j] = x3 * c.x + x2 * c.y;
          }
        }
      }
#pragma unroll
      for (int jn = 0; jn < 4; ++jn) {
        const int m = m0 + wy * 64 + jn * 16 + r;
#pragma unroll
        for (int i = 0; i < 4; ++i) {
          const int n = n0 + wx * 64 + i * 16 + 4 * q;
          u32x2 o;
          o.x = pack2(acc[i][jn][0], acc[i][jn][1]);
          o.y = pack2(acc[i][jn][2], acc[i][jn][3]);
          *(u32x2*)(proj + (size_t)m * ldp + n) = o;
        }
      }
    }
    mt = mtn; nt = ntn; have = haven;
  }
 }
}

DI void phase_gemm_out(const Params& p, int l, char* smem, int inst) {
  const int tid = opaque_tid(), lane = tid & 63, wid = tid >> 6, r = lane & 15, q = lane >> 4;
  const int wx = wid >> 1, wy = wid & 1;
  const bfr* WT = (const bfr*)(p.ws + OFF_WOUT + (size_t)l * SZ_WOUT);
  const bfr* U = (const bfr*)(p.ws + OFF_U);
  bfr* ybuf = (bfr*)(p.ws + OFF_PROJ);
  const int MT = (l == 3) ? (ML >> 7) : (MR >> 7);
  const int pm_n = MT >> 3, NP = pm_n;
  TileQ tq;
  tq.base = (unsigned*)(p.ws + OFF_BAR) + 34 * 64 + inst * 128;
  tq.slot = (int*)(smem + SMEM_BYTES - 16);
  tq.has_pend = false; tq.pend = 0;
  const int xcc0 = (int)(__builtin_amdgcn_s_getreg((3 << 11) | 20) & 7u);
  tq.dq = 0; tq.x = xcc0;
  GemmStage gst;
  int mt = 0, nt = 0;
  bool have = tileq_next(tq, pm_n, NP, 8, xcc0, mt, nt);
  bool loaded = false;
  while (have) {
    const int m0 = mt * 128, n0 = nt * 128;
    const bfr* X = WT + (size_t)n0 * 2048;
    const bfr* Y = U + (size_t)m0 * 2048;
    if (!loaded) gemm_prologue(X, 2048, Y, 2048, gst);
    int mtn = 0, ntn = 0;
    const bool haven = tileq_next(tq, pm_n, NP, 8, xcc0, mtn, ntn);
    const bfr* Xn = WT + (size_t)(ntn * 128) * 2048;
    const bfr* Yn = U + (size_t)(mtn * 128) * 2048;
    f32x4 acc[4][4];
#pragma unroll
    for (int i = 0; i < 4; ++i)
#pragma unroll
      for (int j = 0; j < 4; ++j) acc[i][j] = (f32x4){0.f, 0.f, 0.f, 0.f};
    gemm_mainloop(X, 2048, Y, 2048, 2048, Xn, Yn, haven, smem, acc, gst);
    loaded = haven;
#pragma unroll
    for (int jn = 0; jn < 4; ++jn) {
      const int m = m0 + wy * 64 + jn * 16 + r;
#pragma unroll
      for (int i = 0; i < 4; ++i) {
        const int n = n0 + wx * 64 + i * 16 + 4 * q;
        u32x2 o;
        o.x = pack2(acc[i][jn][0], acc[i][jn][1]);
        o.y = pack2(acc[i][jn][2], acc[i][jn][3]);
        *(u32x2*)(ybuf + (size_t)m * 1024 + n) = o;
      }
    }
    mt = mtn; nt = ntn; have = haven;
  }
}

template <int DV, int QT, int KT, int MODE>
DI void attn_engine(const bfr* __restrict__ qbase, int ldq, const bfr* __restrict__ kbase, int ldk,
                    const bfr* __restrict__ vt, int nloc, int loc_row0, int loc_pos0, int nctx, int ctx_row0,
                    const float* rpb_s, int roff0, char* smem, f32x4 (&O)[DV / 16][QT], float (&lsum)[QT]) {
  constexpr int STAGE = 8192 + DV * 128;
  constexpr int NVL = DV / 32;
  const int tid = opaque_tid(), lane = tid & 63, wid = tid >> 6, r = lane & 15, q = lane >> 4;
  const int lr = tid >> 3, lc = tid & 7;
  constexpr float SC = 0.125f * L2E;

  bf16x8 Qf[QT][2];
#pragma unroll
  for (int qt = 0; qt < QT; ++qt)
#pragma unroll
    for (int s = 0; s < 2; ++s)
      Qf[qt][s] = *(const bf16x8*)(qbase + (size_t)(wid * 16 * QT + qt * 16 + r) * ldq + s * 32 + q * 8);
  float mrun[QT];
#pragma unroll
  for (int qt = 0; qt < QT; ++qt) {
    mrun[qt] = -1e30f;
    lsum[qt] = 0.f;
#pragma unroll
    for (int dt = 0; dt < DV / 16; ++dt) O[dt][qt] = (f32x4){0.f, 0.f, 0.f, 0.f};
  }

  const int nch = nloc + nctx;
  u32x4 kreg0, kreg1, vreg[NVL];
  const int ksw0 = sw128(lr, lc), ksw1 = sw128(lr + 32, lc);
#define AT_LOAD(c_)                                                                                          \
  {                                                                                                          \
    const int cc_ = (c_);                                                                                    \
    const int row_ = (cc_ < nloc) ? (loc_row0 + cc_ * 64) : (ctx_row0 + (cc_ - nloc) * 64);                  \
    const int pos_ = (cc_ < nloc) ? (loc_pos0 + cc_ * 64) : (4096 + (cc_ - nloc) * 64);                      \
    kreg0 = *(const u32x4*)(kbase + (size_t)(row_ + lr) * ldk + lc * 8);                                     \
    kreg1 = *(const u32x4*)(kbase + (size_t)(row_ + lr + 32) * ldk + lc * 8);                                \
    _Pragma("unroll") for (int i_ = 0; i_ < NVL; ++i_)                                                       \
        vreg[i_] = *(const u32x4*)(vt + (size_t)(lr + 32 * i_) * KEYS + pos_ + lc * 8);                      \
  }
#define AT_STORE(c_)                                                                                         \
  {                                                                                                          \
    char* sb_ = smem + ((c_) & 1) * STAGE;                                                                   \
    *(u32x4*)(sb_ + ksw0) = kreg0;                                                                           \
    *(u32x4*)(sb_ + ksw1) = kreg1;                                                                           \
    _Pragma("unroll") for (int i_ = 0; i_ < NVL; ++i_)                                                       \
        *(u32x4*)(sb_ + 8192 + sw128(lr + 32 * i_, lc)) = vreg[i_];                                          \
  }
  if (nch > 0) { AT_LOAD(0); AT_STORE(0); }
  for (int c = 0; c < nch; ++c) {
    __syncthreads();
    const bool more = (c + 1 < nch);
    const char* sK = smem + (c & 1) * STAGE;
    const char* sV = sK + 8192;
    if (more) AT_LOAD(c + 1);
    f32x4 stall[4 / KT][KT][QT];
#pragma unroll
    for (int sbk = 0; sbk < 4 / KT; ++sbk) {
#pragma unroll
      for (int kt = 0; kt < KT; ++kt)
#pragma unroll
        for (int qt = 0; qt < QT; ++qt) stall[sbk][kt][qt] = (f32x4){0.f, 0.f, 0.f, 0.f};
#pragma unroll
      for (int s = 0; s < 2; ++s)
#pragma unroll
        for (int kt = 0; kt < KT; ++kt) {
          const bf16x8 ka = *(const bf16x8*)(sK + sw128(sbk * KT * 16 + kt * 16 + r, s * 4 + q));
#pragma unroll
          for (int qt = 0; qt < QT; ++qt) stall[sbk][kt][qt] = mfma16(ka, Qf[qt][s], stall[sbk][kt][qt]);
        }
    }
#pragma unroll
    for (int sbk = 0; sbk < 4 / KT; ++sbk) {
      f32x4 (&st)[KT][QT] = stall[sbk];
      bf16x8 pb[KT / 2][QT];
      if (MODE == 1) {
#pragma unroll
        for (int kt = 0; kt < KT; ++kt)
#pragma unroll
          for (int qt = 0; qt < QT; ++qt)
#pragma unroll
            for (int j = 0; j < 4; ++j) {
              float v = st[kt][qt][j] * SC;
              if (c < nloc) {
                const int kc = sbk * KT * 16 + kt * 16 + 4 * q + j;
                const int qc = wid * 16 + r;
                int wst = qc - 8; wst = wst < 0 ? 0 : (wst > 48 ? 48 : wst);
                const bool valid = (kc >= wst) && (kc < wst + 16);
                int co = kc - qc + 15; co = co < 0 ? 0 : (co > 30 ? 30 : co);
                const float bias = rpb_s[(roff0 + c) * 31 + co] * L2E;
                v = valid ? (v + bias) : -INFINITY;
              }
              st[kt][qt][j] = v;
            }
      }
#pragma unroll
      for (int qt = 0; qt < QT; ++qt) {
        float mx = fmaxf(fmaxf(st[0][qt][0], st[0][qt][1]), fmaxf(st[0][qt][2], st[0][qt][3]));
#pragma unroll
        for (int kt = 1; kt < KT; ++kt) {
          mx = __builtin_fmaxf(mx, __builtin_fmaxf(st[kt][qt][0], st[kt][qt][1]));
          mx = __builtin_fmaxf(mx, __builtin_fmaxf(st[kt][qt][2], st[kt][qt][3]));
        }
        if (MODE != 1) mx *= SC;
        if (__any(mx > mrun[qt] + 8.f)) {
          mx = fmaxf(mx, shx<16>(mx, lane));
          mx = fmaxf(mx, shx<32>(mx, lane));
          const float mnew2 = fmaxf(mrun[qt], mx);
          const float alpha = fexp2(mrun[qt] - mnew2);
          mrun[qt] = mnew2;
          lsum[qt] *= alpha;
#pragma unroll
          for (int dt = 0; dt < DV / 16; ++dt) {
            O[dt][qt][0] *= alpha; O[dt][qt][1] *= alpha; O[dt][qt][2] *= alpha; O[dt][qt][3] *= alpha;
          }
        }
        const float mnew = mrun[qt];
        f32x2_t ps2 = {0.f, 0.f};
#pragma unroll
        for (int kt = 0; kt < KT; ++kt) {
          float e0, e1, e2, e3;
          if (MODE == 1) {
            e0 = fexp2(st[kt][qt][0] - mnew); e1 = fexp2(st[kt][qt][1] - mnew);
            e2 = fexp2(st[kt][qt][2] - mnew); e3 = fexp2(st[kt][qt][3] - mnew);
          } else {
            e0 = fexp2(__builtin_fmaf(st[kt][qt][0], SC, -mnew)); e1 = fexp2(__builtin_fmaf(st[kt][qt][1], SC, -mnew));
            e2 = fexp2(__builtin_fmaf(st[kt][qt][2], SC, -mnew)); e3 = fexp2(__builtin_fmaf(st[kt][qt][3], SC, -mnew));
          }
          st[kt][qt][0] = e0; st[kt][qt][1] = e1; st[kt][qt][2] = e2; st[kt][qt][3] = e3;
          const f32x2_t a01 = {e0, e1}, a23 = {e2, e3};
          ps2 = ps2 + a01;
          ps2 = ps2 + a23;
        }
        lsum[qt] += ps2.x + ps2.y;
#pragma unroll
        for (int ks = 0; ks < KT / 2; ++ks) {
          u32x4 pk;
          pk.x = pack2(st[2 * ks][qt][0], st[2 * ks][qt][1]);
          pk.y = pack2(st[2 * ks][qt][2], st[2 * ks][qt][3]);
          pk.z = pack2(st[2 * ks + 1][qt][0], st[2 * ks + 1][qt][1]);
          pk.w = pack2(st[2 * ks + 1][qt][2], st[2 * ks + 1][qt][3]);
          pb[ks][qt] = __builtin_bit_cast(bf16x8, pk);
        }
      }
#pragma unroll
      for (int dt = 0; dt < DV / 16; ++dt)
#pragma unroll
        for (int ks = 0; ks < KT / 2; ++ks) {
          const bf16x8 va = *(const bf16x8*)(sV + sw128(dt * 16 + r, (sbk * (KT / 2) + ks) * 4 + q));
#pragma unroll
          for (int qt = 0; qt < QT; ++qt) O[dt][qt] = mfma16(va, pb[ks][qt], O[dt][qt]);
        }
    }
    if (more) AT_STORE(c + 1);
  }
#undef AT_LOAD
#undef AT_STORE
  __syncthreads();
#pragma unroll
  for (int qt = 0; qt < QT; ++qt) {
    float L = lsum[qt];
    L += shx<16>(L, lane);
    L += shx<32>(L, lane);
    lsum[qt] = L;
  }
}

DI void diff_attn_item(const Params& p, int l, int b, int head, int qrow0, bool ctxq, char* smem) {
  const int tid = opaque_tid(), lane = tid & 63, wid = tid >> 6, r = lane & 15, q = lane >> 4;
  const bfr* proj = (const bfr*)(p.ws + OFF_PROJ);
  const bfr* VT = (const bfr*)(p.ws + OFF_VT);
  bfr* U = (bfr*)(p.ws + OFF_U);
  const float* lamv = (const float*)(p.ws + OFF_LAM);
  const float lam = lamv[l >> 1], lam_init = lamv[2 + (l >> 1)];
  f32x4 O[8][2];
  float ls[2];
  char* parkb = smem + 49152 + tid * 16;
  attn_engine<128, 2, 2, 0>(proj + (size_t)qrow0 * NEV + 2048 + head * 128, NEV, proj + head * 128, NEV,
                            VT + (size_t)(b * 1024 + head * 128) * KEYS, ctxq ? 0 : 64, b * 4096, 0, 4,
                            ML + b * 256, nullptr, 0, smem, O, ls);
  u32x4 pkr0, pkr1;
  {
    const float i0 = 1.f / ls[0], i1 = 1.f / ls[1];
#pragma unroll
    for (int dt = 0; dt < 8; dt += 2) {
      u32x4 v0, v1;
      v0.x = pack2(O[dt][0][0] * i0, O[dt][0][1] * i0);
      v0.y = pack2(O[dt][0][2] * i0, O[dt][0][3] * i0);
      v0.z = pack2(O[dt + 1][0][0] * i0, O[dt + 1][0][1] * i0);
      v0.w = pack2(O[dt + 1][0][2] * i0, O[dt + 1][0][3] * i0);
      v1.x = pack2(O[dt][1][0] * i1, O[dt][1][1] * i1);
      v1.y = pack2(O[dt][1][2] * i1, O[dt][1][3] * i1);
      v1.z = pack2(O[dt + 1][1][0] * i1, O[dt + 1][1][1] * i1);
      v1.w = pack2(O[dt + 1][1][2] * i1, O[dt + 1][1][3] * i1);
      if (dt < 6) {
        *(u32x4*)(parkb + (dt / 2) * 4096) = v0;
        *(u32x4*)(parkb + (3 + dt / 2) * 4096) = v1;
      } else { pkr0 = v0; pkr1 = v1; }
    }
  }
  attn_engine<128, 2, 2, 0>(proj + (size_t)qrow0 * NEV + 2048 + head * 128 + 64, NEV, proj + head * 128 + 64, NEV,
                            VT + (size_t)(b * 1024 + head * 128) * KEYS, ctxq ? 0 : 64, b * 4096, 0, 4,
                            ML + b * 256, nullptr, 0, smem, O, ls);
  const float* subln = p.ev_subln + (l >> 1) * 128;
#pragma unroll
  for (int qt = 0; qt < 2; ++qt) {
    const float i1 = lam / ls[qt];
    float ss = 0.f;
#pragma unroll
    for (int dt = 0; dt < 8; ++dt) {
      unsigned pa, pc;
      if (dt < 6) {
        const u32x2 pk2 = *(const u32x2*)(parkb + (qt * 3 + dt / 2) * 4096 + (dt & 1) * 8);
        pa = pk2.x; pc = pk2.y;
      } else {
        const u32x4 pr = qt ? pkr1 : pkr0;
        pa = (dt & 1) ? pr.z : pr.x; pc = (dt & 1) ? pr.w : pr.y;
      }
      const float o0 = lo_bf(pa) - O[dt][qt][0] * i1;
      const float o1 = hi_bf(pa) - O[dt][qt][1] * i1;
      const float o2 = lo_bf(pc) - O[dt][qt][2] * i1;
      const float o3 = hi_bf(pc) - O[dt][qt][3] * i1;
      O[dt][qt][0] = o0; O[dt][qt][1] = o1; O[dt][qt][2] = o2; O[dt][qt][3] = o3;
      ss += o0 * o0 + o1 * o1 + o2 * o2 + o3 * o3;
    }
    ss += shx<16>(ss, lane);
    ss += shx<32>(ss, lane);
    const float rn = rsqrtf(ss * (1.f / 128.f) + 1e-6f) * (1.f - lam_init);
    const int row = qrow0 + wid * 32 + qt * 16 + r;
#pragma unroll
    for (int dt = 0; dt < 8; ++dt) {
      const int dv = dt * 16 + 4 * q;
      const u32x2 ag = *(const u32x2*)(proj + (size_t)row * NEV + 3072 + head * 128 + dv);
      const float4 sl = *(const float4*)(subln + dv);
      u32x2 o;
      o.x = pack2(O[dt][qt][0] * rn * sl.x * silu(lo_bf(ag.x)), O[dt][qt][1] * rn * sl.y * silu(hi_bf(ag.x)));
      o.y = pack2(O[dt][qt][2] * rn * sl.z * silu(lo_bf(ag.y)), O[dt][qt][3] * rn * sl.w * silu(hi_bf(ag.y)));
      *(u32x2*)(U + (size_t)row * 2048 + head * 128 + dv) = o;
    }
  }
}

DI void na_item(const Params& p, int l, int b, int head, int rho, bool ctxq, int cq0, char* smem) {
  const int tid = opaque_tid(), lane = tid & 63, wid = tid >> 6, r = lane & 15, q = lane >> 4;
  const bfr* proj = (const bfr*)(p.ws + OFF_PROJ);
  const bfr* VT = (const bfr*)(p.ws + OFF_VT);
  bfr* U = (bfr*)(p.ws + OFF_U);
  float* rpb_s = (float*)(smem + 2 * (8192 + 64 * 128));
  int rs = rho - 4; rs = rs < 0 ? 0 : (rs > 56 ? 56 : rs);
  const int qrow0 = ctxq ? (ML + b * 256 + cq0) : (b * 4096 + rho * 64);
  f32x4 O[4][1];
  float ls[1];
  if (!ctxq) {
    const float* rp = p.od_rpb + ((size_t)(l >> 1) * 16 + head) * 465;
    for (int i = tid; i < 465; i += 256) rpb_s[i] = rp[i];
    attn_engine<64, 1, 4, 1>(proj + (size_t)qrow0 * NOD + 3584 + head * 64, NOD, proj + head * 64, NOD,
                                VT + (size_t)(b * 1024 + head * 64) * KEYS, 8, b * 4096 + rs * 64, rs * 64, 4,
                                ML + b * 256, rpb_s, rs - rho + 7, smem, O, ls);
  } else {
    attn_engine<64, 1, 4, 0>(proj + (size_t)qrow0 * NOD + 3584 + head * 64, NOD, proj + head * 64, NOD,
                                VT + (size_t)(b * 1024 + head * 64) * KEYS, 0, 0, 0, 4, ML + b * 256, nullptr, 0,
                                smem, O, ls);
  }
  const float inv = 1.f / ls[0];
  const int row = qrow0 + wid * 16 + r;
#pragma unroll
  for (int dt = 0; dt < 4; ++dt) {
    const int dv = dt * 16 + 4 * q;
    const u32x2 cgv = *(const u32x2*)(proj + (size_t)row * NOD + 5120 + head * 64 + dv);
    u32x2 o;
    o.x = pack2(O[dt][0][0] * inv * silu(lo_bf(cgv.x)), O[dt][0][1] * inv * silu(hi_bf(cgv.x)));
    o.y = pack2(O[dt][0][2] * inv * silu(lo_bf(cgv.y)), O[dt][0][3] * inv * silu(hi_bf(cgv.y)));
    *(u32x2*)(U + (size_t)row * 2048 + head * 64 + dv) = o;
  }
}

DI void conv_item(const Params& p, int l, int item) {
  const int tid = opaque_tid();
  const bfr* proj = (const bfr*)(p.ws + OFF_PROJ);
  bfr* U = (bfr*)(p.ws + OFF_U);
  const float* cw = p.ev_conv + (size_t)(l >> 1) * 3 * 1024;
#pragma unroll 1
  for (int i = 0; i < 8; ++i) {
    const int v = tid + 256 * i;
    const int ri = v >> 7, ch = (v & 127) * 8;
    const int m = item * 16 + ri;
    int t, T;
    if (m < ML) { t = m & 4095; T = 4096; } else { t = (m - ML) & 255; T = 256; }
    const bfr* pr = proj + (size_t)m * NEV;
    float acc[8];
#pragma unroll
    for (int e = 0; e < 8; ++e) acc[e] = 0.f;
#pragma unroll
    for (int w = 0; w < 3; ++w) {
      const int tt = t + w - 1;
      if (tt >= 0 && tt < T) {
        const bfr* prw = pr + (ptrdiff_t)(w - 1) * NEV;
        const u32x4 bh = *(const u32x4*)(prw + 4096 + ch);
        const u32x4 bc = *(const u32x4*)(prw + 6144 + ch);
        const float4 w0 = *(const float4*)(cw + w * 1024 + ch);
        const float4 w1 = *(const float4*)(cw + w * 1024 + ch + 4);
        acc[0] += w0.x * lo_bf(bh.x) * lo_bf(bc.x); acc[1] += w0.y * hi_bf(bh.x) * hi_bf(bc.x);
        acc[2] += w0.z * lo_bf(bh.y) * lo_bf(bc.y); acc[3] += w0.w * hi_bf(bh.y) * hi_bf(bc.y);
        acc[4] += w1.x * lo_bf(bh.z) * lo_bf(bc.z); acc[5] += w1.y * hi_bf(bh.z) * hi_bf(bc.z);
        acc[6] += w1.z * lo_bf(bh.w) * lo_bf(bc.w); acc[7] += w1.w * hi_bf(bh.w) * hi_bf(bc.w);
      }
    }
    const u32x4 bb = *(const u32x4*)(pr + 5120 + ch);
    const u32x4 bg = *(const u32x4*)(pr + 7168 + ch);
    u32x4 o;
    o.x = pack2(lo_bf(bb.x) * acc[0] * silu(lo_bf(bg.x)), hi_bf(bb.x) * acc[1] * silu(hi_bf(bg.x)));
    o.y = pack2(lo_bf(bb.y) * acc[2] * silu(lo_bf(bg.y)), hi_bf(bb.y) * acc[3] * silu(hi_bf(bg.y)));
    o.z = pack2(lo_bf(bb.z) * acc[4] * silu(lo_bf(bg.z)), hi_bf(bb.z) * acc[5] * silu(hi_bf(bg.z)));
    o.w = pack2(lo_bf(bb.w) * acc[6] * silu(lo_bf(bg.w)), hi_bf(bb.w) * acc[7] * silu(hi_bf(bg.w)));
    *(u32x4*)(U + (size_t)m * 2048 + 1024 + ch) = o;
  }
}

DI void gla_item(const Params& p, int l, int item, char* smem) {
  const int tid0 = opaque_tid();
  const int slice = item & 7, dir = (item >> 3) & 1, head = (item >> 4) & 3, b = item >> 6;
  const bfr* proj = (const bfr*)(p.ws + OFF_PROJ);
  const char* etb = p.ws + (dir ? OFF_ETB : OFF_ETF) + (size_t)head * 16384;
  const float* decb = (const float*)(p.ws + OFF_DEC) + ((size_t)dir * (MR / 64) * 4 + head) * 128;
  char* sQb = smem;
  char* sKc = smem + 16384;
  char* sKbT = smem + 32768;
  char* sVt = smem + 49152;
  char* sAtt = smem + 53248;
  char* sST = smem + 61440;
  float* sDec = (float*)(smem + 77824);
  const float qscale = 0.08838834764831845f;

  f32x4 S[2][2];
#pragma unroll
  for (int a = 0; a < 2; ++a)
#pragma unroll
    for (int c2 = 0; c2 < 2; ++c2) S[a][c2] = (f32x4){0.f, 0.f, 0.f, 0.f};
  __syncthreads();
  for (int i = tid0; i < 512; i += 256) ((u32x4*)sST)[i] = (u32x4){0u, 0u, 0u, 0u};

  u32x4 pq0, pq1, pq2, pq3, pk0, pk1, pk2, pk3, pv, pe0, pe1, pe2, pe3, pdec;
#define GLA_ROW0(ci_) (((ci_) < 4) ? (ML + b * 256 + (dir ? (3 - (ci_)) : (ci_)) * 64) : (b * 4096 + (dir ? (67 - (ci_)) : ((ci_) - 4)) * 64))
#define GLA_LOAD(ci_)                                                                                         \
  {                                                                                                           \
    const int prow = tid >> 4, pch = tid & 15, vs = tid >> 2, vpart = tid & 3;                                \
    const int r0_ = GLA_ROW0(ci_);                                                                            \
    const bfr* pr_ = proj + (size_t)(r0_ + prow) * NOD + head * 128 + pch * 8;                                \
    pq0 = *(const u32x4*)(pr_ + 4608);                     pk0 = *(const u32x4*)(pr_ + 2048);                 \
    pq1 = *(const u32x4*)(pr_ + 4608 + (size_t)16 * NOD);  pk1 = *(const u32x4*)(pr_ + 2048 + (size_t)16 * NOD); \
    pq2 = *(const u32x4*)(pr_ + 4608 + (size_t)32 * NOD);  pk2 = *(const u32x4*)(pr_ + 2048 + (size_t)32 * NOD); \
    pq3 = *(const u32x4*)(pr_ + 4608 + (size_t)48 * NOD);  pk3 = *(const u32x4*)(pr_ + 2048 + (size_t)48 * NOD); \
    pv = *(const u32x4*)(proj + (size_t)(r0_ + vs) * NOD + 2560 + head * 256 + slice * 32 + vpart * 8);       \
    const char* et_ = etb + (size_t)(r0_ >> 6) * 65536 + tid * 16;                                            \
    pe0 = *(const u32x4*)(et_);         pe1 = *(const u32x4*)(et_ + 4096);                                    \
    pe2 = *(const u32x4*)(et_ + 8192);  pe3 = *(const u32x4*)(et_ + 12288);                                   \
    if (tid < 32) pdec = *(const u32x4*)(decb + (size_t)(r0_ >> 6) * 512 + tid * 4);                          \
  }
  { const int tid = tid0; GLA_LOAD(0); }
  for (int ci = 0; ci < 68; ++ci) {
    int tid = tid0; asm volatile("" : "+v"(tid));
    const int lane = tid & 63, wid = tid >> 6, r = lane & 15, q = lane >> 4;
    const int d = tid & 127, half = tid >> 7;
    const int prow = tid >> 4, pch = tid & 15, vs = tid >> 2, vpart = tid & 3;
    const int row0 = GLA_ROW0(ci);
    const char* stc = sST + (ci & 1) * 8192;
    char* stn = sST + ((ci + 1) & 1) * 8192;
    __syncthreads();
    {
      *(u32x4*)(sQb + sw256(prow, pch)) = pq0;       *(u32x4*)(sKc + sw256(prow, pch)) = pk0;
      *(u32x4*)(sQb + sw256(prow + 16, pch)) = pq1;  *(u32x4*)(sKc + sw256(prow + 16, pch)) = pk1;
      *(u32x4*)(sQb + sw256(prow + 32, pch)) = pq2;  *(u32x4*)(sKc + sw256(prow + 32, pch)) = pk2;
      *(u32x4*)(sQb + sw256(prow + 48, pch)) = pq3;  *(u32x4*)(sKc + sw256(prow + 48, pch)) = pk3;
      *(u32x4*)(sKbT + tid * 16) = pe0;              *(u32x4*)(sKbT + tid * 16 + 4096) = pe1;
      *(u32x4*)(sKbT + tid * 16 + 8192) = pe2;       *(u32x4*)(sKbT + tid * 16 + 12288) = pe3;
      if (tid < 32) *(u32x4*)((char*)sDec + tid * 16) = pdec;
      const unsigned vv[4] = {pv.x, pv.y, pv.z, pv.w};
#pragma unroll
      for (int j = 0; j < 4; ++j) {
        const int e0 = vpart * 8 + 2 * j;
        *(bfr*)(sVt + sw128(e0, vs >> 3) + (vs & 7) * 2) = (bfr)(vv[j] & 0xffffu);
        *(bfr*)(sVt + sw128(e0 + 1, vs >> 3) + (vs & 7) * 2) = (bfr)(vv[j] >> 16);
      }
    }
    __syncthreads();
    {
      const float dec = sDec[d];
#pragma unroll
      for (int i8 = 0; i8 < 4; ++i8) {
        const u32x4 ev = *(const u32x4*)(sKbT + sw128(d, half * 4 + i8));
        const unsigned ew[4] = {ev.x, ev.y, ev.z, ev.w};
        unsigned kb[4];
#pragma unroll
        for (int ii = 0; ii < 8; ++ii) {
          const int s = half * 32 + i8 * 8 + ii;
          const float E = (ii & 1) ? hi_bf(ew[ii >> 1]) : lo_bf(ew[ii >> 1]);
          const float Ei = __builtin_amdgcn_rcpf(E);
          bfr* qa_ = (bfr*)(sQb + sw256(s, d >> 3) + (d & 7) * 2);
          bfr* ka_ = (bfr*)(sKc + sw256(s, d >> 3) + (d & 7) * 2);
          const float qv = bf2f(*qa_) * qscale * E;
          const float kc = bf2f(*ka_) * Ei;
          *qa_ = f2bf(qv);
          *ka_ = f2bf(kc);
          const unsigned kbv = f2bf(kc * dec);
          if (ii & 1) kb[ii >> 1] |= kbv << 16; else kb[ii >> 1] = kbv;
        }
        *(u32x4*)(sKbT + sw128(d, half * 4 + i8)) = (u32x4){kb[0], kb[1], kb[2], kb[3]};
      }
    }
    __syncthreads();
    if (ci + 1 < 68) GLA_LOAD(ci + 1);
    {
      f32x4 at[4];
#pragma unroll
      for (int st = 0; st < 4; ++st) at[st] = (f32x4){0.f, 0.f, 0.f, 0.f};
#pragma unroll
      for (int ks = 0; ks < 4; ++ks) {
        const bf16x8 qa = *(const bf16x8*)(sQb + sw256(wid * 16 + r, ks * 4 + q));
#pragma unroll
        for (int st = 0; st < 4; ++st) {
          const bf16x8 kb2 = *(const bf16x8*)(sKc + sw256(st * 16 + r, ks * 4 + q));
          at[st] = mfma16(qa, kb2, at[st]);
        }
      }
#pragma unroll
      for (int st = 0; st < 4; ++st)
#pragma unroll
        for (int j = 0; j < 4; ++j) {
          const int t = wid * 16 + 4 * q + j, s = st * 16 + r;
          const bool keep = dir ? (s >= t) : (s <= t);
          *(bfr*)(sAtt + sw128(t, s >> 3) + (s & 7) * 2) = f2bf(keep ? at[st][j] : 0.f);
        }
    }
    {
#pragma unroll
      for (int dti = 0; dti < 2; ++dti) {
        const float dc = sDec[(2 * wid + dti) * 16 + r];
#pragma unroll
        for (int et = 0; et < 2; ++et) {
          S[et][dti][0] *= dc; S[et][dti][1] *= dc; S[et][dti][2] *= dc; S[et][dti][3] *= dc;
        }
      }
#pragma unroll
      for (int ks = 0; ks < 2; ++ks) {
        bf16x8 va[2], kb2[2];
#pragma unroll
        for (int et = 0; et < 2; ++et) va[et] = *(const bf16x8*)(sVt + sw128(et * 16 + r, ks * 4 + q));
#pragma unroll
        for (int dti = 0; dti < 2; ++dti) kb2[dti] = *(const bf16x8*)(sKbT + sw128((2 * wid + dti) * 16 + r, ks * 4 + q));
#pragma unroll
        for (int et = 0; et < 2; ++et)
#pragma unroll
          for (int dti = 0; dti < 2; ++dti) S[et][dti] = mfma16(va[et], kb2[dti], S[et][dti]);
      }
#pragma unroll
      for (int et = 0; et < 2; ++et)
#pragma unroll
        for (int dti = 0; dti < 2; ++dti)
#pragma unroll
          for (int j = 0; j < 4; ++j) {
            const int e = et * 16 + 4 * q + j, dd = (2 * wid + dti) * 16 + r;
            *(bfr*)(stn + sw256(e, dd >> 3) + (dd & 7) * 2) = f2bf(S[et][dti][j]);
          }
    }
    __syncthreads();
    {
      f32x4 o[2];
      o[0] = (f32x4){0.f, 0.f, 0.f, 0.f};
      o[1] = (f32x4){0.f, 0.f, 0.f, 0.f};
#pragma unroll
      for (int ks = 0; ks < 4; ++ks) {
        const bf16x8 qa = *(const bf16x8*)(sQb + sw256(wid * 16 + r, ks * 4 + q));
#pragma unroll
        for (int et = 0; et < 2; ++et) {
          const bf16x8 sb2 = *(const bf16x8*)(stc + sw256(et * 16 + r, ks * 4 + q));
          o[et] = mfma16(qa, sb2, o[et]);
        }
      }
#pragma unroll
      for (int ks = 0; ks < 2; ++ks) {
        const bf16x8 aa = *(const bf16x8*)(sAtt + sw128(wid * 16 + r, ks * 4 + q));
#pragma unroll
        for (int et = 0; et < 2; ++et) {
          const bf16x8 vb = *(const bf16x8*)(sVt + sw128(et * 16 + r, ks * 4 + q));
          o[et] = mfma16(aa, vb, o[et]);
        }
      }
      {
        const int lam = head * 8 + slice;
#pragma unroll
        for (int j = 0; j < 4; ++j) {
          const int row = row0 + wid * 16 + 4 * q + j;
          const int m2 = row >> 1, par = row & 1;
          bfr* lp = dir ? ((bfr*)(p.ws + OFF_H) + ((size_t)m2 * 32 + lam) * 64)
                        : ((bfr*)(p.ws + OFF_U) + (size_t)(2 * m2 + (lam >> 4)) * 2048 + 1024 + (lam & 15) * 64);
#pragma unroll
          for (int et = 0; et < 2; ++et) lp[par * 32 + et * 16 + r] = f2bf(o[et][j]);
        }
      }
    }
  }
#undef GLA_LOAD
#undef GLA_ROW0
  __syncthreads();
}

DI void phase_gla_combine(const Params& p, int l) {
  const int tid = opaque_tid(), lane = tid & 63, wid = tid >> 6;
  const bfr* proj = (const bfr*)(p.ws + OFF_PROJ);
  const bfr* OB = (const bfr*)(p.ws + OFF_H);
  bfr* U = (bfr*)(p.ws + OFF_U);
  const int h = lane >> 4, e16 = (lane & 15) * 16;
  const int lam = h * 8 + ((lane & 15) >> 1), ein = (lane & 1) * 16;
  const float* gn = p.od_gnorm + (l >> 1) * 256 + e16;
  for (int m2 = blockIdx.x * 4 + wid; m2 < MR / 2; m2 += gridDim.x * 4) {
    const bfr* ofl = U + (size_t)(2 * m2 + (lam >> 4)) * 2048 + 1024 + (lam & 15) * 64 + ein;
    const bfr* obl = OB + ((size_t)m2 * 32 + lam) * 64 + ein;
    u32x4 a[2][2], bq[2][2], g[2][2];
#pragma unroll
    for (int par = 0; par < 2; ++par) {
      a[par][0] = *(const u32x4*)(ofl + par * 32);  a[par][1] = *(const u32x4*)(ofl + par * 32 + 8);
      bq[par][0] = *(const u32x4*)(obl + par * 32); bq[par][1] = *(const u32x4*)(obl + par * 32 + 8);
      const bfr* gp = proj + (size_t)(2 * m2 + par) * NOD + 6144 + h * 256 + e16;
      g[par][0] = *(const u32x4*)gp; g[par][1] = *(const u32x4*)(gp + 8);
    }
    u32x4 res[2][2];
#pragma unroll
    for (int par = 0; par < 2; ++par) {
      float o[16], dg[16];
      float ss = 0.f;
#pragma unroll
      for (int hv = 0; hv < 2; ++hv)
#pragma unroll
        for (int i = 0; i < 4; ++i) {
          const unsigned av = a[par][hv][i], bv = bq[par][hv][i], gv = g[par][hv][i];
          const int k = hv * 8 + i * 2;
          o[k] = lo_bf(av) + lo_bf(bv); o[k + 1] = hi_bf(av) + hi_bf(bv);
          dg[k] = lo_bf(gv); dg[k + 1] = hi_bf(gv);
          ss += o[k] * o[k] + o[k + 1] * o[k + 1];
        }
      ss += shx<1>(ss, lane); ss += shx<2>(ss, lane); ss += shx<4>(ss, lane); ss += shx<8>(ss, lane);
      const float rn = rsqrtf(ss * (1.f / 256.f) + 1e-6f);
#pragma unroll
      for (int hv = 0; hv < 2; ++hv)
#pragma unroll
        for (int i = 0; i < 4; ++i) {
          const int k = hv * 8 + i * 2;
          res[par][hv][i] = pack2(o[k] * rn * gn[k] * silu(dg[k]), o[k + 1] * rn * gn[k + 1] * silu(dg[k + 1]));
        }
    }
#pragma unroll
    for (int par = 0; par < 2; ++par) {
      bfr* up = U + (size_t)(2 * m2 + par) * 2048 + 1024 + h * 256 + e16;
      *(u32x4*)up = res[par][0];
      *(u32x4*)(up + 8) = res[par][1];
    }
  }
}

DI int next_item(int* ctr, int* slot) {
  __syncthreads();
  if (threadIdx.x == 0) *slot = atomicAdd(ctr, 1);
  __syncthreads();
  return *slot;
}

DI void phase_mix_even(const Params& p, int l, int g, char* smem, int coff = 0) {
  int* ctr0 = (int*)(p.ws + OFF_CTR) + ((g * 2 + (l >> 1)) * 8) + coff;
  int* slot = (int*)(smem + SMEM_BYTES - 16);
  const int PER_LAT = GB * 32, PER_CTX = GB * 2, PER_CONV = MR / 16 / 8;
  const int per_q = PER_LAT + PER_CTX + PER_CONV;
  const int myq = (int)(__builtin_amdgcn_s_getreg((3 << 11) | 20) & 7u);
  for (int dq = 0; dq < 8; ++dq) {
    const int x = (myq + dq) & 7;
    for (;;) {
      int it = next_item(ctr0 + x, slot);
      if (it >= per_q) break;
      if (it < PER_LAT) {
        const int qb = it & 31, b = it >> 5;
        diff_attn_item(p, l, b, x, b * 4096 + qb * 128, false, smem);
      } else if (it < PER_LAT + PER_CTX) {
        it -= PER_LAT;
        const int qb = it & 1, b = it >> 1;
        diff_attn_item(p, l, b, x, ML + b * 256 + qb * 128, true, smem);
      } else {
        conv_item(p, l, (it - PER_LAT - PER_CTX) * 8 + x);
      }
    }
  }
}

DI void phase_mix_odd(const Params& p, int l, int g, char* smem) {
  int* ctr = (int*)(p.ws + OFF_CTR) + (g * 4 + l);
  int* slot = (int*)(smem + SMEM_BYTES - 16);
  const int N_GLA = GB * 4 * 2 * 8, N_NA = GB * 16 * 64, N_CTX = (l == 3) ? 0 : GB * 16 * 4;
  const int total = N_GLA + N_NA + N_CTX;
  (void)ctr; (void)slot; (void)total;
  const int nb = gridDim.x, bx = blockIdx.x;
  const int nup = (nb > N_GLA) ? (nb - N_GLA) : 0;
  const int NA_UP = 17;
  for (int k = 0;; ++k) {
    int it;
    if (nup == 0) { it = bx + k * nb; if (it >= total) break; }
    else if (bx < N_GLA) {
      if (k == 0) it = bx;
      else { it = N_GLA + NA_UP * nup + bx + (k - 1) * N_GLA; if (it >= total) break; }
    } else {
      if (k >= NA_UP) break;
      it = N_GLA + (bx - N_GLA) + k * nup;
      if (it >= total) break;
    }
    __syncthreads();
    if (it < N_GLA) {
      __builtin_amdgcn_s_setprio(3);
      gla_item(p, l, it, smem);
      __builtin_amdgcn_s_setprio(0);
    } else if (it < N_GLA + N_NA) {
      it -= N_GLA;
      const int rho = it & 63, bh = it >> 6;
      na_item(p, l, bh >> 4, bh & 15, rho, false, 0, smem);
    } else {
      it -= N_GLA + N_NA;
      const int qb = it & 3, bh = it >> 2;
      na_item(p, l, bh >> 4, bh & 15, 0, true, qb * 64, smem);
    }
  }
}


DI void grid_barrier(unsigned* bar, unsigned& bgen, unsigned xcc, unsigned nxcc, unsigned nx) {
  asm volatile("s_waitcnt vmcnt(0)" ::: "memory");
  __syncthreads();
  const unsigned target = bgen + 1;
  if (threadIdx.x == 0) {
    const unsigned old = __hip_atomic_fetch_add(bar + xcc * 64, 1u, __ATOMIC_RELAXED, __HIP_MEMORY_SCOPE_AGENT);
    if (old == target * nxcc - 1) {
      __builtin_amdgcn_fence(__ATOMIC_RELEASE, "agent");
      asm volatile("s_waitcnt vmcnt(0)" ::: "memory");
      const unsigned o2 = __hip_atomic_fetch_add(bar + 16 * 64, 1u, __ATOMIC_RELAXED, __HIP_MEMORY_SCOPE_AGENT);
      if (o2 == target * nx - 1) __hip_atomic_store(bar + 17 * 64, target, __ATOMIC_RELAXED, __HIP_MEMORY_SCOPE_AGENT);
    }
    while (__hip_atomic_load(bar + 17 * 64, __ATOMIC_RELAXED, __HIP_MEMORY_SCOPE_AGENT) < target) __builtin_amdgcn_s_sleep(1);
    __builtin_amdgcn_fence(__ATOMIC_ACQUIRE, "agent");
    asm volatile("s_waitcnt vmcnt(0)" ::: "memory");
  }
  bgen = target;
  __syncthreads();
}
typedef const __attribute__((address_space(4))) Params* KParamsPtr;
DI Params load_params() {
#if defined(__HIP_DEVICE_COMPILE__)
  KParamsPtr kp = (KParamsPtr)__builtin_amdgcn_kernarg_segment_ptr();
  asm volatile("" : "+s"(kp));
  Params r;
  __builtin_memcpy(&r, kp, sizeof(Params));
  return r;
#else
  return Params{};
#endif
}
#define PH(call) { const Params p = load_params(); call; }
__global__ void __launch_bounds__(256, 2) mega_kernel(Params p_unused) {
  extern __shared__ __attribute__((aligned(16))) char smem[];
  cg::grid_group grid = cg::this_grid();
  unsigned bgen = 0;
  const unsigned xcc = (unsigned)__builtin_amdgcn_s_getreg((3 << 11) | 20) & 15u;
  if (threadIdx.x == 0) {
    const Params pb = load_params();
    __hip_atomic_fetch_add((unsigned*)(pb.ws + OFF_BAR) + (18 + xcc) * 64, 1u, __ATOMIC_RELAXED, __HIP_MEMORY_SCOPE_AGENT);
  }
  PH(phase0(p, smem));
  grid.sync();
  unsigned nxcc = 0, nx = 0;
  {
    const Params pb = load_params();
    const unsigned* cen = (const unsigned*)(pb.ws + OFF_BAR) + 18 * 64;
    for (unsigned j = 0; j < 16; ++j) {
      const unsigned cj = __hip_atomic_load(cen + j * 64, __ATOMIC_RELAXED, __HIP_MEMORY_SCOPE_AGENT);
      nx += (cj != 0);
      if (j == xcc) nxcc = cj;
    }
  }
#define GBAR() { const Params pb = load_params(); grid_barrier((unsigned*)(pb.ws + OFF_BAR), bgen, xcc, nxcc, nx); }
#pragma unroll 1
  for (int g = 0; g < NGRP; ++g) {
#pragma unroll 1
    for (int l = 0; l < 4; ++l) {
      PH(phase_norm(p, l, g));
      GBAR();
      PH(phase_gemm_in(p, l, smem, g * 4 + l));
      GBAR();
      if (l & 1) {
        PH(phase_mix_odd(p, l, g, smem));
        GBAR();
        PH(phase_gla_combine(p, l));
      } else {
        PH(phase_mix_even(p, l, g, smem));
      }
      GBAR();
      PH(phase_gemm_out(p, l, smem, 8 + g * 4 + l));
      GBAR();
    }
    PH(phase_norm(p, 4, g));
    GBAR();
  }
}

extern "C" void kernel_launch(void* const* d_in, const int* in_sizes, int n_in, void* d_out, int out_size, void* d_ws,
                              size_t ws_size, hipStream_t stream) {
  static int grid_blocks = 0;
  if (!grid_blocks) {
    int dev = 0, cus = 0, per_cu = 0;
    hipGetDevice(&dev);
    hipDeviceGetAttribute(&cus, hipDeviceAttributeMultiprocessorCount, dev);
    hipFuncSetAttribute((const void*)mega_kernel, hipFuncAttributeMaxDynamicSharedMemorySize, SMEM_BYTES);
    hipOccupancyMaxActiveBlocksPerMultiprocessor(&per_cu, mega_kernel, 256, SMEM_BYTES);
    if (per_cu > 2) per_cu = 2;
    if (per_cu < 1) per_cu = 1;
    grid_blocks = cus * per_cu;
    grid_blocks &= ~15;
  }
  if (ws_size < WS_NEED) { fprintf(stderr, "workspace too small: %zu < %zu\n", ws_size, (size_t)WS_NEED); return; }
  Params p{};
  p.x = (const float*)d_in[0]; p.c = (const float*)d_in[1]; p.ctx = (const float*)d_in[2]; p.c_ctx = (const float*)d_in[3];
  p.w_mod = (const float*)d_in[4]; p.b_mod = (const float*)d_in[5]; p.g_pre = (const float*)d_in[6]; p.g_post = (const float*)d_in[7];
  p.w_out = (const float*)d_in[8]; p.ev_w_in = (const float*)d_in[9]; p.ev_lambda = (const float*)d_in[10]; p.ev_subln = (const float*)d_in[11];
  p.ev_conv = (const float*)d_in[12]; p.od_w_in = (const float*)d_in[13]; p.od_rpb = (const float*)d_in[14]; p.od_gate_up = (const float*)d_in[15];
  p.od_gate_bias = (const float*)d_in[16]; p.od_gnorm = (const float*)d_in[17];
  p.out = (float*)d_out;
  p.ws = (char*)d_ws;
  (void)hipMemsetAsync((char*)d_ws + OFF_BAR, 0, BAR_BYTES, stream);
  void* args[] = {&p};
  hipError_t e = hipLaunchCooperativeKernel((const void*)mega_kernel, dim3(grid_blocks), dim3(256), args, SMEM_BYTES, stream);
  if (e != hipSuccess) fprintf(stderr, "cooperative launch failed: %s (grid %d)\n", hipGetErrorString(e), grid_blocks);
}
```

```cpp
#include <hip/hip_runtime.h>
#include <hip/hip_cooperative_groups.h>
#include <cstdio>
namespace cg = cooperative_groups;

typedef unsigned short bfr;
typedef __attribute__((ext_vector_type(8))) short bf16x8;
typedef __attribute__((ext_vector_type(4))) float f32x4;
typedef __attribute__((ext_vector_type(4))) unsigned u32x4;
typedef __attribute__((ext_vector_type(2))) unsigned u32x2;
typedef __attribute__((ext_vector_type(16))) unsigned u32x16;
typedef __attribute__((ext_vector_type(2))) __bf16 bf16x2_t;
#define DI __device__ __forceinline__
DI float dot2bf(unsigned a, unsigned b, float c) { return __builtin_amdgcn_fdot2_f32_bf16(__builtin_bit_cast(bf16x2_t, a), __builtin_bit_cast(bf16x2_t, b), c, false); }
DI int opaque_tid() { int t = threadIdx.x; asm volatile("" : "+v"(t)); return t; }

constexpr int GB   = 4;
constexpr int NGRP = 2;
constexpr int ML   = GB * 4096;
constexpr int MC   = GB * 256;
constexpr int MR   = ML + MC;
constexpr int NEV  = 8192;
constexpr int NOD  = 7296;
constexpr int KEYS = 4352;
constexpr float L2E = 1.4426950408889634f;
constexpr float LN2 = 0.6931471805599453f;

constexpr size_t SZ_PROJ = (size_t)MR * 8192 * 2;
constexpr size_t SZ_H    = (size_t)MR * 1024 * 2;
constexpr size_t SZ_U    = (size_t)MR * 2048 * 2;
constexpr size_t SZ_VT   = (size_t)GB * 1024 * KEYS * 2;
constexpr size_t SZ_WE   = (size_t)NEV * 1024 * 2;
constexpr size_t SZ_WO   = (size_t)NOD * 1024 * 2;
constexpr size_t SZ_WOUT = (size_t)1024 * 2048 * 2;
constexpr size_t OFF_PROJ = 0;
constexpr size_t OFF_H    = OFF_PROJ + SZ_PROJ;
constexpr size_t OFF_U    = OFF_H + SZ_H;
constexpr size_t OFF_VT   = OFF_U + SZ_U;
constexpr size_t OFF_WIN  = OFF_VT + SZ_VT;
constexpr size_t OFF_WOUT = OFF_WIN + 2 * SZ_WE + 2 * SZ_WO;
constexpr size_t OFF_XC   = OFF_WOUT + 4 * SZ_WOUT;
constexpr size_t OFF_MOD  = OFF_XC + (size_t)8 * 256 * 1024 * 4;
constexpr size_t OFF_CS   = OFF_MOD + (size_t)4 * 9 * 3072 * 4;
constexpr size_t OFF_LAM  = OFF_CS + 64 * 16 * 8;
constexpr size_t OFF_CTR  = OFF_LAM + 256;
constexpr size_t OFF_BAR  = OFF_CTR + 256;
constexpr size_t BAR_BYTES = 34 * 256 + 192 * 64;
constexpr size_t SZ_ET    = (size_t)(MR / 64) * 4 * 16384;
constexpr size_t OFF_ETF  = OFF_PROJ + (size_t)MR * NOD * 2;
constexpr size_t OFF_ETB  = (OFF_BAR + BAR_BYTES + 255) & ~(size_t)255;
constexpr size_t OFF_DEC  = OFF_ETB + SZ_ET;
constexpr size_t WS_NEED  = OFF_DEC + (size_t)2 * (MR / 64) * 4 * 128 * 4;
static_assert(OFF_ETF + SZ_ET <= OFF_H, "E^T forward tiles must fit behind the odd proj rows");

constexpr int SMEM_BYTES = 80896;

struct Params {
  const float *x, *c, *ctx, *c_ctx, *w_mod, *b_mod, *g_pre, *g_post, *w_out, *ev_w_in, *ev_lambda, *ev_subln,
      *ev_conv, *od_w_in, *od_rpb, *od_gate_up, *od_gate_bias, *od_gnorm;
  float* out;
  char* ws;
};

DI size_t win_off(int l) { return OFF_WIN + (size_t)(l >> 1) * (SZ_WE + SZ_WO) + ((l & 1) ? SZ_WE : 0); }

DI float bf2f(bfr v) { return __uint_as_float(((unsigned)v) << 16); }
typedef __attribute__((ext_vector_type(2))) float f32x2_t;
DI bfr f2bf(float x) { return __builtin_bit_cast(bfr, (__bf16)x); }
DI unsigned pack2(float a, float b) { f32x2_t v = {a, b}; return __builtin_bit_cast(unsigned, __builtin_convertvector(v, bf16x2_t)); }
DI float lo_bf(unsigned u) { return __uint_as_float(u << 16); }
DI float hi_bf(unsigned u) { return __uint_as_float(u & 0xffff0000u); }
DI float fexp2(float x) { return __builtin_amdgcn_exp2f(x); }
DI float flog2(float x) { return __builtin_amdgcn_logf(x); }
DI float silu(float x) { return x / (1.f + fexp2(-x * L2E)); }
DI float max3f(float a, float b, float c) { float r; asm("v_max3_f32 %0, %1, %2, %3" : "=v"(r) : "v"(a), "v"(b), "v"(c)); return r; }
template <int M>
DI float shx(float v, int lane) {
  if (M < 32) return __builtin_bit_cast(float, __builtin_amdgcn_ds_swizzle(__builtin_bit_cast(int, v), (M << 10) | 0x1f));
  return __builtin_bit_cast(float, __builtin_amdgcn_ds_bpermute((lane ^ 32) << 2, __builtin_bit_cast(int, v)));
}
DI float wave_sum(float v, int lane) {
  v += shx<1>(v, lane); v += shx<2>(v, lane); v += shx<4>(v, lane); v += shx<8>(v, lane); v += shx<16>(v, lane); v += shx<32>(v, lane);
  return v;
}
DI f32x4 mfma16(bf16x8 a, bf16x8 b, f32x4 c) { return __builtin_amdgcn_mfma_f32_16x16x32_bf16(a, b, c, 0, 0, 0); }
DI int sw128(int row, int chunk) { return row * 128 + ((chunk ^ ((row >> 1) & 7)) << 4); }
DI int sw256(int row, int chunk) { return row * 256 + ((chunk ^ (row & 15)) << 4); }

struct GemmStage { u32x4 xa0[4], ya0[4], xa1[4], ya1[4]; };
DI void gemm_prologue(const bfr* __restrict__ X, int ldx, const bfr* __restrict__ Y, int ldy, GemmStage& st) {
  const int tid = opaque_tid();
  const int lr = tid >> 3, lc = tid & 7;
  const bfr* xp = X + (size_t)lr * ldx + lc * 8;
  const bfr* yp = Y + (size_t)lr * ldy + lc * 8;
#pragma unroll
  for (int i = 0; i < 4; ++i) {
    st.xa0[i] = *(const u32x4*)(xp + (size_t)(32 * i) * ldx);
    st.ya0[i] = *(const u32x4*)(yp + (size_t)(32 * i) * ldy);
    st.xa1[i] = *(const u32x4*)(xp + (size_t)(32 * i) * ldx + 64);
    st.ya1[i] = *(const u32x4*)(yp + (size_t)(32 * i) * ldy + 64);
  }
}
DI void gemm_mainloop(const bfr* __restrict__ X, int ldx, const bfr* __restrict__ Y, int ldy, int K,
                      const bfr* __restrict__ Xn, const bfr* __restrict__ Yn, bool hasnext, char* smem,
                      f32x4 (&acc)[4][4], GemmStage& st) {
  const int tid = opaque_tid(), lane = tid & 63, wid = tid >> 6, r = lane & 15, q = lane >> 4;
  const int wx = wid >> 1, wy = wid & 1;
  const int lr = tid >> 3, lc = tid & 7;
  const bfr* xp = X + (size_t)lr * ldx + lc * 8;
  const bfr* yp = Y + (size_t)lr * ldy + lc * 8;
  const bfr* xpn = Xn + (size_t)lr * ldx + lc * 8;
  const bfr* ypn = Yn + (size_t)lr * ldy + lc * 8;
  const int nk = K >> 6;
#define GEMM_STEP(XR, YR, BUF, KT)                                                                       \
  {                                                                                                      \
    char* sX = smem + (BUF) * 32768;                                                                     \
    char* sY = sX + 16384;                                                                               \
    _Pragma("unroll") for (int i = 0; i < 4; ++i) {                                                      \
      *(u32x4*)(sX + sw128(lr + 32 * i, lc)) = XR[i];                                                    \
      *(u32x4*)(sY + sw128(lr + 32 * i, lc)) = YR[i];                                                    \
    }                                                                                                    \
    __syncthreads();                                                                                     \
    if ((KT) + 2 < nk) {                                                                                 \
      const int ko = ((KT) + 2) * 64;                                                                    \
      _Pragma("unroll") for (int i = 0; i < 4; ++i) {                                                    \
        XR[i] = *(const u32x4*)(xp + (size_t)(32 * i) * ldx + ko);                                       \
        YR[i] = *(const u32x4*)(yp + (size_t)(32 * i) * ldy + ko);                                       \
      }                                                                                                  \
    } else if (hasnext) {                                                                                \
      const int ko = ((KT) + 2 - nk) * 64;                                                               \
      _Pragma("unroll") for (int i = 0; i < 4; ++i) {                                                    \
        XR[i] = *(const u32x4*)(xpn + (size_t)(32 * i) * ldx + ko);                                      \
        YR[i] = *(const u32x4*)(ypn + (size_t)(32 * i) * ldy + ko);                                      \
      }                                                                                                  \
    }                                                                                                    \
    _Pragma("unroll") for (int s = 0; s < 2; ++s) {                                                      \
      bf16x8 xf[4], yf[4];                                                                               \
      _Pragma("unroll") for (int i = 0; i < 4; ++i)                                                      \
          xf[i] = *(const bf16x8*)(sX + sw128(wx * 64 + i * 16 + r, s * 4 + q));                         \
      _Pragma("unroll") for (int j = 0; j < 4; ++j)                                                      \
          yf[j] = *(const bf16x8*)(sY + sw128(wy * 64 + j * 16 + r, s * 4 + q));                         \
      __builtin_amdgcn_s_setprio(1);                                                                     \
      _Pragma("unroll") for (int i = 0; i < 4; ++i)                                                      \
          _Pragma("unroll") for (int j = 0; j < 4; ++j) acc[i][j] = mfma16(xf[i], yf[j], acc[i][j]);     \
      __builtin_amdgcn_s_setprio(0);                                                                     \
    }                                                                                                    \
  }
  for (int kt = 0; kt < nk; kt += 2) {
    GEMM_STEP(st.xa0, st.ya0, 0, kt);
    GEMM_STEP(st.xa1, st.ya1, 1, kt + 1);
  }
#undef GEMM_STEP
  __syncthreads();
}

DI bool tile_map(int T, int MT, int NT, int& mt, int& nt) {
  const int pm_n = MT >> 3;
  const int P = (T >> 9) * 8 + (T & 7);
  const int li = (T & 511) >> 3;
  const int pm = P % pm_n, pn = P / pm_n;
  mt = pm * 8 + (li & 7);
  nt = pn * 8 + (li >> 3);
  return nt < NT;
}

DI int odd_col_src(int n) {
  if (n < 3584) return n;
  if (n < 7168) return n + 32;
  if (n < 7200) return n - 7168 + 3584;
  return -1;
}

DI void phase0(const Params& p, char* smem) {
  const int tid = opaque_tid();
  if (blockIdx.x < 384) {
    float* sc = (float*)smem;
    float* red = sc + 9 * 1024;
    for (int i = tid; i < 9 * 1024; i += 256) {
      const int b = i >> 10, k = i & 1023;
      const float v = (b < 8) ? p.c[b * 1024 + k] : p.c_ctx[k];
      sc[i] = v / (1.f + __expf(-v));
    }
    __syncthreads();
    float* modb = (float*)(p.ws + OFF_MOD);
    for (int it = blockIdx.x; it < 384; it += gridDim.x) {
      const int l = it / 96, cgp = it % 96;
      const int col = cgp * 32 + (tid & 31), ks = tid >> 5;
      float a[9];
#pragma unroll
      for (int b = 0; b < 9; ++b) a[b] = 0.f;
      const float* w = p.w_mod + ((size_t)l * 1024 + ks * 128) * 3072 + col;
#pragma unroll 4
      for (int k = 0; k < 128; ++k) {
        const float wv = w[(size_t)k * 3072];
#pragma unroll
        for (int b = 0; b < 9; ++b) a[b] += sc[b * 1024 + ks * 128 + k] * wv;
      }
#pragma unroll
      for (int b = 0; b < 9; ++b) red[(ks * 9 + b) * 32 + (tid & 31)] = a[b];
      __syncthreads();
      for (int idx = tid; idx < 288; idx += 256) {
        const int b = idx >> 5, cc = idx & 31;
        float s = p.b_mod[l * 3072 + cgp * 32 + cc];
#pragma unroll
        for (int k2 = 0; k2 < 8; ++k2) s += red[(k2 * 9 + b) * 32 + cc];
        modb[(size_t)(l * 9 + b) * 3072 + cgp * 32 + cc] = s;
      }
      __syncthreads();
    }
  }
  if (blockIdx.x == gridDim.x - 1) {
    float2* cs = (float2*)(p.ws + OFF_CS);
    for (int idx = tid; idx < 1024; idx += 256) {
      const int pos = idx >> 4, f = idx & 15;
      const float inv = 1.0f / powf(10000.f, (float)f * 0.0625f);
      const float ang = (float)pos * inv;
      const double ad = (double)ang;
      const double n = rint(ad * 0.15915494309189535);
      const float rr = (float)(ad - n * 6.283185307179586);
      cs[idx] = make_float2(__cosf(rr), __sinf(rr));
    }
    if (tid < 2) {
      const float* lp = p.ev_lambda + tid * 256;
      float s1 = 0.f, s2 = 0.f;
      for (int i = 0; i < 64; ++i) { s1 += lp[i] * lp[64 + i]; s2 += lp[128 + i] * lp[192 + i]; }
      const float li = (tid == 0) ? 0.2f : (0.8f - 0.6f * 0.5488116360940264f);
      float* lam = (float*)(p.ws + OFF_LAM);
      lam[tid] = __expf(s1) - __expf(s2) + li;
      lam[2 + tid] = li;
    }
    if (tid < 32) ((int*)(p.ws + OFF_CTR))[tid] = 0;
  }
  float* tile = (float*)smem;
  __syncthreads();
  for (int it = blockIdx.x; it < 9792; it += gridDim.x) {
    int rr = it, l, ktile, ntile, K, Nsrc;
    const float* src;
    bfr* dst;
    bool oddmap = false;
    if (rr < 7744) {
      if (rr < 2048) { l = 0; } else if (rr < 3872) { l = 1; rr -= 2048; } else if (rr < 5920) { l = 2; rr -= 3872; } else { l = 3; rr -= 5920; }
      ktile = rr & 15; ntile = rr >> 4; K = 1024;
      oddmap = (l & 1);
      Nsrc = oddmap ? 7200 : 8192;
      src = (oddmap ? p.od_w_in : p.ev_w_in) + (size_t)(l >> 1) * 1024 * Nsrc;
      dst = (bfr*)(p.ws + win_off(l));
    } else {
      rr -= 7744; l = rr >> 9; rr &= 511;
      ktile = rr & 31; ntile = rr >> 5; K = 2048; Nsrc = 1024;
      src = p.w_out + (size_t)l * 2048 * 1024;
      dst = (bfr*)(p.ws + OFF_WOUT + (size_t)l * SZ_WOUT);
    }
    const int k0 = ktile * 64, n0 = ntile * 64;
    {
      const int nn = tid & 63;
      const int nd = n0 + nn;
      const int ns = oddmap ? odd_col_src(nd) : nd;
#pragma unroll 4
      for (int i = 0; i < 16; ++i) {
        const int kk = (tid >> 6) + 4 * i;
        tile[kk * 65 + nn] = (ns >= 0) ? src[(size_t)(k0 + kk) * Nsrc + ns] : 0.f;
      }
    }
    __syncthreads();
    {
      const int kk8 = (tid & 7) * 8;
#pragma unroll
      for (int i2 = 0; i2 < 2; ++i2) {
        const int nn = (tid >> 3) + 32 * i2;
        u32x4 v;
        v.x = pack2(tile[(kk8 + 0) * 65 + nn], tile[(kk8 + 1) * 65 + nn]);
        v.y = pack2(tile[(kk8 + 2) * 65 + nn], tile[(kk8 + 3) * 65 + nn]);
        v.z = pack2(tile[(kk8 + 4) * 65 + nn], tile[(kk8 + 5) * 65 + nn]);
        v.w = pack2(tile[(kk8 + 6) * 65 + nn], tile[(kk8 + 7) * 65 + nn]);
        *(u32x4*)(dst + (size_t)(n0 + nn) * K + k0 + kk8) = v;
      }
    }
    __syncthreads();
  }
}

DI void phase_norm(const Params& p, int l, int g) {
  const int tid = opaque_tid(), lane = tid & 63, wid = tid >> 6;
  const int rows = (l == 4) ? ML : MR;
  const float* modb = (const float*)(p.ws + OFF_MOD);
  const bfr* ybuf = (const bfr*)(p.ws + OFF_PROJ);
  bfr* hbuf = (bfr*)(p.ws + OFF_H);
  float* xcb = (float*)(p.ws + OFF_XC);
  for (int row = blockIdx.x * 4 + wid; row < rows; row += gridDim.x * 4) {
    const bool lat = row < ML;
    const int mb = lat ? (g * GB + (row >> 12)) : 8;
    const size_t grow = lat ? ((size_t)g * ML + row) : ((size_t)g * MC + (row - ML));
    const float* xin;
    float* xst;
    if (lat) { xin = ((l <= 1) ? p.x : (const float*)p.out) + grow * 1024; xst = p.out + grow * 1024; }
    else     { xin = ((l <= 1) ? p.ctx : (const float*)xcb) + grow * 1024; xst = xcb + grow * 1024; }
    float4 xv[4];
#pragma unroll
    for (int i = 0; i < 4; ++i) xv[i] = *(const float4*)(xin + lane * 4 + 256 * i);
    if (l >= 1) {
      float4 yv[4];
      float ss = 0.f;
#pragma unroll
      for (int i = 0; i < 4; ++i) {
        const u32x2 yr = *(const u32x2*)(ybuf + (size_t)row * 1024 + lane * 4 + 256 * i);
        yv[i] = make_float4(lo_bf(yr.x), hi_bf(yr.x), lo_bf(yr.y), hi_bf(yr.y));
        ss += yv[i].x * yv[i].x + yv[i].y * yv[i].y + yv[i].z * yv[i].z + yv[i].w * yv[i].w;
      }
      ss = wave_sum(ss, lane);
      const float rn = rsqrtf(ss * (1.f / 1024.f) + 1e-6f);
      const float* gate = modb + (size_t)((l - 1) * 9 + mb) * 3072 + 2048;
      const float* gp = p.g_post + (l - 1) * 1024;
#pragma unroll
      for (int i = 0; i < 4; ++i) {
        const int c0 = lane * 4 + 256 * i;
        const float4 gt = *(const float4*)(gate + c0);
        const float4 gg = *(const float4*)(gp + c0);
        xv[i].x += gt.x * (yv[i].x * rn * gg.x);
        xv[i].y += gt.y * (yv[i].y * rn * gg.y);
        xv[i].z += gt.z * (yv[i].z * rn * gg.z);
        xv[i].w += gt.w * (yv[i].w * rn * gg.w);
        *(float4*)(xst + c0) = xv[i];
      }
    }
    if (l < 4) {
      float ss = 0.f;
#pragma unroll
      for (int i = 0; i < 4; ++i) ss += xv[i].x * xv[i].x + xv[i].y * xv[i].y + xv[i].z * xv[i].z + xv[i].w * xv[i].w;
      ss = wave_sum(ss, lane);
      const float rn = rsqrtf(ss * (1.f / 1024.f) + 1e-6f);
      const float* mrow = modb + (size_t)(l * 9 + mb) * 3072;
      const float* gpre = p.g_pre + l * 1024;
#pragma unroll
      for (int i = 0; i < 4; ++i) {
        const int c0 = lane * 4 + 256 * i;
        const float4 sh = *(const float4*)(mrow + c0);
        const float4 scl = *(const float4*)(mrow + 1024 + c0);
        const float4 gg = *(const float4*)(gpre + c0);
        u32x2 o;
        o.x = pack2(xv[i].x * rn * gg.x * (1.f + scl.x) + sh.x, xv[i].y * rn * gg.y * (1.f + scl.y) + sh.y);
        o.y = pack2(xv[i].z * rn * gg.z * (1.f + scl.z) + sh.z, xv[i].w * rn * gg.w * (1.f + scl.w) + sh.w);
        *(u32x2*)(hbuf + (size_t)row * 1024 + c0) = o;
      }
    }
  }
}

DI void gla_gate_precompute(const Params& p, int l, int m0, const char* sLr, float* sHs) {
  const int tid = opaque_tid();
  const int d = tid & 127, half = tid >> 7;
  const int jl = l >> 1;
#pragma unroll 1
  for (int unit = 0; unit < 16; ++unit) {
    const int cc = unit & 1, dir = (unit >> 1) & 1, head = unit >> 2;
    unsigned gu[8];
#pragma unroll
    for (int k = 0; k < 8; ++k)
      gu[k] = pack2(p.od_gate_up[(((size_t)jl * 2 + dir) * 16 + 2 * k) * 512 + head * 128 + d],
                    p.od_gate_up[(((size_t)jl * 2 + dir) * 16 + 2 * k + 1) * 512 + head * 128 + d]);
    const float gbias = p.od_gate_bias[((size_t)jl * 2 + dir) * 512 + head * 128 + d];
    float gl[32];
    float tot = 0.f;
#pragma unroll
    for (int i = 0; i < 32; ++i) {
      const int tk = cc * 64 + half * 32 + i;
      const u32x4 la = *(const u32x4*)(sLr + tk * 64 + dir * 32);
      const u32x4 lb = *(const u32x4*)(sLr + tk * 64 + dir * 32 + 16);
      float z = gbias;
      z = dot2bf(la.x, gu[0], z); z = dot2bf(la.y, gu[1], z); z = dot2bf(la.z, gu[2], z); z = dot2bf(la.w, gu[3], z);
      z = dot2bf(lb.x, gu[4], z); z = dot2bf(lb.y, gu[5], z); z = dot2bf(lb.z, gu[6], z); z = dot2bf(lb.w, gu[7], z);
      const float tneg = fexp2(-fabsf(z) * L2E);
      const float g = (fminf(z, 0.f) - flog2(1.f + tneg) * LN2) * (L2E / 16.f);
      gl[i] = g;
      tot += g;
    }
    if (dir == 0) {
      float run = 0.f;
#pragma unroll
      for (int i = 0; i < 32; ++i) { run += gl[i]; gl[i] = run; }
    } else {
      float run = 0.f;
#pragma unroll
      for (int i = 31; i >= 0; --i) { run += gl[i]; gl[i] = run; }
    }
    __syncthreads();
    sHs[half * 128 + d] = tot;
    __syncthreads();
    const float other = sHs[(1 - half) * 128 + d];
    const float offs = (dir == 0) ? (half ? other : 0.f) : (half ? 0.f : other);
    const int chunk = (m0 >> 6) + cc;
    char* et = p.ws + (dir ? OFF_ETB : OFF_ETF) + ((size_t)chunk * 4 + head) * 16384;
#pragma unroll
    for (int i8 = 0; i8 < 4; ++i8) {
      u32x4 v;
      v.x = pack2(fexp2(gl[i8 * 8 + 0] + offs), fexp2(gl[i8 * 8 + 1] + offs));
      v.y = pack2(fexp2(gl[i8 * 8 + 2] + offs), fexp2(gl[i8 * 8 + 3] + offs));
      v.z = pack2(fexp2(gl[i8 * 8 + 4] + offs), fexp2(gl[i8 * 8 + 5] + offs));
      v.w = pack2(fexp2(gl[i8 * 8 + 6] + offs), fexp2(gl[i8 * 8 + 7] + offs));
      *(u32x4*)(et + sw128(d, half * 4 + i8)) = v;
    }
    if (half == 0)
      ((float*)(p.ws + OFF_DEC))[(((size_t)dir * (MR / 64) + chunk) * 4 + head) * 128 + d] = fexp2(tot + other);
  }
}

struct TileQ {
  unsigned* base;
  int* slot;
  int x, dq, pend;
  bool has_pend;
};
DI int tileq_fetch(TileQ& tq) {
  __syncthreads();
  if (threadIdx.x == 0) {
    int j = tq.has_pend ? tq.pend : (int)__hip_atomic_fetch_add(tq.base + tq.x * 16, 1u, __ATOMIC_RELAXED, __HIP_MEMORY_SCOPE_AGENT);
    *tq.slot = j;
  }
  tq.has_pend = false;
  __syncthreads();
  return *tq.slot;
}
DI void tileq_prefetch(TileQ& tq) {
  if (threadIdx.x == 0) {
    tq.pend = (int)__hip_atomic_fetch_add(tq.base + tq.x * 16, 1u, __ATOMIC_RELAXED, __HIP_MEMORY_SCOPE_AGENT);
  }
  tq.has_pend = true;
}

DI bool tileq_next(TileQ& tq, int pm_n, int NP, int NT, int xcc0, int& mt, int& nt) {
  for (;;) {
    if (tq.dq >= 8) return false;
    const int j = tileq_fetch(tq);
    const int P = (j >> 6) * 8 + tq.x;
    if (P >= NP) { ++tq.dq; tq.x = (xcc0 + tq.dq) & 7; tq.has_pend = false; continue; }
    const int li = j & 63;
    mt = (P % pm_n) * 8 + (li & 7);
    nt = (P / pm_n) * 8 + (li >> 3);
    if (nt >= NT) continue;
    tileq_prefetch(tq);
    return true;
  }
}

DI void phase_gemm_in(const Params& p, int l, char* smem, int inst) {
  const int tid = opaque_tid(), lane = tid & 63, wid = tid >> 6, r = lane & 15, q = lane >> 4;
  const int wx = wid >> 1, wy = wid & 1;
  const bool even = !(l & 1);
  const int ldp = even ? NEV : NOD;
  const int NT = even ? 64 : 56, MT = MR >> 7;
  const bfr* WT = (const bfr*)(p.ws + win_off(l));
  const bfr* H = (const bfr*)(p.ws + OFF_H);
  bfr* proj = (bfr*)(p.ws + OFF_PROJ);
  bfr* VT = (bfr*)(p.ws + OFF_VT);
  const float2* cs = (const float2*)(p.ws + OFF_CS);
  const int pm_n = MT >> 3, NP = pm_n * ((NT + 7) >> 3);
  TileQ tq;
  tq.base = (unsigned*)(p.ws + OFF_BAR) + 34 * 64 + inst * 128;
  tq.slot = (int*)(smem + SMEM_BYTES - 16);
  tq.has_pend = false; tq.pend = 0;
  const int xcc0 = (int)(__builtin_amdgcn_s_getreg((3 << 11) | 20) & 7u);
  if (!even) {
    TileQ lq;
    lq.base = (unsigned*)(p.ws + OFF_BAR) + 34 * 64 + (16 + inst) * 128;
    lq.slot = tq.slot; lq.has_pend = false; lq.pend = 0; lq.x = 0; lq.dq = 0;
    for (;;) {
      const int j = tileq_fetch(lq);
      if (j >= MT) break;
      const int m0 = j * 128, n0 = 7168;
      GemmStage g2;
      gemm_prologue(WT + (size_t)n0 * 1024, 1024, H + (size_t)m0 * 1024, 1024, g2);
      f32x4 acc[4][4];
#pragma unroll
      for (int i = 0; i < 4; ++i)
#pragma unroll
        for (int jj = 0; jj < 4; ++jj) acc[i][jj] = (f32x4){0.f, 0.f, 0.f, 0.f};
      gemm_mainloop(WT + (size_t)n0 * 1024, 1024, H + (size_t)m0 * 1024, 1024, 1024, WT, H, false, smem, acc, g2);
#pragma unroll
      for (int jn = 0; jn < 4; ++jn) {
        const int m = m0 + wy * 64 + jn * 16 + r;
#pragma unroll
        for (int i = 0; i < 4; ++i) {
          const int n = n0 + wx * 64 + i * 16 + 4 * q;
          u32x2 o;
          o.x = pack2(acc[i][jn][0], acc[i][jn][1]);
          o.y = pack2(acc[i][jn][2], acc[i][jn][3]);
          *(u32x2*)(proj + (size_t)m * ldp + n) = o;
        }
      }
      char* sLr = smem;
      float* sHs = (float*)(smem + 8192);
      if (wx == 0) {
#pragma unroll
        for (int jn = 0; jn < 4; ++jn)
#pragma unroll
          for (int i = 0; i < 2; ++i) {
            u32x2 o;
            o.x = pack2(acc[i][jn][0], acc[i][jn][1]);
            o.y = pack2(acc[i][jn][2], acc[i][jn][3]);
            *(u32x2*)(sLr + (wy * 64 + jn * 16 + r) * 64 + (i * 16 + 4 * q) * 2) = o;
          }
      }
      __syncthreads();
      gla_gate_precompute(p, l, m0, sLr, sHs);
      __syncthreads();
    }
  }
  tq.dq = 0; tq.x = xcc0;
  GemmStage gst;
  int mt = 0, nt = 0;
  bool have = tileq_next(tq, pm_n, NP, NT, xcc0, mt, nt);
  bool loaded = false;
  {
   while (have) {
    const int m0 = mt * 128, n0 = nt * 128;
    const bool vt = (n0 >= 1024 && n0 < 2048);
    const bfr* X = vt ? (H + (size_t)m0 * 1024) : (WT + (size_t)n0 * 1024);
    const bfr* Y = vt ? (WT + (size_t)n0 * 1024) : (H + (size_t)m0 * 1024);
    if (!loaded) gemm_prologue(X, 1024, Y, 1024, gst);
    int mtn = 0, ntn = 0;
    const bool haven = tileq_next(tq, pm_n, NP, NT, xcc0, mtn, ntn);
    const bool stream = haven;
    const int m0n = mtn * 128, n0n = ntn * 128;
    const bool vtn = (n0n >= 1024 && n0n < 2048);
    const bfr* Xn = vtn ? (H + (size_t)m0n * 1024) : (WT + (size_t)n0n * 1024);
    const bfr* Yn = vtn ? (WT + (size_t)n0n * 1024) : (H + (size_t)m0n * 1024);
    f32x4 acc[4][4];
#pragma unroll
    for (int i = 0; i < 4; ++i)
#pragma unroll
      for (int j = 0; j < 4; ++j) acc[i][j] = (f32x4){0.f, 0.f, 0.f, 0.f};
    gemm_mainloop(X, 1024, Y, 1024, 1024, Xn, Yn, stream, smem, acc, gst);
    loaded = stream;
    if (vt) {
#pragma unroll
      for (int i = 0; i < 4; ++i) {
        const int mbase = m0 + wx * 64 + i * 16;
        int b, kp;
        if (mbase < ML) { b = mbase >> 12; kp = mbase & 4095; } else { const int mm = mbase - ML; b = mm >> 8; kp = 4096 + (mm & 255); }
        const int pos = (kp & ~31) + q * 8 + ((kp >> 4) & 1) * 4;
#pragma unroll
        for (int jn = 0; jn < 4; ++jn) {
          const int f = n0 - 1024 + wy * 64 + jn * 16 + r;
          u32x2 o;
          o.x = pack2(acc[i][jn][0], acc[i][jn][1]);
          o.y = pack2(acc[i][jn][2], acc[i][jn][3]);
          *(u32x2*)(VT + ((size_t)(b * 1024 + f)) * KEYS + pos) = o;
        }
      }
    } else {
      const bool rope = even && (n0 < 1024 || (n0 >= 2048 && n0 < 3072)) && (m0 < ML);
      if (rope) {
#pragma unroll
        for (int jn = 0; jn < 4; ++jn) {
          asm volatile("" ::: "memory");
          const int m = m0 + wy * 64 + jn * 16 + r;
          const int t = m & 4095;
          const int grow = t >> 6, gcol = t & 63;
#pragma unroll
          for (int j = 0; j < 4; ++j) {
            const float2 a = cs[grow * 16 + 4 * q + j];
            const float2 c = cs[gcol * 16 + 4 * q + j];
            const float x0 = acc[0][jn][j], x1 = acc[1][jn][j], x2 = acc[2][jn][j], x3 = acc[3][jn][j];
            acc[0][jn][j] = x0 * a.x - x1 * a.y;
            acc[1][jn][j] = x1 * a.x + x0 * a.y;
            acc[2][jn][j] = x2 * c.x - x3 * c.y;
            acc[3][jn][j] = x3 * c.x + x2 * c.y;
          }
        }
      }
#pragma unroll
      for (int jn = 0; jn < 4; ++jn) {
        const int m = m0 + wy * 64 + jn * 16 + r;
#pragma unroll
        for (int i = 0; i < 4; ++i) {
          const int n = n0 + wx * 64 + i * 16 + 4 * q;
          u32x2 o;
          o.x = pack2(acc[i][jn][0], acc[i][jn][1]);
          o.y = pack2(acc[i][jn][2], acc[i][jn][3]);
          *(u32x2*)(proj + (size_t)m * ldp + n) = o;
        }
      }
    }
    mt = mtn; nt = ntn; have = haven;
  }
 }
}

DI void phase_gemm_out(const Params& p, int l, char* smem, int inst) {
  const int tid = opaque_tid(), lane = tid & 63, wid = tid >> 6, r = lane & 15, q = lane >> 4;
  const int wx = wid >> 1, wy = wid & 1;
  const bfr* WT = (const bfr*)(p.ws + OFF_WOUT + (size_t)l * SZ_WOUT);
  const bfr* U = (const bfr*)(p.ws + OFF_U);
  bfr* ybuf = (bfr*)(p.ws + OFF_PROJ);
  const int MT = (l == 3) ? (ML >> 7) : (MR >> 7);
  const int pm_n = MT >> 3, NP = pm_n;
  TileQ tq;
  tq.base = (unsigned*)(p.ws + OFF_BAR) + 34 * 64 + inst * 128;
  tq.slot = (int*)(smem + SMEM_BYTES - 16);
  tq.has_pend = false; tq.pend = 0;
  const int xcc0 = (int)(__builtin_amdgcn_s_getreg((3 << 11) | 20) & 7u);
  tq.dq = 0; tq.x = xcc0;
  GemmStage gst;
  int mt = 0, nt = 0;
  bool have = tileq_next(tq, pm_n, NP, 8, xcc0, mt, nt);
  bool loaded = false;
  while (have) {
    const int m0 = mt * 128, n0 = nt * 128;
    const bfr* X = WT + (size_t)n0 * 2048;
    const bfr* Y = U + (size_t)m0 * 2048;
    if (!loaded) gemm_prologue(X, 2048, Y, 2048, gst);
    int mtn = 0, ntn = 0;
    const bool haven = tileq_next(tq, pm_n, NP, 8, xcc0, mtn, ntn);
    const bfr* Xn = WT + (size_t)(ntn * 128) * 2048;
    const bfr* Yn = U + (size_t)(mtn * 128) * 2048;
    f32x4 acc[4][4];
#pragma unroll
    for (int i = 0; i < 4; ++i)
#pragma unroll
      for (int j = 0; j < 4; ++j) acc[i][j] = (f32x4){0.f, 0.f, 0.f, 0.f};
    gemm_mainloop(X, 2048, Y, 2048, 2048, Xn, Yn, haven, smem, acc, gst);
    loaded = haven;
#pragma unroll
    for (int jn = 0; jn < 4; ++jn) {
      const int m = m0 + wy * 64 + jn * 16 + r;
#pragma unroll
      for (int i = 0; i < 4; ++i) {
        const int n = n0 + wx * 64 + i * 16 + 4 * q;
        u32x2 o;
        o.x = pack2(acc[i][jn][0], acc[i][jn][1]);
        o.y = pack2(acc[i][jn][2], acc[i][jn][3]);
        *(u32x2*)(ybuf + (size_t)m * 1024 + n) = o;
      }
    }
    mt = mtn; nt = ntn; have = haven;
  }
}

template <int DV, int QT, int KT, int MODE>
DI void attn_engine(const bfr* __restrict__ qbase, int ldq, const bfr* __restrict__ kbase, int ldk,
                    const bfr* __restrict__ vt, int nloc, int loc_row0, int loc_pos0, int nctx, int ctx_row0,
                    const float* rpb_s, int roff0, char* smem, f32x4 (&O)[DV / 16][QT], float (&lsum)[QT]) {
  constexpr int STAGE = 8192 + DV * 128;
  constexpr int NVL = DV / 32;
  const int tid = opaque_tid(), lane = tid & 63, wid = tid >> 6, r = lane & 15, q = lane >> 4;
  const int lr = tid >> 3, lc = tid & 7;
  constexpr float SC = 0.125f * L2E;

  bf16x8 Qf[QT][2];
#pragma unroll
  for (int qt = 0; qt < QT; ++qt)
#pragma unroll
    for (int s = 0; s < 2; ++s)
      Qf[qt][s] = *(const bf16x8*)(qbase + (size_t)(wid * 16 * QT + qt * 16 + r) * ldq + s * 32 + q * 8);
  float mrun[QT];
#pragma unroll
  for (int qt = 0; qt < QT; ++qt) {
    mrun[qt] = -1e30f;
    lsum[qt] = 0.f;
#pragma unroll
    for (int dt = 0; dt < DV / 16; ++dt) O[dt][qt] = (f32x4){0.f, 0.f, 0.f, 0.f};
  }

  const int nch = nloc + nctx;
  u32x4 kreg0, kreg1, vreg[NVL];
  const int ksw0 = sw128(lr, lc), ksw1 = sw128(lr + 32, lc);
#define AT_LOAD(c_)                                                                                          \
  {                                                                                                          \
    const int cc_ = (c_);                                                                                    \
    const int row_ = (cc_ < nloc) ? (loc_row0 + cc_ * 64) : (ctx_row0 + (cc_ - nloc) * 64);                  \
    const int pos_ = (cc_ < nloc) ? (loc_pos0 + cc_ * 64) : (4096 + (cc_ - nloc) * 64);                      \
    kreg0 = *(const u32x4*)(kbase + (size_t)(row_ + lr) * ldk + lc * 8);                                     \
    kreg1 = *(const u32x4*)(kbase + (size_t)(row_ + lr + 32) * ldk + lc * 8);                                \
    _Pragma("unroll") for (int i_ = 0; i_ < NVL; ++i_)                                                       \
        vreg[i_] = *(const u32x4*)(vt + (size_t)(lr + 32 * i_) * KEYS + pos_ + lc * 8);                      \
  }
#define AT_STORE(c_)                                                                                         \
  {                                                                                                          \
    char* sb_ = smem + ((c_) & 1) * STAGE;                                                                   \
    *(u32x4*)(sb_ + ksw0) = kreg0;                                                                           \
    *(u32x4*)(sb_ + ksw1) = kreg1;                                                                           \
    _Pragma("unroll") for (int i_ = 0; i_ < NVL; ++i_)                                                       \
        *(u32x4*)(sb_ + 8192 + sw128(lr + 32 * i_, lc)) = vreg[i_];                                          \
  }
  if (nch > 0) { AT_LOAD(0); AT_STORE(0); }
  for (int c = 0; c < nch; ++c) {
    __syncthreads();
    const bool more = (c + 1 < nch);
    const char* sK = smem + (c & 1) * STAGE;
    const char* sV = sK + 8192;
    if (more) AT_LOAD(c + 1);
    f32x4 stall[4 / KT][KT][QT];
#pragma unroll
    for (int sbk = 0; sbk < 4 / KT; ++sbk) {
#pragma unroll
      for (int kt = 0; kt < KT; ++kt)
#pragma unroll
        for (int qt = 0; qt < QT; ++qt) stall[sbk][kt][qt] = (f32x4){0.f, 0.f, 0.f, 0.f};
#pragma unroll
      for (int s = 0; s < 2; ++s)
#pragma unroll
        for (int kt = 0; kt < KT; ++kt) {
          const bf16x8 ka = *(const bf16x8*)(sK + sw128(sbk * KT * 16 + kt * 16 + r, s * 4 + q));
#pragma unroll
          for (int qt = 0; qt < QT; ++qt) stall[sbk][kt][qt] = mfma16(ka, Qf[qt][s], stall[sbk][kt][qt]);
        }
    }
#pragma unroll
    for (int sbk = 0; sbk < 4 / KT; ++sbk) {
      f32x4 (&st)[KT][QT] = stall[sbk];
      bf16x8 pb[KT / 2][QT];
      if (MODE == 1) {
#pragma unroll
        for (int kt = 0; kt < KT; ++kt)
#pragma unroll
          for (int qt = 0; qt < QT; ++qt)
#pragma unroll
            for (int j = 0; j < 4; ++j) {
              float v = st[kt][qt][j] * SC;
              if (c < nloc) {
                const int kc = sbk * KT * 16 + kt * 16 + 4 * q + j;
                const int qc = wid * 16 + r;
                int wst = qc - 8; wst = wst < 0 ? 0 : (wst > 48 ? 48 : wst);
                const bool valid = (kc >= wst) && (kc < wst + 16);
                int co = kc - qc + 15; co = co < 0 ? 0 : (co > 30 ? 30 : co);
                const float bias = rpb_s[(roff0 + c) * 31 + co] * L2E;
                v = valid ? (v + bias) : -INFINITY;
              }
              st[kt][qt][j] = v;
            }
      }
#pragma unroll
      for (int qt = 0; qt < QT; ++qt) {
        float mx = max3f(st[0][qt][0], st[0][qt][1], st[0][qt][2]);
        mx = max3f(mx, st[0][qt][3], st[1][qt][0]);
        mx = max3f(mx, st[1][qt][1], st[1][qt][2]);
#pragma unroll
        for (int kt = 2; kt < KT; ++kt) {
          mx = max3f(mx, st[kt - 1][qt][3], st[kt][qt][0]);
          mx = max3f(mx, st[kt][qt][1], st[kt][qt][2]);
        }
        mx = max3f(mx, st[KT - 1][qt][3], st[KT - 1][qt][3]);
        if (MODE != 1) mx *= SC;
        if (__any(mx > mrun[qt] + 8.f)) {
          mx = fmaxf(mx, shx<16>(mx, lane));
          mx = fmaxf(mx, shx<32>(mx, lane));
          const float mnew2 = fmaxf(mrun[qt], mx);
          const float alpha = fexp2(mrun[qt] - mnew2);
          mrun[qt] = mnew2;
          lsum[qt] *= alpha;
#pragma unroll
          for (int dt = 0; dt < DV / 16; ++dt) {
            O[dt][qt][0] *= alpha; O[dt][qt][1] *= alpha; O[dt][qt][2] *= alpha; O[dt][qt][3] *= alpha;
          }
        }
        const float mnew = mrun[qt];
        f32x2_t ps2 = {0.f, 0.f};
#pragma unroll
        for (int kt = 0; kt < KT; ++kt) {
          float e0, e1, e2, e3;
          if (MODE == 1) {
            e0 = fexp2(st[kt][qt][0] - mnew); e1 = fexp2(st[kt][qt][1] - mnew);
            e2 = fexp2(st[kt][qt][2] - mnew); e3 = fexp2(st[kt][qt][3] - mnew);
          } else {
            e0 = fexp2(__builtin_fmaf(st[kt][qt][0], SC, -mnew)); e1 = fexp2(__builtin_fmaf(st[kt][qt][1], SC, -mnew));
            e2 = fexp2(__builtin_fmaf(st[kt][qt][2], SC, -mnew)); e3 = fexp2(__builtin_fmaf(st[kt][qt][3], SC, -mnew));
          }
          st[kt][qt][0] = e0; st[kt][qt][1] = e1; st[kt][qt][2] = e2; st[kt][qt][3] = e3;
          const f32x2_t a01 = {e0, e1}, a23 = {e2, e3};
          ps2 = ps2 + a01;
          ps2 = ps2 + a23;
        }
        lsum[qt] += ps2.x + ps2.y;
#pragma unroll
        for (int ks = 0; ks < KT / 2; ++ks) {
          u32x4 pk;
          pk.x = pack2(st[2 * ks][qt][0], st[2 * ks][qt][1]);
          pk.y = pack2(st[2 * ks][qt][2], st[2 * ks][qt][3]);
          pk.z = pack2(st[2 * ks + 1][qt][0], st[2 * ks + 1][qt][1]);
          pk.w = pack2(st[2 * ks + 1][qt][2], st[2 * ks + 1][qt][3]);
          pb[ks][qt] = __builtin_bit_cast(bf16x8, pk);
        }
      }
#pragma unroll
      for (int dt = 0; dt < DV / 16; ++dt)
#pragma unroll
        for (int ks = 0; ks < KT / 2; ++ks) {
          const bf16x8 va = *(const bf16x8*)(sV + sw128(dt * 16 + r, (sbk * (KT / 2) + ks) * 4 + q));
#pragma unroll
          for (int qt = 0; qt < QT; ++qt) O[dt][qt] = mfma16(va, pb[ks][qt], O[dt][qt]);
        }
    }
    if (more) AT_STORE(c + 1);
  }
#undef AT_LOAD
#undef AT_STORE
  __syncthreads();
#pragma unroll
  for (int qt = 0; qt < QT; ++qt) {
    float L = lsum[qt];
    L += shx<16>(L, lane);
    L += shx<32>(L, lane);
    lsum[qt] = L;
  }
}

DI void diff_attn_item(const Params& p, int l, int b, int head, int qrow0, bool ctxq, char* smem) {
  const int tid = opaque_tid(), lane = tid & 63, wid = tid >> 6, r = lane & 15, q = lane >> 4;
  const bfr* proj = (const bfr*)(p.ws + OFF_PROJ);
  const bfr* VT = (const bfr*)(p.ws + OFF_VT);
  bfr* U = (bfr*)(p.ws + OFF_U);
  const float* lamv = (const float*)(p.ws + OFF_LAM);
  const float lam = lamv[l >> 1], lam_init = lamv[2 + (l >> 1)];
  f32x4 O[8][2];
  float ls[2];
  char* parkb = smem + 49152 + tid * 16;
  attn_engine<128, 2, 2, 0>(proj + (size_t)qrow0 * NEV + 2048 + head * 128, NEV, proj + head * 128, NEV,
                            VT + (size_t)(b * 1024 + head * 128) * KEYS, ctxq ? 0 : 64, b * 4096, 0, 4,
                            ML + b * 256, nullptr, 0, smem, O, ls);
  u32x4 pkr0, pkr1;
  {
    const float i0 = 1.f / ls[0], i1 = 1.f / ls[1];
#pragma unroll
    for (int dt = 0; dt < 8; dt += 2) {
      u32x4 v0, v1;
      v0.x = pack2(O[dt][0][0] * i0, O[dt][0][1] * i0);
      v0.y = pack2(O[dt][0][2] * i0, O[dt][0][3] * i0);
      v0.z = pack2(O[dt + 1][0][0] * i0, O[dt + 1][0][1] * i0);
      v0.w = pack2(O[dt + 1][0][2] * i0, O[dt + 1][0][3] * i0);
      v1.x = pack2(O[dt][1][0] * i1, O[dt][1][1] * i1);
      v1.y = pack2(O[dt][1][2] * i1, O[dt][1][3] * i1);
      v1.z = pack2(O[dt + 1][1][0] * i1, O[dt + 1][1][1] * i1);
      v1.w = pack2(O[dt + 1][1][2] * i1, O[dt + 1][1][3] * i1);
      if (dt < 6) {
        *(u32x4*)(parkb + (dt / 2) * 4096) = v0;
        *(u32x4*)(parkb + (3 + dt / 2) * 4096) = v1;
      } else { pkr0 = v0; pkr1 = v1; }
    }
  }
  attn_engine<128, 2, 2, 0>(proj + (size_t)qrow0 * NEV + 2048 + head * 128 + 64, NEV, proj + head * 128 + 64, NEV,
                            VT + (size_t)(b * 1024 + head * 128) * KEYS, ctxq ? 0 : 64, b * 4096, 0, 4,
                            ML + b * 256, nullptr, 0, smem, O, ls);
  const float* subln = p.ev_subln + (l >> 1) * 128;
#pragma unroll
  for (int qt = 0; qt < 2; ++qt) {
    const float i1 = lam / ls[qt];
    float ss = 0.f;
#pragma unroll
    for (int dt = 0; dt < 8; ++dt) {
      unsigned pa, pc;
      if (dt < 6) {
        const u32x2 pk2 = *(const u32x2*)(parkb + (qt * 3 + dt / 2) * 4096 + (dt & 1) * 8);
        pa = pk2.x; pc = pk2.y;
      } else {
        const u32x4 pr = qt ? pkr1 : pkr0;
        pa = (dt & 1) ? pr.z : pr.x; pc = (dt & 1) ? pr.w : pr.y;
      }
      const float o0 = lo_bf(pa) - O[dt][qt][0] * i1;
      const float o1 = hi_bf(pa) - O[dt][qt][1] * i1;
      const float o2 = lo_bf(pc) - O[dt][qt][2] * i1;
      const float o3 = hi_bf(pc) - O[dt][qt][3] * i1;
      O[dt][qt][0] = o0; O[dt][qt][1] = o1; O[dt][qt][2] = o2; O[dt][qt][3] = o3;
      ss += o0 * o0 + o1 * o1 + o2 * o2 + o3 * o3;
    }
    ss += shx<16>(ss, lane);
    ss += shx<32>(ss, lane);
    const float rn = rsqrtf(ss * (1.f / 128.f) + 1e-6f) * (1.f - lam_init);
    const int row = qrow0 + wid * 32 + qt * 16 + r;
#pragma unroll
    for (int dt = 0; dt < 8; ++dt) {
      const int dv = dt * 16 + 4 * q;
      const u32x2 ag = *(const u32x2*)(proj + (size_t)row * NEV + 3072 + head * 128 + dv);
      const float4 sl = *(const float4*)(subln + dv);
      u32x2 o;
      o.x = pack2(O[dt][qt][0] * rn * sl.x * silu(lo_bf(ag.x)), O[dt][qt][1] * rn * sl.y * silu(hi_bf(ag.x)));
      o.y = pack2(O[dt][qt][2] * rn * sl.z * silu(lo_bf(ag.y)), O[dt][qt][3] * rn * sl.w * silu(hi_bf(ag.y)));
      *(u32x2*)(U + (size_t)row * 2048 + head * 128 + dv) = o;
    }
  }
}

DI void na_item(const Params& p, int l, int b, int head, int rho, bool ctxq, int cq0, char* smem) {
  const int tid = opaque_tid(), lane = tid & 63, wid = tid >> 6, r = lane & 15, q = lane >> 4;
  const bfr* proj = (const bfr*)(p.ws + OFF_PROJ);
  const bfr* VT = (const bfr*)(p.ws + OFF_VT);
  bfr* U = (bfr*)(p.ws + OFF_U);
  float* rpb_s = (float*)(smem + 2 * (8192 + 64 * 128));
  int rs = rho - 4; rs = rs < 0 ? 0 : (rs > 56 ? 56 : rs);
  const int qrow0 = ctxq ? (ML + b * 256 + cq0) : (b * 4096 + rho * 64);
  f32x4 O[4][1];
  float ls[1];
  if (!ctxq) {
    const float* rp = p.od_rpb + ((size_t)(l >> 1) * 16 + head) * 465;
    for (int i = tid; i < 465; i += 256) rpb_s[i] = rp[i];
    attn_engine<64, 1, 4, 1>(proj + (size_t)qrow0 * NOD + 3584 + head * 64, NOD, proj + head * 64, NOD,
                                VT + (size_t)(b * 1024 + head * 64) * KEYS, 8, b * 4096 + rs * 64, rs * 64, 4,
                                ML + b * 256, rpb_s, rs - rho + 7, smem, O, ls);
  } else {
    attn_engine<64, 1, 4, 0>(proj + (size_t)qrow0 * NOD + 3584 + head * 64, NOD, proj + head * 64, NOD,
                                VT + (size_t)(b * 1024 + head * 64) * KEYS, 0, 0, 0, 4, ML + b * 256, nullptr, 0,
                                smem, O, ls);
  }
  const float inv = 1.f / ls[0];
  const int row = qrow0 + wid * 16 + r;
#pragma unroll
  for (int dt = 0; dt < 4; ++dt) {
    const int dv = dt * 16 + 4 * q;
    const u32x2 cgv = *(const u32x2*)(proj + (size_t)row * NOD + 5120 + head * 64 + dv);
    u32x2 o;
    o.x = pack2(O[dt][0][0] * inv * silu(lo_bf(cgv.x)), O[dt][0][1] * inv * silu(hi_bf(cgv.x)));
    o.y = pack2(O[dt][0][2] * inv * silu(lo_bf(cgv.y)), O[dt][0][3] * inv * silu(hi_bf(cgv.y)));
    *(u32x2*)(U + (size_t)row * 2048 + head * 64 + dv) = o;
  }
}

DI void conv_item(const Params& p, int l, int item) {
  const int tid = opaque_tid();
  const bfr* proj = (const bfr*)(p.ws + OFF_PROJ);
  bfr* U = (bfr*)(p.ws + OFF_U);
  const float* cw = p.ev_conv + (size_t)(l >> 1) * 3 * 1024;
#pragma unroll 1
  for (int i = 0; i < 8; ++i) {
    const int v = tid + 256 * i;
    const int ri = v >> 7, ch = (v & 127) * 8;
    const int m = item * 16 + ri;
    int t, T;
    if (m < ML) { t = m & 4095; T = 4096; } else { t = (m - ML) & 255; T = 256; }
    const bfr* pr = proj + (size_t)m * NEV;
    float acc[8];
#pragma unroll
    for (int e = 0; e < 8; ++e) acc[e] = 0.f;
#pragma unroll
    for (int w = 0; w < 3; ++w) {
      const int tt = t + w - 1;
      if (tt >= 0 && tt < T) {
        const bfr* prw = pr + (ptrdiff_t)(w - 1) * NEV;
        const u32x4 bh = *(const u32x4*)(prw + 4096 + ch);
        const u32x4 bc = *(const u32x4*)(prw + 6144 + ch);
        const float4 w0 = *(const float4*)(cw + w * 1024 + ch);
        const float4 w1 = *(const float4*)(cw + w * 1024 + ch + 4);
        acc[0] += w0.x * lo_bf(bh.x) * lo_bf(bc.x); acc[1] += w0.y * hi_bf(bh.x) * hi_bf(bc.x);
        acc[2] += w0.z * lo_bf(bh.y) * lo_bf(bc.y); acc[3] += w0.w * hi_bf(bh.y) * hi_bf(bc.y);
        acc[4] += w1.x * lo_bf(bh.z) * lo_bf(bc.z); acc[5] += w1.y * hi_bf(bh.z) * hi_bf(bc.z);
        acc[6] += w1.z * lo_bf(bh.w) * lo_bf(bc.w); acc[7] += w1.w * hi_bf(bh.w) * hi_bf(bc.w);
      }
    }
    const u32x4 bb = *(const u32x4*)(pr + 5120 + ch);
    const u32x4 bg = *(const u32x4*)(pr + 7168 + ch);
    u32x4 o;
    o.x = pack2(lo_bf(bb.x) * acc[0] * silu(lo_bf(bg.x)), hi_bf(bb.x) * acc[1] * silu(hi_bf(bg.x)));
    o.y = pack2(lo_bf(bb.y) * acc[2] * silu(lo_bf(bg.y)), hi_bf(bb.y) * acc[3] * silu(hi_bf(bg.y)));
    o.z = pack2(lo_bf(bb.z) * acc[4] * silu(lo_bf(bg.z)), hi_bf(bb.z) * acc[5] * silu(hi_bf(bg.z)));
    o.w = pack2(lo_bf(bb.w) * acc[6] * silu(lo_bf(bg.w)), hi_bf(bb.w) * acc[7] * silu(hi_bf(bg.w)));
    *(u32x4*)(U + (size_t)m * 2048 + 1024 + ch) = o;
  }
}

DI void gla_item(const Params& p, int l, int item, char* smem) {
  const int tid0 = opaque_tid();
  const int slice = item & 7, dir = (item >> 3) & 1, head = (item >> 4) & 3, b = item >> 6;
  const bfr* proj = (const bfr*)(p.ws + OFF_PROJ);
  const char* etb = p.ws + (dir ? OFF_ETB : OFF_ETF) + (size_t)head * 16384;
  const float* decb = (const float*)(p.ws + OFF_DEC) + ((size_t)dir * (MR / 64) * 4 + head) * 128;
  char* sQb = smem;
  char* sKc = smem + 16384;
  char* sKbT = smem + 32768;
  char* sVt = smem + 49152;
  char* sAtt = smem + 53248;
  char* sST = smem + 61440;
  float* sDec = (float*)(smem + 77824);
  const float qscale = 0.08838834764831845f;

  f32x4 S[2][2];
#pragma unroll
  for (int a = 0; a < 2; ++a)
#pragma unroll
    for (int c2 = 0; c2 < 2; ++c2) S[a][c2] = (f32x4){0.f, 0.f, 0.f, 0.f};
  __syncthreads();
  for (int i = tid0; i < 512; i += 256) ((u32x4*)sST)[i] = (u32x4){0u, 0u, 0u, 0u};

  u32x4 pq0, pq1, pq2, pq3, pk0, pk1, pk2, pk3, pv, pe0, pe1, pe2, pe3, pdec;
#define GLA_ROW0(ci_) (((ci_) < 4) ? (ML + b * 256 + (dir ? (3 - (ci_)) : (ci_)) * 64) : (b * 4096 + (dir ? (67 - (ci_)) : ((ci_) - 4)) * 64))
#define GLA_LOAD(ci_)                                                                                         \
  {                                                                                                           \
    const int prow = tid >> 4, pch = tid & 15, vs = tid >> 2, vpart = tid & 3;                                \
    const int r0_ = GLA_ROW0(ci_);                                                                            \
    const bfr* pr_ = proj + (size_t)(r0_ + prow) * NOD + head * 128 + pch * 8;                                \
    pq0 = *(const u32x4*)(pr_ + 4608);                     pk0 = *(const u32x4*)(pr_ + 2048);                 \
    pq1 = *(const u32x4*)(pr_ + 4608 + (size_t)16 * NOD);  pk1 = *(const u32x4*)(pr_ + 2048 + (size_t)16 * NOD); \
    pq2 = *(const u32x4*)(pr_ + 4608 + (size_t)32 * NOD);  pk2 = *(const u32x4*)(pr_ + 2048 + (size_t)32 * NOD); \
    pq3 = *(const u32x4*)(pr_ + 4608 + (size_t)48 * NOD);  pk3 = *(const u32x4*)(pr_ + 2048 + (size_t)48 * NOD); \
    pv = *(const u32x4*)(proj + (size_t)(r0_ + vs) * NOD + 2560 + head * 256 + slice * 32 + vpart * 8);       \
    const char* et_ = etb + (size_t)(r0_ >> 6) * 65536 + tid * 16;                                            \
    pe0 = *(const u32x4*)(et_);         pe1 = *(const u32x4*)(et_ + 4096);                                    \
    pe2 = *(const u32x4*)(et_ + 8192);  pe3 = *(const u32x4*)(et_ + 12288);                                   \
    if (tid < 32) pdec = *(const u32x4*)(decb + (size_t)(r0_ >> 6) * 512 + tid * 4);                          \
  }
  { const int tid = tid0; GLA_LOAD(0); }
  for (int ci = 0; ci < 68; ++ci) {
    int tid = tid0; asm volatile("" : "+v"(tid));
    const int lane = tid & 63, wid = tid >> 6, r = lane & 15, q = lane >> 4;
    const int d = tid & 127, half = tid >> 7;
    const int prow = tid >> 4, pch = tid & 15, vs = tid >> 2, vpart = tid & 3;
    const int row0 = GLA_ROW0(ci);
    const char* stc = sST + (ci & 1) * 8192;
    char* stn = sST + ((ci + 1) & 1) * 8192;
    __syncthreads();
    {
      *(u32x4*)(sQb + sw256(prow, pch)) = pq0;       *(u32x4*)(sKc + sw256(prow, pch)) = pk0;
      *(u32x4*)(sQb + sw256(prow + 16, pch)) = pq1;  *(u32x4*)(sKc + sw256(prow + 16, pch)) = pk1;
      *(u32x4*)(sQb + sw256(prow + 32, pch)) = pq2;  *(u32x4*)(sKc + sw256(prow + 32, pch)) = pk2;
      *(u32x4*)(sQb + sw256(prow + 48, pch)) = pq3;  *(u32x4*)(sKc + sw256(prow + 48, pch)) = pk3;
      *(u32x4*)(sKbT + tid * 16) = pe0;              *(u32x4*)(sKbT + tid * 16 + 4096) = pe1;
      *(u32x4*)(sKbT + tid * 16 + 8192) = pe2;       *(u32x4*)(sKbT + tid * 16 + 12288) = pe3;
      if (tid < 32) *(u32x4*)((char*)sDec + tid * 16) = pdec;
      const unsigned vv[4] = {pv.x, pv.y, pv.z, pv.w};
#pragma unroll
      for (int j = 0; j < 4; ++j) {
        const int e0 = vpart * 8 + 2 * j;
        *(bfr*)(sVt + sw128(e0, vs >> 3) + (vs & 7) * 2) = (bfr)(vv[j] & 0xffffu);
        *(bfr*)(sVt + sw128(e0 + 1, vs >> 3) + (vs & 7) * 2) = (bfr)(vv[j] >> 16);
      }
    }
    __syncthreads();
    {
      const float dec = sDec[d];
#pragma unroll
      for (int i8 = 0; i8 < 4; ++i8) {
        const u32x4 ev = *(const u32x4*)(sKbT + sw128(d, half * 4 + i8));
        const unsigned ew[4] = {ev.x, ev.y, ev.z, ev.w};
        unsigned kb[4];
#pragma unroll
        for (int ii = 0; ii < 8; ++ii) {
          const int s = half * 32 + i8 * 8 + ii;
          const float E = (ii & 1) ? hi_bf(ew[ii >> 1]) : lo_bf(ew[ii >> 1]);
          const float Ei = __builtin_amdgcn_rcpf(E);
          bfr* qa_ = (bfr*)(sQb + sw256(s, d >> 3) + (d & 7) * 2);
          bfr* ka_ = (bfr*)(sKc + sw256(s, d >> 3) + (d & 7) * 2);
          const float qv = bf2f(*qa_) * qscale * E;
          const float kc = bf2f(*ka_) * Ei;
          *qa_ = f2bf(qv);
          *ka_ = f2bf(kc);
          const unsigned kbv = f2bf(kc * dec);
          if (ii & 1) kb[ii >> 1] |= kbv << 16; else kb[ii >> 1] = kbv;
        }
        *(u32x4*)(sKbT + sw128(d, half * 4 + i8)) = (u32x4){kb[0], kb[1], kb[2], kb[3]};
      }
    }
    __syncthreads();
    if (ci + 1 < 68) GLA_LOAD(ci + 1);
    {
      f32x4 at[4];
#pragma unroll
      for (int st = 0; st < 4; ++st) at[st] = (f32x4){0.f, 0.f, 0.f, 0.f};
#pragma unroll
      for (int ks = 0; ks < 4; ++ks) {
        const bf16x8 qa = *(const bf16x8*)(sQb + sw256(wid * 16 + r, ks * 4 + q));
#pragma unroll
        for (int st = 0; st < 4; ++st) {
          const bf16x8 kb2 = *(const bf16x8*)(sKc + sw256(st * 16 + r, ks * 4 + q));
          at[st] = mfma16(qa, kb2, at[st]);
        }
      }
#pragma unroll
      for (int st = 0; st < 4; ++st)
#pragma unroll
        for (int j = 0; j < 4; ++j) {
          const int t = wid * 16 + 4 * q + j, s = st * 16 + r;
          const bool keep = dir ? (s >= t) : (s <= t);
          *(bfr*)(sAtt + sw128(t, s >> 3) + (s & 7) * 2) = f2bf(keep ? at[st][j] : 0.f);
        }
    }
    {
#pragma unroll
      for (int dti = 0; dti < 2; ++dti) {
        const float dc = sDec[(2 * wid + dti) * 16 + r];
#pragma unroll
        for (int et = 0; et < 2; ++et) {
          S[et][dti][0] *= dc; S[et][dti][1] *= dc; S[et][dti][2] *= dc; S[et][dti][3] *= dc;
        }
      }
#pragma unroll
      for (int ks = 0; ks < 2; ++ks) {
        bf16x8 va[2], kb2[2];
#pragma unroll
        for (int et = 0; et < 2; ++et) va[et] = *(const bf16x8*)(sVt + sw128(et * 16 + r, ks * 4 + q));
#pragma unroll
        for (int dti = 0; dti < 2; ++dti) kb2[dti] = *(const bf16x8*)(sKbT + sw128((2 * wid + dti) * 16 + r, ks * 4 + q));
#pragma unroll
        for (int et = 0; et < 2; ++et)
#pragma unroll
          for (int dti = 0; dti < 2; ++dti) S[et][dti] = mfma16(va[et], kb2[dti], S[et][dti]);
      }
#pragma unroll
      for (int et = 0; et < 2; ++et)
#pragma unroll
        for (int dti = 0; dti < 2; ++dti)
#pragma unroll
          for (int j = 0; j < 4; ++j) {
            const int e = et * 16 + 4 * q + j, dd = (2 * wid + dti) * 16 + r;
            *(bfr*)(stn + sw256(e, dd >> 3) + (dd & 7) * 2) = f2bf(S[et][dti][j]);
          }
    }
    __syncthreads();
    {
      f32x4 o[2];
      o[0] = (f32x4){0.f, 0.f, 0.f, 0.f};
      o[1] = (f32x4){0.f, 0.f, 0.f, 0.f};
#pragma unroll
      for (int ks = 0; ks < 4; ++ks) {
        const bf16x8 qa = *(const bf16x8*)(sQb + sw256(wid * 16 + r, ks * 4 + q));
#pragma unroll
        for (int et = 0; et < 2; ++et) {
          const bf16x8 sb2 = *(const bf16x8*)(stc + sw256(et * 16 + r, ks * 4 + q));
          o[et] = mfma16(qa, sb2, o[et]);
        }
      }
#pragma unroll
      for (int ks = 0; ks < 2; ++ks) {
        const bf16x8 aa = *(const bf16x8*)(sAtt + sw128(wid * 16 + r, ks * 4 + q));
#pragma unroll
        for (int et = 0; et < 2; ++et) {
          const bf16x8 vb = *(const bf16x8*)(sVt + sw128(et * 16 + r, ks * 4 + q));
          o[et] = mfma16(aa, vb, o[et]);
        }
      }
      {
        const int lam = head * 8 + slice;
#pragma unroll
        for (int j = 0; j < 4; ++j) {
          const int row = row0 + wid * 16 + 4 * q + j;
          const int m2 = row >> 1, par = row & 1;
          bfr* lp = dir ? ((bfr*)(p.ws + OFF_H) + ((size_t)m2 * 32 + lam) * 64)
                        : ((bfr*)(p.ws + OFF_U) + (size_t)(2 * m2 + (lam >> 4)) * 2048 + 1024 + (lam & 15) * 64);
#pragma unroll
          for (int et = 0; et < 2; ++et) lp[par * 32 + et * 16 + r] = f2bf(o[et][j]);
        }
      }
    }
  }
#undef GLA_LOAD
#undef GLA_ROW0
  __syncthreads();
}

DI void phase_gla_combine(const Params& p, int l) {
  const int tid = opaque_tid(), lane = tid & 63, wid = tid >> 6;
  const bfr* proj = (const bfr*)(p.ws + OFF_PROJ);
  const bfr* OB = (const bfr*)(p.ws + OFF_H);
  bfr* U = (bfr*)(p.ws + OFF_U);
  const int h = lane >> 4, e16 = (lane & 15) * 16;
  const int lam = h * 8 + ((lane & 15) >> 1), ein = (lane & 1) * 16;
  const float* gn = p.od_gnorm + (l >> 1) * 256 + e16;
  for (int m2 = blockIdx.x * 4 + wid; m2 < MR / 2; m2 += gridDim.x * 4) {
    const bfr* ofl = U + (size_t)(2 * m2 + (lam >> 4)) * 2048 + 1024 + (lam & 15) * 64 + ein;
    const bfr* obl = OB + ((size_t)m2 * 32 + lam) * 64 + ein;
    u32x4 a[2][2], bq[2][2], g[2][2];
#pragma unroll
    for (int par = 0; par < 2; ++par) {
      a[par][0] = *(const u32x4*)(ofl + par * 32);  a[par][1] = *(const u32x4*)(ofl + par * 32 + 8);
      bq[par][0] = *(const u32x4*)(obl + par * 32); bq[par][1] = *(const u32x4*)(obl + par * 32 + 8);
      const bfr* gp = proj + (size_t)(2 * m2 + par) * NOD + 6144 + h * 256 + e16;
      g[par][0] = *(const u32x4*)gp; g[par][1] = *(const u32x4*)(gp + 8);
    }
    u32x4 res[2][2];
#pragma unroll
    for (int par = 0; par < 2; ++par) {
      float o[16], dg[16];
      float ss = 0.f;
#pragma unroll
      for (int hv = 0; hv < 2; ++hv)
#pragma unroll
        for (int i = 0; i < 4; ++i) {
          const unsigned av = a[par][hv][i], bv = bq[par][hv][i], gv = g[par][hv][i];
          const int k = hv * 8 + i * 2;
          o[k] = lo_bf(av) + lo_bf(bv); o[k + 1] = hi_bf(av) + hi_bf(bv);
          dg[k] = lo_bf(gv); dg[k + 1] = hi_bf(gv);
          ss += o[k] * o[k] + o[k + 1] * o[k + 1];
        }
      ss += shx<1>(ss, lane); ss += shx<2>(ss, lane); ss += shx<4>(ss, lane); ss += shx<8>(ss, lane);
      const float rn = rsqrtf(ss * (1.f / 256.f) + 1e-6f);
#pragma unroll
      for (int hv = 0; hv < 2; ++hv)
#pragma unroll
        for (int i = 0; i < 4; ++i) {
          const int k = hv * 8 + i * 2;
          res[par][hv][i] = pack2(o[k] * rn * gn[k] * silu(dg[k]), o[k + 1] * rn * gn[k + 1] * silu(dg[k + 1]));
        }
    }
#pragma unroll
    for (int par = 0; par < 2; ++par) {
      bfr* up = U + (size_t)(2 * m2 + par) * 2048 + 1024 + h * 256 + e16;
      *(u32x4*)up = res[par][0];
      *(u32x4*)(up + 8) = res[par][1];
    }
  }
}

DI int next_item(int* ctr, int* slot) {
  __syncthreads();
  if (threadIdx.x == 0) *slot = atomicAdd(ctr, 1);
  __syncthreads();
  return *slot;
}

DI void phase_mix_even(const Params& p, int l, int g, char* smem, int coff = 0) {
  int* ctr0 = (int*)(p.ws + OFF_CTR) + ((g * 2 + (l >> 1)) * 8) + coff;
  int* slot = (int*)(smem + SMEM_BYTES - 16);
  const int PER_LAT = GB * 32, PER_CTX = GB * 2, PER_CONV = MR / 16 / 8;
  const int per_q = PER_LAT + PER_CTX + PER_CONV;
  const int myq = (int)(__builtin_amdgcn_s_getreg((3 << 11) | 20) & 7u);
  for (int dq = 0; dq < 8; ++dq) {
    const int x = (myq + dq) & 7;
    for (;;) {
      int it = next_item(ctr0 + x, slot);
      if (it >= per_q) break;
      if (it < PER_LAT) {
        const int qb = it & 31, b = it >> 5;
        diff_attn_item(p, l, b, x, b * 4096 + qb * 128, false, smem);
      } else if (it < PER_LAT + PER_CTX) {
        it -= PER_LAT;
        const int qb = it & 1, b = it >> 1;
        diff_attn_item(p, l, b, x, ML + b * 256 + qb * 128, true, smem);
      } else {
        conv_item(p, l, (it - PER_LAT - PER_CTX) * 8 + x);
      }
    }
  }
}

DI void phase_mix_odd(const Params& p, int l, int g, char* smem) {
  int* ctr = (int*)(p.ws + OFF_CTR) + (g * 4 + l);
  int* slot = (int*)(smem + SMEM_BYTES - 16);
  const int N_GLA = GB * 4 * 2 * 8, N_NA = GB * 16 * 64, N_CTX = (l == 3) ? 0 : GB * 16 * 4;
  const int total = N_GLA + N_NA + N_CTX;
  (void)ctr; (void)slot; (void)total;
  const int nb = gridDim.x, bx = blockIdx.x;
  const int nup = (nb > N_GLA) ? (nb - N_GLA) : 0;
  const int NA_UP = 17;
  for (int k = 0;; ++k) {
    int it;
    if (nup == 0) { it = bx + k * nb; if (it >= total) break; }
    else if (bx < N_GLA) {
      if (k == 0) it = bx;
      else { it = N_GLA + NA_UP * nup + bx + (k - 1) * N_GLA; if (it >= total) break; }
    } else {
      if (k >= NA_UP) break;
      it = N_GLA + (bx - N_GLA) + k * nup;
      if (it >= total) break;
    }
    __syncthreads();
    if (it < N_GLA) {
      __builtin_amdgcn_s_setprio(3);
      gla_item(p, l, it, smem);
      __builtin_amdgcn_s_setprio(0);
    } else if (it < N_GLA + N_NA) {
      it -= N_GLA;
      const int rho = it & 63, bh = it >> 6;
      na_item(p, l, bh >> 4, bh & 15, rho, false, 0, smem);
    } else {
      it -= N_GLA + N_NA;
      const int qb = it & 3, bh = it >> 2;
      na_item(p, l, bh >> 4, bh & 15, 0, true, qb * 64, smem);
    }
  }
}


DI void grid_barrier(unsigned* bar, unsigned& bgen, unsigned xcc, unsigned nxcc, unsigned nx) {
  asm volatile("s_waitcnt vmcnt(0)" ::: "memory");
  __syncthreads();
  const unsigned target = bgen + 1;
  if (threadIdx.x == 0) {
    const unsigned old = __hip_atomic_fetch_add(bar + xcc * 64, 1u, __ATOMIC_RELAXED, __HIP_MEMORY_SCOPE_AGENT);
    if (old == target * nxcc - 1) {
      __builtin_amdgcn_fence(__ATOMIC_RELEASE, "agent");
      asm volatile("s_waitcnt vmcnt(0)" ::: "memory");
      const unsigned o2 = __hip_atomic_fetch_add(bar + 16 * 64, 1u, __ATOMIC_RELAXED, __HIP_MEMORY_SCOPE_AGENT);
      if (o2 == target * nx - 1) __hip_atomic_store(bar + 17 * 64, target, __ATOMIC_RELAXED, __HIP_MEMORY_SCOPE_AGENT);
    }
    while (__hip_atomic_load(bar + 17 * 64, __ATOMIC_RELAXED, __HIP_MEMORY_SCOPE_AGENT) < target) __builtin_amdgcn_s_sleep(1);
    __builtin_amdgcn_fence(__ATOMIC_ACQUIRE, "agent");
    asm volatile("s_waitcnt vmcnt(0)" ::: "memory");
  }
  bgen = target;
  __syncthreads();
}
typedef const __attribute__((address_space(4))) Params* KParamsPtr;
DI Params load_params() {
#if defined(__HIP_DEVICE_COMPILE__)
  KParamsPtr kp = (KParamsPtr)__builtin_amdgcn_kernarg_segment_ptr();
  asm volatile("" : "+s"(kp));
  Params r;
  __builtin_memcpy(&r, kp, sizeof(Params));
  return r;
#else
  return Params{};
#endif
}
#define PH(call) { const Params p = load_params(); call; }
__global__ void __launch_bounds__(256, 2) mega_kernel(Params p_unused) {
  extern __shared__ __attribute__((aligned(16))) char smem[];
  cg::grid_group grid = cg::this_grid();
  unsigned bgen = 0;
  const unsigned xcc = (unsigned)__builtin_amdgcn_s_getreg((3 << 11) | 20) & 15u;
  if (threadIdx.x == 0) {
    const Params pb = load_params();
    __hip_atomic_fetch_add((unsigned*)(pb.ws + OFF_BAR) + (18 + xcc) * 64, 1u, __ATOMIC_RELAXED, __HIP_MEMORY_SCOPE_AGENT);
  }
  PH(phase0(p, smem));
  grid.sync();
  unsigned nxcc = 0, nx = 0;
  {
    const Params pb = load_params();
    const unsigned* cen = (const unsigned*)(pb.ws + OFF_BAR) + 18 * 64;
    for (unsigned j = 0; j < 16; ++j) {
      const unsigned cj = __hip_atomic_load(cen + j * 64, __ATOMIC_RELAXED, __HIP_MEMORY_SCOPE_AGENT);
      nx += (cj != 0);
      if (j == xcc) nxcc = cj;
    }
  }
#define GBAR() { const Params pb = load_params(); grid_barrier((unsigned*)(pb.ws + OFF_BAR), bgen, xcc, nxcc, nx); }
#pragma unroll 1
  for (int g = 0; g < NGRP; ++g) {
#pragma unroll 1
    for (int l = 0; l < 4; ++l) {
      PH(phase_norm(p, l, g));
      GBAR();
      PH(phase_gemm_in(p, l, smem, g * 4 + l));
      GBAR();
      if (l & 1) {
        PH(phase_mix_odd(p, l, g, smem));
        GBAR();
        PH(phase_gla_combine(p, l));
      } else {
        PH(phase_mix_even(p, l, g, smem));
      }
      GBAR();
      PH(phase_gemm_out(p, l, smem, 8 + g * 4 + l));
      GBAR();
    }
    PH(phase_norm(p, 4, g));
    GBAR();
  }
}

extern "C" void kernel_launch(void* const* d_in, const int* in_sizes, int n_in, void* d_out, int out_size, void* d_ws,
                              size_t ws_size, hipStream_t stream) {
  static int grid_blocks = 0;
  if (!grid_blocks) {
    int dev = 0, cus = 0, per_cu = 0;
    hipGetDevice(&dev);
    hipDeviceGetAttribute(&cus, hipDeviceAttributeMultiprocessorCount, dev);
    hipFuncSetAttribute((const void*)mega_kernel, hipFuncAttributeMaxDynamicSharedMemorySize, SMEM_BYTES);
    hipOccupancyMaxActiveBlocksPerMultiprocessor(&per_cu, mega_kernel, 256, SMEM_BYTES);
    if (per_cu > 2) per_cu = 2;
    if (per_cu < 1) per_cu = 1;
    grid_blocks = cus * per_cu;
    grid_blocks &= ~15;
  }
  if (ws_size < WS_NEED) { fprintf(stderr, "workspace too small: %zu < %zu\n", ws_size, (size_t)WS_NEED); return; }
  Params p{};
  p.x = (const float*)d_in[0]; p.c = (const float*)d_in[1]; p.ctx = (const float*)d_in[2]; p.c_ctx = (const float*)d_in[3];
  p.w_mod = (const float*)d_in[4]; p.b_mod = (const float*)d_in[5]; p.g_pre = (const float*)d_in[6]; p.g_post = (const float*)d_in[7];
  p.w_out = (const float*)d_in[8]; p.ev_w_in = (const float*)d_in[9]; p.ev_lambda = (const float*)d_in[10]; p.ev_subln = (const float*)d_in[11];
  p.ev_conv = (const float*)d_in[12]; p.od_w_in = (const float*)d_in[13]; p.od_rpb = (const float*)d_in[14]; p.od_gate_up = (const float*)d_in[15];
  p.od_gate_bias = (const float*)d_in[16]; p.od_gnorm = (const float*)d_in[17];
  p.out = (float*)d_out;
  p.ws = (char*)d_ws;
  (void)hipMemsetAsync((char*)d_ws + OFF_BAR, 0, BAR_BYTES, stream);
  void* args[] = {&p};
  hipError_t e = hipLaunchCooperativeKernel((const void*)mega_kernel, dim3(grid_blocks), dim3(256), args, SMEM_BYTES, stream);
  if (e != hipSuccess) fprintf(stderr, "cooperative launch failed: %s (grid %d)\n", hipGetErrorString(e), grid_blocks);
}
```

```cpp
#include <hip/hip_runtime.h>
#include <hip/hip_cooperative_groups.h>
#include <cstdio>
namespace cg = cooperative_groups;

typedef unsigned short bfr;
typedef __attribute__((ext_vector_type(8))) short bf16x8;
typedef __attribute__((ext_vector_type(4))) float f32x4;
typedef __attribute__((ext_vector_type(4))) unsigned u32x4;
typedef __attribute__((ext_vector_type(2))) unsigned u32x2;
typedef __attribute__((ext_vector_type(16))) unsigned u32x16;
typedef __attribute__((ext_vector_type(2))) __bf16 bf16x2_t;
#define DI __device__ __forceinline__
DI float dot2bf(unsigned a, unsigned b, float c) { return __builtin_amdgcn_fdot2_f32_bf16(__builtin_bit_cast(bf16x2_t, a), __builtin_bit_cast(bf16x2_t, b), c, false); }
DI int opaque_tid() { int t = threadIdx.x; asm volatile("" : "+v"(t)); return t; }

constexpr int GB   = 4;
constexpr int NGRP = 2;
constexpr int ML   = GB * 4096;
constexpr int MC   = GB * 256;
constexpr int MR   = ML + MC;
constexpr int NEV  = 8192;
constexpr int NOD  = 7296;
constexpr int KEYS = 4352;
constexpr float L2E = 1.4426950408889634f;
constexpr float LN2 = 0.6931471805599453f;

constexpr size_t SZ_PROJ = (size_t)MR * 8192 * 2;
constexpr size_t SZ_H    = (size_t)MR * 1024 * 2;
constexpr size_t SZ_U    = (size_t)MR * 2048 * 2;
constexpr size_t SZ_VT   = (size_t)GB * 1024 * KEYS * 2;
constexpr size_t SZ_WE   = (size_t)NEV * 1024 * 2;
constexpr size_t SZ_WO   = (size_t)NOD * 1024 * 2;
constexpr size_t SZ_WOUT = (size_t)1024 * 2048 * 2;
constexpr size_t OFF_PROJ = 0;
constexpr size_t OFF_H    = OFF_PROJ + SZ_PROJ;
constexpr size_t OFF_U    = OFF_H + SZ_H;
constexpr size_t OFF_VT   = OFF_U + SZ_U;
constexpr size_t OFF_WIN  = OFF_VT + SZ_VT;
constexpr size_t OFF_WOUT = OFF_WIN + 2 * SZ_WE + 2 * SZ_WO;
constexpr size_t OFF_XC   = OFF_WOUT + 4 * SZ_WOUT;
constexpr size_t OFF_MOD  = OFF_XC + (size_t)8 * 256 * 1024 * 4;
constexpr size_t OFF_CS   = OFF_MOD + (size_t)4 * 9 * 3072 * 4;
constexpr size_t OFF_LAM  = OFF_CS + 64 * 16 * 8;
constexpr size_t OFF_CTR  = OFF_LAM + 256;
constexpr size_t OFF_BAR  = OFF_CTR + 256;
constexpr size_t BAR_BYTES = 34 * 256 + 192 * 64;
constexpr size_t SZ_ET    = (size_t)(MR / 64) * 4 * 16384;
constexpr size_t OFF_ETF  = OFF_PROJ + (size_t)MR * NOD * 2;
constexpr size_t OFF_ETB  = (OFF_BAR + BAR_BYTES + 255) & ~(size_t)255;
constexpr size_t OFF_DEC  = OFF_ETB + SZ_ET;
constexpr size_t WS_NEED  = OFF_DEC + (size_t)2 * (MR / 64) * 4 * 128 * 4;
static_assert(OFF_ETF + SZ_ET <= OFF_H, "E^T forward tiles must fit behind the odd proj rows");

constexpr int SMEM_BYTES = 80896;

struct Params {
  const float *x, *c, *ctx, *c_ctx, *w_mod, *b_mod, *g_pre, *g_post, *w_out, *ev_w_in, *ev_lambda, *ev_subln,
      *ev_conv, *od_w_in, *od_rpb, *od_gate_up, *od_gate_bias, *od_gnorm;
  float* out;
  char* ws;
};

DI size_t win_off(int l) { return OFF_WIN + (size_t)(l >> 1) * (SZ_WE + SZ_WO) + ((l & 1) ? SZ_WE : 0); }

DI float bf2f(bfr v) { return __uint_as_float(((unsigned)v) << 16); }
typedef __attribute__((ext_vector_type(2))) float f32x2_t;
DI bfr f2bf(float x) { return __builtin_bit_cast(bfr, (__bf16)x); }
DI unsigned pack2(float a, float b) { f32x2_t v = {a, b}; return __builtin_bit_cast(unsigned, __builtin_convertvector(v, bf16x2_t)); }
DI float lo_bf(unsigned u) { return __uint_as_float(u << 16); }
DI float hi_bf(unsigned u) { return __uint_as_float(u & 0xffff0000u); }
DI float fexp2(float x) { return __builtin_amdgcn_exp2f(x); }
DI float flog2(float x) { return __builtin_amdgcn_logf(x); }
DI float silu(float x) { return x / (1.f + fexp2(-x * L2E)); }
DI float max3f(float a, float b, float c) { float r; asm("v_max3_f32 %0, %1, %2, %3" : "=v"(r) : "v"(a), "v"(b), "v"(c)); return r; }
template <int M>
DI float shx(float v, int lane) {
  if (M < 32) return __builtin_bit_cast(float, __builtin_amdgcn_ds_swizzle(__builtin_bit_cast(int, v), (M << 10) | 0x1f));
  return __builtin_bit_cast(float, __builtin_amdgcn_ds_bpermute((lane ^ 32) << 2, __builtin_bit_cast(int, v)));
}
DI float wave_sum(float v, int lane) {
  v += shx<1>(v, lane); v += shx<2>(v, lane); v += shx<4>(v, lane); v += shx<8>(v, lane); v += shx<16>(v, lane); v += shx<32>(v, lane);
  return v;
}
DI f32x4 mfma16(bf16x8 a, bf16x8 b, f32x4 c) { return __builtin_amdgcn_mfma_f32_16x16x32_bf16(a, b, c, 0, 0, 0); }
DI int sw128(int row, int chunk) { return row * 128 + ((chunk ^ ((row >> 1) & 7)) << 4); }
DI int sw256(int row, int chunk) { return row * 256 + ((chunk ^ (row & 15)) << 4); }

DI void store_pair16(bfr* tile_i_ptr, const f32x4& a, const f32x4& b, int q) {
  const unsigned ax = pack2(a[0], a[1]), ay = pack2(a[2], a[3]), bx = pack2(b[0], b[1]), by = pack2(b[2], b[3]);
  const u32x2 r0 = __builtin_amdgcn_permlane16_swap(ax, bx, false, false);
  const u32x2 r1 = __builtin_amdgcn_permlane16_swap(ay, by, false, false);
  *(u32x4*)(tile_i_ptr + (q & 1) * 16 + (q >> 1) * 8) = (u32x4){r0.x, r1.x, r0.y, r1.y};
}

struct GemmStage { u32x4 xa0[4], ya0[4], xa1[4], ya1[4]; };
DI void gemm_prologue(const bfr* __restrict__ X, int ldx, const bfr* __restrict__ Y, int ldy, GemmStage& st) {
  const int tid = opaque_tid();
  const int lr = tid >> 3, lc = tid & 7;
  const bfr* xp = X + (size_t)lr * ldx + lc * 8;
  const bfr* yp = Y + (size_t)lr * ldy + lc * 8;
#pragma unroll
  for (int i = 0; i < 4; ++i) {
    st.xa0[i] = *(const u32x4*)(xp + (size_t)(32 * i) * ldx);
    st.ya0[i] = *(const u32x4*)(yp + (size_t)(32 * i) * ldy);
    st.xa1[i] = *(const u32x4*)(xp + (size_t)(32 * i) * ldx + 64);
    st.ya1[i] = *(const u32x4*)(yp + (size_t)(32 * i) * ldy + 64);
  }
}
DI void gemm_mainloop(const bfr* __restrict__ X, int ldx, const bfr* __restrict__ Y, int ldy, int K,
                      const bfr* __restrict__ Xn, const bfr* __restrict__ Yn, bool hasnext, char* smem,
                      f32x4 (&acc)[4][4], GemmStage& st) {
  const int tid = opaque_tid(), lane = tid & 63, wid = tid >> 6, r = lane & 15, q = lane >> 4;
  const int wx = wid >> 1, wy = wid & 1;
  const int lr = tid >> 3, lc = tid & 7;
  const bfr* xp = X + (size_t)lr * ldx + lc * 8;
  const bfr* yp = Y + (size_t)lr * ldy + lc * 8;
  const bfr* xpn = Xn + (size_t)lr * ldx + lc * 8;
  const bfr* ypn = Yn + (size_t)lr * ldy + lc * 8;
  const int nk = K >> 6;
#define GEMM_STEP(XR, YR, BUF, KT)                                                                       \
  {                                                                                                      \
    char* sX = smem + (BUF) * 32768;                                                                     \
    char* sY = sX + 16384;                                                                               \
    _Pragma("unroll") for (int i = 0; i < 4; ++i) {                                                      \
      *(u32x4*)(sX + sw128(lr + 32 * i, lc)) = XR[i];                                                    \
      *(u32x4*)(sY + sw128(lr + 32 * i, lc)) = YR[i];                                                    \
    }                                                                                                    \
    __syncthreads();                                                                                     \
    if ((KT) + 2 < nk) {                                                                                 \
      const int ko = ((KT) + 2) * 64;                                                                    \
      _Pragma("unroll") for (int i = 0; i < 4; ++i) {                                                    \
        XR[i] = *(const u32x4*)(xp + (size_t)(32 * i) * ldx + ko);                                       \
        YR[i] = *(const u32x4*)(yp + (size_t)(32 * i) * ldy + ko);                                       \
      }                                                                                                  \
    } else if (hasnext) {                                                                                \
      const int ko = ((KT) + 2 - nk) * 64;                                                               \
      _Pragma("unroll") for (int i = 0; i < 4; ++i) {                                                    \
        XR[i] = *(const u32x4*)(xpn + (size_t)(32 * i) * ldx + ko);                                      \
        YR[i] = *(const u32x4*)(ypn + (size_t)(32 * i) * ldy + ko);                                      \
      }                                                                                                  \
    }                                                                                                    \
    _Pragma("unroll") for (int s = 0; s < 2; ++s) {                                                      \
      bf16x8 xf[4], yf[4];                                                                               \
      _Pragma("unroll") for (int i = 0; i < 4; ++i)                                                      \
          xf[i] = *(const bf16x8*)(sX + sw128(wx * 64 + i * 16 + r, s * 4 + q));                         \
      _Pragma("unroll") for (int j = 0; j < 4; ++j)                                                      \
          yf[j] = *(const bf16x8*)(sY + sw128(wy * 64 + j * 16 + r, s * 4 + q));                         \
      __builtin_amdgcn_s_setprio(1);                                                                     \
      _Pragma("unroll") for (int i = 0; i < 4; ++i)                                                      \
          _Pragma("unroll") for (int j = 0; j < 4; ++j) acc[i][j] = mfma16(xf[i], yf[j], acc[i][j]);     \
      __builtin_amdgcn_s_setprio(0);                                                                     \
    }                                                                                                    \
  }
  for (int kt = 0; kt < nk; kt += 2) {
    GEMM_STEP(st.xa0, st.ya0, 0, kt);
    GEMM_STEP(st.xa1, st.ya1, 1, kt + 1);
  }
#undef GEMM_STEP
  __syncthreads();
}

DI bool tile_map(int T, int MT, int NT, int& mt, int& nt) {
  const int pm_n = MT >> 3;
  const int P = (T >> 9) * 8 + (T & 7);
  const int li = (T & 511) >> 3;
  const int pm = P % pm_n, pn = P / pm_n;
  mt = pm * 8 + (li & 7);
  nt = pn * 8 + (li >> 3);
  return nt < NT;
}

DI int odd_col_src(int n) {
  if (n < 3584) return n;
  if (n < 7168) return n + 32;
  if (n < 7200) return n - 7168 + 3584;
  return -1;
}

DI void phase0(const Params& p, char* smem) {
  const int tid = opaque_tid();
  if (blockIdx.x < 384) {
    float* sc = (float*)smem;
    float* red = sc + 9 * 1024;
    for (int i = tid; i < 9 * 1024; i += 256) {
      const int b = i >> 10, k = i & 1023;
      const float v = (b < 8) ? p.c[b * 1024 + k] : p.c_ctx[k];
      sc[i] = v / (1.f + __expf(-v));
    }
    __syncthreads();
    float* modb = (float*)(p.ws + OFF_MOD);
    for (int it = blockIdx.x; it < 384; it += gridDim.x) {
      const int l = it / 96, cgp = it % 96;
      const int col = cgp * 32 + (tid & 31), ks = tid >> 5;
      float a[9];
#pragma unroll
      for (int b = 0; b < 9; ++b) a[b] = 0.f;
      const float* w = p.w_mod + ((size_t)l * 1024 + ks * 128) * 3072 + col;
#pragma unroll 4
      for (int k = 0; k < 128; ++k) {
        const float wv = w[(size_t)k * 3072];
#pragma unroll
        for (int b = 0; b < 9; ++b) a[b] += sc[b * 1024 + ks * 128 + k] * wv;
      }
#pragma unroll
      for (int b = 0; b < 9; ++b) red[(ks * 9 + b) * 32 + (tid & 31)] = a[b];
      __syncthreads();
      for (int idx = tid; idx < 288; idx += 256) {
        const int b = idx >> 5, cc = idx & 31;
        float s = p.b_mod[l * 3072 + cgp * 32 + cc];
#pragma unroll
        for (int k2 = 0; k2 < 8; ++k2) s += red[(k2 * 9 + b) * 32 + cc];
        modb[(size_t)(l * 9 + b) * 3072 + cgp * 32 + cc] = s;
      }
      __syncthreads();
    }
  }
  if (blockIdx.x == gridDim.x - 1) {
    float2* cs = (float2*)(p.ws + OFF_CS);
    for (int idx = tid; idx < 1024; idx += 256) {
      const int pos = idx >> 4, f = idx & 15;
      const float inv = 1.0f / powf(10000.f, (float)f * 0.0625f);
      const float ang = (float)pos * inv;
      const double ad = (double)ang;
      const double n = rint(ad * 0.15915494309189535);
      const float rr = (float)(ad - n * 6.283185307179586);
      cs[idx] = make_float2(__cosf(rr), __sinf(rr));
    }
    if (tid < 2) {
      const float* lp = p.ev_lambda + tid * 256;
      float s1 = 0.f, s2 = 0.f;
      for (int i = 0; i < 64; ++i) { s1 += lp[i] * lp[64 + i]; s2 += lp[128 + i] * lp[192 + i]; }
      const float li = (tid == 0) ? 0.2f : (0.8f - 0.6f * 0.5488116360940264f);
      float* lam = (float*)(p.ws + OFF_LAM);
      lam[tid] = __expf(s1) - __expf(s2) + li;
      lam[2 + tid] = li;
    }
    if (tid < 32) ((int*)(p.ws + OFF_CTR))[tid] = 0;
  }
  float* tile = (float*)smem;
  __syncthreads();
  for (int it = blockIdx.x; it < 9792; it += gridDim.x) {
    int rr = it, l, ktile, ntile, K, Nsrc;
    const float* src;
    bfr* dst;
    bool oddmap = false;
    if (rr < 7744) {
      if (rr < 2048) { l = 0; } else if (rr < 3872) { l = 1; rr -= 2048; } else if (rr < 5920) { l = 2; rr -= 3872; } else { l = 3; rr -= 5920; }
      ktile = rr & 15; ntile = rr >> 4; K = 1024;
      oddmap = (l & 1);
      Nsrc = oddmap ? 7200 : 8192;
      src = (oddmap ? p.od_w_in : p.ev_w_in) + (size_t)(l >> 1) * 1024 * Nsrc;
      dst = (bfr*)(p.ws + win_off(l));
    } else {
      rr -= 7744; l = rr >> 9; rr &= 511;
      ktile = rr & 31; ntile = rr >> 5; K = 2048; Nsrc = 1024;
      src = p.w_out + (size_t)l * 2048 * 1024;
      dst = (bfr*)(p.ws + OFF_WOUT + (size_t)l * SZ_WOUT);
    }
    const int k0 = ktile * 64, n0 = ntile * 64;
    {
      const int nn = tid & 63;
      const int nd = n0 + nn;
      const int ns = oddmap ? odd_col_src(nd) : nd;
#pragma unroll 4
      for (int i = 0; i < 16; ++i) {
        const int kk = (tid >> 6) + 4 * i;
        tile[kk * 65 + nn] = (ns >= 0) ? src[(size_t)(k0 + kk) * Nsrc + ns] : 0.f;
      }
    }
    __syncthreads();
    {
      const int kk8 = (tid & 7) * 8;
#pragma unroll
      for (int i2 = 0; i2 < 2; ++i2) {
        const int nn = (tid >> 3) + 32 * i2;
        u32x4 v;
        v.x = pack2(tile[(kk8 + 0) * 65 + nn], tile[(kk8 + 1) * 65 + nn]);
        v.y = pack2(tile[(kk8 + 2) * 65 + nn], tile[(kk8 + 3) * 65 + nn]);
        v.z = pack2(tile[(kk8 + 4) * 65 + nn], tile[(kk8 + 5) * 65 + nn]);
        v.w = pack2(tile[(kk8 + 6) * 65 + nn], tile[(kk8 + 7) * 65 + nn]);
        *(u32x4*)(dst + (size_t)(n0 + nn) * K + k0 + kk8) = v;
      }
    }
    __syncthreads();
  }
}

DI void phase_norm(const Params& p, int l, int g) {
  const int tid = opaque_tid(), lane = tid & 63, wid = tid >> 6;
  const int rows = (l == 4) ? ML : MR;
  const float* modb = (const float*)(p.ws + OFF_MOD);
  const bfr* ybuf = (const bfr*)(p.ws + OFF_PROJ);
  bfr* hbuf = (bfr*)(p.ws + OFF_H);
  float* xcb = (float*)(p.ws + OFF_XC);
  for (int row = blockIdx.x * 4 + wid; row < rows; row += gridDim.x * 4) {
    const bool lat = row < ML;
    const int mb = lat ? (g * GB + (row >> 12)) : 8;
    const size_t grow = lat ? ((size_t)g * ML + row) : ((size_t)g * MC + (row - ML));
    const float* xin;
    float* xst;
    if (lat) { xin = ((l <= 1) ? p.x : (const float*)p.out) + grow * 1024; xst = p.out + grow * 1024; }
    else     { xin = ((l <= 1) ? p.ctx : (const float*)xcb) + grow * 1024; xst = xcb + grow * 1024; }
    float4 xv[4];
#pragma unroll
    for (int i = 0; i < 4; ++i) xv[i] = *(const float4*)(xin + lane * 4 + 256 * i);
    if (l >= 1) {
      float4 yv[4];
      float ss = 0.f;
#pragma unroll
      for (int i = 0; i < 4; ++i) {
        const u32x2 yr = *(const u32x2*)(ybuf + (size_t)row * 1024 + lane * 4 + 256 * i);
        yv[i] = make_float4(lo_bf(yr.x), hi_bf(yr.x), lo_bf(yr.y), hi_bf(yr.y));
        ss += yv[i].x * yv[i].x + yv[i].y * yv[i].y + yv[i].z * yv[i].z + yv[i].w * yv[i].w;
      }
      ss = wave_sum(ss, lane);
      const float rn = rsqrtf(ss * (1.f / 1024.f) + 1e-6f);
      const float* gate = modb + (size_t)((l - 1) * 9 + mb) * 3072 + 2048;
      const float* gp = p.g_post + (l - 1) * 1024;
#pragma unroll
      for (int i = 0; i < 4; ++i) {
        const int c0 = lane * 4 + 256 * i;
        const float4 gt = *(const float4*)(gate + c0);
        const float4 gg = *(const float4*)(gp + c0);
        xv[i].x += gt.x * (yv[i].x * rn * gg.x);
        xv[i].y += gt.y * (yv[i].y * rn * gg.y);
        xv[i].z += gt.z * (yv[i].z * rn * gg.z);
        xv[i].w += gt.w * (yv[i].w * rn * gg.w);
        *(float4*)(xst + c0) = xv[i];
      }
    }
    if (l < 4) {
      float ss = 0.f;
#pragma unroll
      for (int i = 0; i < 4; ++i) ss += xv[i].x * xv[i].x + xv[i].y * xv[i].y + xv[i].z * xv[i].z + xv[i].w * xv[i].w;
      ss = wave_sum(ss, lane);
      const float rn = rsqrtf(ss * (1.f / 1024.f) + 1e-6f);
      const float* mrow = modb + (size_t)(l * 9 + mb) * 3072;
      const float* gpre = p.g_pre + l * 1024;
#pragma unroll
      for (int i = 0; i < 4; ++i) {
        const int c0 = lane * 4 + 256 * i;
        const float4 sh = *(const float4*)(mrow + c0);
        const float4 scl = *(const float4*)(mrow + 1024 + c0);
        const float4 gg = *(const float4*)(gpre + c0);
        u32x2 o;
        o.x = pack2(xv[i].x * rn * gg.x * (1.f + scl.x) + sh.x, xv[i].y * rn * gg.y * (1.f + scl.y) + sh.y);
        o.y = pack2(xv[i].z * rn * gg.z * (1.f + scl.z) + sh.z, xv[i].w * rn * gg.w * (1.f + scl.w) + sh.w);
        *(u32x2*)(hbuf + (size_t)row * 1024 + c0) = o;
      }
    }
  }
}

DI void gla_gate_precompute(const Params& p, int l, int m0, const char* sLr, float* sHs) {
  const int tid = opaque_tid();
  const int d = tid & 127, half = tid >> 7;
  const int jl = l >> 1;
#pragma unroll 1
  for (int unit = 0; unit < 16; ++unit) {
    const int cc = unit & 1, dir = (unit >> 1) & 1, head = unit >> 2;
    unsigned gu[8];
#pragma unroll
    for (int k = 0; k < 8; ++k)
      gu[k] = pack2(p.od_gate_up[(((size_t)jl * 2 + dir) * 16 + 2 * k) * 512 + head * 128 + d],
                    p.od_gate_up[(((size_t)jl * 2 + dir) * 16 + 2 * k + 1) * 512 + head * 128 + d]);
    const float gbias = p.od_gate_bias[((size_t)jl * 2 + dir) * 512 + head * 128 + d];
    float gl[32];
    float tot = 0.f;
#pragma unroll
    for (int i = 0; i < 32; ++i) {
      const int tk = cc * 64 + half * 32 + i;
      const u32x4 la = *(const u32x4*)(sLr + tk * 64 + dir * 32);
      const u32x4 lb = *(const u32x4*)(sLr + tk * 64 + dir * 32 + 16);
      float z = gbias;
      z = dot2bf(la.x, gu[0], z); z = dot2bf(la.y, gu[1], z); z = dot2bf(la.z, gu[2], z); z = dot2bf(la.w, gu[3], z);
      z = dot2bf(lb.x, gu[4], z); z = dot2bf(lb.y, gu[5], z); z = dot2bf(lb.z, gu[6], z); z = dot2bf(lb.w, gu[7], z);
      const float tneg = fexp2(-fabsf(z) * L2E);
      const float g = (fminf(z, 0.f) - flog2(1.f + tneg) * LN2) * (L2E / 16.f);
      gl[i] = g;
      tot += g;
    }
    if (dir == 0) {
      float run = 0.f;
#pragma unroll
      for (int i = 0; i < 32; ++i) { run += gl[i]; gl[i] = run; }
    } else {
      float run = 0.f;
#pragma unroll
      for (int i = 31; i >= 0; --i) { run += gl[i]; gl[i] = run; }
    }
    __syncthreads();
    sHs[half * 128 + d] = tot;
    __syncthreads();
    const float other = sHs[(1 - half) * 128 + d];
    const float offs = (dir == 0) ? (half ? other : 0.f) : (half ? 0.f : other);
    const int chunk = (m0 >> 6) + cc;
    char* et = p.ws + (dir ? OFF_ETB : OFF_ETF) + ((size_t)chunk * 4 + head) * 16384;
#pragma unroll
    for (int i8 = 0; i8 < 4; ++i8) {
      u32x4 v;
      v.x = pack2(fexp2(gl[i8 * 8 + 0] + offs), fexp2(gl[i8 * 8 + 1] + offs));
      v.y = pack2(fexp2(gl[i8 * 8 + 2] + offs), fexp2(gl[i8 * 8 + 3] + offs));
      v.z = pack2(fexp2(gl[i8 * 8 + 4] + offs), fexp2(gl[i8 * 8 + 5] + offs));
      v.w = pack2(fexp2(gl[i8 * 8 + 6] + offs), fexp2(gl[i8 * 8 + 7] + offs));
      *(u32x4*)(et + sw128(d, half * 4 + i8)) = v;
    }
    if (half == 0)
      ((float*)(p.ws + OFF_DEC))[(((size_t)dir * (MR / 64) + chunk) * 4 + head) * 128 + d] = fexp2(tot + other);
  }
}

struct TileQ {
  unsigned* base;
  int* slot;
  int x, dq, pend;
  bool has_pend;
};
DI int tileq_fetch(TileQ& tq) {
  __syncthreads();
  if (threadIdx.x == 0) {
    int j = tq.has_pend ? tq.pend : (int)__hip_atomic_fetch_add(tq.base + tq.x * 16, 1u, __ATOMIC_RELAXED, __HIP_MEMORY_SCOPE_AGENT);
    *tq.slot = j;
  }
  tq.has_pend = false;
  __syncthreads();
  return *tq.slot;
}
DI void tileq_prefetch(TileQ& tq) {
  if (threadIdx.x == 0) {
    tq.pend = (int)__hip_atomic_fetch_add(tq.base + tq.x * 16, 1u, __ATOMIC_RELAXED, __HIP_MEMORY_SCOPE_AGENT);
  }
  tq.has_pend = true;
}

DI bool tileq_next(TileQ& tq, int pm_n, int NP, int NT, int xcc0, int& mt, int& nt) {
  for (;;) {
    if (tq.dq >= 8) return false;
    const int j = tileq_fetch(tq);
    const int P = (j >> 6) * 8 + tq.x;
    if (P >= NP) { ++tq.dq; tq.x = (xcc0 + tq.dq) & 7; tq.has_pend = false; continue; }
    const int li = j & 63;
    mt = (P % pm_n) * 8 + (li & 7);
    nt = (P / pm_n) * 8 + (li >> 3);
    if (nt >= NT) continue;
    tileq_prefetch(tq);
    return true;
  }
}

DI void phase_gemm_in(const Params& p, int l, char* smem, int inst) {
  const int tid = opaque_tid(), lane = tid & 63, wid = tid >> 6, r = lane & 15, q = lane >> 4;
  const int wx = wid >> 1, wy = wid & 1;
  const bool even = !(l & 1);
  const int ldp = even ? NEV : NOD;
  const int NT = even ? 64 : 56, MT = MR >> 7;
  const bfr* WT = (const bfr*)(p.ws + win_off(l));
  const bfr* H = (const bfr*)(p.ws + OFF_H);
  bfr* proj = (bfr*)(p.ws + OFF_PROJ);
  bfr* VT = (bfr*)(p.ws + OFF_VT);
  const float2* cs = (const float2*)(p.ws + OFF_CS);
  const int pm_n = MT >> 3, NP = pm_n * ((NT + 7) >> 3);
  TileQ tq;
  tq.base = (unsigned*)(p.ws + OFF_BAR) + 34 * 64 + inst * 128;
  tq.slot = (int*)(smem + SMEM_BYTES - 16);
  tq.has_pend = false; tq.pend = 0;
  const int xcc0 = (int)(__builtin_amdgcn_s_getreg((3 << 11) | 20) & 7u);
  if (!even) {
    TileQ lq;
    lq.base = (unsigned*)(p.ws + OFF_BAR) + 34 * 64 + (16 + inst) * 128;
    lq.slot = tq.slot; lq.has_pend = false; lq.pend = 0; lq.x = 0; lq.dq = 0;
    for (;;) {
      const int j = tileq_fetch(lq);
      if (j >= MT) break;
      const int m0 = j * 128, n0 = 7168;
      GemmStage g2;
      gemm_prologue(WT + (size_t)n0 * 1024, 1024, H + (size_t)m0 * 1024, 1024, g2);
      f32x4 acc[4][4];
#pragma unroll
      for (int i = 0; i < 4; ++i)
#pragma unroll
        for (int jj = 0; jj < 4; ++jj) acc[i][jj] = (f32x4){0.f, 0.f, 0.f, 0.f};
      gemm_mainloop(WT + (size_t)n0 * 1024, 1024, H + (size_t)m0 * 1024, 1024, 1024, WT, H, false, smem, acc, g2);
#pragma unroll
      for (int jn = 0; jn < 4; ++jn) {
        const int m = m0 + wy * 64 + jn * 16 + r;
#pragma unroll
        for (int i = 0; i < 4; ++i) {
          const int n = n0 + wx * 64 + i * 16 + 4 * q;
          u32x2 o;
          o.x = pack2(acc[i][jn][0], acc[i][jn][1]);
          o.y = pack2(acc[i][jn][2], acc[i][jn][3]);
          *(u32x2*)(proj + (size_t)m * ldp + n) = o;
        }
      }
      char* sLr = smem;
      float* sHs = (float*)(smem + 8192);
      if (wx == 0) {
#pragma unroll
        for (int jn = 0; jn < 4; ++jn)
#pragma unroll
          for (int i = 0; i < 2; ++i) {
            u32x2 o;
            o.x = pack2(acc[i][jn][0], acc[i][jn][1]);
            o.y = pack2(acc[i][jn][2], acc[i][jn][3]);
            *(u32x2*)(sLr + (wy * 64 + jn * 16 + r) * 64 + (i * 16 + 4 * q) * 2) = o;
          }
      }
      __syncthreads();
      gla_gate_precompute(p, l, m0, sLr, sHs);
      __syncthreads();
    }
  }
  tq.dq = 0; tq.x = xcc0;
  GemmStage gst;
  int mt = 0, nt = 0;
  bool have = tileq_next(tq, pm_n, NP, NT, xcc0, mt, nt);
  bool loaded = false;
  {
   while (have) {
    const int m0 = mt * 128, n0 = nt * 128;
    const bool vt = (n0 >= 1024 && n0 < 2048);
    const bfr* X = vt ? (H + (size_t)m0 * 1024) : (WT + (size_t)n0 * 1024);
    const bfr* Y = vt ? (WT + (size_t)n0 * 1024) : (H + (size_t)m0 * 1024);
    if (!loaded) gemm_prologue(X, 1024, Y, 1024, gst);
    int mtn = 0, ntn = 0;
    const bool haven = tileq_next(tq, pm_n, NP, NT, xcc0, mtn, ntn);
    const bool stream = haven;
    const int m0n = mtn * 128, n0n = ntn * 128;
    const bool vtn = (n0n >= 1024 && n0n < 2048);
    const bfr* Xn = vtn ? (H + (size_t)m0n * 1024) : (WT + (size_t)n0n * 1024);
    const bfr* Yn = vtn ? (WT + (size_t)n0n * 1024) : (H + (size_t)m0n * 1024);
    f32x4 acc[4][4];
#pragma unroll
    for (int i = 0; i < 4; ++i)
#pragma unroll
      for (int j = 0; j < 4; ++j) acc[i][j] = (f32x4){0.f, 0.f, 0.f, 0.f};
    gemm_mainloop(X, 1024, Y, 1024, 1024, Xn, Yn, stream, smem, acc, gst);
    loaded = stream;
    if (vt) {
#pragma unroll
      for (int i = 0; i < 4; i += 2) {
        const int mbase = m0 + wx * 64 + i * 16;
        int b, kp;
        if (mbase < ML) { b = mbase >> 12; kp = mbase & 4095; } else { const int mm = mbase - ML; b = mm >> 8; kp = 4096 + (mm & 255); }
        const int pos = (kp & ~31) + q * 8;
#pragma unroll
        for (int jn = 0; jn < 4; ++jn) {
          const int f = n0 - 1024 + wy * 64 + jn * 16 + r;
          u32x4 o;
          o.x = pack2(acc[i][jn][0], acc[i][jn][1]);
          o.y = pack2(acc[i][jn][2], acc[i][jn][3]);
          o.z = pack2(acc[i + 1][jn][0], acc[i + 1][jn][1]);
          o.w = pack2(acc[i + 1][jn][2], acc[i + 1][jn][3]);
          *(u32x4*)(VT + ((size_t)(b * 1024 + f)) * KEYS + pos) = o;
        }
      }
    } else {
      const bool rope = even && (n0 < 1024 || (n0 >= 2048 && n0 < 3072)) && (m0 < ML);
      if (rope) {
#pragma unroll
        for (int jn = 0; jn < 4; ++jn) {
          asm volatile("" ::: "memory");
          const int m = m0 + wy * 64 + jn * 16 + r;
          const int t = m & 4095;
          const int grow = t >> 6, gcol = t & 63;
#pragma unroll
          for (int j = 0; j < 4; ++j) {
            const float2 a = cs[grow * 16 + 4 * q + j];
            const float2 c = cs[gcol * 16 + 4 * q + j];
            const float x0 = acc[0][jn][j], x1 = acc[1][jn][j], x2 = acc[2][jn][j], x3 = acc[3][jn][j];
            acc[0][jn][j] = x0 * a.x - x1 * a.y;
            acc[1][jn][j] = x1 * a.x + x0 * a.y;
            acc[2][jn][j] = x2 * c.x - x3 * c.y;
            acc[3][jn][j] = x3 * c.x + x2 * c.y;
          }
        }
      }
#pragma unroll
      for (int jn = 0; jn < 4; ++jn) {
        const int m = m0 + wy * 64 + jn * 16 + r;
        bfr* rp = proj + (size_t)m * ldp + n0 + wx * 64;
        store_pair16(rp, acc[0][jn], acc[1][jn], q);
        store_pair16(rp + 32, acc[2][jn], acc[3][jn], q);
      }
    }
    mt = mtn; nt = ntn; have = haven;
  }
 }
}

DI void phase_gemm_out(const Params& p, int l, char* smem, int inst) {
  const int tid = opaque_tid(), lane = tid & 63, wid = tid >> 6, r = lane & 15, q = lane >> 4;
  const int wx = wid >> 1, wy = wid & 1;
  const bfr* WT = (const bfr*)(p.ws + OFF_WOUT + (size_t)l * SZ_WOUT);
  const bfr* U = (const bfr*)(p.ws + OFF_U);
  bfr* ybuf = (bfr*)(p.ws + OFF_PROJ);
  const int MT = (l == 3) ? (ML >> 7) : (MR >> 7);
  const int pm_n = MT >> 3, NP = pm_n;
  TileQ tq;
  tq.base = (unsigned*)(p.ws + OFF_BAR) + 34 * 64 + inst * 128;
  tq.slot = (int*)(smem + SMEM_BYTES - 16);
  tq.has_pend = false; tq.pend = 0;
  const int xcc0 = (int)(__builtin_amdgcn_s_getreg((3 << 11) | 20) & 7u);
  tq.dq = 0; tq.x = xcc0;
  GemmStage gst;
  int mt = 0, nt = 0;
  bool have = tileq_next(tq, pm_n, NP, 8, xcc0, mt, nt);
  bool loaded = false;
  while (have) {
    const int m0 = mt * 128, n0 = nt * 128;
    const bfr* X = WT + (size_t)n0 * 2048;
    const bfr* Y = U + (size_t)m0 * 2048;
    if (!loaded) gemm_prologue(X, 2048, Y, 2048, gst);
    int mtn = 0, ntn = 0;
    const bool haven = tileq_next(tq, pm_n, NP, 8, xcc0, mtn, ntn);
    const bfr* Xn = WT + (size_t)(ntn * 128) * 2048;
    const bfr* Yn = U + (size_t)(mtn * 128) * 2048;
    f32x4 acc[4][4];
#pragma unroll
    for (int i = 0; i < 4; ++i)
#pragma unroll
      for (int j = 0; j < 4; ++j) acc[i][j] = (f32x4){0.f, 0.f, 0.f, 0.f};
    gemm_mainloop(X, 2048, Y, 2048, 2048, Xn, Yn, haven, smem, acc, gst);
    loaded = haven;
#pragma unroll
    for (int jn = 0; jn < 4; ++jn) {
      const int m = m0 + wy * 64 + jn * 16 + r;
      bfr* rp = ybuf + (size_t)m * 1024 + n0 + wx * 64;
      store_pair16(rp, acc[0][jn], acc[1][jn], q);
      store_pair16(rp + 32, acc[2][jn], acc[3][jn], q);
    }
    mt = mtn; nt = ntn; have = haven;
  }
}

template <int DV, int QT, int KT, int MODE>
DI void attn_engine(const bfr* __restrict__ qbase, int ldq, const bfr* __restrict__ kbase, int ldk,
                    const bfr* __restrict__ vt, int nloc, int loc_row0, int loc_pos0, int nctx, int ctx_row0,
                    const float* rpb_s, int roff0, char* smem, f32x4 (&O)[DV / 16][QT], float (&lsum)[QT]) {
  constexpr int STAGE = 8192 + DV * 128;
  constexpr int NVL = DV / 32;
  const int tid = opaque_tid(), lane = tid & 63, wid = tid >> 6, r = lane & 15, q = lane >> 4;
  const int lr = tid >> 3, lc = tid & 7;
  constexpr float SC = 0.125f * L2E;

  bf16x8 Qf[QT][2];
#pragma unroll
  for (int qt = 0; qt < QT; ++qt)
#pragma unroll
    for (int s = 0; s < 2; ++s)
      Qf[qt][s] = *(const bf16x8*)(qbase + (size_t)(wid * 16 * QT + qt * 16 + r) * ldq + s * 32 + q * 8);
  float mrun[QT];
#pragma unroll
  for (int qt = 0; qt < QT; ++qt) {
    mrun[qt] = -1e30f;
    lsum[qt] = 0.f;
#pragma unroll
    for (int dt = 0; dt < DV / 16; ++dt) O[dt][qt] = (f32x4){0.f, 0.f, 0.f, 0.f};
  }

  const int nch = nloc + nctx;
  u32x4 kreg0, kreg1, vreg[NVL];
  const int ksw0 = sw128(lr, lc), ksw1 = sw128(lr + 32, lc);
#define AT_LOAD(c_)                                                                                          \
  {                                                                                                          \
    const int cc_ = (c_);                                                                                    \
    const int row_ = (cc_ < nloc) ? (loc_row0 + cc_ * 64) : (ctx_row0 + (cc_ - nloc) * 64);                  \
    const int pos_ = (cc_ < nloc) ? (loc_pos0 + cc_ * 64) : (4096 + (cc_ - nloc) * 64);                      \
    kreg0 = *(const u32x4*)(kbase + (size_t)(row_ + lr) * ldk + lc * 8);                                     \
    kreg1 = *(const u32x4*)(kbase + (size_t)(row_ + lr + 32) * ldk + lc * 8);                                \
    _Pragma("unroll") for (int i_ = 0; i_ < NVL; ++i_)                                                       \
        vreg[i_] = *(const u32x4*)(vt + (size_t)(lr + 32 * i_) * KEYS + pos_ + lc * 8);                      \
  }
#define AT_STORE(c_)                                                                                         \
  {                                                                                                          \
    char* sb_ = smem + ((c_) & 1) * STAGE;                                                                   \
    *(u32x4*)(sb_ + ksw0) = kreg0;                                                                           \
    *(u32x4*)(sb_ + ksw1) = kreg1;                                                                           \
    _Pragma("unroll") for (int i_ = 0; i_ < NVL; ++i_)                                                       \
        *(u32x4*)(sb_ + 8192 + sw128(lr + 32 * i_, lc)) = vreg[i_];                                          \
  }
  if (nch > 0) { AT_LOAD(0); AT_STORE(0); }
  for (int c = 0; c < nch; ++c) {
    __syncthreads();
    const bool more = (c + 1 < nch);
    const char* sK = smem + (c & 1) * STAGE;
    const char* sV = sK + 8192;
    if (more) AT_LOAD(c + 1);
    f32x4 stall[4 / KT][KT][QT];
#pragma unroll
    for (int sbk = 0; sbk < 4 / KT; ++sbk) {
#pragma unroll
      for (int kt = 0; kt < KT; ++kt)
#pragma unroll
        for (int qt = 0; qt < QT; ++qt) stall[sbk][kt][qt] = (f32x4){0.f, 0.f, 0.f, 0.f};
#pragma unroll
      for (int s = 0; s < 2; ++s)
#pragma unroll
        for (int kt = 0; kt < KT; ++kt) {
          const bf16x8 ka = *(const bf16x8*)(sK + sw128(sbk * KT * 16 + kt * 16 + r, s * 4 + q));
#pragma unroll
          for (int qt = 0; qt < QT; ++qt) stall[sbk][kt][qt] = mfma16(ka, Qf[qt][s], stall[sbk][kt][qt]);
        }
    }
#pragma unroll
    for (int sbk = 0; sbk < 4 / KT; ++sbk) {
      f32x4 (&st)[KT][QT] = stall[sbk];
      bf16x8 pb[KT / 2][QT];
      if (MODE == 1) {
#pragma unroll
        for (int kt = 0; kt < KT; ++kt)
#pragma unroll
          for (int qt = 0; qt < QT; ++qt)
#pragma unroll
            for (int j = 0; j < 4; ++j) {
              float v = st[kt][qt][j] * SC;
              if (c < nloc) {
                const int kc = sbk * KT * 16 + kt * 16 + 4 * q + j;
                const int qc = wid * 16 + r;
                int wst = qc - 8; wst = wst < 0 ? 0 : (wst > 48 ? 48 : wst);
                const bool valid = (kc >= wst) && (kc < wst + 16);
                int co = kc - qc + 15; co = co < 0 ? 0 : (co > 30 ? 30 : co);
                const float bias = rpb_s[(roff0 + c) * 31 + co] * L2E;
                v = valid ? (v + bias) : -INFINITY;
              }
              st[kt][qt][j] = v;
            }
      }
#pragma unroll
      for (int qt = 0; qt < QT; ++qt) {
        float mx = max3f(st[0][qt][0], st[0][qt][1], st[0][qt][2]);
        mx = max3f(mx, st[0][qt][3], st[1][qt][0]);
        mx = max3f(mx, st[1][qt][1], st[1][qt][2]);
#pragma unroll
        for (int kt = 2; kt < KT; ++kt) {
          mx = max3f(mx, st[kt - 1][qt][3], st[kt][qt][0]);
          mx = max3f(mx, st[kt][qt][1], st[kt][qt][2]);
        }
        mx = max3f(mx, st[KT - 1][qt][3], st[KT - 1][qt][3]);
        if (MODE != 1) mx *= SC;
        if (__any(mx > mrun[qt] + 8.f)) {
          mx = fmaxf(mx, shx<16>(mx, lane));
          mx = fmaxf(mx, shx<32>(mx, lane));
          const float mnew2 = fmaxf(mrun[qt], mx);
          const float alpha = fexp2(mrun[qt] - mnew2);
          mrun[qt] = mnew2;
          lsum[qt] *= alpha;
#pragma unroll
          for (int dt = 0; dt < DV / 16; ++dt) {
            O[dt][qt][0] *= alpha; O[dt][qt][1] *= alpha; O[dt][qt][2] *= alpha; O[dt][qt][3] *= alpha;
          }
        }
        const float mnew = mrun[qt];
        f32x2_t ps2 = {0.f, 0.f};
#pragma unroll
        for (int kt = 0; kt < KT; ++kt) {
          float e0, e1, e2, e3;
          if (MODE == 1) {
            e0 = fexp2(st[kt][qt][0] - mnew); e1 = fexp2(st[kt][qt][1] - mnew);
            e2 = fexp2(st[kt][qt][2] - mnew); e3 = fexp2(st[kt][qt][3] - mnew);
          } else {
            e0 = fexp2(__builtin_fmaf(st[kt][qt][0], SC, -mnew)); e1 = fexp2(__builtin_fmaf(st[kt][qt][1], SC, -mnew));
            e2 = fexp2(__builtin_fmaf(st[kt][qt][2], SC, -mnew)); e3 = fexp2(__builtin_fmaf(st[kt][qt][3], SC, -mnew));
          }
          st[kt][qt][0] = e0; st[kt][qt][1] = e1; st[kt][qt][2] = e2; st[kt][qt][3] = e3;
          const f32x2_t a01 = {e0, e1}, a23 = {e2, e3};
          ps2 = ps2 + a01;
          ps2 = ps2 + a23;
        }
        lsum[qt] += ps2.x + ps2.y;
#pragma unroll
        for (int ks = 0; ks < KT / 2; ++ks) {
          u32x4 pk;
          pk.x = pack2(st[2 * ks][qt][0], st[2 * ks][qt][1]);
          pk.y = pack2(st[2 * ks][qt][2], st[2 * ks][qt][3]);
          pk.z = pack2(st[2 * ks + 1][qt][0], st[2 * ks + 1][qt][1]);
          pk.w = pack2(st[2 * ks + 1][qt][2], st[2 * ks + 1][qt][3]);
          pb[ks][qt] = __builtin_bit_cast(bf16x8, pk);
        }
      }
#pragma unroll
      for (int dt = 0; dt < DV / 16; ++dt)
#pragma unroll
        for (int ks = 0; ks < KT / 2; ++ks) {
          const bf16x8 va = *(const bf16x8*)(sV + sw128(dt * 16 + r, (sbk * (KT / 2) + ks) * 4 + q));
#pragma unroll
          for (int qt = 0; qt < QT; ++qt) O[dt][qt] = mfma16(va, pb[ks][qt], O[dt][qt]);
        }
    }
    if (more) AT_STORE(c + 1);
  }
#undef AT_LOAD
#undef AT_STORE
  __syncthreads();
#pragma unroll
  for (int qt = 0; qt < QT; ++qt) {
    float L = lsum[qt];
    L += shx<16>(L, lane);
    L += shx<32>(L, lane);
    lsum[qt] = L;
  }
}

DI void diff_attn_item(const Params& p, int l, int b, int head, int qrow0, bool ctxq, char* smem) {
  const int tid = opaque_tid(), lane = tid & 63, wid = tid >> 6, r = lane & 15, q = lane >> 4;
  const bfr* proj = (const bfr*)(p.ws + OFF_PROJ);
  const bfr* VT = (const bfr*)(p.ws + OFF_VT);
  bfr* U = (bfr*)(p.ws + OFF_U);
  const float* lamv = (const float*)(p.ws + OFF_LAM);
  const float lam = lamv[l >> 1], lam_init = lamv[2 + (l >> 1)];
  f32x4 O[8][2];
  float ls[2];
  char* parkb = smem + 49152 + tid * 16;
  attn_engine<128, 2, 2, 0>(proj + (size_t)qrow0 * NEV + 2048 + head * 128, NEV, proj + head * 128, NEV,
                            VT + (size_t)(b * 1024 + head * 128) * KEYS, ctxq ? 0 : 64, b * 4096, 0, 4,
                            ML + b * 256, nullptr, 0, smem, O, ls);
  u32x4 pkr0, pkr1;
  {
    const float i0 = 1.f / ls[0], i1 = 1.f / ls[1];
#pragma unroll
    for (int dt = 0; dt < 8; dt += 2) {
      u32x4 v0, v1;
      v0.x = pack2(O[dt][0][0] * i0, O[dt][0][1] * i0);
      v0.y = pack2(O[dt][0][2] * i0, O[dt][0][3] * i0);
      v0.z = pack2(O[dt + 1][0][0] * i0, O[dt + 1][0][1] * i0);
      v0.w = pack2(O[dt + 1][0][2] * i0, O[dt + 1][0][3] * i0);
      v1.x = pack2(O[dt][1][0] * i1, O[dt][1][1] * i1);
      v1.y = pack2(O[dt][1][2] * i1, O[dt][1][3] * i1);
      v1.z = pack2(O[dt + 1][1][0] * i1, O[dt + 1][1][1] * i1);
      v1.w = pack2(O[dt + 1][1][2] * i1, O[dt + 1][1][3] * i1);
      if (dt < 6) {
        *(u32x4*)(parkb + (dt / 2) * 4096) = v0;
        *(u32x4*)(parkb + (3 + dt / 2) * 4096) = v1;
      } else { pkr0 = v0; pkr1 = v1; }
    }
  }
  attn_engine<128, 2, 2, 0>(proj + (size_t)qrow0 * NEV + 2048 + head * 128 + 64, NEV, proj + head * 128 + 64, NEV,
                            VT + (size_t)(b * 1024 + head * 128) * KEYS, ctxq ? 0 : 64, b * 4096, 0, 4,
                            ML + b * 256, nullptr, 0, smem, O, ls);
  const float* subln = p.ev_subln + (l >> 1) * 128;
#pragma unroll
  for (int qt = 0; qt < 2; ++qt) {
    const float i1 = lam / ls[qt];
    float ss = 0.f;
#pragma unroll
    for (int dt = 0; dt < 8; ++dt) {
      unsigned pa, pc;
      if (dt < 6) {
        const u32x2 pk2 = *(const u32x2*)(parkb + (qt * 3 + dt / 2) * 4096 + (dt & 1) * 8);
        pa = pk2.x; pc = pk2.y;
      } else {
        const u32x4 pr = qt ? pkr1 : pkr0;
        pa = (dt & 1) ? pr.z : pr.x; pc = (dt & 1) ? pr.w : pr.y;
      }
      const float o0 = lo_bf(pa) - O[dt][qt][0] * i1;
      const float o1 = hi_bf(pa) - O[dt][qt][1] * i1;
      const float o2 = lo_bf(pc) - O[dt][qt][2] * i1;
      const float o3 = hi_bf(pc) - O[dt][qt][3] * i1;
      O[dt][qt][0] = o0; O[dt][qt][1] = o1; O[dt][qt][2] = o2; O[dt][qt][3] = o3;
      ss += o0 * o0 + o1 * o1 + o2 * o2 + o3 * o3;
    }
    ss += shx<16>(ss, lane);
    ss += shx<32>(ss, lane);
    const float rn = rsqrtf(ss * (1.f / 128.f) + 1e-6f) * (1.f - lam_init);
    const int row = qrow0 + wid * 32 + qt * 16 + r;
#pragma unroll
    for (int dt = 0; dt < 8; ++dt) {
      const int dv = dt * 16 + 4 * q;
      const u32x2 ag = *(const u32x2*)(proj + (size_t)row * NEV + 3072 + head * 128 + dv);
      const float4 sl = *(const float4*)(subln + dv);
      u32x2 o;
      o.x = pack2(O[dt][qt][0] * rn * sl.x * silu(lo_bf(ag.x)), O[dt][qt][1] * rn * sl.y * silu(hi_bf(ag.x)));
      o.y = pack2(O[dt][qt][2] * rn * sl.z * silu(lo_bf(ag.y)), O[dt][qt][3] * rn * sl.w * silu(hi_bf(ag.y)));
      *(u32x2*)(U + (size_t)row * 2048 + head * 128 + dv) = o;
    }
  }
}

DI void na_item(const Params& p, int l, int b, int head, int rho, bool ctxq, int cq0, char* smem) {
  const int tid = opaque_tid(), lane = tid & 63, wid = tid >> 6, r = lane & 15, q = lane >> 4;
  const bfr* proj = (const bfr*)(p.ws + OFF_PROJ);
  const bfr* VT = (const bfr*)(p.ws + OFF_VT);
  bfr* U = (bfr*)(p.ws + OFF_U);
  float* rpb_s = (float*)(smem + 2 * (8192 + 64 * 128));
  int rs = rho - 4; rs = rs < 0 ? 0 : (rs > 56 ? 56 : rs);
  const int qrow0 = ctxq ? (ML + b * 256 + cq0) : (b * 4096 + rho * 64);
  f32x4 O[4][1];
  float ls[1];
  if (!ctxq) {
    const float* rp = p.od_rpb + ((size_t)(l >> 1) * 16 + head) * 465;
    for (int i = tid; i < 465; i += 256) rpb_s[i] = rp[i];
    attn_engine<64, 1, 4, 1>(proj + (size_t)qrow0 * NOD + 3584 + head * 64, NOD, proj + head * 64, NOD,
                                VT + (size_t)(b * 1024 + head * 64) * KEYS, 8, b * 4096 + rs * 64, rs * 64, 4,
                                ML + b * 256, rpb_s, rs - rho + 7, smem, O, ls);
  } else {
    attn_engine<64, 1, 4, 0>(proj + (size_t)qrow0 * NOD + 3584 + head * 64, NOD, proj + head * 64, NOD,
                                VT + (size_t)(b * 1024 + head * 64) * KEYS, 0, 0, 0, 4, ML + b * 256, nullptr, 0,
                                smem, O, ls);
  }
  const float inv = 1.f / ls[0];
  const int row = qrow0 + wid * 16 + r;
#pragma unroll
  for (int dt = 0; dt < 4; ++dt) {
    const int dv = dt * 16 + 4 * q;
    const u32x2 cgv = *(const u32x2*)(proj + (size_t)row * NOD + 5120 + head * 64 + dv);
    u32x2 o;
    o.x = pack2(O[dt][0][0] * inv * silu(lo_bf(cgv.x)), O[dt][0][1] * inv * silu(hi_bf(cgv.x)));
    o.y = pack2(O[dt][0][2] * inv * silu(lo_bf(cgv.y)), O[dt][0][3] * inv * silu(hi_bf(cgv.y)));
    *(u32x2*)(U + (size_t)row * 2048 + head * 64 + dv) = o;
  }
}

DI void conv_item(const Params& p, int l, int item) {
  const int tid = opaque_tid();
  const bfr* proj = (const bfr*)(p.ws + OFF_PROJ);
  bfr* U = (bfr*)(p.ws + OFF_U);
  const float* cw = p.ev_conv + (size_t)(l >> 1) * 3 * 1024;
#pragma unroll 1
  for (int i = 0; i < 8; ++i) {
    const int v = tid + 256 * i;
    const int ri = v >> 7, ch = (v & 127) * 8;
    const int m = item * 16 + ri;
    int t, T;
    if (m < ML) { t = m & 4095; T = 4096; } else { t = (m - ML) & 255; T = 256; }
    const bfr* pr = proj + (size_t)m * NEV;
    float acc[8];
#pragma unroll
    for (int e = 0; e < 8; ++e) acc[e] = 0.f;
#pragma unroll
    for (int w = 0; w < 3; ++w) {
      const int tt = t + w - 1;
      if (tt >= 0 && tt < T) {
        const bfr* prw = pr + (ptrdiff_t)(w - 1) * NEV;
        const u32x4 bh = *(const u32x4*)(prw + 4096 + ch);
        const u32x4 bc = *(const u32x4*)(prw + 6144 + ch);
        const float4 w0 = *(const float4*)(cw + w * 1024 + ch);
        const float4 w1 = *(const float4*)(cw + w * 1024 + ch + 4);
        acc[0] += w0.x * lo_bf(bh.x) * lo_bf(bc.x); acc[1] += w0.y * hi_bf(bh.x) * hi_bf(bc.x);
        acc[2] += w0.z * lo_bf(bh.y) * lo_bf(bc.y); acc[3] += w0.w * hi_bf(bh.y) * hi_bf(bc.y);
        acc[4] += w1.x * lo_bf(bh.z) * lo_bf(bc.z); acc[5] += w1.y * hi_bf(bh.z) * hi_bf(bc.z);
        acc[6] += w1.z * lo_bf(bh.w) * lo_bf(bc.w); acc[7] += w1.w * hi_bf(bh.w) * hi_bf(bc.w);
      }
    }
    const u32x4 bb = *(const u32x4*)(pr + 5120 + ch);
    const u32x4 bg = *(const u32x4*)(pr + 7168 + ch);
    u32x4 o;
    o.x = pack2(lo_bf(bb.x) * acc[0] * silu(lo_bf(bg.x)), hi_bf(bb.x) * acc[1] * silu(hi_bf(bg.x)));
    o.y = pack2(lo_bf(bb.y) * acc[2] * silu(lo_bf(bg.y)), hi_bf(bb.y) * acc[3] * silu(hi_bf(bg.y)));
    o.z = pack2(lo_bf(bb.z) * acc[4] * silu(lo_bf(bg.z)), hi_bf(bb.z) * acc[5] * silu(hi_bf(bg.z)));
    o.w = pack2(lo_bf(bb.w) * acc[6] * silu(lo_bf(bg.w)), hi_bf(bb.w) * acc[7] * silu(hi_bf(bg.w)));
    *(u32x4*)(U + (size_t)m * 2048 + 1024 + ch) = o;
  }
}

DI void gla_item(const Params& p, int l, int item, char* smem) {
  const int tid0 = opaque_tid();
  const int slice = item & 7, dir = (item >> 3) & 1, head = (item >> 4) & 3, b = item >> 6;
  const bfr* proj = (const bfr*)(p.ws + OFF_PROJ);
  const char* etb = p.ws + (dir ? OFF_ETB : OFF_ETF) + (size_t)head * 16384;
  const float* decb = (const float*)(p.ws + OFF_DEC) + ((size_t)dir * (MR / 64) * 4 + head) * 128;
  char* sQb = smem;
  char* sKc = smem + 16384;
  char* sKbT = smem + 32768;
  char* sVt = smem + 49152;
  char* sAtt = smem + 53248;
  char* sST = smem + 61440;
  float* sDec = (float*)(smem + 77824);
  const float qscale = 0.08838834764831845f;

  f32x4 S[2][2];
#pragma unroll
  for (int a = 0; a < 2; ++a)
#pragma unroll
    for (int c2 = 0; c2 < 2; ++c2) S[a][c2] = (f32x4){0.f, 0.f, 0.f, 0.f};
  __syncthreads();
  for (int i = tid0; i < 512; i += 256) ((u32x4*)sST)[i] = (u32x4){0u, 0u, 0u, 0u};

  u32x4 pq0, pq1, pq2, pq3, pk0, pk1, pk2, pk3, pv, pe0, pe1, pe2, pe3, pdec;
#define GLA_ROW0(ci_) (((ci_) < 4) ? (ML + b * 256 + (dir ? (3 - (ci_)) : (ci_)) * 64) : (b * 4096 + (dir ? (67 - (ci_)) : ((ci_) - 4)) * 64))
#define GLA_LOAD(ci_)                                                                                         \
  {                                                                                                           \
    const int prow = tid >> 4, pch = tid & 15, vs = tid >> 2, vpart = tid & 3;                                \
    const int r0_ = GLA_ROW0(ci_);                                                                            \
    const bfr* pr_ = proj + (size_t)(r0_ + prow) * NOD + head * 128 + pch * 8;                                \
    pq0 = *(const u32x4*)(pr_ + 4608);                     pk0 = *(const u32x4*)(pr_ + 2048);                 \
    pq1 = *(const u32x4*)(pr_ + 4608 + (size_t)16 * NOD);  pk1 = *(const u32x4*)(pr_ + 2048 + (size_t)16 * NOD); \
    pq2 = *(const u32x4*)(pr_ + 4608 + (size_t)32 * NOD);  pk2 = *(const u32x4*)(pr_ + 2048 + (size_t)32 * NOD); \
    pq3 = *(const u32x4*)(pr_ + 4608 + (size_t)48 * NOD);  pk3 = *(const u32x4*)(pr_ + 2048 + (size_t)48 * NOD); \
    pv = *(const u32x4*)(proj + (size_t)(r0_ + vs) * NOD + 2560 + head * 256 + slice * 32 + vpart * 8);       \
    const char* et_ = etb + (size_t)(r0_ >> 6) * 65536 + tid * 16;                                            \
    pe0 = *(const u32x4*)(et_);         pe1 = *(const u32x4*)(et_ + 4096);                                    \
    pe2 = *(const u32x4*)(et_ + 8192);  pe3 = *(const u32x4*)(et_ + 12288);                                   \
    if (tid < 32) pdec = *(const u32x4*)(decb + (size_t)(r0_ >> 6) * 512 + tid * 4);                          \
  }
  { const int tid = tid0; GLA_LOAD(0); }
  for (int ci = 0; ci < 68; ++ci) {
    int tid = tid0; asm volatile("" : "+v"(tid));
    const int lane = tid & 63, wid = tid >> 6, r = lane & 15, q = lane >> 4;
    const int d = tid & 127, half = tid >> 7;
    const int prow = tid >> 4, pch = tid & 15, vs = tid >> 2, vpart = tid & 3;
    const int row0 = GLA_ROW0(ci);
    const char* stc = sST + (ci & 1) * 8192;
    char* stn = sST + ((ci + 1) & 1) * 8192;
    __syncthreads();
    {
      *(u32x4*)(sQb + sw256(prow, pch)) = pq0;       *(u32x4*)(sKc + sw256(prow, pch)) = pk0;
      *(u32x4*)(sQb + sw256(prow + 16, pch)) = pq1;  *(u32x4*)(sKc + sw256(prow + 16, pch)) = pk1;
      *(u32x4*)(sQb + sw256(prow + 32, pch)) = pq2;  *(u32x4*)(sKc + sw256(prow + 32, pch)) = pk2;
      *(u32x4*)(sQb + sw256(prow + 48, pch)) = pq3;  *(u32x4*)(sKc + sw256(prow + 48, pch)) = pk3;
      *(u32x4*)(sKbT + tid * 16) = pe0;              *(u32x4*)(sKbT + tid * 16 + 4096) = pe1;
      *(u32x4*)(sKbT + tid * 16 + 8192) = pe2;       *(u32x4*)(sKbT + tid * 16 + 12288) = pe3;
      if (tid < 32) *(u32x4*)((char*)sDec + tid * 16) = pdec;
      const unsigned vv[4] = {pv.x, pv.y, pv.z, pv.w};
#pragma unroll
      for (int j = 0; j < 4; ++j) {
        const int e0 = vpart * 8 + 2 * j;
        *(bfr*)(sVt + sw128(e0, vs >> 3) + (vs & 7) * 2) = (bfr)(vv[j] & 0xffffu);
        *(bfr*)(sVt + sw128(e0 + 1, vs >> 3) + (vs & 7) * 2) = (bfr)(vv[j] >> 16);
      }
    }
    __syncthreads();
    {
      const float dec = sDec[d];
#pragma unroll
      for (int i8 = 0; i8 < 4; ++i8) {
        const u32x4 ev = *(const u32x4*)(sKbT + sw128(d, half * 4 + i8));
        const unsigned ew[4] = {ev.x, ev.y, ev.z, ev.w};
        unsigned kb[4];
#pragma unroll
        for (int ii = 0; ii < 8; ++ii) {
          const int s = half * 32 + i8 * 8 + ii;
          const float E = (ii & 1) ? hi_bf(ew[ii >> 1]) : lo_bf(ew[ii >> 1]);
          const float Ei = __builtin_amdgcn_rcpf(E);
          bfr* qa_ = (bfr*)(sQb + sw256(s, d >> 3) + (d & 7) * 2);
          bfr* ka_ = (bfr*)(sKc + sw256(s, d >> 3) + (d & 7) * 2);
          const float qv = bf2f(*qa_) * qscale * E;
          const float kc = bf2f(*ka_) * Ei;
          *qa_ = f2bf(qv);
          *ka_ = f2bf(kc);
          const unsigned kbv = f2bf(kc * dec);
          if (ii & 1) kb[ii >> 1] |= kbv << 16; else kb[ii >> 1] = kbv;
        }
        *(u32x4*)(sKbT + sw128(d, half * 4 + i8)) = (u32x4){kb[0], kb[1], kb[2], kb[3]};
      }
    }
    __syncthreads();
    if (ci + 1 < 68) GLA_LOAD(ci + 1);
    {
      f32x4 at[4];
#pragma unroll
      for (int st = 0; st < 4; ++st) at[st] = (f32x4){0.f, 0.f, 0.f, 0.f};
#pragma unroll
      for (int ks = 0; ks < 4; ++ks) {
        const bf16x8 qa = *(const bf16x8*)(sQb + sw256(wid * 16 + r, ks * 4 + q));
#pragma unroll
        for (int st = 0; st < 4; ++st) {
          const bf16x8 kb2 = *(const bf16x8*)(sKc + sw256(st * 16 + r, ks * 4 + q));
          at[st] = mfma16(qa, kb2, at[st]);
        }
      }
#pragma unroll
      for (int st = 0; st < 4; ++st)
#pragma unroll
        for (int j = 0; j < 4; ++j) {
          const int t = wid * 16 + 4 * q + j, s = st * 16 + r;
          const bool keep = dir ? (s >= t) : (s <= t);
          *(bfr*)(sAtt + sw128(t, s >> 3) + (s & 7) * 2) = f2bf(keep ? at[st][j] : 0.f);
        }
    }
    {
#pragma unroll
      for (int dti = 0; dti < 2; ++dti) {
        const float dc = sDec[(2 * wid + dti) * 16 + r];
#pragma unroll
        for (int et = 0; et < 2; ++et) {
          S[et][dti][0] *= dc; S[et][dti][1] *= dc; S[et][dti][2] *= dc; S[et][dti][3] *= dc;
        }
      }
#pragma unroll
      for (int ks = 0; ks < 2; ++ks) {
        bf16x8 va[2], kb2[2];
#pragma unroll
        for (int et = 0; et < 2; ++et) va[et] = *(const bf16x8*)(sVt + sw128(et * 16 + r, ks * 4 + q));
#pragma unroll
        for (int dti = 0; dti < 2; ++dti) kb2[dti] = *(const bf16x8*)(sKbT + sw128((2 * wid + dti) * 16 + r, ks * 4 + q));
#pragma unroll
        for (int et = 0; et < 2; ++et)
#pragma unroll
          for (int dti = 0; dti < 2; ++dti) S[et][dti] = mfma16(va[et], kb2[dti], S[et][dti]);
      }
#pragma unroll
      for (int et = 0; et < 2; ++et)
#pragma unroll
        for (int dti = 0; dti < 2; ++dti)
#pragma unroll
          for (int j = 0; j < 4; ++j) {
            const int e = et * 16 + 4 * q + j, dd = (2 * wid + dti) * 16 + r;
            *(bfr*)(stn + sw256(e, dd >> 3) + (dd & 7) * 2) = f2bf(S[et][dti][j]);
          }
    }
    __syncthreads();
    {
      f32x4 o[2];
      o[0] = (f32x4){0.f, 0.f, 0.f, 0.f};
      o[1] = (f32x4){0.f, 0.f, 0.f, 0.f};
#pragma unroll
      for (int ks = 0; ks < 4; ++ks) {
        const bf16x8 qa = *(const bf16x8*)(sQb + sw256(wid * 16 + r, ks * 4 + q));
#pragma unroll
        for (int et = 0; et < 2; ++et) {
          const bf16x8 sb2 = *(const bf16x8*)(stc + sw256(et * 16 + r, ks * 4 + q));
          o[et] = mfma16(qa, sb2, o[et]);
        }
      }
#pragma unroll
      for (int ks = 0; ks < 2; ++ks) {
        const bf16x8 aa = *(const bf16x8*)(sAtt + sw128(wid * 16 + r, ks * 4 + q));
#pragma unroll
        for (int et = 0; et < 2; ++et) {
          const bf16x8 vb = *(const bf16x8*)(sVt + sw128(et * 16 + r, ks * 4 + q));
          o[et] = mfma16(aa, vb, o[et]);
        }
      }
      {
        const int lam = head * 8 + slice;
#pragma unroll
        for (int j = 0; j < 4; ++j) {
          const int row = row0 + wid * 16 + 4 * q + j;
          const int m2 = row >> 1, par = row & 1;
          bfr* lp = dir ? ((bfr*)(p.ws + OFF_H) + ((size_t)m2 * 32 + lam) * 64)
                        : ((bfr*)(p.ws + OFF_U) + (size_t)(2 * m2 + (lam >> 4)) * 2048 + 1024 + (lam & 15) * 64);
#pragma unroll
          for (int et = 0; et < 2; ++et) lp[par * 32 + et * 16 + r] = f2bf(o[et][j]);
        }
      }
    }
  }
#undef GLA_LOAD
#undef GLA_ROW0
  __syncthreads();
}

DI void phase_gla_combine(const Params& p, int l) {
  const int tid = opaque_tid(), lane = tid & 63, wid = tid >> 6;
  const bfr* proj = (const bfr*)(p.ws + OFF_PROJ);
  const bfr* OB = (const bfr*)(p.ws + OFF_H);
  bfr* U = (bfr*)(p.ws + OFF_U);
  const int h = lane >> 4, e16 = (lane & 15) * 16;
  const int lam = h * 8 + ((lane & 15) >> 1), ein = (lane & 1) * 16;
  const float* gn = p.od_gnorm + (l >> 1) * 256 + e16;
  for (int m2 = blockIdx.x * 4 + wid; m2 < MR / 2; m2 += gridDim.x * 4) {
    const bfr* ofl = U + (size_t)(2 * m2 + (lam >> 4)) * 2048 + 1024 + (lam & 15) * 64 + ein;
    const bfr* obl = OB + ((size_t)m2 * 32 + lam) * 64 + ein;
    u32x4 a[2][2], bq[2][2], g[2][2];
#pragma unroll
    for (int par = 0; par < 2; ++par) {
      a[par][0] = *(const u32x4*)(ofl + par * 32);  a[par][1] = *(const u32x4*)(ofl + par * 32 + 8);
      bq[par][0] = *(const u32x4*)(obl + par * 32); bq[par][1] = *(const u32x4*)(obl + par * 32 + 8);
      const bfr* gp = proj + (size_t)(2 * m2 + par) * NOD + 6144 + h * 256 + e16;
      g[par][0] = *(const u32x4*)gp; g[par][1] = *(const u32x4*)(gp + 8);
    }
    u32x4 res[2][2];
#pragma unroll
    for (int par = 0; par < 2; ++par) {
      float o[16], dg[16];
      float ss = 0.f;
#pragma unroll
      for (int hv = 0; hv < 2; ++hv)
#pragma unroll
        for (int i = 0; i < 4; ++i) {
          const unsigned av = a[par][hv][i], bv = bq[par][hv][i], gv = g[par][hv][i];
          const int k = hv * 8 + i * 2;
          o[k] = lo_bf(av) + lo_bf(bv); o[k + 1] = hi_bf(av) + hi_bf(bv);
          dg[k] = lo_bf(gv); dg[k + 1] = hi_bf(gv);
          ss += o[k] * o[k] + o[k + 1] * o[k + 1];
        }
      ss += shx<1>(ss, lane); ss += shx<2>(ss, lane); ss += shx<4>(ss, lane); ss += shx<8>(ss, lane);
      const float rn = rsqrtf(ss * (1.f / 256.f) + 1e-6f);
#pragma unroll
      for (int hv = 0; hv < 2; ++hv)
#pragma unroll
        for (int i = 0; i < 4; ++i) {
          const int k = hv * 8 + i * 2;
          res[par][hv][i] = pack2(o[k] * rn * gn[k] * silu(dg[k]), o[k + 1] * rn * gn[k + 1] * silu(dg[k + 1]));
        }
    }
#pragma unroll
    for (int par = 0; par < 2; ++par) {
      bfr* up = U + (size_t)(2 * m2 + par) * 2048 + 1024 + h * 256 + e16;
      *(u32x4*)up = res[par][0];
      *(u32x4*)(up + 8) = res[par][1];
    }
  }
}

DI int next_item(int* ctr, int* slot) {
  __syncthreads();
  if (threadIdx.x == 0) *slot = atomicAdd(ctr, 1);
  __syncthreads();
  return *slot;
}

DI void phase_mix_even(const Params& p, int l, int g, char* smem, int coff = 0) {
  int* ctr0 = (int*)(p.ws + OFF_CTR) + ((g * 2 + (l >> 1)) * 8) + coff;
  int* slot = (int*)(smem + SMEM_BYTES - 16);
  const int PER_LAT = GB * 32, PER_CTX = GB * 2, PER_CONV = MR / 16 / 8;
  const int per_q = PER_LAT + PER_CTX + PER_CONV;
  const int myq = (int)(__builtin_amdgcn_s_getreg((3 << 11) | 20) & 7u);
  for (int dq = 0; dq < 8; ++dq) {
    const int x = (myq + dq) & 7;
    for (;;) {
      int it = next_item(ctr0 + x, slot);
      if (it >= per_q) break;
      if (it < PER_LAT) {
        const int qb = it & 31, b = it >> 5;
        diff_attn_item(p, l, b, x, b * 4096 + qb * 128, false, smem);
      } else if (it < PER_LAT + PER_CTX) {
        it -= PER_LAT;
        const int qb = it & 1, b = it >> 1;
        diff_attn_item(p, l, b, x, ML + b * 256 + qb * 128, true, smem);
      } else {
        conv_item(p, l, (it - PER_LAT - PER_CTX) * 8 + x);
      }
    }
  }
}

DI void phase_mix_odd(const Params& p, int l, int g, char* smem) {
  int* ctr = (int*)(p.ws + OFF_CTR) + (g * 4 + l);
  int* slot = (int*)(smem + SMEM_BYTES - 16);
  const int N_GLA = GB * 4 * 2 * 8, N_NA = GB * 16 * 64, N_CTX = (l == 3) ? 0 : GB * 16 * 4;
  const int total = N_GLA + N_NA + N_CTX;
  (void)ctr; (void)slot; (void)total;
  const int nb = gridDim.x, bx = blockIdx.x;
  const int nup = (nb > N_GLA) ? (nb - N_GLA) : 0;
  const int NA_UP = 17;
  for (int k = 0;; ++k) {
    int it;
    if (nup == 0) { it = bx + k * nb; if (it >= total) break; }
    else if (bx < N_GLA) {
      if (k == 0) it = bx;
      else { it = N_GLA + NA_UP * nup + bx + (k - 1) * N_GLA; if (it >= total) break; }
    } else {
      if (k >= NA_UP) break;
      it = N_GLA + (bx - N_GLA) + k * nup;
      if (it >= total) break;
    }
    __syncthreads();
    if (it < N_GLA) {
      __builtin_amdgcn_s_setprio(3);
      gla_item(p, l, it, smem);
      __builtin_amdgcn_s_setprio(0);
    } else if (it < N_GLA + N_NA) {
      it -= N_GLA;
      const int rho = it & 63, bh = it >> 6;
      na_item(p, l, bh >> 4, bh & 15, rho, false, 0, smem);
    } else {
      it -= N_GLA + N_NA;
      const int qb = it & 3, bh = it >> 2;
      na_item(p, l, bh >> 4, bh & 15, 0, true, qb * 64, smem);
    }
  }
}


DI void grid_barrier(unsigned* bar, unsigned& bgen, unsigned xcc, unsigned nxcc, unsigned nx) {
  asm volatile("s_waitcnt vmcnt(0)" ::: "memory");
  __syncthreads();
  const unsigned target = bgen + 1;
  if (threadIdx.x == 0) {
    const unsigned old = __hip_atomic_fetch_add(bar + xcc * 64, 1u, __ATOMIC_RELAXED, __HIP_MEMORY_SCOPE_AGENT);
    if (old == target * nxcc - 1) {
      __builtin_amdgcn_fence(__ATOMIC_RELEASE, "agent");
      asm volatile("s_waitcnt vmcnt(0)" ::: "memory");
      const unsigned o2 = __hip_atomic_fetch_add(bar + 16 * 64, 1u, __ATOMIC_RELAXED, __HIP_MEMORY_SCOPE_AGENT);
      if (o2 == target * nx - 1) __hip_atomic_store(bar + 17 * 64, target, __ATOMIC_RELAXED, __HIP_MEMORY_SCOPE_AGENT);
    }
    while (__hip_atomic_load(bar + 17 * 64, __ATOMIC_RELAXED, __HIP_MEMORY_SCOPE_AGENT) < target) __builtin_amdgcn_s_sleep(1);
    __builtin_amdgcn_fence(__ATOMIC_ACQUIRE, "agent");
    asm volatile("s_waitcnt vmcnt(0)" ::: "memory");
  }
  bgen = target;
  __syncthreads();
}
typedef const __attribute__((address_space(4))) Params* KParamsPtr;
DI Params load_params() {
#if defined(__HIP_DEVICE_COMPILE__)
  KParamsPtr kp = (KParamsPtr)__builtin_amdgcn_kernarg_segment_ptr();
  asm volatile("" : "+s"(kp));
  Params r;
  __builtin_memcpy(&r, kp, sizeof(Params));
  return r;
#else
  return Params{};
#endif
}
#define PH(call) { const Params p = load_params(); call; }
__global__ void __launch_bounds__(256, 2) mega_kernel(Params p_unused) {
  extern __shared__ __attribute__((aligned(16))) char smem[];
  cg::grid_group grid = cg::this_grid();
  unsigned bgen = 0;
  const unsigned xcc = (unsigned)__builtin_amdgcn_s_getreg((3 << 11) | 20) & 15u;
  if (threadIdx.x == 0) {
    const Params pb = load_params();
    __hip_atomic_fetch_add((unsigned*)(pb.ws + OFF_BAR) + (18 + xcc) * 64, 1u, __ATOMIC_RELAXED, __HIP_MEMORY_SCOPE_AGENT);
  }
  PH(phase0(p, smem));
  grid.sync();
  unsigned nxcc = 0, nx = 0;
  {
    const Params pb = load_params();
    const unsigned* cen = (const unsigned*)(pb.ws + OFF_BAR) + 18 * 64;
    for (unsigned j = 0; j < 16; ++j) {
      const unsigned cj = __hip_atomic_load(cen + j * 64, __ATOMIC_RELAXED, __HIP_MEMORY_SCOPE_AGENT);
      nx += (cj != 0);
      if (j == xcc) nxcc = cj;
    }
  }
#define GBAR() { const Params pb = load_params(); grid_barrier((unsigned*)(pb.ws + OFF_BAR), bgen, xcc, nxcc, nx); }
#pragma unroll 1
  for (int g = 0; g < NGRP; ++g) {
#pragma unroll 1
    for (int l = 0; l < 4; ++l) {
      PH(phase_norm(p, l, g));
      GBAR();
      PH(phase_gemm_in(p, l, smem, g * 4 + l));
      GBAR();
      if (l & 1) {
        PH(phase_mix_odd(p, l, g, smem));
        GBAR();
        PH(phase_gla_combine(p, l));
      } else {
        PH(phase_mix_even(p, l, g, smem));
      }
      GBAR();
      PH(phase_gemm_out(p, l, smem, 8 + g * 4 + l));
      GBAR();
    }
    PH(phase_norm(p, 4, g));
    GBAR();
  }
}

extern "C" void kernel_launch(void* const* d_in, const int* in_sizes, int n_in, void* d_out, int out_size, void* d_ws,
                              size_t ws_size, hipStream_t stream) {
  static int grid_blocks = 0;
  if (!grid_blocks) {
    int dev = 0, cus = 0, per_cu = 0;
    hipGetDevice(&dev);
    hipDeviceGetAttribute(&cus, hipDeviceAttributeMultiprocessorCount, dev);
    hipFuncSetAttribute((const void*)mega_kernel, hipFuncAttributeMaxDynamicSharedMemorySize, SMEM_BYTES);
    hipOccupancyMaxActiveBlocksPerMultiprocessor(&per_cu, mega_kernel, 256, SMEM_BYTES);
    if (per_cu > 2) per_cu = 2;
    if (per_cu < 1) per_cu = 1;
    grid_blocks = cus * per_cu;
    grid_blocks &= ~15;
  }
  if (ws_size < WS_NEED) { fprintf(stderr, "workspace too small: %zu < %zu\n", ws_size, (size_t)WS_NEED); return; }
  Params p{};
  p.x = (const float*)d_in[0]; p.c = (const float*)d_in[1]; p.ctx = (const float*)d_in[2]; p.c_ctx = (const float*)d_in[3];
  p.w_mod = (const float*)d_in[4]; p.b_mod = (const float*)d_in[5]; p.g_pre = (const float*)d_in[6]; p.g_post = (const float*)d_in[7];
  p.w_out = (const float*)d_in[8]; p.ev_w_in = (const float*)d_in[9]; p.ev_lambda = (const float*)d_in[10]; p.ev_subln = (const float*)d_in[11];
  p.ev_conv = (const float*)d_in[12]; p.od_w_in = (const float*)d_in[13]; p.od_rpb = (const float*)d_in[14]; p.od_gate_up = (const float*)d_in[15];
  p.od_gate_bias = (const float*)d_in[16]; p.od_gnorm = (const float*)d_in[17];
  p.out = (float*)d_out;
  p.ws = (char*)d_ws;
  (void)hipMemsetAsync((char*)d_ws + OFF_BAR, 0, BAR_BYTES, stream);
  void* args[] = {&p};
  hipError_t e = hipLaunchCooperativeKernel((const void*)mega_kernel, dim3(grid_blocks), dim3(256), args, SMEM_BYTES, stream);
  if (e != hipSuccess) fprintf(stderr, "cooperative launch failed: %s (grid %d)\n", hipGetErrorString(e), grid_blocks);
}
```

```cpp
#include <hip/hip_runtime.h>
#include <hip/hip_cooperative_groups.h>
#include <cstdio>
namespace cg = cooperative_groups;

typedef unsigned short bfr;
typedef __attribute__((ext_vector_type(8))) short bf16x8;
typedef __attribute__((ext_vector_type(4))) float f32x4;
typedef __attribute__((ext_vector_type(4))) unsigned u32x4;
typedef __attribute__((ext_vector_type(2))) unsigned u32x2;
typedef __attribute__((ext_vector_type(16))) unsigned u32x16;
typedef __attribute__((ext_vector_type(2))) __bf16 bf16x2_t;
#define DI __device__ __forceinline__
DI float dot2bf(unsigned a, unsigned b, float c) { return __builtin_amdgcn_fdot2_f32_bf16(__builtin_bit_cast(bf16x2_t, a), __builtin_bit_cast(bf16x2_t, b), c, false); }
DI int opaque_tid() { int t = threadIdx.x; asm volatile("" : "+v"(t)); return t; }

constexpr int GB   = 4;
constexpr int NGRP = 2;
constexpr int ML   = GB * 4096;
constexpr int MC   = GB * 256;
constexpr int MR   = ML + MC;
constexpr int NEV  = 8192;
constexpr int NOD  = 7296;
constexpr int KEYS = 4352;
constexpr float L2E = 1.4426950408889634f;
constexpr float LN2 = 0.6931471805599453f;

constexpr size_t SZ_PROJ = (size_t)MR * 8192 * 2;
constexpr size_t SZ_H    = (size_t)MR * 1024 * 2;
constexpr size_t SZ_U    = (size_t)MR * 2048 * 2;
constexpr size_t SZ_VT   = (size_t)GB * 1024 * KEYS * 2;
constexpr size_t SZ_WE   = (size_t)NEV * 1024 * 2;
constexpr size_t SZ_WO   = (size_t)NOD * 1024 * 2;
constexpr size_t SZ_WOUT = (size_t)1024 * 2048 * 2;
constexpr size_t OFF_PROJ = 0;
constexpr size_t OFF_H    = OFF_PROJ + SZ_PROJ;
constexpr size_t OFF_U    = OFF_H + SZ_H;
constexpr size_t OFF_VT   = OFF_U + SZ_U;
constexpr size_t OFF_WIN  = OFF_VT + SZ_VT;
constexpr size_t OFF_WOUT = OFF_WIN + 2 * SZ_WE + 2 * SZ_WO;
constexpr size_t OFF_XC   = OFF_WOUT + 4 * SZ_WOUT;
constexpr size_t OFF_MOD  = OFF_XC + (size_t)8 * 256 * 1024 * 4;
constexpr size_t OFF_CS   = OFF_MOD + (size_t)4 * 9 * 3072 * 4;
constexpr size_t OFF_LAM  = OFF_CS + 64 * 16 * 8;
constexpr size_t OFF_CTR  = OFF_LAM + 256;
constexpr size_t OFF_BAR  = OFF_CTR + 256;
constexpr size_t BAR_BYTES = 34 * 256 + 192 * 64;
constexpr size_t SZ_ET    = (size_t)(MR / 64) * 4 * 16384;
constexpr size_t OFF_ETF  = OFF_PROJ + (size_t)MR * NOD * 2;
constexpr size_t OFF_ETB  = (OFF_BAR + BAR_BYTES + 255) & ~(size_t)255;
constexpr size_t OFF_DEC  = OFF_ETB + SZ_ET;
constexpr size_t WS_NEED  = OFF_DEC + (size_t)2 * (MR / 64) * 4 * 128 * 4;
static_assert(OFF_ETF + SZ_ET <= OFF_H, "E^T forward tiles must fit behind the odd proj rows");

constexpr int SMEM_BYTES = 80896;

struct Params {
  const float *x, *c, *ctx, *c_ctx, *w_mod, *b_mod, *g_pre, *g_post, *w_out, *ev_w_in, *ev_lambda, *ev_subln,
      *ev_conv, *od_w_in, *od_rpb, *od_gate_up, *od_gate_bias, *od_gnorm;
  float* out;
  char* ws;
};

DI size_t win_off(int l) { return OFF_WIN + (size_t)(l >> 1) * (SZ_WE + SZ_WO) + ((l & 1) ? SZ_WE : 0); }

DI float bf2f(bfr v) { return __uint_as_float(((unsigned)v) << 16); }
typedef __attribute__((ext_vector_type(2))) float f32x2_t;
DI bfr f2bf(float x) { return __builtin_bit_cast(bfr, (__bf16)x); }
DI unsigned pack2(float a, float b) { f32x2_t v = {a, b}; return __builtin_bit_cast(unsigned, __builtin_convertvector(v, bf16x2_t)); }
DI float lo_bf(unsigned u) { return __uint_as_float(u << 16); }
DI float hi_bf(unsigned u) { return __uint_as_float(u & 0xffff0000u); }
DI float fexp2(float x) { return __builtin_amdgcn_exp2f(x); }
DI float flog2(float x) { return __builtin_amdgcn_logf(x); }
DI float silu(float x) { return x / (1.f + fexp2(-x * L2E)); }
DI float max3f(float a, float b, float c) { float r; asm("v_max3_f32 %0, %1, %2, %3" : "=v"(r) : "v"(a), "v"(b), "v"(c)); return r; }
template <int M>
DI float shx(float v, int lane) {
  if (M < 32) return __builtin_bit_cast(float, __builtin_amdgcn_ds_swizzle(__builtin_bit_cast(int, v), (M << 10) | 0x1f));
  return __builtin_bit_cast(float, __builtin_amdgcn_ds_bpermute((lane ^ 32) << 2, __builtin_bit_cast(int, v)));
}
DI float wave_sum(float v, int lane) {
  v += shx<1>(v, lane); v += shx<2>(v, lane); v += shx<4>(v, lane); v += shx<8>(v, lane); v += shx<16>(v, lane); v += shx<32>(v, lane);
  return v;
}
DI f32x4 mfma16(bf16x8 a, bf16x8 b, f32x4 c) { return __builtin_amdgcn_mfma_f32_16x16x32_bf16(a, b, c, 0, 0, 0); }
DI int sw128(int row, int chunk) { return row * 128 + ((chunk ^ ((row >> 1) & 7)) << 4); }
DI int sw256(int row, int chunk) { return row * 256 + ((chunk ^ (row & 15)) << 4); }

DI void store_pair16(bfr* tile_i_ptr, const f32x4& a, const f32x4& b, int q) {
  const unsigned ax = pack2(a[0], a[1]), ay = pack2(a[2], a[3]), bx = pack2(b[0], b[1]), by = pack2(b[2], b[3]);
  const u32x2 r0 = __builtin_amdgcn_permlane16_swap(ax, bx, false, false);
  const u32x2 r1 = __builtin_amdgcn_permlane16_swap(ay, by, false, false);
  *(u32x4*)(tile_i_ptr + (q & 1) * 16 + (q >> 1) * 8) = (u32x4){r0.x, r1.x, r0.y, r1.y};
}

struct GemmStage { u32x4 xa0[4], ya0[4], xa1[4], ya1[4]; };
DI void gemm_prologue(const bfr* __restrict__ X, int ldx, const bfr* __restrict__ Y, int ldy, GemmStage& st) {
  const int tid = opaque_tid();
  const int lr = tid >> 3, lc = tid & 7;
  const bfr* xp = X + (size_t)lr * ldx + lc * 8;
  const bfr* yp = Y + (size_t)lr * ldy + lc * 8;
#pragma unroll
  for (int i = 0; i < 4; ++i) {
    st.xa0[i] = *(const u32x4*)(xp + (size_t)(32 * i) * ldx);
    st.ya0[i] = *(const u32x4*)(yp + (size_t)(32 * i) * ldy);
    st.xa1[i] = *(const u32x4*)(xp + (size_t)(32 * i) * ldx + 64);
    st.ya1[i] = *(const u32x4*)(yp + (size_t)(32 * i) * ldy + 64);
  }
}
DI void gemm_mainloop(const bfr* __restrict__ X, int ldx, const bfr* __restrict__ Y, int ldy, int K,
                      const bfr* __restrict__ Xn, const bfr* __restrict__ Yn, bool hasnext, char* smem,
                      f32x4 (&acc)[4][4], GemmStage& st) {
  const int tid = opaque_tid(), lane = tid & 63, wid = tid >> 6, r = lane & 15, q = lane >> 4;
  const int wx = wid >> 1, wy = wid & 1;
  const int lr = tid >> 3, lc = tid & 7;
  const bfr* xp = X + (size_t)lr * ldx + lc * 8;
  const bfr* yp = Y + (size_t)lr * ldy + lc * 8;
  const bfr* xpn = Xn + (size_t)lr * ldx + lc * 8;
  const bfr* ypn = Yn + (size_t)lr * ldy + lc * 8;
  const int nk = K >> 6;
#define GEMM_STEP(XR, YR, BUF, KT)                                                                       \
  {                                                                                                      \
    char* sX = smem + (BUF) * 32768;                                                                     \
    char* sY = sX + 16384;                                                                               \
    _Pragma("unroll") for (int i = 0; i < 4; ++i) {                                                      \
      *(u32x4*)(sX + sw128(lr + 32 * i, lc)) = XR[i];                                                    \
      *(u32x4*)(sY + sw128(lr + 32 * i, lc)) = YR[i];                                                    \
    }                                                                                                    \
    __syncthreads();                                                                                     \
    if ((KT) + 2 < nk) {                                                                                 \
      const int ko = ((KT) + 2) * 64;                                                                    \
      _Pragma("unroll") for (int i = 0; i < 4; ++i) {                                                    \
        XR[i] = *(const u32x4*)(xp + (size_t)(32 * i) * ldx + ko);                                       \
        YR[i] = *(const u32x4*)(yp + (size_t)(32 * i) * ldy + ko);                                       \
      }                                                                                                  \
    } else if (hasnext) {                                                                                \
      const int ko = ((KT) + 2 - nk) * 64;                                                               \
      _Pragma("unroll") for (int i = 0; i < 4; ++i) {                                                    \
        XR[i] = *(const u32x4*)(xpn + (size_t)(32 * i) * ldx + ko);                                      \
        YR[i] = *(const u32x4*)(ypn + (size_t)(32 * i) * ldy + ko);                                      \
      }                                                                                                  \
    }                                                                                                    \
    _Pragma("unroll") for (int s = 0; s < 2; ++s) {                                                      \
      bf16x8 xf[4], yf[4];                                                                               \
      _Pragma("unroll") for (int i = 0; i < 4; ++i)                                                      \
          xf[i] = *(const bf16x8*)(sX + sw128(wx * 64 + i * 16 + r, s * 4 + q));                         \
      _Pragma("unroll") for (int j = 0; j < 4; ++j)                                                      \
          yf[j] = *(const bf16x8*)(sY + sw128(wy * 64 + j * 16 + r, s * 4 + q));                         \
      __builtin_amdgcn_s_setprio(1);                                                                     \
      _Pragma("unroll") for (int i = 0; i < 4; ++i)                                                      \
          _Pragma("unroll") for (int j = 0; j < 4; ++j) acc[i][j] = mfma16(xf[i], yf[j], acc[i][j]);     \
      __builtin_amdgcn_s_setprio(0);                                                                     \
    }                                                                                                    \
  }
  for (int kt = 0; kt < nk; kt += 2) {
    GEMM_STEP(st.xa0, st.ya0, 0, kt);
    GEMM_STEP(st.xa1, st.ya1, 1, kt + 1);
  }
#undef GEMM_STEP
  __syncthreads();
}

DI bool tile_map(int T, int MT, int NT, int& mt, int& nt) {
  const int pm_n = MT >> 3;
  const int P = (T >> 9) * 8 + (T & 7);
  const int li = (T & 511) >> 3;
  const int pm = P % pm_n, pn = P / pm_n;
  mt = pm * 8 + (li & 7);
  nt = pn * 8 + (li >> 3);
  return nt < NT;
}

DI int odd_col_src(int n) {
  if (n < 3584) return n;
  if (n < 7168) return n + 32;
  if (n < 7200) return n - 7168 + 3584;
  return -1;
}

DI void phase0(const Params& p, char* smem) {
  const int tid = opaque_tid();
  if (blockIdx.x < 384) {
    float* sc = (float*)smem;
    float* red = sc + 9 * 1024;
    for (int i = tid; i < 9 * 1024; i += 256) {
      const int b = i >> 10, k = i & 1023;
      const float v = (b < 8) ? p.c[b * 1024 + k] : p.c_ctx[k];
      sc[i] = v / (1.f + __expf(-v));
    }
    __syncthreads();
    float* modb = (float*)(p.ws + OFF_MOD);
    for (int it = blockIdx.x; it < 384; it += gridDim.x) {
      const int l = it / 96, cgp = it % 96;
      const int col = cgp * 32 + (tid & 31), ks = tid >> 5;
      float a[9];
#pragma unroll
      for (int b = 0; b < 9; ++b) a[b] = 0.f;
      const float* w = p.w_mod + ((size_t)l * 1024 + ks * 128) * 3072 + col;
#pragma unroll 4
      for (int k = 0; k < 128; ++k) {
        const float wv = w[(size_t)k * 3072];
#pragma unroll
        for (int b = 0; b < 9; ++b) a[b] += sc[b * 1024 + ks * 128 + k] * wv;
      }
#pragma unroll
      for (int b = 0; b < 9; ++b) red[(ks * 9 + b) * 32 + (tid & 31)] = a[b];
      __syncthreads();
      for (int idx = tid; idx < 288; idx += 256) {
        const int b = idx >> 5, cc = idx & 31;
        float s = p.b_mod[l * 3072 + cgp * 32 + cc];
#pragma unroll
        for (int k2 = 0; k2 < 8; ++k2) s += red[(k2 * 9 + b) * 32 + cc];
        modb[(size_t)(l * 9 + b) * 3072 + cgp * 32 + cc] = s;
      }
      __syncthreads();
    }
  }
  if (blockIdx.x == gridDim.x - 1) {
    float2* cs = (float2*)(p.ws + OFF_CS);
    for (int idx = tid; idx < 1024; idx += 256) {
      const int pos = idx >> 4, f = idx & 15;
      const float inv = 1.0f / powf(10000.f, (float)f * 0.0625f);
      const float ang = (float)pos * inv;
      const double ad = (double)ang;
      const double n = rint(ad * 0.15915494309189535);
      const float rr = (float)(ad - n * 6.283185307179586);
      cs[idx] = make_float2(__cosf(rr), __sinf(rr));
    }
    if (tid < 2) {
      const float* lp = p.ev_lambda + tid * 256;
      float s1 = 0.f, s2 = 0.f;
      for (int i = 0; i < 64; ++i) { s1 += lp[i] * lp[64 + i]; s2 += lp[128 + i] * lp[192 + i]; }
      const float li = (tid == 0) ? 0.2f : (0.8f - 0.6f * 0.5488116360940264f);
      float* lam = (float*)(p.ws + OFF_LAM);
      lam[tid] = __expf(s1) - __expf(s2) + li;
      lam[2 + tid] = li;
    }
    if (tid < 32) ((int*)(p.ws + OFF_CTR))[tid] = 0;
  }
  float* tile = (float*)smem;
  __syncthreads();
  for (int it = blockIdx.x; it < 9792; it += gridDim.x) {
    int rr = it, l, ktile, ntile, K, Nsrc;
    const float* src;
    bfr* dst;
    bool oddmap = false;
    if (rr < 7744) {
      if (rr < 2048) { l = 0; } else if (rr < 3872) { l = 1; rr -= 2048; } else if (rr < 5920) { l = 2; rr -= 3872; } else { l = 3; rr -= 5920; }
      ktile = rr & 15; ntile = rr >> 4; K = 1024;
      oddmap = (l & 1);
      Nsrc = oddmap ? 7200 : 8192;
      src = (oddmap ? p.od_w_in : p.ev_w_in) + (size_t)(l >> 1) * 1024 * Nsrc;
      dst = (bfr*)(p.ws + win_off(l));
    } else {
      rr -= 7744; l = rr >> 9; rr &= 511;
      ktile = rr & 31; ntile = rr >> 5; K = 2048; Nsrc = 1024;
      src = p.w_out + (size_t)l * 2048 * 1024;
      dst = (bfr*)(p.ws + OFF_WOUT + (size_t)l * SZ_WOUT);
    }
    const int k0 = ktile * 64, n0 = ntile * 64;
    {
      const int nn = tid & 63;
      const int nd = n0 + nn;
      const int ns = oddmap ? odd_col_src(nd) : nd;
#pragma unroll 4
      for (int i = 0; i < 16; ++i) {
        const int kk = (tid >> 6) + 4 * i;
        tile[kk * 65 + nn] = (ns >= 0) ? src[(size_t)(k0 + kk) * Nsrc + ns] : 0.f;
      }
    }
    __syncthreads();
    {
      const int kk8 = (tid & 7) * 8;
#pragma unroll
      for (int i2 = 0; i2 < 2; ++i2) {
        const int nn = (tid >> 3) + 32 * i2;
        u32x4 v;
        v.x = pack2(tile[(kk8 + 0) * 65 + nn], tile[(kk8 + 1) * 65 + nn]);
        v.y = pack2(tile[(kk8 + 2) * 65 + nn], tile[(kk8 + 3) * 65 + nn]);
        v.z = pack2(tile[(kk8 + 4) * 65 + nn], tile[(kk8 + 5) * 65 + nn]);
        v.w = pack2(tile[(kk8 + 6) * 65 + nn], tile[(kk8 + 7) * 65 + nn]);
        *(u32x4*)(dst + (size_t)(n0 + nn) * K + k0 + kk8) = v;
      }
    }
    __syncthreads();
  }
}

DI void phase_norm(const Params& p, int l, int g) {
  const int tid = opaque_tid(), lane = tid & 63, wid = tid >> 6;
  const int rows = (l == 4) ? ML : MR;
  const float* modb = (const float*)(p.ws + OFF_MOD);
  const bfr* ybuf = (const bfr*)(p.ws + OFF_PROJ);
  bfr* hbuf = (bfr*)(p.ws + OFF_H);
  float* xcb = (float*)(p.ws + OFF_XC);
  for (int row = blockIdx.x * 4 + wid; row < rows; row += gridDim.x * 4) {
    const bool lat = row < ML;
    const int mb = lat ? (g * GB + (row >> 12)) : 8;
    const size_t grow = lat ? ((size_t)g * ML + row) : ((size_t)g * MC + (row - ML));
    const float* xin;
    float* xst;
    if (lat) { xin = ((l <= 1) ? p.x : (const float*)p.out) + grow * 1024; xst = p.out + grow * 1024; }
    else     { xin = ((l <= 1) ? p.ctx : (const float*)xcb) + grow * 1024; xst = xcb + grow * 1024; }
    float4 xv[4];
#pragma unroll
    for (int i = 0; i < 4; ++i) xv[i] = *(const float4*)(xin + lane * 4 + 256 * i);
    if (l >= 1) {
      float4 yv[4];
      float ss = 0.f;
#pragma unroll
      for (int i = 0; i < 4; ++i) {
        const u32x2 yr = *(const u32x2*)(ybuf + (size_t)row * 1024 + lane * 4 + 256 * i);
        yv[i] = make_float4(lo_bf(yr.x), hi_bf(yr.x), lo_bf(yr.y), hi_bf(yr.y));
        ss += yv[i].x * yv[i].x + yv[i].y * yv[i].y + yv[i].z * yv[i].z + yv[i].w * yv[i].w;
      }
      ss = wave_sum(ss, lane);
      const float rn = rsqrtf(ss * (1.f / 1024.f) + 1e-6f);
      const float* gate = modb + (size_t)((l - 1) * 9 + mb) * 3072 + 2048;
      const float* gp = p.g_post + (l - 1) * 1024;
#pragma unroll
      for (int i = 0; i < 4; ++i) {
        const int c0 = lane * 4 + 256 * i;
        const float4 gt = *(const float4*)(gate + c0);
        const float4 gg = *(const float4*)(gp + c0);
        xv[i].x += gt.x * (yv[i].x * rn * gg.x);
        xv[i].y += gt.y * (yv[i].y * rn * gg.y);
        xv[i].z += gt.z * (yv[i].z * rn * gg.z);
        xv[i].w += gt.w * (yv[i].w * rn * gg.w);
        *(float4*)(xst + c0) = xv[i];
      }
    }
    if (l < 4) {
      float ss = 0.f;
#pragma unroll
      for (int i = 0; i < 4; ++i) ss += xv[i].x * xv[i].x + xv[i].y * xv[i].y + xv[i].z * xv[i].z + xv[i].w * xv[i].w;
      ss = wave_sum(ss, lane);
      const float rn = rsqrtf(ss * (1.f / 1024.f) + 1e-6f);
      const float* mrow = modb + (size_t)(l * 9 + mb) * 3072;
      const float* gpre = p.g_pre + l * 1024;
#pragma unroll
      for (int i = 0; i < 4; ++i) {
        const int c0 = lane * 4 + 256 * i;
        const float4 sh = *(const float4*)(mrow + c0);
        const float4 scl = *(const float4*)(mrow + 1024 + c0);
        const float4 gg = *(const float4*)(gpre + c0);
        u32x2 o;
        o.x = pack2(xv[i].x * rn * gg.x * (1.f + scl.x) + sh.x, xv[i].y * rn * gg.y * (1.f + scl.y) + sh.y);
        o.y = pack2(xv[i].z * rn * gg.z * (1.f + scl.z) + sh.z, xv[i].w * rn * gg.w * (1.f + scl.w) + sh.w);
        *(u32x2*)(hbuf + (size_t)row * 1024 + c0) = o;
      }
    }
  }
}

DI void gla_gate_precompute(const Params& p, int l, int m0, const char* sLr, float* sHs) {
  const int tid = opaque_tid();
  const int d = tid & 127, half = tid >> 7;
  const int jl = l >> 1;
#pragma unroll 1
  for (int unit = 0; unit < 16; ++unit) {
    const int cc = unit & 1, dir = (unit >> 1) & 1, head = unit >> 2;
    unsigned gu[8];
#pragma unroll
    for (int k = 0; k < 8; ++k)
      gu[k] = pack2(p.od_gate_up[(((size_t)jl * 2 + dir) * 16 + 2 * k) * 512 + head * 128 + d],
                    p.od_gate_up[(((size_t)jl * 2 + dir) * 16 + 2 * k + 1) * 512 + head * 128 + d]);
    const float gbias = p.od_gate_bias[((size_t)jl * 2 + dir) * 512 + head * 128 + d];
    float gl[32];
    float tot = 0.f;
#pragma unroll
    for (int i = 0; i < 32; ++i) {
      const int tk = cc * 64 + half * 32 + i;
      const u32x4 la = *(const u32x4*)(sLr + tk * 64 + dir * 32);
      const u32x4 lb = *(const u32x4*)(sLr + tk * 64 + dir * 32 + 16);
      float z = gbias;
      z = dot2bf(la.x, gu[0], z); z = dot2bf(la.y, gu[1], z); z = dot2bf(la.z, gu[2], z); z = dot2bf(la.w, gu[3], z);
      z = dot2bf(lb.x, gu[4], z); z = dot2bf(lb.y, gu[5], z); z = dot2bf(lb.z, gu[6], z); z = dot2bf(lb.w, gu[7], z);
      const float tneg = fexp2(-fabsf(z) * L2E);
      const float g = (fminf(z, 0.f) - flog2(1.f + tneg) * LN2) * (L2E / 16.f);
      gl[i] = g;
      tot += g;
    }
    if (dir == 0) {
      float run = 0.f;
#pragma unroll
      for (int i = 0; i < 32; ++i) { run += gl[i]; gl[i] = run; }
    } else {
      float run = 0.f;
#pragma unroll
      for (int i = 31; i >= 0; --i) { run += gl[i]; gl[i] = run; }
    }
    __syncthreads();
    sHs[half * 128 + d] = tot;
    __syncthreads();
    const float other = sHs[(1 - half) * 128 + d];
    const float offs = (dir == 0) ? (half ? other : 0.f) : (half ? 0.f : other);
    const int chunk = (m0 >> 6) + cc;
    char* et = p.ws + (dir ? OFF_ETB : OFF_ETF) + ((size_t)chunk * 4 + head) * 16384;
#pragma unroll
    for (int i8 = 0; i8 < 4; ++i8) {
      u32x4 v;
      v.x = pack2(fexp2(gl[i8 * 8 + 0] + offs), fexp2(gl[i8 * 8 + 1] + offs));
      v.y = pack2(fexp2(gl[i8 * 8 + 2] + offs), fexp2(gl[i8 * 8 + 3] + offs));
      v.z = pack2(fexp2(gl[i8 * 8 + 4] + offs), fexp2(gl[i8 * 8 + 5] + offs));
      v.w = pack2(fexp2(gl[i8 * 8 + 6] + offs), fexp2(gl[i8 * 8 + 7] + offs));
      *(u32x4*)(et + sw128(d, half * 4 + i8)) = v;
    }
    if (half == 0)
      ((float*)(p.ws + OFF_DEC))[(((size_t)dir * (MR / 64) + chunk) * 4 + head) * 128 + d] = fexp2(tot + other);
  }
}

struct TileQ {
  unsigned* base;
  int* slot;
  int x, dq, pend;
  bool has_pend;
};
DI int tileq_fetch(TileQ& tq) {
  __syncthreads();
  if (threadIdx.x == 0) {
    int j = tq.has_pend ? tq.pend : (int)__hip_atomic_fetch_add(tq.base + tq.x * 16, 1u, __ATOMIC_RELAXED, __HIP_MEMORY_SCOPE_AGENT);
    *tq.slot = j;
  }
  tq.has_pend = false;
  __syncthreads();
  return *tq.slot;
}
DI void tileq_prefetch(TileQ& tq) {
  if (threadIdx.x == 0) {
    tq.pend = (int)__hip_atomic_fetch_add(tq.base + tq.x * 16, 1u, __ATOMIC_RELAXED, __HIP_MEMORY_SCOPE_AGENT);
  }
  tq.has_pend = true;
}

DI bool tileq_next(TileQ& tq, int pm_n, int NP, int NT, int xcc0, int& mt, int& nt) {
  for (;;) {
    if (tq.dq >= 8) return false;
    const int j = tileq_fetch(tq);
    const int P = (j >> 6) * 8 + tq.x;
    if (P >= NP) { ++tq.dq; tq.x = (xcc0 + tq.dq) & 7; tq.has_pend = false; continue; }
    const int li = j & 63;
    mt = (P % pm_n) * 8 + (li & 7);
    nt = (P / pm_n) * 8 + (li >> 3);
    if (nt >= NT) continue;
    tileq_prefetch(tq);
    return true;
  }
}

DI void phase_gemm_in(const Params& p, int l, char* smem, int inst) {
  const int tid = opaque_tid(), lane = tid & 63, wid = tid >> 6, r = lane & 15, q = lane >> 4;
  const int wx = wid >> 1, wy = wid & 1;
  const bool even = !(l & 1);
  const int ldp = even ? NEV : NOD;
  const int NT = even ? 64 : 56, MT = MR >> 7;
  const bfr* WT = (const bfr*)(p.ws + win_off(l));
  const bfr* H = (const bfr*)(p.ws + OFF_H);
  bfr* proj = (bfr*)(p.ws + OFF_PROJ);
  bfr* VT = (bfr*)(p.ws + OFF_VT);
  const float2* cs = (const float2*)(p.ws + OFF_CS);
  const int pm_n = MT >> 3, NP = pm_n * ((NT + 7) >> 3);
  TileQ tq;
  tq.base = (unsigned*)(p.ws + OFF_BAR) + 34 * 64 + inst * 128;
  tq.slot = (int*)(smem + SMEM_BYTES - 16);
  tq.has_pend = false; tq.pend = 0;
  const int xcc0 = (int)(__builtin_amdgcn_s_getreg((3 << 11) | 20) & 7u);
  if (!even) {
    TileQ lq;
    lq.base = (unsigned*)(p.ws + OFF_BAR) + 34 * 64 + (16 + inst) * 128;
    lq.slot = tq.slot; lq.has_pend = false; lq.pend = 0; lq.x = 0; lq.dq = 0;
    for (;;) {
      const int j = tileq_fetch(lq);
      if (j >= MT) break;
      const int m0 = j * 128, n0 = 7168;
      GemmStage g2;
      gemm_prologue(WT + (size_t)n0 * 1024, 1024, H + (size_t)m0 * 1024, 1024, g2);
      f32x4 acc[4][4];
#pragma unroll
      for (int i = 0; i < 4; ++i)
#pragma unroll
        for (int jj = 0; jj < 4; ++jj) acc[i][jj] = (f32x4){0.f, 0.f, 0.f, 0.f};
      gemm_mainloop(WT + (size_t)n0 * 1024, 1024, H + (size_t)m0 * 1024, 1024, 1024, WT, H, false, smem, acc, g2);
#pragma unroll
      for (int jn = 0; jn < 4; ++jn) {
        const int m = m0 + wy * 64 + jn * 16 + r;
#pragma unroll
        for (int i = 0; i < 4; ++i) {
          const int n = n0 + wx * 64 + i * 16 + 4 * q;
          u32x2 o;
          o.x = pack2(acc[i][jn][0], acc[i][jn][1]);
          o.y = pack2(acc[i][jn][2], acc[i][jn][3]);
          *(u32x2*)(proj + (size_t)m * ldp + n) = o;
        }
      }
      char* sLr = smem;
      float* sHs = (float*)(smem + 8192);
      if (wx == 0) {
#pragma unroll
        for (int jn = 0; jn < 4; ++jn)
#pragma unroll
          for (int i = 0; i < 2; ++i) {
            u32x2 o;
            o.x = pack2(acc[i][jn][0], acc[i][jn][1]);
            o.y = pack2(acc[i][jn][2], acc[i][jn][3]);
            *(u32x2*)(sLr + (wy * 64 + jn * 16 + r) * 64 + (i * 16 + 4 * q) * 2) = o;
          }
      }
      __syncthreads();
      gla_gate_precompute(p, l, m0, sLr, sHs);
      __syncthreads();
    }
  }
  tq.dq = 0; tq.x = xcc0;
  GemmStage gst;
  int mt = 0, nt = 0;
  bool have = tileq_next(tq, pm_n, NP, NT, xcc0, mt, nt);
  bool loaded = false;
  {
   while (have) {
    const int m0 = mt * 128, n0 = nt * 128;
    const bool vt = (n0 >= 1024 && n0 < 2048);
    const bfr* X = vt ? (H + (size_t)m0 * 1024) : (WT + (size_t)n0 * 1024);
    const bfr* Y = vt ? (WT + (size_t)n0 * 1024) : (H + (size_t)m0 * 1024);
    if (!loaded) gemm_prologue(X, 1024, Y, 1024, gst);
    int mtn = 0, ntn = 0;
    const bool haven = tileq_next(tq, pm_n, NP, NT, xcc0, mtn, ntn);
    const bool stream = haven;
    const int m0n = mtn * 128, n0n = ntn * 128;
    const bool vtn = (n0n >= 1024 && n0n < 2048);
    const bfr* Xn = vtn ? (H + (size_t)m0n * 1024) : (WT + (size_t)n0n * 1024);
    const bfr* Yn = vtn ? (WT + (size_t)n0n * 1024) : (H + (size_t)m0n * 1024);
    f32x4 acc[4][4];
#pragma unroll
    for (int i = 0; i < 4; ++i)
#pragma unroll
      for (int j = 0; j < 4; ++j) acc[i][j] = (f32x4){0.f, 0.f, 0.f, 0.f};
    gemm_mainloop(X, 1024, Y, 1024, 1024, Xn, Yn, stream, smem, acc, gst);
    loaded = stream;
    if (vt) {
#pragma unroll
      for (int i = 0; i < 4; i += 2) {
        const int mbase = m0 + wx * 64 + i * 16;
        int b, kp;
        if (mbase < ML) { b = mbase >> 12; kp = mbase & 4095; } else { const int mm = mbase - ML; b = mm >> 8; kp = 4096 + (mm & 255); }
        const int pos = (kp & ~31) + q * 8;
#pragma unroll
        for (int jn = 0; jn < 4; ++jn) {
          const int f = n0 - 1024 + wy * 64 + jn * 16 + r;
          u32x4 o;
          o.x = pack2(acc[i][jn][0], acc[i][jn][1]);
          o.y = pack2(acc[i][jn][2], acc[i][jn][3]);
          o.z = pack2(acc[i + 1][jn][0], acc[i + 1][jn][1]);
          o.w = pack2(acc[i + 1][jn][2], acc[i + 1][jn][3]);
          *(u32x4*)(VT + ((size_t)(b * 1024 + f)) * KEYS + pos) = o;
        }
      }
    } else {
      const bool rope = even && (n0 < 1024 || (n0 >= 2048 && n0 < 3072)) && (m0 < ML);
      if (rope) {
#pragma unroll
        for (int jn = 0; jn < 4; ++jn) {
          asm volatile("" ::: "memory");
          const int m = m0 + wy * 64 + jn * 16 + r;
          const int t = m & 4095;
          const int grow = t >> 6, gcol = t & 63;
          const float4* ar = (const float4*)(cs + grow * 16 + 4 * q);
          const float4* cr = (const float4*)(cs + gcol * 16 + 4 * q);
          const float4 a01 = ar[0], a23 = ar[1], c01 = cr[0], c23 = cr[1];
          const float ac[4] = {a01.x, a01.z, a23.x, a23.z}, as_[4] = {a01.y, a01.w, a23.y, a23.w};
          const float cc[4] = {c01.x, c01.z, c23.x, c23.z}, cs_[4] = {c01.y, c01.w, c23.y, c23.w};
#pragma unroll
          for (int j = 0; j < 4; ++j) {
            const float x0 = acc[0][jn][j], x1 = acc[1][jn][j], x2 = acc[2][jn][j], x3 = acc[3][jn][j];
            acc[0][jn][j] = x0 * ac[j] - x1 * as_[j];
            acc[1][jn][j] = x1 * ac[j] + x0 * as_[j];
            acc[2][jn][j] = x2 * cc[j] - x3 * cs_[j];
            acc[3][jn][j] = x3 * cc[j] + x2 * cs_[j];
          }
        }
      }
#pragma unroll
      for (int jn = 0; jn < 4; ++jn) {
        const int m = m0 + wy * 64 + jn * 16 + r;
        bfr* rp = proj + (size_t)m * ldp + n0 + wx * 64;
        store_pair16(rp, acc[0][jn], acc[1][jn], q);
        store_pair16(rp + 32, acc[2][jn], acc[3][jn], q);
      }
    }
    mt = mtn; nt = ntn; have = haven;
  }
 }
}

DI void phase_gemm_out(const Params& p, int l, char* smem, int inst) {
  const int tid = opaque_tid(), lane = tid & 63, wid = tid >> 6, r = lane & 15, q = lane >> 4;
  const int wx = wid >> 1, wy = wid & 1;
  const bfr* WT = (const bfr*)(p.ws + OFF_WOUT + (size_t)l * SZ_WOUT);
  const bfr* U = (const bfr*)(p.ws + OFF_U);
  bfr* ybuf = (bfr*)(p.ws + OFF_PROJ);
  const int MT = (l == 3) ? (ML >> 7) : (MR >> 7);
  const int pm_n = MT >> 3, NP = pm_n;
  TileQ tq;
  tq.base = (unsigned*)(p.ws + OFF_BAR) + 34 * 64 + inst * 128;
  tq.slot = (int*)(smem + SMEM_BYTES - 16);
  tq.has_pend = false; tq.pend = 0;
  const int xcc0 = (int)(__builtin_amdgcn_s_getreg((3 << 11) | 20) & 7u);
  tq.dq = 0; tq.x = xcc0;
  GemmStage gst;
  int mt = 0, nt = 0;
  bool have = tileq_next(tq, pm_n, NP, 8, xcc0, mt, nt);
  bool loaded = false;
  while (have) {
    const int m0 = mt * 128, n0 = nt * 128;
    const bfr* X = WT + (size_t)n0 * 2048;
    const bfr* Y = U + (size_t)m0 * 2048;
    if (!loaded) gemm_prologue(X, 2048, Y, 2048, gst);
    int mtn = 0, ntn = 0;
    const bool haven = tileq_next(tq, pm_n, NP, 8, xcc0, mtn, ntn);
    const bfr* Xn = WT + (size_t)(ntn * 128) * 2048;
    const bfr* Yn = U + (size_t)(mtn * 128) * 2048;
    f32x4 acc[4][4];
#pragma unroll
    for (int i = 0; i < 4; ++i)
#pragma unroll
      for (int j = 0; j < 4; ++j) acc[i][j] = (f32x4){0.f, 0.f, 0.f, 0.f};
    gemm_mainloop(X, 2048, Y, 2048, 2048, Xn, Yn, haven, smem, acc, gst);
    loaded = haven;
#pragma unroll
    for (int jn = 0; jn < 4; ++jn) {
      const int m = m0 + wy * 64 + jn * 16 + r;
      bfr* rp = ybuf + (size_t)m * 1024 + n0 + wx * 64;
      store_pair16(rp, acc[0][jn], acc[1][jn], q);
      store_pair16(rp + 32, acc[2][jn], acc[3][jn], q);
    }
    mt = mtn; nt = ntn; have = haven;
  }
}

template <int DV, int QT, int KT, int MODE>
DI void attn_engine(const bfr* __restrict__ qbase, int ldq, const bfr* __restrict__ kbase, int ldk,
                    const bfr* __restrict__ vt, int nloc, int loc_row0, int loc_pos0, int nctx, int ctx_row0,
                    const float* rpb_s, int roff0, char* smem, f32x4 (&O)[DV / 16][QT], float (&lsum)[QT]) {
  constexpr int STAGE = 8192 + DV * 128;
  constexpr int NVL = DV / 32;
  const int tid = opaque_tid(), lane = tid & 63, wid = tid >> 6, r = lane & 15, q = lane >> 4;
  const int lr = tid >> 3, lc = tid & 7;
  constexpr float SC = 0.125f * L2E;

  bf16x8 Qf[QT][2];
#pragma unroll
  for (int qt = 0; qt < QT; ++qt)
#pragma unroll
    for (int s = 0; s < 2; ++s)
      Qf[qt][s] = *(const bf16x8*)(qbase + (size_t)(wid * 16 * QT + qt * 16 + r) * ldq + s * 32 + q * 8);
  float mrun[QT];
#pragma unroll
  for (int qt = 0; qt < QT; ++qt) {
    mrun[qt] = -1e30f;
    lsum[qt] = 0.f;
#pragma unroll
    for (int dt = 0; dt < DV / 16; ++dt) O[dt][qt] = (f32x4){0.f, 0.f, 0.f, 0.f};
  }

  const int nch = nloc + nctx;
  u32x4 kreg0, kreg1, vreg[NVL];
  const int ksw0 = sw128(lr, lc), ksw1 = sw128(lr + 32, lc);
#define AT_LOAD(c_)                                                                                          \
  {                                                                                                          \
    const int cc_ = (c_);                                                                                    \
    const int row_ = (cc_ < nloc) ? (loc_row0 + cc_ * 64) : (ctx_row0 + (cc_ - nloc) * 64);                  \
    const int pos_ = (cc_ < nloc) ? (loc_pos0 + cc_ * 64) : (4096 + (cc_ - nloc) * 64);                      \
    kreg0 = *(const u32x4*)(kbase + (size_t)(row_ + lr) * ldk + lc * 8);                                     \
    kreg1 = *(const u32x4*)(kbase + (size_t)(row_ + lr + 32) * ldk + lc * 8);                                \
    _Pragma("unroll") for (int i_ = 0; i_ < NVL; ++i_)                                                       \
        vreg[i_] = *(const u32x4*)(vt + (size_t)(lr + 32 * i_) * KEYS + pos_ + lc * 8);                      \
  }
#define AT_STORE(c_)                                                                                         \
  {                                                                                                          \
    char* sb_ = smem + ((c_) & 1) * STAGE;                                                                   \
    *(u32x4*)(sb_ + ksw0) = kreg0;                                                                           \
    *(u32x4*)(sb_ + ksw1) = kreg1;                                                                           \
    _Pragma("unroll") for (int i_ = 0; i_ < NVL; ++i_)                                                       \
        *(u32x4*)(sb_ + 8192 + sw128(lr + 32 * i_, lc)) = vreg[i_];                                          \
  }
  if (nch > 0) { AT_LOAD(0); AT_STORE(0); }
  for (int c = 0; c < nch; ++c) {
    __syncthreads();
    const bool more = (c + 1 < nch);
    const char* sK = smem + (c & 1) * STAGE;
    const char* sV = sK + 8192;
    if (more) AT_LOAD(c + 1);
    f32x4 stall[4 / KT][KT][QT];
#pragma unroll
    for (int sbk = 0; sbk < 4 / KT; ++sbk) {
#pragma unroll
      for (int kt = 0; kt < KT; ++kt)
#pragma unroll
        for (int qt = 0; qt < QT; ++qt) stall[sbk][kt][qt] = (f32x4){0.f, 0.f, 0.f, 0.f};
#pragma unroll
      for (int s = 0; s < 2; ++s)
#pragma unroll
        for (int kt = 0; kt < KT; ++kt) {
          const bf16x8 ka = *(const bf16x8*)(sK + sw128(sbk * KT * 16 + kt * 16 + r, s * 4 + q));
#pragma unroll
          for (int qt = 0; qt < QT; ++qt) stall[sbk][kt][qt] = mfma16(ka, Qf[qt][s], stall[sbk][kt][qt]);
        }
    }
#pragma unroll
    for (int sbk = 0; sbk < 4 / KT; ++sbk) {
      f32x4 (&st)[KT][QT] = stall[sbk];
      bf16x8 pb[KT / 2][QT];
      if (MODE == 1) {
#pragma unroll
        for (int kt = 0; kt < KT; ++kt)
#pragma unroll
          for (int qt = 0; qt < QT; ++qt)
#pragma unroll
            for (int j = 0; j < 4; ++j) {
              float v = st[kt][qt][j] * SC;
              if (c < nloc) {
                const int kc = sbk * KT * 16 + kt * 16 + 4 * q + j;
                const int qc = wid * 16 + r;
                int wst = qc - 8; wst = wst < 0 ? 0 : (wst > 48 ? 48 : wst);
                const bool valid = (kc >= wst) && (kc < wst + 16);
                int co = kc - qc + 15; co = co < 0 ? 0 : (co > 30 ? 30 : co);
                const float bias = rpb_s[(roff0 + c) * 31 + co] * L2E;
                v = valid ? (v + bias) : -INFINITY;
              }
              st[kt][qt][j] = v;
            }
      }
#pragma unroll
      for (int qt = 0; qt < QT; ++qt) {
        float mx = max3f(st[0][qt][0], st[0][qt][1], st[0][qt][2]);
        mx = max3f(mx, st[0][qt][3], st[1][qt][0]);
        mx = max3f(mx, st[1][qt][1], st[1][qt][2]);
#pragma unroll
        for (int kt = 2; kt < KT; ++kt) {
          mx = max3f(mx, st[kt - 1][qt][3], st[kt][qt][0]);
          mx = max3f(mx, st[kt][qt][1], st[kt][qt][2]);
        }
        mx = max3f(mx, st[KT - 1][qt][3], st[KT - 1][qt][3]);
        if (MODE != 1) mx *= SC;
        if (__any(mx > mrun[qt] + 8.f)) {
          mx = fmaxf(mx, shx<16>(mx, lane));
          mx = fmaxf(mx, shx<32>(mx, lane));
          const float mnew2 = fmaxf(mrun[qt], mx);
          const float alpha = fexp2(mrun[qt] - mnew2);
          mrun[qt] = mnew2;
          lsum[qt] *= alpha;
#pragma unroll
          for (int dt = 0; dt < DV / 16; ++dt) {
            O[dt][qt][0] *= alpha; O[dt][qt][1] *= alpha; O[dt][qt][2] *= alpha; O[dt][qt][3] *= alpha;
          }
        }
        const float mnew = mrun[qt];
        f32x2_t ps2 = {0.f, 0.f};
#pragma unroll
        for (int kt = 0; kt < KT; ++kt) {
          float e0, e1, e2, e3;
          if (MODE == 1) {
            e0 = fexp2(st[kt][qt][0] - mnew); e1 = fexp2(st[kt][qt][1] - mnew);
            e2 = fexp2(st[kt][qt][2] - mnew); e3 = fexp2(st[kt][qt][3] - mnew);
          } else {
            e0 = fexp2(__builtin_fmaf(st[kt][qt][0], SC, -mnew)); e1 = fexp2(__builtin_fmaf(st[kt][qt][1], SC, -mnew));
            e2 = fexp2(__builtin_fmaf(st[kt][qt][2], SC, -mnew)); e3 = fexp2(__builtin_fmaf(st[kt][qt][3], SC, -mnew));
          }
          st[kt][qt][0] = e0; st[kt][qt][1] = e1; st[kt][qt][2] = e2; st[kt][qt][3] = e3;
          const f32x2_t a01 = {e0, e1}, a23 = {e2, e3};
          ps2 = ps2 + a01;
          ps2 = ps2 + a23;
        }
        lsum[qt] += ps2.x + ps2.y;
#pragma unroll
        for (int ks = 0; ks < KT / 2; ++ks) {
          u32x4 pk;
          pk.x = pack2(st[2 * ks][qt][0], st[2 * ks][qt][1]);
          pk.y = pack2(st[2 * ks][qt][2], st[2 * ks][qt][3]);
          pk.z = pack2(st[2 * ks + 1][qt][0], st[2 * ks + 1][qt][1]);
          pk.w = pack2(st[2 * ks + 1][qt][2], st[2 * ks + 1][qt][3]);
          pb[ks][qt] = __builtin_bit_cast(bf16x8, pk);
        }
      }
#pragma unroll
      for (int dt = 0; dt < DV / 16; ++dt)
#pragma unroll
        for (int ks = 0; ks < KT / 2; ++ks) {
          const bf16x8 va = *(const bf16x8*)(sV + sw128(dt * 16 + r, (sbk * (KT / 2) + ks) * 4 + q));
#pragma unroll
          for (int qt = 0; qt < QT; ++qt) O[dt][qt] = mfma16(va, pb[ks][qt], O[dt][qt]);
        }
    }
    if (more) AT_STORE(c + 1);
  }
#undef AT_LOAD
#undef AT_STORE
  __syncthreads();
#pragma unroll
  for (int qt = 0; qt < QT; ++qt) {
    float L = lsum[qt];
    L += shx<16>(L, lane);
    L += shx<32>(L, lane);
    lsum[qt] = L;
  }
}

DI void diff_attn_item(const Params& p, int l, int b, int head, int qrow0, bool ctxq, char* smem) {
  const int tid = opaque_tid(), lane = tid & 63, wid = tid >> 6, r = lane & 15, q = lane >> 4;
  const bfr* proj = (const bfr*)(p.ws + OFF_PROJ);
  const bfr* VT = (const bfr*)(p.ws + OFF_VT);
  bfr* U = (bfr*)(p.ws + OFF_U);
  const float* lamv = (const float*)(p.ws + OFF_LAM);
  const float lam = lamv[l >> 1], lam_init = lamv[2 + (l >> 1)];
  f32x4 O[8][2];
  float ls[2];
  char* parkb = smem + 49152 + tid * 16;
  attn_engine<128, 2, 2, 0>(proj + (size_t)qrow0 * NEV + 2048 + head * 128, NEV, proj + head * 128, NEV,
                            VT + (size_t)(b * 1024 + head * 128) * KEYS, ctxq ? 0 : 64, b * 4096, 0, 4,
                            ML + b * 256, nullptr, 0, smem, O, ls);
  u32x4 pkr0, pkr1;
  {
    const float i0 = 1.f / ls[0], i1 = 1.f / ls[1];
#pragma unroll
    for (int dt = 0; dt < 8; dt += 2) {
      u32x4 v0, v1;
      v0.x = pack2(O[dt][0][0] * i0, O[dt][0][1] * i0);
      v0.y = pack2(O[dt][0][2] * i0, O[dt][0][3] * i0);
      v0.z = pack2(O[dt + 1][0][0] * i0, O[dt + 1][0][1] * i0);
      v0.w = pack2(O[dt + 1][0][2] * i0, O[dt + 1][0][3] * i0);
      v1.x = pack2(O[dt][1][0] * i1, O[dt][1][1] * i1);
      v1.y = pack2(O[dt][1][2] * i1, O[dt][1][3] * i1);
      v1.z = pack2(O[dt + 1][1][0] * i1, O[dt + 1][1][1] * i1);
      v1.w = pack2(O[dt + 1][1][2] * i1, O[dt + 1][1][3] * i1);
      if (dt < 6) {
        *(u32x4*)(parkb + (dt / 2) * 4096) = v0;
        *(u32x4*)(parkb + (3 + dt / 2) * 4096) = v1;
      } else { pkr0 = v0; pkr1 = v1; }
    }
  }
  attn_engine<128, 2, 2, 0>(proj + (size_t)qrow0 * NEV + 2048 + head * 128 + 64, NEV, proj + head * 128 + 64, NEV,
                            VT + (size_t)(b * 1024 + head * 128) * KEYS, ctxq ? 0 : 64, b * 4096, 0, 4,
                            ML + b * 256, nullptr, 0, smem, O, ls);
  const float* subln = p.ev_subln + (l >> 1) * 128;
#pragma unroll
  for (int qt = 0; qt < 2; ++qt) {
    const float i1 = lam / ls[qt];
    float ss = 0.f;
#pragma unroll
    for (int dt = 0; dt < 8; ++dt) {
      unsigned pa, pc;
      if (dt < 6) {
        const u32x2 pk2 = *(const u32x2*)(parkb + (qt * 3 + dt / 2) * 4096 + (dt & 1) * 8);
        pa = pk2.x; pc = pk2.y;
      } else {
        const u32x4 pr = qt ? pkr1 : pkr0;
        pa = (dt & 1) ? pr.z : pr.x; pc = (dt & 1) ? pr.w : pr.y;
      }
      const float o0 = lo_bf(pa) - O[dt][qt][0] * i1;
      const float o1 = hi_bf(pa) - O[dt][qt][1] * i1;
      const float o2 = lo_bf(pc) - O[dt][qt][2] * i1;
      const float o3 = hi_bf(pc) - O[dt][qt][3] * i1;
      O[dt][qt][0] = o0; O[dt][qt][1] = o1; O[dt][qt][2] = o2; O[dt][qt][3] = o3;
      ss += o0 * o0 + o1 * o1 + o2 * o2 + o3 * o3;
    }
    ss += shx<16>(ss, lane);
    ss += shx<32>(ss, lane);
    const float rn = rsqrtf(ss * (1.f / 128.f) + 1e-6f) * (1.f - lam_init);
    const int row = qrow0 + wid * 32 + qt * 16 + r;
#pragma unroll
    for (int dt = 0; dt < 8; dt += 2) {
      f32x4 va, vb;
#pragma unroll
      for (int hh = 0; hh < 2; ++hh) {
        const int dv = (dt + hh) * 16 + 4 * q;
        const u32x2 ag = *(const u32x2*)(proj + (size_t)row * NEV + 3072 + head * 128 + dv);
        const float4 sl = *(const float4*)(subln + dv);
        f32x4 v;
        v[0] = O[dt + hh][qt][0] * rn * sl.x * silu(lo_bf(ag.x)); v[1] = O[dt + hh][qt][1] * rn * sl.y * silu(hi_bf(ag.x));
        v[2] = O[dt + hh][qt][2] * rn * sl.z * silu(lo_bf(ag.y)); v[3] = O[dt + hh][qt][3] * rn * sl.w * silu(hi_bf(ag.y));
        if (hh == 0) va = v; else vb = v;
      }
      store_pair16(U + (size_t)row * 2048 + head * 128 + dt * 16, va, vb, q);
    }
  }
}

DI void na_item(const Params& p, int l, int b, int head, int rho, bool ctxq, int cq0, char* smem) {
  const int tid = opaque_tid(), lane = tid & 63, wid = tid >> 6, r = lane & 15, q = lane >> 4;
  const bfr* proj = (const bfr*)(p.ws + OFF_PROJ);
  const bfr* VT = (const bfr*)(p.ws + OFF_VT);
  bfr* U = (bfr*)(p.ws + OFF_U);
  float* rpb_s = (float*)(smem + 2 * (8192 + 64 * 128));
  int rs = rho - 4; rs = rs < 0 ? 0 : (rs > 56 ? 56 : rs);
  const int qrow0 = ctxq ? (ML + b * 256 + cq0) : (b * 4096 + rho * 64);
  f32x4 O[4][1];
  float ls[1];
  if (!ctxq) {
    const float* rp = p.od_rpb + ((size_t)(l >> 1) * 16 + head) * 465;
    for (int i = tid; i < 465; i += 256) rpb_s[i] = rp[i];
    attn_engine<64, 1, 4, 1>(proj + (size_t)qrow0 * NOD + 3584 + head * 64, NOD, proj + head * 64, NOD,
                                VT + (size_t)(b * 1024 + head * 64) * KEYS, 8, b * 4096 + rs * 64, rs * 64, 4,
                                ML + b * 256, rpb_s, rs - rho + 7, smem, O, ls);
  } else {
    attn_engine<64, 1, 4, 0>(proj + (size_t)qrow0 * NOD + 3584 + head * 64, NOD, proj + head * 64, NOD,
                                VT + (size_t)(b * 1024 + head * 64) * KEYS, 0, 0, 0, 4, ML + b * 256, nullptr, 0,
                                smem, O, ls);
  }
  const float inv = 1.f / ls[0];
  const int row = qrow0 + wid * 16 + r;
#pragma unroll
  for (int dt = 0; dt < 4; ++dt) {
    const int dv = dt * 16 + 4 * q;
    const u32x2 cgv = *(const u32x2*)(proj + (size_t)row * NOD + 5120 + head * 64 + dv);
    u32x2 o;
    o.x = pack2(O[dt][0][0] * inv * silu(lo_bf(cgv.x)), O[dt][0][1] * inv * silu(hi_bf(cgv.x)));
    o.y = pack2(O[dt][0][2] * inv * silu(lo_bf(cgv.y)), O[dt][0][3] * inv * silu(hi_bf(cgv.y)));
    *(u32x2*)(U + (size_t)row * 2048 + head * 64 + dv) = o;
  }
}

DI void conv_item(const Params& p, int l, int item) {
  const int tid = opaque_tid();
  const bfr* proj = (const bfr*)(p.ws + OFF_PROJ);
  bfr* U = (bfr*)(p.ws + OFF_U);
  const float* cw = p.ev_conv + (size_t)(l >> 1) * 3 * 1024;
#pragma unroll 1
  for (int i = 0; i < 8; ++i) {
    const int v = tid + 256 * i;
    const int ri = v >> 7, ch = (v & 127) * 8;
    const int m = item * 16 + ri;
    int t, T;
    if (m < ML) { t = m & 4095; T = 4096; } else { t = (m - ML) & 255; T = 256; }
    const bfr* pr = proj + (size_t)m * NEV;
    float acc[8];
#pragma unroll
    for (int e = 0; e < 8; ++e) acc[e] = 0.f;
#pragma unroll
    for (int w = 0; w < 3; ++w) {
      const int tt = t + w - 1;
      if (tt >= 0 && tt < T) {
        const bfr* prw = pr + (ptrdiff_t)(w - 1) * NEV;
        const u32x4 bh = *(const u32x4*)(prw + 4096 + ch);
        const u32x4 bc = *(const u32x4*)(prw + 6144 + ch);
        const float4 w0 = *(const float4*)(cw + w * 1024 + ch);
        const float4 w1 = *(const float4*)(cw + w * 1024 + ch + 4);
        acc[0] += w0.x * lo_bf(bh.x) * lo_bf(bc.x); acc[1] += w0.y * hi_bf(bh.x) * hi_bf(bc.x);
        acc[2] += w0.z * lo_bf(bh.y) * lo_bf(bc.y); acc[3] += w0.w * hi_bf(bh.y) * hi_bf(bc.y);
        acc[4] += w1.x * lo_bf(bh.z) * lo_bf(bc.z); acc[5] += w1.y * hi_bf(bh.z) * hi_bf(bc.z);
        acc[6] += w1.z * lo_bf(bh.w) * lo_bf(bc.w); acc[7] += w1.w * hi_bf(bh.w) * hi_bf(bc.w);
      }
    }
    const u32x4 bb = *(const u32x4*)(pr + 5120 + ch);
    const u32x4 bg = *(const u32x4*)(pr + 7168 + ch);
    u32x4 o;
    o.x = pack2(lo_bf(bb.x) * acc[0] * silu(lo_bf(bg.x)), hi_bf(bb.x) * acc[1] * silu(hi_bf(bg.x)));
    o.y = pack2(lo_bf(bb.y) * acc[2] * silu(lo_bf(bg.y)), hi_bf(bb.y) * acc[3] * silu(hi_bf(bg.y)));
    o.z = pack2(lo_bf(bb.z) * acc[4] * silu(lo_bf(bg.z)), hi_bf(bb.z) * acc[5] * silu(hi_bf(bg.z)));
    o.w = pack2(lo_bf(bb.w) * acc[6] * silu(lo_bf(bg.w)), hi_bf(bb.w) * acc[7] * silu(hi_bf(bg.w)));
    *(u32x4*)(U + (size_t)m * 2048 + 1024 + ch) = o;
  }
}

DI void gla_item(const Params& p, int l, int item, char* smem) {
  const int tid0 = opaque_tid();
  const int slice = item & 7, dir = (item >> 3) & 1, head = (item >> 4) & 3, b = item >> 6;
  const bfr* proj = (const bfr*)(p.ws + OFF_PROJ);
  const char* etb = p.ws + (dir ? OFF_ETB : OFF_ETF) + (size_t)head * 16384;
  const float* decb = (const float*)(p.ws + OFF_DEC) + ((size_t)dir * (MR / 64) * 4 + head) * 128;
  char* sQb = smem;
  char* sKc = smem + 16384;
  char* sKbT = smem + 32768;
  char* sVt = smem + 49152;
  char* sAtt = smem + 53248;
  char* sST = smem + 61440;
  float* sDec = (float*)(smem + 77824);
  const float qscale = 0.08838834764831845f;

  f32x4 S[2][2];
#pragma unroll
  for (int a = 0; a < 2; ++a)
#pragma unroll
    for (int c2 = 0; c2 < 2; ++c2) S[a][c2] = (f32x4){0.f, 0.f, 0.f, 0.f};
  __syncthreads();
  for (int i = tid0; i < 512; i += 256) ((u32x4*)sST)[i] = (u32x4){0u, 0u, 0u, 0u};

  u32x4 pq0, pq1, pq2, pq3, pk0, pk1, pk2, pk3, pv, pe0, pe1, pe2, pe3, pdec;
#define GLA_ROW0(ci_) (((ci_) < 4) ? (ML + b * 256 + (dir ? (3 - (ci_)) : (ci_)) * 64) : (b * 4096 + (dir ? (67 - (ci_)) : ((ci_) - 4)) * 64))
#define GLA_LOAD(ci_)                                                                                         \
  {                                                                                                           \
    const int prow = tid >> 4, pch = tid & 15, vs = tid >> 2, vpart = tid & 3;                                \
    const int r0_ = GLA_ROW0(ci_);                                                                            \
    const bfr* pr_ = proj + (size_t)(r0_ + prow) * NOD + head * 128 + pch * 8;                                \
    pq0 = *(const u32x4*)(pr_ + 4608);                     pk0 = *(const u32x4*)(pr_ + 2048);                 \
    pq1 = *(const u32x4*)(pr_ + 4608 + (size_t)16 * NOD);  pk1 = *(const u32x4*)(pr_ + 2048 + (size_t)16 * NOD); \
    pq2 = *(const u32x4*)(pr_ + 4608 + (size_t)32 * NOD);  pk2 = *(const u32x4*)(pr_ + 2048 + (size_t)32 * NOD); \
    pq3 = *(const u32x4*)(pr_ + 4608 + (size_t)48 * NOD);  pk3 = *(const u32x4*)(pr_ + 2048 + (size_t)48 * NOD); \
    pv = *(const u32x4*)(proj + (size_t)(r0_ + vs) * NOD + 2560 + head * 256 + slice * 32 + vpart * 8);       \
    const char* et_ = etb + (size_t)(r0_ >> 6) * 65536 + tid * 16;                                            \
    pe0 = *(const u32x4*)(et_);         pe1 = *(const u32x4*)(et_ + 4096);                                    \
    pe2 = *(const u32x4*)(et_ + 8192);  pe3 = *(const u32x4*)(et_ + 12288);                                   \
    if (tid < 32) pdec = *(const u32x4*)(decb + (size_t)(r0_ >> 6) * 512 + tid * 4);                          \
  }
  { const int tid = tid0; GLA_LOAD(0); }
  for (int ci = 0; ci < 68; ++ci) {
    int tid = tid0; asm volatile("" : "+v"(tid));
    const int lane = tid & 63, wid = tid >> 6, r = lane & 15, q = lane >> 4;
    const int d = tid & 127, half = tid >> 7;
    const int prow = tid >> 4, pch = tid & 15, vs = tid >> 2, vpart = tid & 3;
    const int row0 = GLA_ROW0(ci);
    const char* stc = sST + (ci & 1) * 8192;
    char* stn = sST + ((ci + 1) & 1) * 8192;
    __syncthreads();
    {
      *(u32x4*)(sQb + sw256(prow, pch)) = pq0;       *(u32x4*)(sKc + sw256(prow, pch)) = pk0;
      *(u32x4*)(sQb + sw256(prow + 16, pch)) = pq1;  *(u32x4*)(sKc + sw256(prow + 16, pch)) = pk1;
      *(u32x4*)(sQb + sw256(prow + 32, pch)) = pq2;  *(u32x4*)(sKc + sw256(prow + 32, pch)) = pk2;
      *(u32x4*)(sQb + sw256(prow + 48, pch)) = pq3;  *(u32x4*)(sKc + sw256(prow + 48, pch)) = pk3;
      *(u32x4*)(sKbT + tid * 16) = pe0;              *(u32x4*)(sKbT + tid * 16 + 4096) = pe1;
      *(u32x4*)(sKbT + tid * 16 + 8192) = pe2;       *(u32x4*)(sKbT + tid * 16 + 12288) = pe3;
      if (tid < 32) *(u32x4*)((char*)sDec + tid * 16) = pdec;
      const unsigned vv[4] = {pv.x, pv.y, pv.z, pv.w};
#pragma unroll
      for (int j = 0; j < 4; ++j) {
        const int e0 = vpart * 8 + 2 * j;
        *(bfr*)(sVt + sw128(e0, vs >> 3) + (vs & 7) * 2) = (bfr)(vv[j] & 0xffffu);
        *(bfr*)(sVt + sw128(e0 + 1, vs >> 3) + (vs & 7) * 2) = (bfr)(vv[j] >> 16);
      }
    }
    __syncthreads();
    {
      const float dec = sDec[d];
#pragma unroll
      for (int i8 = 0; i8 < 4; ++i8) {
        const u32x4 ev = *(const u32x4*)(sKbT + sw128(d, half * 4 + i8));
        const unsigned ew[4] = {ev.x, ev.y, ev.z, ev.w};
        unsigned kb[4];
#pragma unroll
        for (int ii = 0; ii < 8; ++ii) {
          const int s = half * 32 + i8 * 8 + ii;
          const float E = (ii & 1) ? hi_bf(ew[ii >> 1]) : lo_bf(ew[ii >> 1]);
          const float Ei = __builtin_amdgcn_rcpf(E);
          bfr* qa_ = (bfr*)(sQb + sw256(s, d >> 3) + (d & 7) * 2);
          bfr* ka_ = (bfr*)(sKc + sw256(s, d >> 3) + (d & 7) * 2);
          const float qv = bf2f(*qa_) * qscale * E;
          const float kc = bf2f(*ka_) * Ei;
          *qa_ = f2bf(qv);
          *ka_ = f2bf(kc);
          const unsigned kbv = f2bf(kc * dec);
          if (ii & 1) kb[ii >> 1] |= kbv << 16; else kb[ii >> 1] = kbv;
        }
        *(u32x4*)(sKbT + sw128(d, half * 4 + i8)) = (u32x4){kb[0], kb[1], kb[2], kb[3]};
      }
    }
    __syncthreads();
    if (ci + 1 < 68) GLA_LOAD(ci + 1);
    {
      f32x4 at[4];
#pragma unroll
      for (int st = 0; st < 4; ++st) at[st] = (f32x4){0.f, 0.f, 0.f, 0.f};
#pragma unroll
      for (int ks = 0; ks < 4; ++ks) {
        const bf16x8 qa = *(const bf16x8*)(sQb + sw256(wid * 16 + r, ks * 4 + q));
#pragma unroll
        for (int st = 0; st < 4; ++st) {
          const bf16x8 kb2 = *(const bf16x8*)(sKc + sw256(st * 16 + r, ks * 4 + q));
          at[st] = mfma16(qa, kb2, at[st]);
        }
      }
#pragma unroll
      for (int st = 0; st < 4; ++st)
#pragma unroll
        for (int j = 0; j < 4; ++j) {
          const int t = wid * 16 + 4 * q + j, s = st * 16 + r;
          const bool keep = dir ? (s >= t) : (s <= t);
          *(bfr*)(sAtt + sw128(t, s >> 3) + (s & 7) * 2) = f2bf(keep ? at[st][j] : 0.f);
        }
    }
    {
#pragma unroll
      for (int dti = 0; dti < 2; ++dti) {
        const float dc = sDec[(2 * wid + dti) * 16 + r];
#pragma unroll
        for (int et = 0; et < 2; ++et) {
          S[et][dti][0] *= dc; S[et][dti][1] *= dc; S[et][dti][2] *= dc; S[et][dti][3] *= dc;
        }
      }
#pragma unroll
      for (int ks = 0; ks < 2; ++ks) {
        bf16x8 va[2], kb2[2];
#pragma unroll
        for (int et = 0; et < 2; ++et) va[et] = *(const bf16x8*)(sVt + sw128(et * 16 + r, ks * 4 + q));
#pragma unroll
        for (int dti = 0; dti < 2; ++dti) kb2[dti] = *(const bf16x8*)(sKbT + sw128((2 * wid + dti) * 16 + r, ks * 4 + q));
#pragma unroll
        for (int et = 0; et < 2; ++et)
#pragma unroll
          for (int dti = 0; dti < 2; ++dti) S[et][dti] = mfma16(va[et], kb2[dti], S[et][dti]);
      }
#pragma unroll
      for (int et = 0; et < 2; ++et)
#pragma unroll
        for (int dti = 0; dti < 2; ++dti)
#pragma unroll
          for (int j = 0; j < 4; ++j) {
            const int e = et * 16 + 4 * q + j, dd = (2 * wid + dti) * 16 + r;
            *(bfr*)(stn + sw256(e, dd >> 3) + (dd & 7) * 2) = f2bf(S[et][dti][j]);
          }
    }
    __syncthreads();
    {
      f32x4 o[2];
      o[0] = (f32x4){0.f, 0.f, 0.f, 0.f};
      o[1] = (f32x4){0.f, 0.f, 0.f, 0.f};
#pragma unroll
      for (int ks = 0; ks < 4; ++ks) {
        const bf16x8 qa = *(const bf16x8*)(sQb + sw256(wid * 16 + r, ks * 4 + q));
#pragma unroll
        for (int et = 0; et < 2; ++et) {
          const bf16x8 sb2 = *(const bf16x8*)(stc + sw256(et * 16 + r, ks * 4 + q));
          o[et] = mfma16(qa, sb2, o[et]);
        }
      }
#pragma unroll
      for (int ks = 0; ks < 2; ++ks) {
        const bf16x8 aa = *(const bf16x8*)(sAtt + sw128(wid * 16 + r, ks * 4 + q));
#pragma unroll
        for (int et = 0; et < 2; ++et) {
          const bf16x8 vb = *(const bf16x8*)(sVt + sw128(et * 16 + r, ks * 4 + q));
          o[et] = mfma16(aa, vb, o[et]);
        }
      }
      {
        const int lam = head * 8 + slice;
#pragma unroll
        for (int j = 0; j < 4; ++j) {
          const int row = row0 + wid * 16 + 4 * q + j;
          const int m2 = row >> 1, par = row & 1;
          bfr* lp = dir ? ((bfr*)(p.ws + OFF_H) + ((size_t)m2 * 32 + lam) * 64)
                        : ((bfr*)(p.ws + OFF_U) + (size_t)(2 * m2 + (lam >> 4)) * 2048 + 1024 + (lam & 15) * 64);
#pragma unroll
          for (int et = 0; et < 2; ++et) lp[par * 32 + et * 16 + r] = f2bf(o[et][j]);
        }
      }
    }
  }
#undef GLA_LOAD
#undef GLA_ROW0
  __syncthreads();
}

DI void phase_gla_combine(const Params& p, int l) {
  const int tid = opaque_tid(), lane = tid & 63, wid = tid >> 6;
  const bfr* proj = (const bfr*)(p.ws + OFF_PROJ);
  const bfr* OB = (const bfr*)(p.ws + OFF_H);
  bfr* U = (bfr*)(p.ws + OFF_U);
  const int h = lane >> 4, e16 = (lane & 15) * 16;
  const int lam = h * 8 + ((lane & 15) >> 1), ein = (lane & 1) * 16;
  const float* gn = p.od_gnorm + (l >> 1) * 256 + e16;
  for (int m2 = blockIdx.x * 4 + wid; m2 < MR / 2; m2 += gridDim.x * 4) {
    const bfr* ofl = U + (size_t)(2 * m2 + (lam >> 4)) * 2048 + 1024 + (lam & 15) * 64 + ein;
    const bfr* obl = OB + ((size_t)m2 * 32 + lam) * 64 + ein;
    u32x4 a[2][2], bq[2][2], g[2][2];
#pragma unroll
    for (int par = 0; par < 2; ++par) {
      a[par][0] = *(const u32x4*)(ofl + par * 32);  a[par][1] = *(const u32x4*)(ofl + par * 32 + 8);
      bq[par][0] = *(const u32x4*)(obl + par * 32); bq[par][1] = *(const u32x4*)(obl + par * 32 + 8);
      const bfr* gp = proj + (size_t)(2 * m2 + par) * NOD + 6144 + h * 256 + e16;
      g[par][0] = *(const u32x4*)gp; g[par][1] = *(const u32x4*)(gp + 8);
    }
    u32x4 res[2][2];
#pragma unroll
    for (int par = 0; par < 2; ++par) {
      float o[16], dg[16];
      float ss = 0.f;
#pragma unroll
      for (int hv = 0; hv < 2; ++hv)
#pragma unroll
        for (int i = 0; i < 4; ++i) {
          const unsigned av = a[par][hv][i], bv = bq[par][hv][i], gv = g[par][hv][i];
          const int k = hv * 8 + i * 2;
          o[k] = lo_bf(av) + lo_bf(bv); o[k + 1] = hi_bf(av) + hi_bf(bv);
          dg[k] = lo_bf(gv); dg[k + 1] = hi_bf(gv);
          ss += o[k] * o[k] + o[k + 1] * o[k + 1];
        }
      ss += shx<1>(ss, lane); ss += shx<2>(ss, lane); ss += shx<4>(ss, lane); ss += shx<8>(ss, lane);
      const float rn = rsqrtf(ss * (1.f / 256.f) + 1e-6f);
#pragma unroll
      for (int hv = 0; hv < 2; ++hv)
#pragma unroll
        for (int i = 0; i < 4; ++i) {
          const int k = hv * 8 + i * 2;
          res[par][hv][i] = pack2(o[k] * rn * gn[k] * silu(dg[k]), o[k + 1] * rn * gn[k + 1] * silu(dg[k + 1]));
        }
    }
#pragma unroll
    for (int par = 0; par < 2; ++par) {
      bfr* up = U + (size_t)(2 * m2 + par) * 2048 + 1024 + h * 256 + e16;
      *(u32x4*)up = res[par][0];
      *(u32x4*)(up + 8) = res[par][1];
    }
  }
}

DI int next_item(int* ctr, int* slot) {
  __syncthreads();
  if (threadIdx.x == 0) *slot = atomicAdd(ctr, 1);
  __syncthreads();
  return *slot;
}

DI void phase_mix_even(const Params& p, int l, int g, char* smem, int coff = 0) {
  int* ctr0 = (int*)(p.ws + OFF_CTR) + ((g * 2 + (l >> 1)) * 8) + coff;
  int* slot = (int*)(smem + SMEM_BYTES - 16);
  const int PER_LAT = GB * 32, PER_CTX = GB * 2, PER_CONV = MR / 16 / 8;
  const int per_q = PER_LAT + PER_CTX + PER_CONV;
  const int myq = (int)(__builtin_amdgcn_s_getreg((3 << 11) | 20) & 7u);
  for (int dq = 0; dq < 8; ++dq) {
    const int x = (myq + dq) & 7;
    for (;;) {
      int it = next_item(ctr0 + x, slot);
      if (it >= per_q) break;
      if (it < PER_LAT) {
        const int qb = it & 31, b = it >> 5;
        diff_attn_item(p, l, b, x, b * 4096 + qb * 128, false, smem);
      } else if (it < PER_LAT + PER_CTX) {
        it -= PER_LAT;
        const int qb = it & 1, b = it >> 1;
        diff_attn_item(p, l, b, x, ML + b * 256 + qb * 128, true, smem);
      } else {
        conv_item(p, l, (it - PER_LAT - PER_CTX) * 8 + x);
      }
    }
  }
}

DI void phase_mix_odd(const Params& p, int l, int g, char* smem) {
  int* ctr = (int*)(p.ws + OFF_CTR) + (g * 4 + l);
  int* slot = (int*)(smem + SMEM_BYTES - 16);
  const int N_GLA = GB * 4 * 2 * 8, N_NA = GB * 16 * 64, N_CTX = (l == 3) ? 0 : GB * 16 * 4;
  const int total = N_GLA + N_NA + N_CTX;
  (void)ctr; (void)slot; (void)total;
  const int nb = gridDim.x, bx = blockIdx.x;
  const int nup = (nb > N_GLA) ? (nb - N_GLA) : 0;
  const int NA_UP = 17;
  for (int k = 0;; ++k) {
    int it;
    if (nup == 0) { it = bx + k * nb; if (it >= total) break; }
    else if (bx < N_GLA) {
      if (k == 0) it = bx;
      else { it = N_GLA + NA_UP * nup + bx + (k - 1) * N_GLA; if (it >= total) break; }
    } else {
      if (k >= NA_UP) break;
      it = N_GLA + (bx - N_GLA) + k * nup;
      if (it >= total) break;
    }
    __syncthreads();
    if (it < N_GLA) {
      __builtin_amdgcn_s_setprio(3);
      gla_item(p, l, it, smem);
      __builtin_amdgcn_s_setprio(0);
    } else if (it < N_GLA + N_NA) {
      it -= N_GLA;
      const int rho = it & 63, bh = it >> 6;
      na_item(p, l, bh >> 4, bh & 15, rho, false, 0, smem);
    } else {
      it -= N_GLA + N_NA;
      const int qb = it & 3, bh = it >> 2;
      na_item(p, l, bh >> 4, bh & 15, 0, true, qb * 64, smem);
    }
  }
}


DI void grid_barrier(unsigned* bar, unsigned& bgen, unsigned xcc, unsigned nxcc, unsigned nx) {
  asm volatile("s_waitcnt vmcnt(0)" ::: "memory");
  __syncthreads();
  const unsigned target = bgen + 1;
  if (threadIdx.x == 0) {
    const unsigned old = __hip_atomic_fetch_add(bar + xcc * 64, 1u, __ATOMIC_RELAXED, __HIP_MEMORY_SCOPE_AGENT);
    if (old == target * nxcc - 1) {
      __builtin_amdgcn_fence(__ATOMIC_RELEASE, "agent");
      asm volatile("s_waitcnt vmcnt(0)" ::: "memory");
      const unsigned o2 = __hip_atomic_fetch_add(bar + 16 * 64, 1u, __ATOMIC_RELAXED, __HIP_MEMORY_SCOPE_AGENT);
      if (o2 == target * nx - 1) __hip_atomic_store(bar + 17 * 64, target, __ATOMIC_RELAXED, __HIP_MEMORY_SCOPE_AGENT);
    }
    while (__hip_atomic_load(bar + 17 * 64, __ATOMIC_RELAXED, __HIP_MEMORY_SCOPE_AGENT) < target) __builtin_amdgcn_s_sleep(1);
    __builtin_amdgcn_fence(__ATOMIC_ACQUIRE, "agent");
    asm volatile("s_waitcnt vmcnt(0)" ::: "memory");
  }
  bgen = target;
  __syncthreads();
}
typedef const __attribute__((address_space(4))) Params* KParamsPtr;
DI Params load_params() {
#if defined(__HIP_DEVICE_COMPILE__)
  KParamsPtr kp = (KParamsPtr)__builtin_amdgcn_kernarg_segment_ptr();
  asm volatile("" : "+s"(kp));
  Params r;
  __builtin_memcpy(&r, kp, sizeof(Params));
  return r;
#else
  return Params{};
#endif
}
#define PH(call) { const Params p = load_params(); call; }
__global__ void __launch_bounds__(256, 2) mega_kernel(Params p_unused) {
  extern __shared__ __attribute__((aligned(16))) char smem[];
  cg::grid_group grid = cg::this_grid();
  unsigned bgen = 0;
  const unsigned xcc = (unsigned)__builtin_amdgcn_s_getreg((3 << 11) | 20) & 15u;
  if (threadIdx.x == 0) {
    const Params pb = load_params();
    __hip_atomic_fetch_add((unsigned*)(pb.ws + OFF_BAR) + (18 + xcc) * 64, 1u, __ATOMIC_RELAXED, __HIP_MEMORY_SCOPE_AGENT);
  }
  PH(phase0(p, smem));
  grid.sync();
  unsigned nxcc = 0, nx = 0;
  {
    const Params pb = load_params();
    const unsigned* cen = (const unsigned*)(pb.ws + OFF_BAR) + 18 * 64;
    for (unsigned j = 0; j < 16; ++j) {
      const unsigned cj = __hip_atomic_load(cen + j * 64, __ATOMIC_RELAXED, __HIP_MEMORY_SCOPE_AGENT);
      nx += (cj != 0);
      if (j == xcc) nxcc = cj;
    }
  }
#define GBAR() { const Params pb = load_params(); grid_barrier((unsigned*)(pb.ws + OFF_BAR), bgen, xcc, nxcc, nx); }
#pragma unroll 1
  for (int g = 0; g < NGRP; ++g) {
#pragma unroll 1
    for (int l = 0; l < 4; ++l) {
      PH(phase_norm(p, l, g));
      GBAR();
      PH(phase_gemm_in(p, l, smem, g * 4 + l));
      GBAR();
      if (l & 1) {
        PH(phase_mix_odd(p, l, g, smem));
        GBAR();
        PH(phase_gla_combine(p, l));
      } else {
        PH(phase_mix_even(p, l, g, smem));
      }
      GBAR();
      PH(phase_gemm_out(p, l, smem, 8 + g * 4 + l));
      GBAR();
    }
    PH(phase_norm(p, 4, g));
    GBAR();
  }
}

extern "C" void kernel_launch(void* const* d_in, const int* in_sizes, int n_in, void* d_out, int out_size, void* d_ws,
                              size_t ws_size, hipStream_t stream) {
  static int grid_blocks = 0;
  if (!grid_blocks) {
    int dev = 0, cus = 0, per_cu = 0;
    hipGetDevice(&dev);
    hipDeviceGetAttribute(&cus, hipDeviceAttributeMultiprocessorCount, dev);
    hipFuncSetAttribute((const void*)mega_kernel, hipFuncAttributeMaxDynamicSharedMemorySize, SMEM_BYTES);
    hipOccupancyMaxActiveBlocksPerMultiprocessor(&per_cu, mega_kernel, 256, SMEM_BYTES);
    if (per_cu > 2) per_cu = 2;
    if (per_cu < 1) per_cu = 1;
    grid_blocks = cus * per_cu;
    grid_blocks &= ~15;
  }
  if (ws_size < WS_NEED) { fprintf(stderr, "workspace too small: %zu < %zu\n", ws_size, (size_t)WS_NEED); return; }
  Params p{};
  p.x = (const float*)d_in[0]; p.c = (const float*)d_in[1]; p.ctx = (const float*)d_in[2]; p.c_ctx = (const float*)d_in[3];
  p.w_mod = (const float*)d_in[4]; p.b_mod = (const float*)d_in[5]; p.g_pre = (const float*)d_in[6]; p.g_post = (const float*)d_in[7];
  p.w_out = (const float*)d_in[8]; p.ev_w_in = (const float*)d_in[9]; p.ev_lambda = (const float*)d_in[10]; p.ev_subln = (const float*)d_in[11];
  p.ev_conv = (const float*)d_in[12]; p.od_w_in = (const float*)d_in[13]; p.od_rpb = (const float*)d_in[14]; p.od_gate_up = (const float*)d_in[15];
  p.od_gate_bias = (const float*)d_in[16]; p.od_gnorm = (const float*)d_in[17];
  p.out = (float*)d_out;
  p.ws = (char*)d_ws;
  (void)hipMemsetAsync((char*)d_ws + OFF_BAR, 0, BAR_BYTES, stream);
  void* args[] = {&p};
  hipError_t e = hipLaunchCooperativeKernel((const void*)mega_kernel, dim3(grid_blocks), dim3(256), args, SMEM_BYTES, stream);
  if (e != hipSuccess) fprintf(stderr, "cooperative launch failed: %s (grid %d)\n", hipGetErrorString(e), grid_blocks);
}
```

```cpp
#include <hip/hip_runtime.h>
#include <hip/hip_cooperative_groups.h>
#include <cstdio>
namespace cg = cooperative_groups;

typedef unsigned short bfr;
typedef __attribute__((ext_vector_type(8))) short bf16x8;
typedef __attribute__((ext_vector_type(4))) float f32x4;
typedef __attribute__((ext_vector_type(4))) unsigned u32x4;
typedef __attribute__((ext_vector_type(2))) unsigned u32x2;
typedef __attribute__((ext_vector_type(16))) unsigned u32x16;
typedef __attribute__((ext_vector_type(2))) __bf16 bf16x2_t;
#define DI __device__ __forceinline__
DI float dot2bf(unsigned a, unsigned b, float c) { return __builtin_amdgcn_fdot2_f32_bf16(__builtin_bit_cast(bf16x2_t, a), __builtin_bit_cast(bf16x2_t, b), c, false); }
DI int opaque_tid() { int t = threadIdx.x; asm volatile("" : "+v"(t)); return t; }

constexpr int GB   = 4;
constexpr int NGRP = 2;
constexpr int ML   = GB * 4096;
constexpr int MC   = GB * 256;
constexpr int MR   = ML + MC;
constexpr int NEV  = 8192;
constexpr int NOD  = 7296;
constexpr int KEYS = 4352;
constexpr float L2E = 1.4426950408889634f;
constexpr float LN2 = 0.6931471805599453f;

constexpr size_t SZ_PROJ = (size_t)MR * 8192 * 2;
constexpr size_t SZ_H    = (size_t)MR * 1024 * 2;
constexpr size_t SZ_U    = (size_t)MR * 2048 * 2;
constexpr size_t SZ_VT   = (size_t)GB * 1024 * KEYS * 2;
constexpr size_t SZ_WE   = (size_t)NEV * 1024 * 2;
constexpr size_t SZ_WO   = (size_t)NOD * 1024 * 2;
constexpr size_t SZ_WOUT = (size_t)1024 * 2048 * 2;
constexpr size_t OFF_PROJ = 0;
constexpr size_t OFF_H    = OFF_PROJ + SZ_PROJ;
constexpr size_t OFF_U    = OFF_H + SZ_H;
constexpr size_t OFF_VT   = OFF_U + SZ_U;
constexpr size_t OFF_WIN  = OFF_VT + SZ_VT;
constexpr size_t OFF_WOUT = OFF_WIN + 2 * SZ_WE + 2 * SZ_WO;
constexpr size_t OFF_XC   = OFF_WOUT + 4 * SZ_WOUT;
constexpr size_t OFF_MOD  = OFF_XC + (size_t)8 * 256 * 1024 * 4;
constexpr size_t OFF_CS   = OFF_MOD + (size_t)4 * 9 * 3072 * 4;
constexpr size_t OFF_LAM  = OFF_CS + 64 * 16 * 8;
constexpr size_t OFF_CTR  = OFF_LAM + 256;
constexpr size_t OFF_BAR  = OFF_CTR + 256;
constexpr size_t BAR_BYTES = 34 * 256 + 192 * 64;
constexpr size_t SZ_ET    = (size_t)(MR / 64) * 4 * 16384;
constexpr size_t OFF_ETF  = OFF_PROJ + (size_t)MR * NOD * 2;
constexpr size_t OFF_ETB  = (OFF_BAR + BAR_BYTES + 255) & ~(size_t)255;
constexpr size_t OFF_DEC  = OFF_ETB + SZ_ET;
constexpr size_t WS_NEED  = OFF_DEC + (size_t)2 * (MR / 64) * 4 * 128 * 4;
static_assert(OFF_ETF + SZ_ET <= OFF_H, "E^T forward tiles must fit behind the odd proj rows");

constexpr int SMEM_BYTES = 80896;

struct Params {
  const float *x, *c, *ctx, *c_ctx, *w_mod, *b_mod, *g_pre, *g_post, *w_out, *ev_w_in, *ev_lambda, *ev_subln,
      *ev_conv, *od_w_in, *od_rpb, *od_gate_up, *od_gate_bias, *od_gnorm;
  float* out;
  char* ws;
};

DI size_t win_off(int l) { return OFF_WIN + (size_t)(l >> 1) * (SZ_WE + SZ_WO) + ((l & 1) ? SZ_WE : 0); }

DI float bf2f(bfr v) { return __uint_as_float(((unsigned)v) << 16); }
typedef __attribute__((ext_vector_type(2))) float f32x2_t;
DI bfr f2bf(float x) { return __builtin_bit_cast(bfr, (__bf16)x); }
DI unsigned pack2(float a, float b) { f32x2_t v = {a, b}; return __builtin_bit_cast(unsigned, __builtin_convertvector(v, bf16x2_t)); }
DI float lo_bf(unsigned u) { return __uint_as_float(u << 16); }
DI float hi_bf(unsigned u) { return __uint_as_float(u & 0xffff0000u); }
DI float fexp2(float x) { return __builtin_amdgcn_exp2f(x); }
DI float flog2(float x) { return __builtin_amdgcn_logf(x); }
DI float silu(float x) { return x / (1.f + fexp2(-x * L2E)); }
DI float max3f(float a, float b, float c) { float r; asm("v_max3_f32 %0, %1, %2, %3" : "=v"(r) : "v"(a), "v"(b), "v"(c)); return r; }
template <int M>
DI float shx(float v, int lane) {
  if (M < 32) return __builtin_bit_cast(float, __builtin_amdgcn_ds_swizzle(__builtin_bit_cast(int, v), (M << 10) | 0x1f));
  return __builtin_bit_cast(float, __builtin_amdgcn_ds_bpermute((lane ^ 32) << 2, __builtin_bit_cast(int, v)));
}
DI float wave_sum(float v, int lane) {
  v += shx<1>(v, lane); v += shx<2>(v, lane); v += shx<4>(v, lane); v += shx<8>(v, lane); v += shx<16>(v, lane); v += shx<32>(v, lane);
  return v;
}
DI f32x4 mfma16(bf16x8 a, bf16x8 b, f32x4 c) { return __builtin_amdgcn_mfma_f32_16x16x32_bf16(a, b, c, 0, 0, 0); }
DI int sw128(int row, int chunk) { return row * 128 + ((chunk ^ ((row >> 1) & 7)) << 4); }
DI int sw256(int row, int chunk) { return row * 256 + ((chunk ^ (row & 15)) << 4); }

DI void store_pair16(bfr* tile_i_ptr, const f32x4& a, const f32x4& b, int q) {
  const unsigned ax = pack2(a[0], a[1]), ay = pack2(a[2], a[3]), bx = pack2(b[0], b[1]), by = pack2(b[2], b[3]);
  const u32x2 r0 = __builtin_amdgcn_permlane16_swap(ax, bx, false, false);
  const u32x2 r1 = __builtin_amdgcn_permlane16_swap(ay, by, false, false);
  *(u32x4*)(tile_i_ptr + (q & 1) * 16 + (q >> 1) * 8) = (u32x4){r0.x, r1.x, r0.y, r1.y};
}

struct GemmStage { u32x4 xa0[4], ya0[4], xa1[4], ya1[4]; };
DI void gemm_prologue(const bfr* __restrict__ X, int ldx, const bfr* __restrict__ Y, int ldy, GemmStage& st) {
  const int tid = opaque_tid();
  const int lr = tid >> 3, lc = tid & 7;
  const bfr* xp = X + (size_t)lr * ldx + lc * 8;
  const bfr* yp = Y + (size_t)lr * ldy + lc * 8;
#pragma unroll
  for (int i = 0; i < 4; ++i) {
    st.xa0[i] = *(const u32x4*)(xp + (size_t)(32 * i) * ldx);
    st.ya0[i] = *(const u32x4*)(yp + (size_t)(32 * i) * ldy);
    st.xa1[i] = *(const u32x4*)(xp + (size_t)(32 * i) * ldx + 64);
    st.ya1[i] = *(const u32x4*)(yp + (size_t)(32 * i) * ldy + 64);
  }
}
DI void gemm_mainloop(const bfr* __restrict__ X, int ldx, const bfr* __restrict__ Y, int ldy, int K,
                      const bfr* __restrict__ Xn, const bfr* __restrict__ Yn, bool hasnext, char* smem,
                      f32x4 (&acc)[4][4], GemmStage& st) {
  const int tid = opaque_tid(), lane = tid & 63, wid = tid >> 6, r = lane & 15, q = lane >> 4;
  const int wx = wid >> 1, wy = wid & 1;
  const int lr = tid >> 3, lc = tid & 7;
  const bfr* xp = X + (size_t)lr * ldx + lc * 8;
  const bfr* yp = Y + (size_t)lr * ldy + lc * 8;
  const bfr* xpn = Xn + (size_t)lr * ldx + lc * 8;
  const bfr* ypn = Yn + (size_t)lr * ldy + lc * 8;
  const int nk = K >> 6;
#define GEMM_STEP(XR, YR, BUF, KT)                                                                       \
  {                                                                                                      \
    char* sX = smem + (BUF) * 32768;                                                                     \
    char* sY = sX + 16384;                                                                               \
    _Pragma("unroll") for (int i = 0; i < 4; ++i) {                                                      \
      *(u32x4*)(sX + sw128(lr + 32 * i, lc)) = XR[i];                                                    \
      *(u32x4*)(sY + sw128(lr + 32 * i, lc)) = YR[i];                                                    \
    }                                                                                                    \
    __syncthreads();                                                                                     \
    if ((KT) + 2 < nk) {                                                                                 \
      const int ko = ((KT) + 2) * 64;                                                                    \
      _Pragma("unroll") for (int i = 0; i < 4; ++i) {                                                    \
        XR[i] = *(const u32x4*)(xp + (size_t)(32 * i) * ldx + ko);                                       \
        YR[i] = *(const u32x4*)(yp + (size_t)(32 * i) * ldy + ko);                                       \
      }                                                                                                  \
    } else if (hasnext) {                                                                                \
      const int ko = ((KT) + 2 - nk) * 64;                                                               \
      _Pragma("unroll") for (int i = 0; i < 4; ++i) {                                                    \
        XR[i] = *(const u32x4*)(xpn + (size_t)(32 * i) * ldx + ko);                                      \
        YR[i] = *(const u32x4*)(ypn + (size_t)(32 * i) * ldy + ko);                                      \
      }                                                                                                  \
    }                                                                                                    \
    _Pragma("unroll") for (int s = 0; s < 2; ++s) {                                                      \
      bf16x8 xf[4], yf[4];                                                                               \
      _Pragma("unroll") for (int i = 0; i < 4; ++i)                                                      \
          xf[i] = *(const bf16x8*)(sX + sw128(wx * 64 + i * 16 + r, s * 4 + q));                         \
      _Pragma("unroll") for (int j = 0; j < 4; ++j)                                                      \
          yf[j] = *(const bf16x8*)(sY + sw128(wy * 64 + j * 16 + r, s * 4 + q));                         \
      __builtin_amdgcn_s_setprio(1);                                                                     \
      _Pragma("unroll") for (int i = 0; i < 4; ++i)                                                      \
          _Pragma("unroll") for (int j = 0; j < 4; ++j) acc[i][j] = mfma16(xf[i], yf[j], acc[i][j]);     \
      __builtin_amdgcn_s_setprio(0);                                                                     \
    }                                                                                                    \
  }
  for (int kt = 0; kt < nk; kt += 2) {
    GEMM_STEP(st.xa0, st.ya0, 0, kt);
    GEMM_STEP(st.xa1, st.ya1, 1, kt + 1);
  }
#undef GEMM_STEP
  __syncthreads();
}

DI bool tile_map(int T, int MT, int NT, int& mt, int& nt) {
  const int pm_n = MT >> 3;
  const int P = (T >> 9) * 8 + (T & 7);
  const int li = (T & 511) >> 3;
  const int pm = P % pm_n, pn = P / pm_n;
  mt = pm * 8 + (li & 7);
  nt = pn * 8 + (li >> 3);
  return nt < NT;
}

DI int odd_col_src(int n) {
  if (n < 3584) return n;
  if (n < 7168) return n + 32;
  if (n < 7200) return n - 7168 + 3584;
  return -1;
}

DI void phase0(const Params& p, char* smem) {
  const int tid = opaque_tid();
  if (blockIdx.x < 384) {
    float* sc = (float*)smem;
    float* red = sc + 9 * 1024;
    for (int i = tid; i < 9 * 1024; i += 256) {
      const int b = i >> 10, k = i & 1023;
      const float v = (b < 8) ? p.c[b * 1024 + k] : p.c_ctx[k];
      sc[i] = v / (1.f + __expf(-v));
    }
    __syncthreads();
    float* modb = (float*)(p.ws + OFF_MOD);
    for (int it = blockIdx.x; it < 384; it += gridDim.x) {
      const int l = it / 96, cgp = it % 96;
      const int col = cgp * 32 + (tid & 31), ks = tid >> 5;
      float a[9];
#pragma unroll
      for (int b = 0; b < 9; ++b) a[b] = 0.f;
      const float* w = p.w_mod + ((size_t)l * 1024 + ks * 128) * 3072 + col;
#pragma unroll 4
      for (int k = 0; k < 128; ++k) {
        const float wv = w[(size_t)k * 3072];
#pragma unroll
        for (int b = 0; b < 9; ++b) a[b] += sc[b * 1024 + ks * 128 + k] * wv;
      }
#pragma unroll
      for (int b = 0; b < 9; ++b) red[(ks * 9 + b) * 32 + (tid & 31)] = a[b];
      __syncthreads();
      for (int idx = tid; idx < 288; idx += 256) {
        const int b = idx >> 5, cc = idx & 31;
        float s = p.b_mod[l * 3072 + cgp * 32 + cc];
#pragma unroll
        for (int k2 = 0; k2 < 8; ++k2) s += red[(k2 * 9 + b) * 32 + cc];
        modb[(size_t)(l * 9 + b) * 3072 + cgp * 32 + cc] = s;
      }
      __syncthreads();
    }
  }
  if (blockIdx.x == gridDim.x - 1) {
    float2* cs = (float2*)(p.ws + OFF_CS);
    for (int idx = tid; idx < 1024; idx += 256) {
      const int pos = idx >> 4, f = idx & 15;
      const float inv = 1.0f / powf(10000.f, (float)f * 0.0625f);
      const float ang = (float)pos * inv;
      const double ad = (double)ang;
      const double n = rint(ad * 0.15915494309189535);
      const float rr = (float)(ad - n * 6.283185307179586);
      cs[idx] = make_float2(__cosf(rr), __sinf(rr));
    }
    if (tid < 2) {
      const float* lp = p.ev_lambda + tid * 256;
      float s1 = 0.f, s2 = 0.f;
      for (int i = 0; i < 64; ++i) { s1 += lp[i] * lp[64 + i]; s2 += lp[128 + i] * lp[192 + i]; }
      const float li = (tid == 0) ? 0.2f : (0.8f - 0.6f * 0.5488116360940264f);
      float* lam = (float*)(p.ws + OFF_LAM);
      lam[tid] = __expf(s1) - __expf(s2) + li;
      lam[2 + tid] = li;
    }
    if (tid < 32) ((int*)(p.ws + OFF_CTR))[tid] = 0;
  }
  float* tile = (float*)smem;
  __syncthreads();
  for (int it = blockIdx.x; it < 9792; it += gridDim.x) {
    int rr = it, l, ktile, ntile, K, Nsrc;
    const float* src;
    bfr* dst;
    bool oddmap = false;
    if (rr < 7744) {
      if (rr < 2048) { l = 0; } else if (rr < 3872) { l = 1; rr -= 2048; } else if (rr < 5920) { l = 2; rr -= 3872; } else { l = 3; rr -= 5920; }
      ktile = rr & 15; ntile = rr >> 4; K = 1024;
      oddmap = (l & 1);
      Nsrc = oddmap ? 7200 : 8192;
      src = (oddmap ? p.od_w_in : p.ev_w_in) + (size_t)(l >> 1) * 1024 * Nsrc;
      dst = (bfr*)(p.ws + win_off(l));
    } else {
      rr -= 7744; l = rr >> 9; rr &= 511;
      ktile = rr & 31; ntile = rr >> 5; K = 2048; Nsrc = 1024;
      src = p.w_out + (size_t)l * 2048 * 1024;
      dst = (bfr*)(p.ws + OFF_WOUT + (size_t)l * SZ_WOUT);
    }
    const int k0 = ktile * 64, n0 = ntile * 64;
    {
      const int nn = tid & 63;
      const int nd = n0 + nn;
      const int ns = oddmap ? odd_col_src(nd) : nd;
#pragma unroll 4
      for (int i = 0; i < 16; ++i) {
        const int kk = (tid >> 6) + 4 * i;
        tile[kk * 65 + nn] = (ns >= 0) ? src[(size_t)(k0 + kk) * Nsrc + ns] : 0.f;
      }
    }
    __syncthreads();
    {
      const int kk8 = (tid & 7) * 8;
#pragma unroll
      for (int i2 = 0; i2 < 2; ++i2) {
        const int nn = (tid >> 3) + 32 * i2;
        u32x4 v;
        v.x = pack2(tile[(kk8 + 0) * 65 + nn], tile[(kk8 + 1) * 65 + nn]);
        v.y = pack2(tile[(kk8 + 2) * 65 + nn], tile[(kk8 + 3) * 65 + nn]);
        v.z = pack2(tile[(kk8 + 4) * 65 + nn], tile[(kk8 + 5) * 65 + nn]);
        v.w = pack2(tile[(kk8 + 6) * 65 + nn], tile[(kk8 + 7) * 65 + nn]);
        *(u32x4*)(dst + (size_t)(n0 + nn) * K + k0 + kk8) = v;
      }
    }
    __syncthreads();
  }
}

DI void phase_norm(const Params& p, int l, int g) {
  const int tid = opaque_tid(), lane = tid & 63, wid = tid >> 6;
  const int rows = (l == 4) ? ML : MR;
  const float* modb = (const float*)(p.ws + OFF_MOD);
  const bfr* ybuf = (const bfr*)(p.ws + OFF_PROJ);
  bfr* hbuf = (bfr*)(p.ws + OFF_H);
  float* xcb = (float*)(p.ws + OFF_XC);
  for (int row = blockIdx.x * 4 + wid; row < rows; row += gridDim.x * 4) {
    const bool lat = row < ML;
    const int mb = lat ? (g * GB + (row >> 12)) : 8;
    const size_t grow = lat ? ((size_t)g * ML + row) : ((size_t)g * MC + (row - ML));
    const float* xin;
    float* xst;
    if (lat) { xin = ((l <= 1) ? p.x : (const float*)p.out) + grow * 1024; xst = p.out + grow * 1024; }
    else     { xin = ((l <= 1) ? p.ctx : (const float*)xcb) + grow * 1024; xst = xcb + grow * 1024; }
    float4 xv[4];
#pragma unroll
    for (int i = 0; i < 4; ++i) xv[i] = *(const float4*)(xin + lane * 4 + 256 * i);
    if (l >= 1) {
      float4 yv[4];
      float ss = 0.f;
#pragma unroll
      for (int i = 0; i < 4; ++i) {
        const u32x2 yr = *(const u32x2*)(ybuf + (size_t)row * 1024 + lane * 4 + 256 * i);
        yv[i] = make_float4(lo_bf(yr.x), hi_bf(yr.x), lo_bf(yr.y), hi_bf(yr.y));
        ss += yv[i].x * yv[i].x + yv[i].y * yv[i].y + yv[i].z * yv[i].z + yv[i].w * yv[i].w;
      }
      ss = wave_sum(ss, lane);
      const float rn = rsqrtf(ss * (1.f / 1024.f) + 1e-6f);
      const float* gate = modb + (size_t)((l - 1) * 9 + mb) * 3072 + 2048;
      const float* gp = p.g_post + (l - 1) * 1024;
#pragma unroll
      for (int i = 0; i < 4; ++i) {
        const int c0 = lane * 4 + 256 * i;
        const float4 gt = *(const float4*)(gate + c0);
        const float4 gg = *(const float4*)(gp + c0);
        xv[i].x += gt.x * (yv[i].x * rn * gg.x);
        xv[i].y += gt.y * (yv[i].y * rn * gg.y);
        xv[i].z += gt.z * (yv[i].z * rn * gg.z);
        xv[i].w += gt.w * (yv[i].w * rn * gg.w);
        *(float4*)(xst + c0) = xv[i];
      }
    }
    if (l < 4) {
      float ss = 0.f;
#pragma unroll
      for (int i = 0; i < 4; ++i) ss += xv[i].x * xv[i].x + xv[i].y * xv[i].y + xv[i].z * xv[i].z + xv[i].w * xv[i].w;
      ss = wave_sum(ss, lane);
      const float rn = rsqrtf(ss * (1.f / 1024.f) + 1e-6f);
      const float* mrow = modb + (size_t)(l * 9 + mb) * 3072;
      const float* gpre = p.g_pre + l * 1024;
#pragma unroll
      for (int i = 0; i < 4; ++i) {
        const int c0 = lane * 4 + 256 * i;
        const float4 sh = *(const float4*)(mrow + c0);
        const float4 scl = *(const float4*)(mrow + 1024 + c0);
        const float4 gg = *(const float4*)(gpre + c0);
        u32x2 o;
        o.x = pack2(xv[i].x * rn * gg.x * (1.f + scl.x) + sh.x, xv[i].y * rn * gg.y * (1.f + scl.y) + sh.y);
        o.y = pack2(xv[i].z * rn * gg.z * (1.f + scl.z) + sh.z, xv[i].w * rn * gg.w * (1.f + scl.w) + sh.w);
        *(u32x2*)(hbuf + (size_t)row * 1024 + c0) = o;
      }
    }
  }
}

DI void gla_gate_precompute(const Params& p, int l, int m0, const char* sLr, float* sHs) {
  const int tid = opaque_tid();
  const int d = tid & 127, half = tid >> 7;
  const int jl = l >> 1;
#pragma unroll 1
  for (int unit = 0; unit < 16; ++unit) {
    const int cc = unit & 1, dir = (unit >> 1) & 1, head = unit >> 2;
    unsigned gu[8];
#pragma unroll
    for (int k = 0; k < 8; ++k)
      gu[k] = pack2(p.od_gate_up[(((size_t)jl * 2 + dir) * 16 + 2 * k) * 512 + head * 128 + d],
                    p.od_gate_up[(((size_t)jl * 2 + dir) * 16 + 2 * k + 1) * 512 + head * 128 + d]);
    const float gbias = p.od_gate_bias[((size_t)jl * 2 + dir) * 512 + head * 128 + d];
    float gl[32];
    float tot = 0.f;
#pragma unroll
    for (int i = 0; i < 32; ++i) {
      const int tk = cc * 64 + half * 32 + i;
      const u32x4 la = *(const u32x4*)(sLr + tk * 64 + dir * 32);
      const u32x4 lb = *(const u32x4*)(sLr + tk * 64 + dir * 32 + 16);
      float z = gbias;
      z = dot2bf(la.x, gu[0], z); z = dot2bf(la.y, gu[1], z); z = dot2bf(la.z, gu[2], z); z = dot2bf(la.w, gu[3], z);
      z = dot2bf(lb.x, gu[4], z); z = dot2bf(lb.y, gu[5], z); z = dot2bf(lb.z, gu[6], z); z = dot2bf(lb.w, gu[7], z);
      const float tneg = fexp2(-fabsf(z) * L2E);
      const float g = (fminf(z, 0.f) - flog2(1.f + tneg) * LN2) * (L2E / 16.f);
      gl[i] = g;
      tot += g;
    }
    if (dir == 0) {
      float run = 0.f;
#pragma unroll
      for (int i = 0; i < 32; ++i) { run += gl[i]; gl[i] = run; }
    } else {
      float run = 0.f;
#pragma unroll
      for (int i = 31; i >= 0; --i) { run += gl[i]; gl[i] = run; }
    }
    __syncthreads();
    sHs[half * 128 + d] = tot;
    __syncthreads();
    const float other = sHs[(1 - half) * 128 + d];
    const float offs = (dir == 0) ? (half ? other : 0.f) : (half ? 0.f : other);
    const int chunk = (m0 >> 6) + cc;
    char* et = p.ws + (dir ? OFF_ETB : OFF_ETF) + ((size_t)chunk * 4 + head) * 16384;
#pragma unroll
    for (int i8 = 0; i8 < 4; ++i8) {
      u32x4 v;
      v.x = pack2(fexp2(gl[i8 * 8 + 0] + offs), fexp2(gl[i8 * 8 + 1] + offs));
      v.y = pack2(fexp2(gl[i8 * 8 + 2] + offs), fexp2(gl[i8 * 8 + 3] + offs));
      v.z = pack2(fexp2(gl[i8 * 8 + 4] + offs), fexp2(gl[i8 * 8 + 5] + offs));
      v.w = pack2(fexp2(gl[i8 * 8 + 6] + offs), fexp2(gl[i8 * 8 + 7] + offs));
      *(u32x4*)(et + sw128(d, half * 4 + i8)) = v;
    }
    if (half == 0)
      ((float*)(p.ws + OFF_DEC))[(((size_t)dir * (MR / 64) + chunk) * 4 + head) * 128 + d] = fexp2(tot + other);
  }
}

struct TileQ {
  unsigned* base;
  int* slot;
  int x, dq, pend;
  bool has_pend;
};
DI int tileq_fetch(TileQ& tq) {
  __syncthreads();
  if (threadIdx.x == 0) {
    int j = tq.has_pend ? tq.pend : (int)__hip_atomic_fetch_add(tq.base + tq.x * 16, 1u, __ATOMIC_RELAXED, __HIP_MEMORY_SCOPE_AGENT);
    *tq.slot = j;
  }
  tq.has_pend = false;
  __syncthreads();
  return *tq.slot;
}
DI void tileq_prefetch(TileQ& tq) {
  if (threadIdx.x == 0) {
    tq.pend = (int)__hip_atomic_fetch_add(tq.base + tq.x * 16, 1u, __ATOMIC_RELAXED, __HIP_MEMORY_SCOPE_AGENT);
  }
  tq.has_pend = true;
}

DI bool tileq_next(TileQ& tq, int pm_n, int NP, int NT, int xcc0, int& mt, int& nt) {
  for (;;) {
    if (tq.dq >= 8) return false;
    const int j = tileq_fetch(tq);
    const int P = (j >> 6) * 8 + tq.x;
    if (P >= NP) { ++tq.dq; tq.x = (xcc0 + tq.dq) & 7; tq.has_pend = false; continue; }
    const int li = j & 63;
    mt = (P % pm_n) * 8 + (li & 7);
    nt = (P / pm_n) * 8 + (li >> 3);
    if (nt >= NT) continue;
    tileq_prefetch(tq);
    return true;
  }
}

DI void phase_gemm_in(const Params& p, int l, char* smem, int inst) {
  const int tid = opaque_tid(), lane = tid & 63, wid = tid >> 6, r = lane & 15, q = lane >> 4;
  const int wx = wid >> 1, wy = wid & 1;
  const bool even = !(l & 1);
  const int ldp = even ? NEV : NOD;
  const int NT = even ? 64 : 56, MT = MR >> 7;
  const bfr* WT = (const bfr*)(p.ws + win_off(l));
  const bfr* H = (const bfr*)(p.ws + OFF_H);
  bfr* proj = (bfr*)(p.ws + OFF_PROJ);
  bfr* VT = (bfr*)(p.ws + OFF_VT);
  const float2* cs = (const float2*)(p.ws + OFF_CS);
  const int pm_n = MT >> 3, NP = pm_n * ((NT + 7) >> 3);
  TileQ tq;
  tq.base = (unsigned*)(p.ws + OFF_BAR) + 34 * 64 + inst * 128;
  tq.slot = (int*)(smem + SMEM_BYTES - 16);
  tq.has_pend = false; tq.pend = 0;
  const int xcc0 = (int)(__builtin_amdgcn_s_getreg((3 << 11) | 20) & 7u);
  if (!even) {
    TileQ lq;
    lq.base = (unsigned*)(p.ws + OFF_BAR) + 34 * 64 + (16 + inst) * 128;
    lq.slot = tq.slot; lq.has_pend = false; lq.pend = 0; lq.x = 0; lq.dq = 0;
    for (;;) {
      const int j = tileq_fetch(lq);
      if (j >= MT) break;
      const int m0 = j * 128, n0 = 7168;
      GemmStage g2;
      gemm_prologue(WT + (size_t)n0 * 1024, 1024, H + (size_t)m0 * 1024, 1024, g2);
      f32x4 acc[4][4];
#pragma unroll
      for (int i = 0; i < 4; ++i)
#pragma unroll
        for (int jj = 0; jj < 4; ++jj) acc[i][jj] = (f32x4){0.f, 0.f, 0.f, 0.f};
      gemm_mainloop(WT + (size_t)n0 * 1024, 1024, H + (size_t)m0 * 1024, 1024, 1024, WT, H, false, smem, acc, g2);
#pragma unroll
      for (int jn = 0; jn < 4; ++jn) {
        const int m = m0 + wy * 64 + jn * 16 + r;
#pragma unroll
        for (int i = 0; i < 4; ++i) {
          const int n = n0 + wx * 64 + i * 16 + 4 * q;
          u32x2 o;
          o.x = pack2(acc[i][jn][0], acc[i][jn][1]);
          o.y = pack2(acc[i][jn][2], acc[i][jn][3]);
          *(u32x2*)(proj + (size_t)m * ldp + n) = o;
        }
      }
      char* sLr = smem;
      float* sHs = (float*)(smem + 8192);
      if (wx == 0) {
#pragma unroll
        for (int jn = 0; jn < 4; ++jn)
#pragma unroll
          for (int i = 0; i < 2; ++i) {
            u32x2 o;
            o.x = pack2(acc[i][jn][0], acc[i][jn][1]);
            o.y = pack2(acc[i][jn][2], acc[i][jn][3]);
            *(u32x2*)(sLr + (wy * 64 + jn * 16 + r) * 64 + (i * 16 + 4 * q) * 2) = o;
          }
      }
      __syncthreads();
      gla_gate_precompute(p, l, m0, sLr, sHs);
      __syncthreads();
    }
  }
  tq.dq = 0; tq.x = xcc0;
  GemmStage gst;
  int mt = 0, nt = 0;
  bool have = tileq_next(tq, pm_n, NP, NT, xcc0, mt, nt);
  bool loaded = false;
  {
   while (have) {
    const int m0 = mt * 128, n0 = nt * 128;
    const bool vt = (n0 >= 1024 && n0 < 2048);
    const bfr* X = vt ? (H + (size_t)m0 * 1024) : (WT + (size_t)n0 * 1024);
    const bfr* Y = vt ? (WT + (size_t)n0 * 1024) : (H + (size_t)m0 * 1024);
    if (!loaded) gemm_prologue(X, 1024, Y, 1024, gst);
    int mtn = 0, ntn = 0;
    const bool haven = tileq_next(tq, pm_n, NP, NT, xcc0, mtn, ntn);
    const bool stream = haven;
    const int m0n = mtn * 128, n0n = ntn * 128;
    const bool vtn = (n0n >= 1024 && n0n < 2048);
    const bfr* Xn = vtn ? (H + (size_t)m0n * 1024) : (WT + (size_t)n0n * 1024);
    const bfr* Yn = vtn ? (WT + (size_t)n0n * 1024) : (H + (size_t)m0n * 1024);
    f32x4 acc[4][4];
#pragma unroll
    for (int i = 0; i < 4; ++i)
#pragma unroll
      for (int j = 0; j < 4; ++j) acc[i][j] = (f32x4){0.f, 0.f, 0.f, 0.f};
    gemm_mainloop(X, 1024, Y, 1024, 1024, Xn, Yn, stream, smem, acc, gst);
    loaded = stream;
    if (vt) {
#pragma unroll
      for (int i = 0; i < 4; i += 2) {
        const int mbase = m0 + wx * 64 + i * 16;
        int b, kp;
        if (mbase < ML) { b = mbase >> 12; kp = mbase & 4095; } else { const int mm = mbase - ML; b = mm >> 8; kp = 4096 + (mm & 255); }
        const int pos = (kp & ~31) + q * 8;
#pragma unroll
        for (int jn = 0; jn < 4; ++jn) {
          const int f = n0 - 1024 + wy * 64 + jn * 16 + r;
          u32x4 o;
          o.x = pack2(acc[i][jn][0], acc[i][jn][1]);
          o.y = pack2(acc[i][jn][2], acc[i][jn][3]);
          o.z = pack2(acc[i + 1][jn][0], acc[i + 1][jn][1]);
          o.w = pack2(acc[i + 1][jn][2], acc[i + 1][jn][3]);
          *(u32x4*)(VT + ((size_t)(b * 1024 + f)) * KEYS + pos) = o;
        }
      }
    } else {
      const bool rope = even && (n0 < 1024 || (n0 >= 2048 && n0 < 3072)) && (m0 < ML);
      if (rope) {
#pragma unroll
        for (int jn = 0; jn < 4; ++jn) {
          asm volatile("" ::: "memory");
          const int m = m0 + wy * 64 + jn * 16 + r;
          const int t = m & 4095;
          const int grow = t >> 6, gcol = t & 63;
#pragma unroll
          for (int j = 0; j < 4; ++j) {
            const float2 a = cs[grow * 16 + 4 * q + j];
            const float2 c = cs[gcol * 16 + 4 * q + j];
            const float x0 = acc[0][jn][j], x1 = acc[1][jn][j], x2 = acc[2][jn][j], x3 = acc[3][jn][j];
            acc[0][jn][j] = x0 * a.x - x1 * a.y;
            acc[1][jn][j] = x1 * a.x + x0 * a.y;
            acc[2][jn][j] = x2 * c.x - x3 * c.y;
            acc[3][jn][j] = x3 * c.x + x2 * c.y;
          }
        }
      }
#pragma unroll
      for (int jn = 0; jn < 4; ++jn) {
        const int m = m0 + wy * 64 + jn * 16 + r;
        bfr* rp = proj + (size_t)m * ldp + n0 + wx * 64;
        store_pair16(rp, acc[0][jn], acc[1][jn], q);
        store_pair16(rp + 32, acc[2][jn], acc[3][jn], q);
      }
    }
    mt = mtn; nt = ntn; have = haven;
  }
 }
}

DI void phase_gemm_out(const Params& p, int l, char* smem, int inst) {
  const int tid = opaque_tid(), lane = tid & 63, wid = tid >> 6, r = lane & 15, q = lane >> 4;
  const int wx = wid >> 1, wy = wid & 1;
  const bfr* WT = (const bfr*)(p.ws + OFF_WOUT + (size_t)l * SZ_WOUT);
  const bfr* U = (const bfr*)(p.ws + OFF_U);
  bfr* ybuf = (bfr*)(p.ws + OFF_PROJ);
  const int MT = (l == 3) ? (ML >> 7) : (MR >> 7);
  const int pm_n = MT >> 3, NP = pm_n;
  TileQ tq;
  tq.base = (unsigned*)(p.ws + OFF_BAR) + 34 * 64 + inst * 128;
  tq.slot = (int*)(smem + SMEM_BYTES - 16);
  tq.has_pend = false; tq.pend = 0;
  const int xcc0 = (int)(__builtin_amdgcn_s_getreg((3 << 11) | 20) & 7u);
  tq.dq = 0; tq.x = xcc0;
  GemmStage gst;
  int mt = 0, nt = 0;
  bool have = tileq_next(tq, pm_n, NP, 8, xcc0, mt, nt);
  bool loaded = false;
  while (have) {
    const int m0 = mt * 128, n0 = nt * 128;
    const bfr* X = WT + (size_t)n0 * 2048;
    const bfr* Y = U + (size_t)m0 * 2048;
    if (!loaded) gemm_prologue(X, 2048, Y, 2048, gst);
    int mtn = 0, ntn = 0;
    const bool haven = tileq_next(tq, pm_n, NP, 8, xcc0, mtn, ntn);
    const bfr* Xn = WT + (size_t)(ntn * 128) * 2048;
    const bfr* Yn = U + (size_t)(mtn * 128) * 2048;
    f32x4 acc[4][4];
#pragma unroll
    for (int i = 0; i < 4; ++i)
#pragma unroll
      for (int j = 0; j < 4; ++j) acc[i][j] = (f32x4){0.f, 0.f, 0.f, 0.f};
    gemm_mainloop(X, 2048, Y, 2048, 2048, Xn, Yn, haven, smem, acc, gst);
    loaded = haven;
#pragma unroll
    for (int jn = 0; jn < 4; ++jn) {
      const int m = m0 + wy * 64 + jn * 16 + r;
      bfr* rp = ybuf + (size_t)m * 1024 + n0 + wx * 64;
      store_pair16(rp, acc[0][jn], acc[1][jn], q);
      store_pair16(rp + 32, acc[2][jn], acc[3][jn], q);
    }
    mt = mtn; nt = ntn; have = haven;
  }
}

template <int DV, int QT, int KT, int MODE>
DI void attn_engine(const bfr* __restrict__ qbase, int ldq, const bfr* __restrict__ kbase, int ldk,
                    const bfr* __restrict__ vt, int nloc, int loc_row0, int loc_pos0, int nctx, int ctx_row0,
                    const float* rpb_s, int roff0, char* smem, f32x4 (&O)[DV / 16][QT], float (&lsum)[QT]) {
  constexpr int STAGE = 8192 + DV * 128;
  constexpr int NVL = DV / 32;
  const int tid = opaque_tid(), lane = tid & 63, wid = tid >> 6, r = lane & 15, q = lane >> 4;
  const int lr = tid >> 3, lc = tid & 7;
  constexpr float SC = 0.125f * L2E;

  bf16x8 Qf[QT][2];
#pragma unroll
  for (int qt = 0; qt < QT; ++qt)
#pragma unroll
    for (int s = 0; s < 2; ++s)
      Qf[qt][s] = *(const bf16x8*)(qbase + (size_t)(wid * 16 * QT + qt * 16 + r) * ldq + s * 32 + q * 8);
  float mrun[QT];
#pragma unroll
  for (int qt = 0; qt < QT; ++qt) {
    mrun[qt] = -1e30f;
    lsum[qt] = 0.f;
#pragma unroll
    for (int dt = 0; dt < DV / 16; ++dt) O[dt][qt] = (f32x4){0.f, 0.f, 0.f, 0.f};
  }

  const int nch = nloc + nctx;
  u32x4 kreg0, kreg1, vreg[NVL];
  const int ksw0 = sw128(lr, lc), ksw1 = sw128(lr + 32, lc);
#define AT_LOAD(c_)                                                                                          \
  {                                                                                                          \
    const int cc_ = (c_);                                                                                    \
    const int row_ = (cc_ < nloc) ? (loc_row0 + cc_ * 64) : (ctx_row0 + (cc_ - nloc) * 64);                  \
    const int pos_ = (cc_ < nloc) ? (loc_pos0 + cc_ * 64) : (4096 + (cc_ - nloc) * 64);                      \
    kreg0 = *(const u32x4*)(kbase + (size_t)(row_ + lr) * ldk + lc * 8);                                     \
    kreg1 = *(const u32x4*)(kbase + (size_t)(row_ + lr + 32) * ldk + lc * 8);                                \
    _Pragma("unroll") for (int i_ = 0; i_ < NVL; ++i_)                                                       \
        vreg[i_] = *(const u32x4*)(vt + (size_t)(lr + 32 * i_) * KEYS + pos_ + lc * 8);                      \
  }
#define AT_STORE(c_)                                                                                         \
  {                                                                                                          \
    char* sb_ = smem + ((c_) & 1) * STAGE;                                                                   \
    *(u32x4*)(sb_ + ksw0) = kreg0;                                                                           \
    *(u32x4*)(sb_ + ksw1) = kreg1;                                                                           \
    _Pragma("unroll") for (int i_ = 0; i_ < NVL; ++i_)                                                       \
        *(u32x4*)(sb_ + 8192 + sw128(lr + 32 * i_, lc)) = vreg[i_];                                          \
  }
  if (nch > 0) { AT_LOAD(0); AT_STORE(0); }
  for (int c = 0; c < nch; ++c) {
    __syncthreads();
    const bool more = (c + 1 < nch);
    const char* sK = smem + (c & 1) * STAGE;
    const char* sV = sK + 8192;
    if (more) AT_LOAD(c + 1);
    f32x4 stall[4 / KT][KT][QT];
#pragma unroll
    for (int sbk = 0; sbk < 4 / KT; ++sbk) {
#pragma unroll
      for (int kt = 0; kt < KT; ++kt)
#pragma unroll
        for (int qt = 0; qt < QT; ++qt) stall[sbk][kt][qt] = (f32x4){0.f, 0.f, 0.f, 0.f};
#pragma unroll
      for (int s = 0; s < 2; ++s)
#pragma unroll
        for (int kt = 0; kt < KT; ++kt) {
          const bf16x8 ka = *(const bf16x8*)(sK + sw128(sbk * KT * 16 + kt * 16 + r, s * 4 + q));
#pragma unroll
          for (int qt = 0; qt < QT; ++qt) stall[sbk][kt][qt] = mfma16(ka, Qf[qt][s], stall[sbk][kt][qt]);
        }
    }
#pragma unroll
    for (int sbk = 0; sbk < 4 / KT; ++sbk) {
      f32x4 (&st)[KT][QT] = stall[sbk];
      bf16x8 pb[KT / 2][QT];
      if (MODE == 1) {
#pragma unroll
        for (int kt = 0; kt < KT; ++kt)
#pragma unroll
          for (int qt = 0; qt < QT; ++qt)
#pragma unroll
            for (int j = 0; j < 4; ++j) {
              float v = st[kt][qt][j] * SC;
              if (c < nloc) {
                const int kc = sbk * KT * 16 + kt * 16 + 4 * q + j;
                const int qc = wid * 16 + r;
                int wst = qc - 8; wst = wst < 0 ? 0 : (wst > 48 ? 48 : wst);
                const bool valid = (kc >= wst) && (kc < wst + 16);
                int co = kc - qc + 15; co = co < 0 ? 0 : (co > 30 ? 30 : co);
                const float bias = rpb_s[(roff0 + c) * 31 + co] * L2E;
                v = valid ? (v + bias) : -INFINITY;
              }
              st[kt][qt][j] = v;
            }
      }
#pragma unroll
      for (int qt = 0; qt < QT; ++qt) {
        float mx = max3f(st[0][qt][0], st[0][qt][1], st[0][qt][2]);
        mx = max3f(mx, st[0][qt][3], st[1][qt][0]);
        mx = max3f(mx, st[1][qt][1], st[1][qt][2]);
#pragma unroll
        for (int kt = 2; kt < KT; ++kt) {
          mx = max3f(mx, st[kt - 1][qt][3], st[kt][qt][0]);
          mx = max3f(mx, st[kt][qt][1], st[kt][qt][2]);
        }
        mx = max3f(mx, st[KT - 1][qt][3], st[KT - 1][qt][3]);
        if (MODE != 1) mx *= SC;
        if (__any(mx > mrun[qt] + 8.f)) {
          mx = fmaxf(mx, shx<16>(mx, lane));
          mx = fmaxf(mx, shx<32>(mx, lane));
          const float mnew2 = fmaxf(mrun[qt], mx);
          const float alpha = fexp2(mrun[qt] - mnew2);
          mrun[qt] = mnew2;
          lsum[qt] *= alpha;
#pragma unroll
          for (int dt = 0; dt < DV / 16; ++dt) {
            O[dt][qt][0] *= alpha; O[dt][qt][1] *= alpha; O[dt][qt][2] *= alpha; O[dt][qt][3] *= alpha;
          }
        }
        const float mnew = mrun[qt];
        f32x2_t ps2 = {0.f, 0.f};
#pragma unroll
        for (int kt = 0; kt < KT; ++kt) {
          float e0, e1, e2, e3;
          if (MODE == 1) {
            e0 = fexp2(st[kt][qt][0] - mnew); e1 = fexp2(st[kt][qt][1] - mnew);
            e2 = fexp2(st[kt][qt][2] - mnew); e3 = fexp2(st[kt][qt][3] - mnew);
          } else {
            e0 = fexp2(__builtin_fmaf(st[kt][qt][0], SC, -mnew)); e1 = fexp2(__builtin_fmaf(st[kt][qt][1], SC, -mnew));
            e2 = fexp2(__builtin_fmaf(st[kt][qt][2], SC, -mnew)); e3 = fexp2(__builtin_fmaf(st[kt][qt][3], SC, -mnew));
          }
          st[kt][qt][0] = e0; st[kt][qt][1] = e1; st[kt][qt][2] = e2; st[kt][qt][3] = e3;
          const f32x2_t a01 = {e0, e1}, a23 = {e2, e3};
          ps2 = ps2 + a01;
          ps2 = ps2 + a23;
        }
        lsum[qt] += ps2.x + ps2.y;
#pragma unroll
        for (int ks = 0; ks < KT / 2; ++ks) {
          u32x4 pk;
          pk.x = pack2(st[2 * ks][qt][0], st[2 * ks][qt][1]);
          pk.y = pack2(st[2 * ks][qt][2], st[2 * ks][qt][3]);
          pk.z = pack2(st[2 * ks + 1][qt][0], st[2 * ks + 1][qt][1]);
          pk.w = pack2(st[2 * ks + 1][qt][2], st[2 * ks + 1][qt][3]);
          pb[ks][qt] = __builtin_bit_cast(bf16x8, pk);
        }
      }
#pragma unroll
      for (int dt = 0; dt < DV / 16; ++dt)
#pragma unroll
        for (int ks = 0; ks < KT / 2; ++ks) {
          const bf16x8 va = *(const bf16x8*)(sV + sw128(dt * 16 + r, (sbk * (KT / 2) + ks) * 4 + q));
#pragma unroll
          for (int qt = 0; qt < QT; ++qt) O[dt][qt] = mfma16(va, pb[ks][qt], O[dt][qt]);
        }
    }
    if (more) AT_STORE(c + 1);
  }
#undef AT_LOAD
#undef AT_STORE
  __syncthreads();
#pragma unroll
  for (int qt = 0; qt < QT; ++qt) {
    float L = lsum[qt];
    L += shx<16>(L, lane);
    L += shx<32>(L, lane);
    lsum[qt] = L;
  }
}

DI void diff_attn_item(const Params& p, int l, int b, int head, int qrow0, bool ctxq, char* smem) {
  const int tid = opaque_tid(), lane = tid & 63, wid = tid >> 6, r = lane & 15, q = lane >> 4;
  const bfr* proj = (const bfr*)(p.ws + OFF_PROJ);
  const bfr* VT = (const bfr*)(p.ws + OFF_VT);
  bfr* U = (bfr*)(p.ws + OFF_U);
  const float* lamv = (const float*)(p.ws + OFF_LAM);
  const float lam = lamv[l >> 1], lam_init = lamv[2 + (l >> 1)];
  f32x4 O[8][2];
  float ls[2];
  char* parkb = smem + 49152 + tid * 16;
  attn_engine<128, 2, 2, 0>(proj + (size_t)qrow0 * NEV + 2048 + head * 128, NEV, proj + head * 128, NEV,
                            VT + (size_t)(b * 1024 + head * 128) * KEYS, ctxq ? 0 : 64, b * 4096, 0, 4,
                            ML + b * 256, nullptr, 0, smem, O, ls);
  u32x4 pkr0, pkr1;
  {
    const float i0 = 1.f / ls[0], i1 = 1.f / ls[1];
#pragma unroll
    for (int dt = 0; dt < 8; dt += 2) {
      u32x4 v0, v1;
      v0.x = pack2(O[dt][0][0] * i0, O[dt][0][1] * i0);
      v0.y = pack2(O[dt][0][2] * i0, O[dt][0][3] * i0);
      v0.z = pack2(O[dt + 1][0][0] * i0, O[dt + 1][0][1] * i0);
      v0.w = pack2(O[dt + 1][0][2] * i0, O[dt + 1][0][3] * i0);
      v1.x = pack2(O[dt][1][0] * i1, O[dt][1][1] * i1);
      v1.y = pack2(O[dt][1][2] * i1, O[dt][1][3] * i1);
      v1.z = pack2(O[dt + 1][1][0] * i1, O[dt + 1][1][1] * i1);
      v1.w = pack2(O[dt + 1][1][2] * i1, O[dt + 1][1][3] * i1);
      if (dt < 6) {
        *(u32x4*)(parkb + (dt / 2) * 4096) = v0;
        *(u32x4*)(parkb + (3 + dt / 2) * 4096) = v1;
      } else { pkr0 = v0; pkr1 = v1; }
    }
  }
  attn_engine<128, 2, 2, 0>(proj + (size_t)qrow0 * NEV + 2048 + head * 128 + 64, NEV, proj + head * 128 + 64, NEV,
                            VT + (size_t)(b * 1024 + head * 128) * KEYS, ctxq ? 0 : 64, b * 4096, 0, 4,
                            ML + b * 256, nullptr, 0, smem, O, ls);
  const float* subln = p.ev_subln + (l >> 1) * 128;
#pragma unroll
  for (int qt = 0; qt < 2; ++qt) {
    const float i1 = lam / ls[qt];
    float ss = 0.f;
#pragma unroll
    for (int dt = 0; dt < 8; ++dt) {
      unsigned pa, pc;
      if (dt < 6) {
        const u32x2 pk2 = *(const u32x2*)(parkb + (qt * 3 + dt / 2) * 4096 + (dt & 1) * 8);
        pa = pk2.x; pc = pk2.y;
      } else {
        const u32x4 pr = qt ? pkr1 : pkr0;
        pa = (dt & 1) ? pr.z : pr.x; pc = (dt & 1) ? pr.w : pr.y;
      }
      const float o0 = lo_bf(pa) - O[dt][qt][0] * i1;
      const float o1 = hi_bf(pa) - O[dt][qt][1] * i1;
      const float o2 = lo_bf(pc) - O[dt][qt][2] * i1;
      const float o3 = hi_bf(pc) - O[dt][qt][3] * i1;
      O[dt][qt][0] = o0; O[dt][qt][1] = o1; O[dt][qt][2] = o2; O[dt][qt][3] = o3;
      ss += o0 * o0 + o1 * o1 + o2 * o2 + o3 * o3;
    }
    ss += shx<16>(ss, lane);
    ss += shx<32>(ss, lane);
    const float rn = rsqrtf(ss * (1.f / 128.f) + 1e-6f) * (1.f - lam_init);
    const int row = qrow0 + wid * 32 + qt * 16 + r;
#pragma unroll
    for (int dt = 0; dt < 8; ++dt) {
      const int dv = dt * 16 + 4 * q;
      const u32x2 ag = *(const u32x2*)(proj + (size_t)row * NEV + 3072 + head * 128 + dv);
      const float4 sl = *(const float4*)(subln + dv);
      u32x2 o;
      o.x = pack2(O[dt][qt][0] * rn * sl.x * silu(lo_bf(ag.x)), O[dt][qt][1] * rn * sl.y * silu(hi_bf(ag.x)));
      o.y = pack2(O[dt][qt][2] * rn * sl.z * silu(lo_bf(ag.y)), O[dt][qt][3] * rn * sl.w * silu(hi_bf(ag.y)));
      *(u32x2*)(U + (size_t)row * 2048 + head * 128 + dv) = o;
    }
  }
}

DI void na_item(const Params& p, int l, int b, int head, int rho, bool ctxq, int cq0, char* smem) {
  const int tid = opaque_tid(), lane = tid & 63, wid = tid >> 6, r = lane & 15, q = lane >> 4;
  const bfr* proj = (const bfr*)(p.ws + OFF_PROJ);
  const bfr* VT = (const bfr*)(p.ws + OFF_VT);
  bfr* U = (bfr*)(p.ws + OFF_U);
  float* rpb_s = (float*)(smem + 2 * (8192 + 64 * 128));
  int rs = rho - 4; rs = rs < 0 ? 0 : (rs > 56 ? 56 : rs);
  const int qrow0 = ctxq ? (ML + b * 256 + cq0) : (b * 4096 + rho * 64);
  f32x4 O[4][1];
  float ls[1];
  if (!ctxq) {
    const float* rp = p.od_rpb + ((size_t)(l >> 1) * 16 + head) * 465;
    for (int i = tid; i < 465; i += 256) rpb_s[i] = rp[i];
    attn_engine<64, 1, 4, 1>(proj + (size_t)qrow0 * NOD + 3584 + head * 64, NOD, proj + head * 64, NOD,
                                VT + (size_t)(b * 1024 + head * 64) * KEYS, 8, b * 4096 + rs * 64, rs * 64, 4,
                                ML + b * 256, rpb_s, rs - rho + 7, smem, O, ls);
  } else {
    attn_engine<64, 1, 4, 0>(proj + (size_t)qrow0 * NOD + 3584 + head * 64, NOD, proj + head * 64, NOD,
                                VT + (size_t)(b * 1024 + head * 64) * KEYS, 0, 0, 0, 4, ML + b * 256, nullptr, 0,
                                smem, O, ls);
  }
  const float inv = 1.f / ls[0];
  const int row = qrow0 + wid * 16 + r;
#pragma unroll
  for (int dt = 0; dt < 4; ++dt) {
    const int dv = dt * 16 + 4 * q;
    const u32x2 cgv = *(const u32x2*)(proj + (size_t)row * NOD + 5120 + head * 64 + dv);
    u32x2 o;
    o.x = pack2(O[dt][0][0] * inv * silu(lo_bf(cgv.x)), O[dt][0][1] * inv * silu(hi_bf(cgv.x)));
    o.y = pack2(O[dt][0][2] * inv * silu(lo_bf(cgv.y)), O[dt][0][3] * inv * silu(hi_bf(cgv.y)));
    *(u32x2*)(U + (size_t)row * 2048 + head * 64 + dv) = o;
  }
}

DI void conv_item(const Params& p, int l, int item) {
  const int tid = opaque_tid();
  const bfr* proj = (const bfr*)(p.ws + OFF_PROJ);
  bfr* U = (bfr*)(p.ws + OFF_U);
  const float* cw = p.ev_conv + (size_t)(l >> 1) * 3 * 1024;
#pragma unroll 1
  for (int i = 0; i < 8; ++i) {
    const int v = tid + 256 * i;
    const int ri = v >> 7, ch = (v & 127) * 8;
    const int m = item * 16 + ri;
    int t, T;
    if (m < ML) { t = m & 4095; T = 4096; } else { t = (m - ML) & 255; T = 256; }
    const bfr* pr = proj + (size_t)m * NEV;
    float acc[8];
#pragma unroll
    for (int e = 0; e < 8; ++e) acc[e] = 0.f;
#pragma unroll
    for (int w = 0; w < 3; ++w) {
      const int tt = t + w - 1;
      if (tt >= 0 && tt < T) {
        const bfr* prw = pr + (ptrdiff_t)(w - 1) * NEV;
        const u32x4 bh = *(const u32x4*)(prw + 4096 + ch);
        const u32x4 bc = *(const u32x4*)(prw + 6144 + ch);
        const float4 w0 = *(const float4*)(cw + w * 1024 + ch);
        const float4 w1 = *(const float4*)(cw + w * 1024 + ch + 4);
        acc[0] += w0.x * lo_bf(bh.x) * lo_bf(bc.x); acc[1] += w0.y * hi_bf(bh.x) * hi_bf(bc.x);
        acc[2] += w0.z * lo_bf(bh.y) * lo_bf(bc.y); acc[3] += w0.w * hi_bf(bh.y) * hi_bf(bc.y);
        acc[4] += w1.x * lo_bf(bh.z) * lo_bf(bc.z); acc[5] += w1.y * hi_bf(bh.z) * hi_bf(bc.z);
        acc[6] += w1.z * lo_bf(bh.w) * lo_bf(bc.w); acc[7] += w1.w * hi_bf(bh.w) * hi_bf(bc.w);
      }
    }
    const u32x4 bb = *(const u32x4*)(pr + 5120 + ch);
    const u32x4 bg = *(const u32x4*)(pr + 7168 + ch);
    u32x4 o;
    o.x = pack2(lo_bf(bb.x) * acc[0] * silu(lo_bf(bg.x)), hi_bf(bb.x) * acc[1] * silu(hi_bf(bg.x)));
    o.y = pack2(lo_bf(bb.y) * acc[2] * silu(lo_bf(bg.y)), hi_bf(bb.y) * acc[3] * silu(hi_bf(bg.y)));
    o.z = pack2(lo_bf(bb.z) * acc[4] * silu(lo_bf(bg.z)), hi_bf(bb.z) * acc[5] * silu(hi_bf(bg.z)));
    o.w = pack2(lo_bf(bb.w) * acc[6] * silu(lo_bf(bg.w)), hi_bf(bb.w) * acc[7] * silu(hi_bf(bg.w)));
    *(u32x4*)(U + (size_t)m * 2048 + 1024 + ch) = o;
  }
}

DI void gla_item(const Params& p, int l, int item, char* smem) {
  const int tid0 = opaque_tid();
  const int slice = item & 7, dir = (item >> 3) & 1, head = (item >> 4) & 3, b = item >> 6;
  const bfr* proj = (const bfr*)(p.ws + OFF_PROJ);
  const char* etb = p.ws + (dir ? OFF_ETB : OFF_ETF) + (size_t)head * 16384;
  const float* decb = (const float*)(p.ws + OFF_DEC) + ((size_t)dir * (MR / 64) * 4 + head) * 128;
  char* sQb = smem;
  char* sKc = smem + 16384;
  char* sKbT = smem + 32768;
  char* sVt = smem + 49152;
  char* sAtt = smem + 53248;
  char* sST = smem + 61440;
  float* sDec = (float*)(smem + 77824);
  const float qscale = 0.08838834764831845f;

  f32x4 S[2][2];
#pragma unroll
  for (int a = 0; a < 2; ++a)
#pragma unroll
    for (int c2 = 0; c2 < 2; ++c2) S[a][c2] = (f32x4){0.f, 0.f, 0.f, 0.f};
  __syncthreads();
  for (int i = tid0; i < 512; i += 256) ((u32x4*)sST)[i] = (u32x4){0u, 0u, 0u, 0u};

  u32x4 pq0, pq1, pq2, pq3, pk0, pk1, pk2, pk3, pv, pe0, pe1, pe2, pe3, pdec;
#define GLA_ROW0(ci_) (((ci_) < 4) ? (ML + b * 256 + (dir ? (3 - (ci_)) : (ci_)) * 64) : (b * 4096 + (dir ? (67 - (ci_)) : ((ci_) - 4)) * 64))
#define GLA_LOAD(ci_)                                                                                         \
  {                                                                                                           \
    const int prow = tid >> 4, pch = tid & 15, vs = tid >> 2, vpart = tid & 3;                                \
    const int r0_ = GLA_ROW0(ci_);                                                                            \
    const bfr* pr_ = proj + (size_t)(r0_ + prow) * NOD + head * 128 + pch * 8;                                \
    pq0 = *(const u32x4*)(pr_ + 4608);                     pk0 = *(const u32x4*)(pr_ + 2048);                 \
    pq1 = *(const u32x4*)(pr_ + 4608 + (size_t)16 * NOD);  pk1 = *(const u32x4*)(pr_ + 2048 + (size_t)16 * NOD); \
    pq2 = *(const u32x4*)(pr_ + 4608 + (size_t)32 * NOD);  pk2 = *(const u32x4*)(pr_ + 2048 + (size_t)32 * NOD); \
    pq3 = *(const u32x4*)(pr_ + 4608 + (size_t)48 * NOD);  pk3 = *(const u32x4*)(pr_ + 2048 + (size_t)48 * NOD); \
    pv = *(const u32x4*)(proj + (size_t)(r0_ + vs) * NOD + 2560 + head * 256 + slice * 32 + vpart * 8);       \
    const char* et_ = etb + (size_t)(r0_ >> 6) * 65536 + tid * 16;                                            \
    pe0 = *(const u32x4*)(et_);         pe1 = *(const u32x4*)(et_ + 4096);                                    \
    pe2 = *(const u32x4*)(et_ + 8192);  pe3 = *(const u32x4*)(et_ + 12288);                                   \
    if (tid < 32) pdec = *(const u32x4*)(decb + (size_t)(r0_ >> 6) * 512 + tid * 4);                          \
  }
  { const int tid = tid0; GLA_LOAD(0); }
  for (int ci = 0; ci < 68; ++ci) {
    int tid = tid0; asm volatile("" : "+v"(tid));
    const int lane = tid & 63, wid = tid >> 6, r = lane & 15, q = lane >> 4;
    const int d = tid & 127, half = tid >> 7;
    const int prow = tid >> 4, pch = tid & 15, vs = tid >> 2, vpart = tid & 3;
    const int row0 = GLA_ROW0(ci);
    const char* stc = sST + (ci & 1) * 8192;
    char* stn = sST + ((ci + 1) & 1) * 8192;
    __syncthreads();
    {
      *(u32x4*)(sQb + sw256(prow, pch)) = pq0;       *(u32x4*)(sKc + sw256(prow, pch)) = pk0;
      *(u32x4*)(sQb + sw256(prow + 16, pch)) = pq1;  *(u32x4*)(sKc + sw256(prow + 16, pch)) = pk1;
      *(u32x4*)(sQb + sw256(prow + 32, pch)) = pq2;  *(u32x4*)(sKc + sw256(prow + 32, pch)) = pk2;
      *(u32x4*)(sQb + sw256(prow + 48, pch)) = pq3;  *(u32x4*)(sKc + sw256(prow + 48, pch)) = pk3;
      *(u32x4*)(sKbT + tid * 16) = pe0;              *(u32x4*)(sKbT + tid * 16 + 4096) = pe1;
      *(u32x4*)(sKbT + tid * 16 + 8192) = pe2;       *(u32x4*)(sKbT + tid * 16 + 12288) = pe3;
      if (tid < 32) *(u32x4*)((char*)sDec + tid * 16) = pdec;
      const unsigned vv[4] = {pv.x, pv.y, pv.z, pv.w};
#pragma unroll
      for (int j = 0; j < 4; ++j) {
        const int e0 = vpart * 8 + 2 * j;
        *(bfr*)(sVt + sw128(e0, vs >> 3) + (vs & 7) * 2) = (bfr)(vv[j] & 0xffffu);
        *(bfr*)(sVt + sw128(e0 + 1, vs >> 3) + (vs & 7) * 2) = (bfr)(vv[j] >> 16);
      }
    }
    __syncthreads();
    {
      const float dec = sDec[d];
#pragma unroll
      for (int i8 = 0; i8 < 4; ++i8) {
        const u32x4 ev = *(const u32x4*)(sKbT + sw128(d, half * 4 + i8));
        const unsigned ew[4] = {ev.x, ev.y, ev.z, ev.w};
        unsigned kb[4];
#pragma unroll
        for (int ii = 0; ii < 8; ++ii) {
          const int s = half * 32 + i8 * 8 + ii;
          const float E = (ii & 1) ? hi_bf(ew[ii >> 1]) : lo_bf(ew[ii >> 1]);
          const float Ei = __builtin_amdgcn_rcpf(E);
          bfr* qa_ = (bfr*)(sQb + sw256(s, d >> 3) + (d & 7) * 2);
          bfr* ka_ = (bfr*)(sKc + sw256(s, d >> 3) + (d & 7) * 2);
          const float qv = bf2f(*qa_) * qscale * E;
          const float kc = bf2f(*ka_) * Ei;
          *qa_ = f2bf(qv);
          *ka_ = f2bf(kc);
          const unsigned kbv = f2bf(kc * dec);
          if (ii & 1) kb[ii >> 1] |= kbv << 16; else kb[ii >> 1] = kbv;
        }
        *(u32x4*)(sKbT + sw128(d, half * 4 + i8)) = (u32x4){kb[0], kb[1], kb[2], kb[3]};
      }
    }
    __syncthreads();
    if (ci + 1 < 68) GLA_LOAD(ci + 1);
    {
      f32x4 at[4];
#pragma unroll
      for (int st = 0; st < 4; ++st) at[st] = (f32x4){0.f, 0.f, 0.f, 0.f};
#pragma unroll
      for (int ks = 0; ks < 4; ++ks) {
        const bf16x8 qa = *(const bf16x8*)(sQb + sw256(wid * 16 + r, ks * 4 + q));
#pragma unroll
        for (int st = 0; st < 4; ++st) {
          const bf16x8 kb2 = *(const bf16x8*)(sKc + sw256(st * 16 + r, ks * 4 + q));
          at[st] = mfma16(qa, kb2, at[st]);
        }
      }
#pragma unroll
      for (int st = 0; st < 4; ++st)
#pragma unroll
        for (int j = 0; j < 4; ++j) {
          const int t = wid * 16 + 4 * q + j, s = st * 16 + r;
          const bool keep = dir ? (s >= t) : (s <= t);
          *(bfr*)(sAtt + sw128(t, s >> 3) + (s & 7) * 2) = f2bf(keep ? at[st][j] : 0.f);
        }
    }
    {
#pragma unroll
      for (int dti = 0; dti < 2; ++dti) {
        const float dc = sDec[(2 * wid + dti) * 16 + r];
#pragma unroll
        for (int et = 0; et < 2; ++et) {
          S[et][dti][0] *= dc; S[et][dti][1] *= dc; S[et][dti][2] *= dc; S[et][dti][3] *= dc;
        }
      }
#pragma unroll
      for (int ks = 0; ks < 2; ++ks) {
        bf16x8 va[2], kb2[2];
#pragma unroll
        for (int et = 0; et < 2; ++et) va[et] = *(const bf16x8*)(sVt + sw128(et * 16 + r, ks * 4 + q));
#pragma unroll
        for (int dti = 0; dti < 2; ++dti) kb2[dti] = *(const bf16x8*)(sKbT + sw128((2 * wid + dti) * 16 + r, ks * 4 + q));
#pragma unroll
        for (int et = 0; et < 2; ++et)
#pragma unroll
          for (int dti = 0; dti < 2; ++dti) S[et][dti] = mfma16(va[et], kb2[dti], S[et][dti]);
      }
#pragma unroll
      for (int et = 0; et < 2; ++et)
#pragma unroll
        for (int dti = 0; dti < 2; ++dti)
#pragma unroll
          for (int j = 0; j < 4; ++j) {
            const int e = et * 16 + 4 * q + j, dd = (2 * wid + dti) * 16 + r;
            *(bfr*)(stn + sw256(e, dd >> 3) + (dd & 7) * 2) = f2bf(S[et][dti][j]);
          }
    }
    __syncthreads();
    {
      f32x4 o[2];
      o[0] = (f32x4){0.f, 0.f, 0.f, 0.f};
      o[1] = (f32x4){0.f, 0.f, 0.f, 0.f};
#pragma unroll
      for (int ks = 0; ks < 4; ++ks) {
        const bf16x8 qa = *(const bf16x8*)(sQb + sw256(wid * 16 + r, ks * 4 + q));
#pragma unroll
        for (int et = 0; et < 2; ++et) {
          const bf16x8 sb2 = *(const bf16x8*)(stc + sw256(et * 16 + r, ks * 4 + q));
          o[et] = mfma16(qa, sb2, o[et]);
        }
      }
#pragma unroll
      for (int ks = 0; ks < 2; ++ks) {
        const bf16x8 aa = *(const bf16x8*)(sAtt + sw128(wid * 16 + r, ks * 4 + q));
#pragma unroll
        for (int et = 0; et < 2; ++et) {
          const bf16x8 vb = *(const bf16x8*)(sVt + sw128(et * 16 + r, ks * 4 + q));
          o[et] = mfma16(aa, vb, o[et]);
        }
      }
      {
        const int lam = head * 8 + slice;
#pragma unroll
        for (int j = 0; j < 4; ++j) {
          const int row = row0 + wid * 16 + 4 * q + j;
          const int m2 = row >> 1, par = row & 1;
          bfr* lp = dir ? ((bfr*)(p.ws + OFF_H) + ((size_t)m2 * 32 + lam) * 64)
                        : ((bfr*)(p.ws + OFF_U) + (size_t)(2 * m2 + (lam >> 4)) * 2048 + 1024 + (lam & 15) * 64);
#pragma unroll
          for (int et = 0; et < 2; ++et) lp[par * 32 + et * 16 + r] = f2bf(o[et][j]);
        }
      }
    }
  }
#undef GLA_LOAD
#undef GLA_ROW0
  __syncthreads();
}

DI void phase_gla_combine(const Params& p, int l) {
  const int tid = opaque_tid(), lane = tid & 63, wid = tid >> 6;
  const bfr* proj = (const bfr*)(p.ws + OFF_PROJ);
  const bfr* OB = (const bfr*)(p.ws + OFF_H);
  bfr* U = (bfr*)(p.ws + OFF_U);
  const int h = lane >> 4, e16 = (lane & 15) * 16;
  const int lam = h * 8 + ((lane & 15) >> 1), ein = (lane & 1) * 16;
  const float* gn = p.od_gnorm + (l >> 1) * 256 + e16;
  for (int m2 = blockIdx.x * 4 + wid; m2 < MR / 2; m2 += gridDim.x * 4) {
    const bfr* ofl = U + (size_t)(2 * m2 + (lam >> 4)) * 2048 + 1024 + (lam & 15) * 64 + ein;
    const bfr* obl = OB + ((size_t)m2 * 32 + lam) * 64 + ein;
    u32x4 a[2][2], bq[2][2], g[2][2];
#pragma unroll
    for (int par = 0; par < 2; ++par) {
      a[par][0] = *(const u32x4*)(ofl + par * 32);  a[par][1] = *(const u32x4*)(ofl + par * 32 + 8);
      bq[par][0] = *(const u32x4*)(obl + par * 32); bq[par][1] = *(const u32x4*)(obl + par * 32 + 8);
      const bfr* gp = proj + (size_t)(2 * m2 + par) * NOD + 6144 + h * 256 + e16;
      g[par][0] = *(const u32x4*)gp; g[par][1] = *(const u32x4*)(gp + 8);
    }
    u32x4 res[2][2];
#pragma unroll
    for (int par = 0; par < 2; ++par) {
      float o[16], dg[16];
      float ss = 0.f;
#pragma unroll
      for (int hv = 0; hv < 2; ++hv)
#pragma unroll
        for (int i = 0; i < 4; ++i) {
          const unsigned av = a[par][hv][i], bv = bq[par][hv][i], gv = g[par][hv][i];
          const int k = hv * 8 + i * 2;
          o[k] = lo_bf(av) + lo_bf(bv); o[k + 1] = hi_bf(av) + hi_bf(bv);
          dg[k] = lo_bf(gv); dg[k + 1] = hi_bf(gv);
          ss += o[k] * o[k] + o[k + 1] * o[k + 1];
        }
      ss += shx<1>(ss, lane); ss += shx<2>(ss, lane); ss += shx<4>(ss, lane); ss += shx<8>(ss, lane);
      const float rn = rsqrtf(ss * (1.f / 256.f) + 1e-6f);
#pragma unroll
      for (int hv = 0; hv < 2; ++hv)
#pragma unroll
        for (int i = 0; i < 4; ++i) {
          const int k = hv * 8 + i * 2;
          res[par][hv][i] = pack2(o[k] * rn * gn[k] * silu(dg[k]), o[k + 1] * rn * gn[k + 1] * silu(dg[k + 1]));
        }
    }
#pragma unroll
    for (int par = 0; par < 2; ++par) {
      bfr* up = U + (size_t)(2 * m2 + par) * 2048 + 1024 + h * 256 + e16;
      *(u32x4*)up = res[par][0];
      *(u32x4*)(up + 8) = res[par][1];
    }
  }
}

DI int next_item(int* ctr, int* slot) {
  __syncthreads();
  if (threadIdx.x == 0) *slot = atomicAdd(ctr, 1);
  __syncthreads();
  return *slot;
}

DI void phase_mix_even(const Params& p, int l, int g, char* smem, int coff = 0) {
  int* ctr0 = (int*)(p.ws + OFF_CTR) + ((g * 2 + (l >> 1)) * 8) + coff;
  int* slot = (int*)(smem + SMEM_BYTES - 16);
  const int PER_LAT = GB * 32, PER_CTX = GB * 2, PER_CONV = MR / 16 / 8;
  const int per_q = PER_LAT + PER_CTX + PER_CONV;
  const int myq = (int)(__builtin_amdgcn_s_getreg((3 << 11) | 20) & 7u);
  for (int dq = 0; dq < 8; ++dq) {
    const int x = (myq + dq) & 7;
    for (;;) {
      int it = next_item(ctr0 + x, slot);
      if (it >= per_q) break;
      if (it < PER_LAT) {
        const int qb = it & 31, b = it >> 5;
        diff_attn_item(p, l, b, x, b * 4096 + qb * 128, false, smem);
      } else if (it < PER_LAT + PER_CTX) {
        it -= PER_LAT;
        const int qb = it & 1, b = it >> 1;
        diff_attn_item(p, l, b, x, ML + b * 256 + qb * 128, true, smem);
      } else {
        conv_item(p, l, (it - PER_LAT - PER_CTX) * 8 + x);
      }
    }
  }
}

DI void phase_mix_odd(const Params& p, int l, int g, char* smem) {
  int* ctr = (int*)(p.ws + OFF_CTR) + (g * 4 + l);
  int* slot = (int*)(smem + SMEM_BYTES - 16);
  const int N_GLA = GB * 4 * 2 * 8, N_NA = GB * 16 * 64, N_CTX = (l == 3) ? 0 : GB * 16 * 4;
  const int total = N_GLA + N_NA + N_CTX;
  (void)ctr; (void)slot; (void)total;
  const int nb = gridDim.x, bx = blockIdx.x;
  const int nup = (nb > N_GLA) ? (nb - N_GLA) : 0;
  const int NA_UP = 17;
  for (int k = 0;; ++k) {
    int it;
    if (nup == 0) { it = bx + k * nb; if (it >= total) break; }
    else if (bx < N_GLA) {
      if (k == 0) it = bx;
      else { it = N_GLA + NA_UP * nup + bx + (k - 1) * N_GLA; if (it >= total) break; }
    } else {
      if (k >= NA_UP) break;
      it = N_GLA + (bx - N_GLA) + k * nup;
      if (it >= total) break;
    }
    __syncthreads();
    if (it < N_GLA) {
      __builtin_amdgcn_s_setprio(3);
      gla_item(p, l, it, smem);
      __builtin_amdgcn_s_setprio(0);
    } else if (it < N_GLA + N_NA) {
      it -= N_GLA;
      const int rho = it & 63, bh = it >> 6;
      na_item(p, l, bh >> 4, bh & 15, rho, false, 0, smem);
    } else {
      it -= N_GLA + N_NA;
      const int qb = it & 3, bh = it >> 2;
      na_item(p, l, bh >> 4, bh & 15, 0, true, qb * 64, smem);
    }
  }
}


DI void grid_barrier(unsigned* bar, unsigned& bgen, unsigned xcc, unsigned nxcc, unsigned nx) {
  asm volatile("s_waitcnt vmcnt(0)" ::: "memory");
  __syncthreads();
  const unsigned target = bgen + 1;
  if (threadIdx.x == 0) {
    const unsigned old = __hip_atomic_fetch_add(bar + xcc * 64, 1u, __ATOMIC_RELAXED, __HIP_MEMORY_SCOPE_AGENT);
    if (old == target * nxcc - 1) {
      __builtin_amdgcn_fence(__ATOMIC_RELEASE, "agent");
      asm volatile("s_waitcnt vmcnt(0)" ::: "memory");
      const unsigned o2 = __hip_atomic_fetch_add(bar + 16 * 64, 1u, __ATOMIC_RELAXED, __HIP_MEMORY_SCOPE_AGENT);
      if (o2 == target * nx - 1) __hip_atomic_store(bar + 17 * 64, target, __ATOMIC_RELAXED, __HIP_MEMORY_SCOPE_AGENT);
    }
    while (__hip_atomic_load(bar + 17 * 64, __ATOMIC_RELAXED, __HIP_MEMORY_SCOPE_AGENT) < target) __builtin_amdgcn_s_sleep(1);
    __builtin_amdgcn_fence(__ATOMIC_ACQUIRE, "agent");
    asm volatile("s_waitcnt vmcnt(0)" ::: "memory");
  }
  bgen = target;
  __syncthreads();
}
typedef const __attribute__((address_space(4))) Params* KParamsPtr;
DI Params load_params() {
#if defined(__HIP_DEVICE_COMPILE__)
  KParamsPtr kp = (KParamsPtr)__builtin_amdgcn_kernarg_segment_ptr();
  asm volatile("" : "+s"(kp));
  Params r;
  __builtin_memcpy(&r, kp, sizeof(Params));
  return r;
#else
  return Params{};
#endif
}
#define PH(call) { const Params p = load_params(); call; }
__global__ void __launch_bounds__(256, 2) mega_kernel(Params p_unused) {
  extern __shared__ __attribute__((aligned(16))) char smem[];
  cg::grid_group grid = cg::this_grid();
  unsigned bgen = 0;
  const unsigned xcc = (unsigned)__builtin_amdgcn_s_getreg((3 << 11) | 20) & 15u;
  if (threadIdx.x == 0) {
    const Params pb = load_params();
    __hip_atomic_fetch_add((unsigned*)(pb.ws + OFF_BAR) + (18 + xcc) * 64, 1u, __ATOMIC_RELAXED, __HIP_MEMORY_SCOPE_AGENT);
  }
  PH(phase0(p, smem));
  grid.sync();
  unsigned nxcc = 0, nx = 0;
  {
    const Params pb = load_params();
    const unsigned* cen = (const unsigned*)(pb.ws + OFF_BAR) + 18 * 64;
    for (unsigned j = 0; j < 16; ++j) {
      const unsigned cj = __hip_atomic_load(cen + j * 64, __ATOMIC_RELAXED, __HIP_MEMORY_SCOPE_AGENT);
      nx += (cj != 0);
      if (j == xcc) nxcc = cj;
    }
  }
#define GBAR() { const Params pb = load_params(); grid_barrier((unsigned*)(pb.ws + OFF_BAR), bgen, xcc, nxcc, nx); }
#pragma unroll 1
  for (int g = 0; g < NGRP; ++g) {
#pragma unroll 1
    for (int l = 0; l < 4; ++l) {
      PH(phase_norm(p, l, g));
      GBAR();
      PH(phase_gemm_in(p, l, smem, g * 4 + l));
      GBAR();
      if (l & 1) {
        PH(phase_mix_odd(p, l, g, smem));
        GBAR();
        PH(phase_gla_combine(p, l));
      } else {
        PH(phase_mix_even(p, l, g, smem));
      }
      GBAR();
      PH(phase_gemm_out(p, l, smem, 8 + g * 4 + l));
      GBAR();
    }
    PH(phase_norm(p, 4, g));
  }
}

extern "C" void kernel_launch(void* const* d_in, const int* in_sizes, int n_in, void* d_out, int out_size, void* d_ws,
                              size_t ws_size, hipStream_t stream) {
  static int grid_blocks = 0;
  if (!grid_blocks) {
    int dev = 0, cus = 0, per_cu = 0;
    hipGetDevice(&dev);
    hipDeviceGetAttribute(&cus, hipDeviceAttributeMultiprocessorCount, dev);
    hipFuncSetAttribute((const void*)mega_kernel, hipFuncAttributeMaxDynamicSharedMemorySize, SMEM_BYTES);
    hipOccupancyMaxActiveBlocksPerMultiprocessor(&per_cu, mega_kernel, 256, SMEM_BYTES);
    if (per_cu > 2) per_cu = 2;
    if (per_cu < 1) per_cu = 1;
    grid_blocks = cus * per_cu;
    grid_blocks &= ~15;
  }
  if (ws_size < WS_NEED) { fprintf(stderr, "workspace too small: %zu < %zu\n", ws_size, (size_t)WS_NEED); return; }
  Params p{};
  p.x = (const float*)d_in[0]; p.c = (const float*)d_in[1]; p.ctx = (const float*)d_in[2]; p.c_ctx = (const float*)d_in[3];
  p.w_mod = (const float*)d_in[4]; p.b_mod = (const float*)d_in[5]; p.g_pre = (const float*)d_in[6]; p.g_post = (const float*)d_in[7];
  p.w_out = (const float*)d_in[8]; p.ev_w_in = (const float*)d_in[9]; p.ev_lambda = (const float*)d_in[10]; p.ev_subln = (const float*)d_in[11];
  p.ev_conv = (const float*)d_in[12]; p.od_w_in = (const float*)d_in[13]; p.od_rpb = (const float*)d_in[14]; p.od_gate_up = (const float*)d_in[15];
  p.od_gate_bias = (const float*)d_in[16]; p.od_gnorm = (const float*)d_in[17];
  p.out = (float*)d_out;
  p.ws = (char*)d_ws;
  (void)hipMemsetAsync((char*)d_ws + OFF_BAR, 0, BAR_BYTES, stream);
  void* args[] = {&p};
  hipError_t e = hipLaunchCooperativeKernel((const void*)mega_kernel, dim3(grid_blocks), dim3(256), args, SMEM_BYTES, stream);
  if (e != hipSuccess) fprintf(stderr, "cooperative launch failed: %s (grid %d)\n", hipGetErrorString(e), grid_blocks);
}
```

```cpp
#include <hip/hip_runtime.h>
#include <hip/hip_cooperative_groups.h>
#include <cstdio>
namespace cg = cooperative_groups;

typedef unsigned short bfr;
typedef __attribute__((ext_vector_type(8))) short bf16x8;
typedef __attribute__((ext_vector_type(4))) float f32x4;
typedef __attribute__((ext_vector_type(4))) unsigned u32x4;
typedef __attribute__((ext_vector_type(2))) unsigned u32x2;
typedef __attribute__((ext_vector_type(16))) unsigned u32x16;
typedef __attribute__((ext_vector_type(2))) __bf16 bf16x2_t;
#define DI __device__ __forceinline__
DI float dot2bf(unsigned a, unsigned b, float c) { return __builtin_amdgcn_fdot2_f32_bf16(__builtin_bit_cast(bf16x2_t, a), __builtin_bit_cast(bf16x2_t, b), c, false); }
DI int opaque_tid() { int t = threadIdx.x; asm volatile("" : "+v"(t)); return t; }

constexpr int GB   = 4;
constexpr int NGRP = 2;
constexpr int ML   = GB * 4096;
constexpr int MC   = GB * 256;
constexpr int MR   = ML + MC;
constexpr int NEV  = 8192;
constexpr int NOD  = 7296;
constexpr int KEYS = 4352;
constexpr float L2E = 1.4426950408889634f;
constexpr float LN2 = 0.6931471805599453f;

constexpr size_t SZ_PROJ = (size_t)MR * 8192 * 2;
constexpr size_t SZ_H    = (size_t)MR * 1024 * 2;
constexpr size_t SZ_U    = (size_t)MR * 2048 * 2;
constexpr size_t SZ_VT   = (size_t)GB * 1024 * KEYS * 2;
constexpr size_t SZ_WE   = (size_t)NEV * 1024 * 2;
constexpr size_t SZ_WO   = (size_t)NOD * 1024 * 2;
constexpr size_t SZ_WOUT = (size_t)1024 * 2048 * 2;
constexpr size_t OFF_PROJ = 0;
constexpr size_t OFF_H    = OFF_PROJ + SZ_PROJ;
constexpr size_t OFF_U    = OFF_H + SZ_H;
constexpr size_t OFF_VT   = OFF_U + SZ_U;
constexpr size_t OFF_WIN  = OFF_VT + SZ_VT;
constexpr size_t OFF_WOUT = OFF_WIN + 2 * SZ_WE + 2 * SZ_WO;
constexpr size_t OFF_XC   = OFF_WOUT + 4 * SZ_WOUT;
constexpr size_t OFF_MOD  = OFF_XC + (size_t)8 * 256 * 1024 * 4;
constexpr size_t OFF_CS   = OFF_MOD + (size_t)4 * 9 * 3072 * 4;
constexpr size_t OFF_LAM  = OFF_CS + 64 * 16 * 8;
constexpr size_t OFF_CTR  = OFF_LAM + 256;
constexpr size_t OFF_BAR  = OFF_CTR + 256;
constexpr size_t BAR_BYTES = 34 * 256 + 192 * 64;
constexpr size_t SZ_ET    = (size_t)(MR / 64) * 4 * 16384;
constexpr size_t OFF_ETF  = OFF_PROJ + (size_t)MR * NOD * 2;
constexpr size_t OFF_ETB  = (OFF_BAR + BAR_BYTES + 255) & ~(size_t)255;
constexpr size_t OFF_DEC  = OFF_ETB + SZ_ET;
constexpr size_t WS_NEED  = OFF_DEC + (size_t)2 * (MR / 64) * 4 * 128 * 4;
static_assert(OFF_ETF + SZ_ET <= OFF_H, "E^T forward tiles must fit behind the odd proj rows");

constexpr int SMEM_BYTES = 80896;

struct Params {
  const float *x, *c, *ctx, *c_ctx, *w_mod, *b_mod, *g_pre, *g_post, *w_out, *ev_w_in, *ev_lambda, *ev_subln,
      *ev_conv, *od_w_in, *od_rpb, *od_gate_up, *od_gate_bias, *od_gnorm;
  float* out;
  char* ws;
};

DI size_t win_off(int l) { return OFF_WIN + (size_t)(l >> 1) * (SZ_WE + SZ_WO) + ((l & 1) ? SZ_WE : 0); }

DI float bf2f(bfr v) { return __uint_as_float(((unsigned)v) << 16); }
typedef __attribute__((ext_vector_type(2))) float f32x2_t;
DI bfr f2bf(float x) { return __builtin_bit_cast(bfr, (__bf16)x); }
DI unsigned pack2(float a, float b) { f32x2_t v = {a, b}; return __builtin_bit_cast(unsigned, __builtin_convertvector(v, bf16x2_t)); }
DI float lo_bf(unsigned u) { return __uint_as_float(u << 16); }
DI float hi_bf(unsigned u) { return __uint_as_float(u & 0xffff0000u); }
DI float fexp2(float x) { return __builtin_amdgcn_exp2f(x); }
DI float flog2(float x) { return __builtin_amdgcn_logf(x); }
DI float silu(float x) { return x / (1.f + fexp2(-x * L2E)); }
DI float max3f(float a, float b, float c) { float r; asm("v_max3_f32 %0, %1, %2, %3" : "=v"(r) : "v"(a), "v"(b), "v"(c)); return r; }
template <int M>
DI float shx(float v, int lane) {
  if (M < 32) return __builtin_bit_cast(float, __builtin_amdgcn_ds_swizzle(__builtin_bit_cast(int, v), (M << 10) | 0x1f));
  return __builtin_bit_cast(float, __builtin_amdgcn_ds_bpermute((lane ^ 32) << 2, __builtin_bit_cast(int, v)));
}
DI float wave_sum(float v, int lane) {
  v += shx<1>(v, lane); v += shx<2>(v, lane); v += shx<4>(v, lane); v += shx<8>(v, lane); v += shx<16>(v, lane); v += shx<32>(v, lane);
  return v;
}
DI f32x4 mfma16(bf16x8 a, bf16x8 b, f32x4 c) { return __builtin_amdgcn_mfma_f32_16x16x32_bf16(a, b, c, 0, 0, 0); }
DI int sw128(int row, int chunk) { return row * 128 + ((chunk ^ ((row >> 1) & 7)) << 4); }
DI int sw256(int row, int chunk) { return row * 256 + ((chunk ^ (row & 15)) << 4); }

DI void store_pair16(bfr* tile_i_ptr, const f32x4& a, const f32x4& b, int q) {
  const unsigned ax = pack2(a[0], a[1]), ay = pack2(a[2], a[3]), bx = pack2(b[0], b[1]), by = pack2(b[2], b[3]);
  const u32x2 r0 = __builtin_amdgcn_permlane16_swap(ax, bx, false, false);
  const u32x2 r1 = __builtin_amdgcn_permlane16_swap(ay, by, false, false);
  *(u32x4*)(tile_i_ptr + (q & 1) * 16 + (q >> 1) * 8) = (u32x4){r0.x, r1.x, r0.y, r1.y};
}

struct GemmStage { u32x4 xa0[4], ya0[4], xa1[4], ya1[4]; };
DI void gemm_prologue(const bfr* __restrict__ X, int ldx, const bfr* __restrict__ Y, int ldy, GemmStage& st) {
  const int tid = opaque_tid();
  const int lr = tid >> 3, lc = tid & 7;
  const bfr* xp = X + (size_t)lr * ldx + lc * 8;
  const bfr* yp = Y + (size_t)lr * ldy + lc * 8;
#pragma unroll
  for (int i = 0; i < 4; ++i) {
    st.xa0[i] = *(const u32x4*)(xp + (size_t)(32 * i) * ldx);
    st.ya0[i] = *(const u32x4*)(yp + (size_t)(32 * i) * ldy);
    st.xa1[i] = *(const u32x4*)(xp + (size_t)(32 * i) * ldx + 64);
    st.ya1[i] = *(const u32x4*)(yp + (size_t)(32 * i) * ldy + 64);
  }
}
DI void gemm_mainloop(const bfr* __restrict__ X, int ldx, const bfr* __restrict__ Y, int ldy, int K,
                      const bfr* __restrict__ Xn, const bfr* __restrict__ Yn, bool hasnext, char* smem,
                      f32x4 (&acc)[4][4], GemmStage& st) {
  const int tid = opaque_tid(), lane = tid & 63, wid = tid >> 6, r = lane & 15, q = lane >> 4;
  const int wx = wid >> 1, wy = wid & 1;
  const int lr = tid >> 3, lc = tid & 7;
  const bfr* xp = X + (size_t)lr * ldx + lc * 8;
  const bfr* yp = Y + (size_t)lr * ldy + lc * 8;
  const bfr* xpn = Xn + (size_t)lr * ldx + lc * 8;
  const bfr* ypn = Yn + (size_t)lr * ldy + lc * 8;
  const int nk = K >> 6;
#define GEMM_STEP(XR, YR, BUF, KT)                                                                       \
  {                                                                                                      \
    char* sX = smem + (BUF) * 32768;                                                                     \
    char* sY = sX + 16384;                                                                               \
    _Pragma("unroll") for (int i = 0; i < 4; ++i) {                                                      \
      *(u32x4*)(sX + sw128(lr + 32 * i, lc)) = XR[i];                                                    \
      *(u32x4*)(sY + sw128(lr + 32 * i, lc)) = YR[i];                                                    \
    }                                                                                                    \
    __syncthreads();                                                                                     \
    if ((KT) + 2 < nk) {                                                                                 \
      const int ko = ((KT) + 2) * 64;                                                                    \
      _Pragma("unroll") for (int i = 0; i < 4; ++i) {                                                    \
        XR[i] = *(const u32x4*)(xp + (size_t)(32 * i) * ldx + ko);                                       \
        YR[i] = *(const u32x4*)(yp + (size_t)(32 * i) * ldy + ko);                                       \
      }                                                                                                  \
    } else if (hasnext) {                                                                                \
      const int ko = ((KT) + 2 - nk) * 64;                                                               \
      _Pragma("unroll") for (int i = 0; i < 4; ++i) {                                                    \
        XR[i] = *(const u32x4*)(xpn + (size_t)(32 * i) * ldx + ko);                                      \
        YR[i] = *(const u32x4*)(ypn + (size_t)(32 * i) * ldy + ko);                                      \
      }                                                                                                  \
    }                                                                                                    \
    _Pragma("unroll") for (int s = 0; s < 2; ++s) {                                                      \
      bf16x8 xf[4], yf[4];                                                                               \
      _Pragma("unroll") for (int i = 0; i < 4; ++i)                                                      \
          xf[i] = *(const bf16x8*)(sX + sw128(wx * 64 + i * 16 + r, s * 4 + q));                         \
      _Pragma("unroll") for (int j = 0; j < 4; ++j)                                                      \
          yf[j] = *(const bf16x8*)(sY + sw128(wy * 64 + j * 16 + r, s * 4 + q));                         \
      __builtin_amdgcn_s_setprio(1);                                                                     \
      _Pragma("unroll") for (int i = 0; i < 4; ++i)                                                      \
          _Pragma("unroll") for (int j = 0; j < 4; ++j) acc[i][j] = mfma16(xf[i], yf[j], acc[i][j]);     \
      __builtin_amdgcn_s_setprio(0);                                                                     \
    }                                                                                                    \
  }
  for (int kt = 0; kt < nk; kt += 2) {
    GEMM_STEP(st.xa0, st.ya0, 0, kt);
    GEMM_STEP(st.xa1, st.ya1, 1, kt + 1);
  }
#undef GEMM_STEP
  __syncthreads();
}

DI bool tile_map(int T, int MT, int NT, int& mt, int& nt) {
  const int pm_n = MT >> 3;
  const int P = (T >> 9) * 8 + (T & 7);
  const int li = (T & 511) >> 3;
  const int pm = P % pm_n, pn = P / pm_n;
  mt = pm * 8 + (li & 7);
  nt = pn * 8 + (li >> 3);
  return nt < NT;
}

DI int odd_col_src(int n) {
  if (n < 3584) return n;
  if (n < 7168) return n + 32;
  if (n < 7200) return n - 7168 + 3584;
  return -1;
}

DI void phase0(const Params& p, char* smem) {
  const int tid = opaque_tid();
  if (blockIdx.x < 384) {
    float* sc = (float*)smem;
    float* red = sc + 9 * 1024;
    for (int i = tid; i < 9 * 1024; i += 256) {
      const int b = i >> 10, k = i & 1023;
      const float v = (b < 8) ? p.c[b * 1024 + k] : p.c_ctx[k];
      sc[i] = v / (1.f + __expf(-v));
    }
    __syncthreads();
    float* modb = (float*)(p.ws + OFF_MOD);
    for (int it = blockIdx.x; it < 384; it += gridDim.x) {
      const int l = it / 96, cgp = it % 96;
      const int col = cgp * 32 + (tid & 31), ks = tid >> 5;
      float a[9];
#pragma unroll
      for (int b = 0; b < 9; ++b) a[b] = 0.f;
      const float* w = p.w_mod + ((size_t)l * 1024 + ks * 128) * 3072 + col;
#pragma unroll 16
      for (int k = 0; k < 128; ++k) {
        const float wv = w[(size_t)k * 3072];
#pragma unroll
        for (int b = 0; b < 9; ++b) a[b] += sc[b * 1024 + ks * 128 + k] * wv;
      }
#pragma unroll
      for (int b = 0; b < 9; ++b) red[(ks * 9 + b) * 32 + (tid & 31)] = a[b];
      __syncthreads();
      for (int idx = tid; idx < 288; idx += 256) {
        const int b = idx >> 5, cc = idx & 31;
        float s = p.b_mod[l * 3072 + cgp * 32 + cc];
#pragma unroll
        for (int k2 = 0; k2 < 8; ++k2) s += red[(k2 * 9 + b) * 32 + cc];
        modb[(size_t)(l * 9 + b) * 3072 + cgp * 32 + cc] = s;
      }
      __syncthreads();
    }
  }
  if (blockIdx.x == gridDim.x - 1) {
    float2* cs = (float2*)(p.ws + OFF_CS);
    for (int idx = tid; idx < 1024; idx += 256) {
      const int pos = idx >> 4, f = idx & 15;
      const float inv = 1.0f / powf(10000.f, (float)f * 0.0625f);
      const float ang = (float)pos * inv;
      const double ad = (double)ang;
      const double n = rint(ad * 0.15915494309189535);
      const float rr = (float)(ad - n * 6.283185307179586);
      cs[idx] = make_float2(__cosf(rr), __sinf(rr));
    }
    if (tid < 2) {
      const float* lp = p.ev_lambda + tid * 256;
      float s1 = 0.f, s2 = 0.f;
      for (int i = 0; i < 64; ++i) { s1 += lp[i] * lp[64 + i]; s2 += lp[128 + i] * lp[192 + i]; }
      const float li = (tid == 0) ? 0.2f : (0.8f - 0.6f * 0.5488116360940264f);
      float* lam = (float*)(p.ws + OFF_LAM);
      lam[tid] = __expf(s1) - __expf(s2) + li;
      lam[2 + tid] = li;
    }
    if (tid < 32) ((int*)(p.ws + OFF_CTR))[tid] = 0;
  }
  float* tile = (float*)smem;
  __syncthreads();
  for (int it = blockIdx.x; it < 9792; it += gridDim.x) {
    int rr = it, l, ktile, ntile, K, Nsrc;
    const float* src;
    bfr* dst;
    bool oddmap = false;
    if (rr < 7744) {
      if (rr < 2048) { l = 0; } else if (rr < 3872) { l = 1; rr -= 2048; } else if (rr < 5920) { l = 2; rr -= 3872; } else { l = 3; rr -= 5920; }
      ktile = rr & 15; ntile = rr >> 4; K = 1024;
      oddmap = (l & 1);
      Nsrc = oddmap ? 7200 : 8192;
      src = (oddmap ? p.od_w_in : p.ev_w_in) + (size_t)(l >> 1) * 1024 * Nsrc;
      dst = (bfr*)(p.ws + win_off(l));
    } else {
      rr -= 7744; l = rr >> 9; rr &= 511;
      ktile = rr & 31; ntile = rr >> 5; K = 2048; Nsrc = 1024;
      src = p.w_out + (size_t)l * 2048 * 1024;
      dst = (bfr*)(p.ws + OFF_WOUT + (size_t)l * SZ_WOUT);
    }
    const int k0 = ktile * 64, n0 = ntile * 64;
    {
      const int nn = tid & 63;
      const int nd = n0 + nn;
      const int ns = oddmap ? odd_col_src(nd) : nd;
#pragma unroll
      for (int i = 0; i < 16; ++i) {
        const int kk = (tid >> 6) + 4 * i;
        tile[kk * 65 + nn] = (ns >= 0) ? src[(size_t)(k0 + kk) * Nsrc + ns] : 0.f;
      }
    }
    __syncthreads();
    {
      const int kk8 = (tid & 7) * 8;
#pragma unroll
      for (int i2 = 0; i2 < 2; ++i2) {
        const int nn = (tid >> 3) + 32 * i2;
        u32x4 v;
        v.x = pack2(tile[(kk8 + 0) * 65 + nn], tile[(kk8 + 1) * 65 + nn]);
        v.y = pack2(tile[(kk8 + 2) * 65 + nn], tile[(kk8 + 3) * 65 + nn]);
        v.z = pack2(tile[(kk8 + 4) * 65 + nn], tile[(kk8 + 5) * 65 + nn]);
        v.w = pack2(tile[(kk8 + 6) * 65 + nn], tile[(kk8 + 7) * 65 + nn]);
        *(u32x4*)(dst + (size_t)(n0 + nn) * K + k0 + kk8) = v;
      }
    }
    __syncthreads();
  }
}

DI void phase_norm(const Params& p, int l, int g) {
  const int tid = opaque_tid(), lane = tid & 63, wid = tid >> 6;
  const int rows = (l == 4) ? ML : MR;
  const float* modb = (const float*)(p.ws + OFF_MOD);
  const bfr* ybuf = (const bfr*)(p.ws + OFF_PROJ);
  bfr* hbuf = (bfr*)(p.ws + OFF_H);
  float* xcb = (float*)(p.ws + OFF_XC);
  for (int row = blockIdx.x * 4 + wid; row < rows; row += gridDim.x * 4) {
    const bool lat = row < ML;
    const int mb = lat ? (g * GB + (row >> 12)) : 8;
    const size_t grow = lat ? ((size_t)g * ML + row) : ((size_t)g * MC + (row - ML));
    const float* xin;
    float* xst;
    if (lat) { xin = ((l <= 1) ? p.x : (const float*)p.out) + grow * 1024; xst = p.out + grow * 1024; }
    else     { xin = ((l <= 1) ? p.ctx : (const float*)xcb) + grow * 1024; xst = xcb + grow * 1024; }
    float4 xv[4];
#pragma unroll
    for (int i = 0; i < 4; ++i) xv[i] = *(const float4*)(xin + lane * 4 + 256 * i);
    if (l >= 1) {
      float4 yv[4];
      float ss = 0.f;
#pragma unroll
      for (int i = 0; i < 4; ++i) {
        const u32x2 yr = *(const u32x2*)(ybuf + (size_t)row * 1024 + lane * 4 + 256 * i);
        yv[i] = make_float4(lo_bf(yr.x), hi_bf(yr.x), lo_bf(yr.y), hi_bf(yr.y));
        ss += yv[i].x * yv[i].x + yv[i].y * yv[i].y + yv[i].z * yv[i].z + yv[i].w * yv[i].w;
      }
      ss = wave_sum(ss, lane);
      const float rn = rsqrtf(ss * (1.f / 1024.f) + 1e-6f);
      const float* gate = modb + (size_t)((l - 1) * 9 + mb) * 3072 + 2048;
      const float* gp = p.g_post + (l - 1) * 1024;
#pragma unroll
      for (int i = 0; i < 4; ++i) {
        const int c0 = lane * 4 + 256 * i;
        const float4 gt = *(const float4*)(gate + c0);
        const float4 gg = *(const float4*)(gp + c0);
        xv[i].x += gt.x * (yv[i].x * rn * gg.x);
        xv[i].y += gt.y * (yv[i].y * rn * gg.y);
        xv[i].z += gt.z * (yv[i].z * rn * gg.z);
        xv[i].w += gt.w * (yv[i].w * rn * gg.w);
        *(float4*)(xst + c0) = xv[i];
      }
    }
    if (l < 4) {
      float ss = 0.f;
#pragma unroll
      for (int i = 0; i < 4; ++i) ss += xv[i].x * xv[i].x + xv[i].y * xv[i].y + xv[i].z * xv[i].z + xv[i].w * xv[i].w;
      ss = wave_sum(ss, lane);
      const float rn = rsqrtf(ss * (1.f / 1024.f) + 1e-6f);
      const float* mrow = modb + (size_t)(l * 9 + mb) * 3072;
      const float* gpre = p.g_pre + l * 1024;
#pragma unroll
      for (int i = 0; i < 4; ++i) {
        const int c0 = lane * 4 + 256 * i;
        const float4 sh = *(const float4*)(mrow + c0);
        const float4 scl = *(const float4*)(mrow + 1024 + c0);
        const float4 gg = *(const float4*)(gpre + c0);
        u32x2 o;
        o.x = pack2(xv[i].x * rn * gg.x * (1.f + scl.x) + sh.x, xv[i].y * rn * gg.y * (1.f + scl.y) + sh.y);
        o.y = pack2(xv[i].z * rn * gg.z * (1.f + scl.z) + sh.z, xv[i].w * rn * gg.w * (1.f + scl.w) + sh.w);
        *(u32x2*)(hbuf + (size_t)row * 1024 + c0) = o;
      }
    }
  }
}

DI void gla_gate_precompute(const Params& p, int l, int m0, const char* sLr, float* sHs) {
  const int tid = opaque_tid();
  const int d = tid & 127, half = tid >> 7;
  const int jl = l >> 1;
#pragma unroll 1
  for (int unit = 0; unit < 16; ++unit) {
    const int cc = unit & 1, dir = (unit >> 1) & 1, head = unit >> 2;
    unsigned gu[8];
#pragma unroll
    for (int k = 0; k < 8; ++k)
      gu[k] = pack2(p.od_gate_up[(((size_t)jl * 2 + dir) * 16 + 2 * k) * 512 + head * 128 + d],
                    p.od_gate_up[(((size_t)jl * 2 + dir) * 16 + 2 * k + 1) * 512 + head * 128 + d]);
    const float gbias = p.od_gate_bias[((size_t)jl * 2 + dir) * 512 + head * 128 + d];
    float gl[32];
    float tot = 0.f;
#pragma unroll
    for (int i = 0; i < 32; ++i) {
      const int tk = cc * 64 + half * 32 + i;
      const u32x4 la = *(const u32x4*)(sLr + tk * 64 + dir * 32);
      const u32x4 lb = *(const u32x4*)(sLr + tk * 64 + dir * 32 + 16);
      float z = gbias;
      z = dot2bf(la.x, gu[0], z); z = dot2bf(la.y, gu[1], z); z = dot2bf(la.z, gu[2], z); z = dot2bf(la.w, gu[3], z);
      z = dot2bf(lb.x, gu[4], z); z = dot2bf(lb.y, gu[5], z); z = dot2bf(lb.z, gu[6], z); z = dot2bf(lb.w, gu[7], z);
      const float tneg = fexp2(-fabsf(z) * L2E);
      const float g = (fminf(z, 0.f) - flog2(1.f + tneg) * LN2) * (L2E / 16.f);
      gl[i] = g;
      tot += g;
    }
    if (dir == 0) {
      float run = 0.f;
#pragma unroll
      for (int i = 0; i < 32; ++i) { run += gl[i]; gl[i] = run; }
    } else {
      float run = 0.f;
#pragma unroll
      for (int i = 31; i >= 0; --i) { run += gl[i]; gl[i] = run; }
    }
    __syncthreads();
    sHs[half * 128 + d] = tot;
    __syncthreads();
    const float other = sHs[(1 - half) * 128 + d];
    const float offs = (dir == 0) ? (half ? other : 0.f) : (half ? 0.f : other);
    const int chunk = (m0 >> 6) + cc;
    char* et = p.ws + (dir ? OFF_ETB : OFF_ETF) + ((size_t)chunk * 4 + head) * 16384;
#pragma unroll
    for (int i8 = 0; i8 < 4; ++i8) {
      u32x4 v;
      v.x = pack2(fexp2(gl[i8 * 8 + 0] + offs), fexp2(gl[i8 * 8 + 1] + offs));
      v.y = pack2(fexp2(gl[i8 * 8 + 2] + offs), fexp2(gl[i8 * 8 + 3] + offs));
      v.z = pack2(fexp2(gl[i8 * 8 + 4] + offs), fexp2(gl[i8 * 8 + 5] + offs));
      v.w = pack2(fexp2(gl[i8 * 8 + 6] + offs), fexp2(gl[i8 * 8 + 7] + offs));
      *(u32x4*)(et + sw128(d, half * 4 + i8)) = v;
    }
    if (half == 0)
      ((float*)(p.ws + OFF_DEC))[(((size_t)dir * (MR / 64) + chunk) * 4 + head) * 128 + d] = fexp2(tot + other);
  }
}

struct TileQ {
  unsigned* base;
  int* slot;
  int x, dq, pend;
  bool has_pend;
};
DI int tileq_fetch(TileQ& tq) {
  __syncthreads();
  if (threadIdx.x == 0) {
    int j = tq.has_pend ? tq.pend : (int)__hip_atomic_fetch_add(tq.base + tq.x * 16, 1u, __ATOMIC_RELAXED, __HIP_MEMORY_SCOPE_AGENT);
    *tq.slot = j;
  }
  tq.has_pend = false;
  __syncthreads();
  return *tq.slot;
}
DI void tileq_prefetch(TileQ& tq) {
  if (threadIdx.x == 0) {
    tq.pend = (int)__hip_atomic_fetch_add(tq.base + tq.x * 16, 1u, __ATOMIC_RELAXED, __HIP_MEMORY_SCOPE_AGENT);
  }
  tq.has_pend = true;
}

DI bool tileq_next(TileQ& tq, int pm_n, int NP, int NT, int xcc0, int& mt, int& nt) {
  for (;;) {
    if (tq.dq >= 8) return false;
    const int j = tileq_fetch(tq);
    const int P = (j >> 6) * 8 + tq.x;
    if (P >= NP) { ++tq.dq; tq.x = (xcc0 + tq.dq) & 7; tq.has_pend = false; continue; }
    const int li = j & 63;
    mt = (P % pm_n) * 8 + (li & 7);
    nt = (P / pm_n) * 8 + (li >> 3);
    if (nt >= NT) continue;
    tileq_prefetch(tq);
    return true;
  }
}

DI void phase_gemm_in(const Params& p, int l, char* smem, int inst) {
  const int tid = opaque_tid(), lane = tid & 63, wid = tid >> 6, r = lane & 15, q = lane >> 4;
  const int wx = wid >> 1, wy = wid & 1;
  const bool even = !(l & 1);
  const int ldp = even ? NEV : NOD;
  const int NT = even ? 64 : 56, MT = MR >> 7;
  const bfr* WT = (const bfr*)(p.ws + win_off(l));
  const bfr* H = (const bfr*)(p.ws + OFF_H);
  bfr* proj = (bfr*)(p.ws + OFF_PROJ);
  bfr* VT = (bfr*)(p.ws + OFF_VT);
  const float2* cs = (const float2*)(p.ws + OFF_CS);
  const int pm_n = MT >> 3, NP = pm_n * ((NT + 7) >> 3);
  TileQ tq;
  tq.base = (unsigned*)(p.ws + OFF_BAR) + 34 * 64 + inst * 128;
  tq.slot = (int*)(smem + SMEM_BYTES - 16);
  tq.has_pend = false; tq.pend = 0;
  const int xcc0 = (int)(__builtin_amdgcn_s_getreg((3 << 11) | 20) & 7u);
  if (!even) {
    TileQ lq;
    lq.base = (unsigned*)(p.ws + OFF_BAR) + 34 * 64 + (16 + inst) * 128;
    lq.slot = tq.slot; lq.has_pend = false; lq.pend = 0; lq.x = 0; lq.dq = 0;
    for (;;) {
      const int j = tileq_fetch(lq);
      if (j >= MT) break;
      const int m0 = j * 128, n0 = 7168;
      GemmStage g2;
      gemm_prologue(WT + (size_t)n0 * 1024, 1024, H + (size_t)m0 * 1024, 1024, g2);
      f32x4 acc[4][4];
#pragma unroll
      for (int i = 0; i < 4; ++i)
#pragma unroll
        for (int jj = 0; jj < 4; ++jj) acc[i][jj] = (f32x4){0.f, 0.f, 0.f, 0.f};
      gemm_mainloop(WT + (size_t)n0 * 1024, 1024, H + (size_t)m0 * 1024, 1024, 1024, WT, H, false, smem, acc, g2);
#pragma unroll
      for (int jn = 0; jn < 4; ++jn) {
        const int m = m0 + wy * 64 + jn * 16 + r;
#pragma unroll
        for (int i = 0; i < 4; ++i) {
          const int n = n0 + wx * 64 + i * 16 + 4 * q;
          u32x2 o;
          o.x = pack2(acc[i][jn][0], acc[i][jn][1]);
          o.y = pack2(acc[i][jn][2], acc[i][jn][3]);
          *(u32x2*)(proj + (size_t)m * ldp + n) = o;
        }
      }
      char* sLr = smem;
      float* sHs = (float*)(smem + 8192);
      if (wx == 0) {
#pragma unroll
        for (int jn = 0; jn < 4; ++jn)
#pragma unroll
          for (int i = 0; i < 2; ++i) {
            u32x2 o;
            o.x = pack2(acc[i][jn][0], acc[i][jn][1]);
            o.y = pack2(acc[i][jn][2], acc[i][jn][3]);
            *(u32x2*)(sLr + (wy * 64 + jn * 16 + r) * 64 + (i * 16 + 4 * q) * 2) = o;
          }
      }
      __syncthreads();
      gla_gate_precompute(p, l, m0, sLr, sHs);
      __syncthreads();
    }
  }
  tq.dq = 0; tq.x = xcc0;
  GemmStage gst;
  int mt = 0, nt = 0;
  bool have = tileq_next(tq, pm_n, NP, NT, xcc0, mt, nt);
  bool loaded = false;
  {
   while (have) {
    const int m0 = mt * 128, n0 = nt * 128;
    const bool vt = (n0 >= 1024 && n0 < 2048);
    const bfr* X = vt ? (H + (size_t)m0 * 1024) : (WT + (size_t)n0 * 1024);
    const bfr* Y = vt ? (WT + (size_t)n0 * 1024) : (H + (size_t)m0 * 1024);
    if (!loaded) gemm_prologue(X, 1024, Y, 1024, gst);
    int mtn = 0, ntn = 0;
    const bool haven = tileq_next(tq, pm_n, NP, NT, xcc0, mtn, ntn);
    const bool stream = haven;
    const int m0n = mtn * 128, n0n = ntn * 128;
    const bool vtn = (n0n >= 1024 && n0n < 2048);
    const bfr* Xn = vtn ? (H + (size_t)m0n * 1024) : (WT + (size_t)n0n * 1024);
    const bfr* Yn = vtn ? (WT + (size_t)n0n * 1024) : (H + (size_t)m0n * 1024);
    f32x4 acc[4][4];
#pragma unroll
    for (int i = 0; i < 4; ++i)
#pragma unroll
      for (int j = 0; j < 4; ++j) acc[i][j] = (f32x4){0.f, 0.f, 0.f, 0.f};
    gemm_mainloop(X, 1024, Y, 1024, 1024, Xn, Yn, stream, smem, acc, gst);
    loaded = stream;
    if (vt) {
#pragma unroll
      for (int i = 0; i < 4; i += 2) {
        const int mbase = m0 + wx * 64 + i * 16;
        int b, kp;
        if (mbase < ML) { b = mbase >> 12; kp = mbase & 4095; } else { const int mm = mbase - ML; b = mm >> 8; kp = 4096 + (mm & 255); }
        const int pos = (kp & ~31) + q * 8;
#pragma unroll
        for (int jn = 0; jn < 4; ++jn) {
          const int f = n0 - 1024 + wy * 64 + jn * 16 + r;
          u32x4 o;
          o.x = pack2(acc[i][jn][0], acc[i][jn][1]);
          o.y = pack2(acc[i][jn][2], acc[i][jn][3]);
          o.z = pack2(acc[i + 1][jn][0], acc[i + 1][jn][1]);
          o.w = pack2(acc[i + 1][jn][2], acc[i + 1][jn][3]);
          *(u32x4*)(VT + ((size_t)(b * 1024 + f)) * KEYS + pos) = o;
        }
      }
    } else {
      const bool rope = even && (n0 < 1024 || (n0 >= 2048 && n0 < 3072)) && (m0 < ML);
      if (rope) {
#pragma unroll
        for (int jn = 0; jn < 4; ++jn) {
          asm volatile("" ::: "memory");
          const int m = m0 + wy * 64 + jn * 16 + r;
          const int t = m & 4095;
          const int grow = t >> 6, gcol = t & 63;
#pragma unroll
          for (int j = 0; j < 4; ++j) {
            const float2 a = cs[grow * 16 + 4 * q + j];
            const float2 c = cs[gcol * 16 + 4 * q + j];
            const float x0 = acc[0][jn][j], x1 = acc[1][jn][j], x2 = acc[2][jn][j], x3 = acc[3][jn][j];
            acc[0][jn][j] = x0 * a.x - x1 * a.y;
            acc[1][jn][j] = x1 * a.x + x0 * a.y;
            acc[2][jn][j] = x2 * c.x - x3 * c.y;
            acc[3][jn][j] = x3 * c.x + x2 * c.y;
          }
        }
      }
#pragma unroll
      for (int jn = 0; jn < 4; ++jn) {
        const int m = m0 + wy * 64 + jn * 16 + r;
        bfr* rp = proj + (size_t)m * ldp + n0 + wx * 64;
        store_pair16(rp, acc[0][jn], acc[1][jn], q);
        store_pair16(rp + 32, acc[2][jn], acc[3][jn], q);
      }
    }
    mt = mtn; nt = ntn; have = haven;
  }
 }
}

DI void phase_gemm_out(const Params& p, int l, char* smem, int inst) {
  const int tid = opaque_tid(), lane = tid & 63, wid = tid >> 6, r = lane & 15, q = lane >> 4;
  const int wx = wid >> 1, wy = wid & 1;
  const bfr* WT = (const bfr*)(p.ws + OFF_WOUT + (size_t)l * SZ_WOUT);
  const bfr* U = (const bfr*)(p.ws + OFF_U);
  bfr* ybuf = (bfr*)(p.ws + OFF_PROJ);
  const int MT = (l == 3) ? (ML >> 7) : (MR >> 7);
  const int pm_n = MT >> 3, NP = pm_n;
  TileQ tq;
  tq.base = (unsigned*)(p.ws + OFF_BAR) + 34 * 64 + inst * 128;
  tq.slot = (int*)(smem + SMEM_BYTES - 16);
  tq.has_pend = false; tq.pend = 0;
  const int xcc0 = (int)(__builtin_amdgcn_s_getreg((3 << 11) | 20) & 7u);
  tq.dq = 0; tq.x = xcc0;
  GemmStage gst;
  int mt = 0, nt = 0;
  bool have = tileq_next(tq, pm_n, NP, 8, xcc0, mt, nt);
  bool loaded = false;
  while (have) {
    const int m0 = mt * 128, n0 = nt * 128;
    const bfr* X = WT + (size_t)n0 * 2048;
    const bfr* Y = U + (size_t)m0 * 2048;
    if (!loaded) gemm_prologue(X, 2048, Y, 2048, gst);
    int mtn = 0, ntn = 0;
    const bool haven = tileq_next(tq, pm_n, NP, 8, xcc0, mtn, ntn);
    const bfr* Xn = WT + (size_t)(ntn * 128) * 2048;
    const bfr* Yn = U + (size_t)(mtn * 128) * 2048;
    f32x4 acc[4][4];
#pragma unroll
    for (int i = 0; i < 4; ++i)
#pragma unroll
      for (int j = 0; j < 4; ++j) acc[i][j] = (f32x4){0.f, 0.f, 0.f, 0.f};
    gemm_mainloop(X, 2048, Y, 2048, 2048, Xn, Yn, haven, smem, acc, gst);
    loaded = haven;
#pragma unroll
    for (int jn = 0; jn < 4; ++jn) {
      const int m = m0 + wy * 64 + jn * 16 + r;
      bfr* rp = ybuf + (size_t)m * 1024 + n0 + wx * 64;
      store_pair16(rp, acc[0][jn], acc[1][jn], q);
      store_pair16(rp + 32, acc[2][jn], acc[3][jn], q);
    }
    mt = mtn; nt = ntn; have = haven;
  }
}

template <int DV, int QT, int KT, int MODE>
DI void attn_engine(const bfr* __restrict__ qbase, int ldq, const bfr* __restrict__ kbase, int ldk,
                    const bfr* __restrict__ vt, int nloc, int loc_row0, int loc_pos0, int nctx, int ctx_row0,
                    const float* rpb_s, int roff0, char* smem, f32x4 (&O)[DV / 16][QT], float (&lsum)[QT]) {
  constexpr int STAGE = 8192 + DV * 128;
  constexpr int NVL = DV / 32;
  const int tid = opaque_tid(), lane = tid & 63, wid = tid >> 6, r = lane & 15, q = lane >> 4;
  const int lr = tid >> 3, lc = tid & 7;
  constexpr float SC = 0.125f * L2E;

  bf16x8 Qf[QT][2];
#pragma unroll
  for (int qt = 0; qt < QT; ++qt)
#pragma unroll
    for (int s = 0; s < 2; ++s)
      Qf[qt][s] = *(const bf16x8*)(qbase + (size_t)(wid * 16 * QT + qt * 16 + r) * ldq + s * 32 + q * 8);
  float mrun[QT];
#pragma unroll
  for (int qt = 0; qt < QT; ++qt) {
    mrun[qt] = -1e30f;
    lsum[qt] = 0.f;
#pragma unroll
    for (int dt = 0; dt < DV / 16; ++dt) O[dt][qt] = (f32x4){0.f, 0.f, 0.f, 0.f};
  }

  const int nch = nloc + nctx;
  u32x4 kreg0, kreg1, vreg[NVL];
  const int ksw0 = sw128(lr, lc), ksw1 = sw128(lr + 32, lc);
#define AT_LOAD(c_)                                                                                          \
  {                                                                                                          \
    const int cc_ = (c_);                                                                                    \
    const int row_ = (cc_ < nloc) ? (loc_row0 + cc_ * 64) : (ctx_row0 + (cc_ - nloc) * 64);                  \
    const int pos_ = (cc_ < nloc) ? (loc_pos0 + cc_ * 64) : (4096 + (cc_ - nloc) * 64);                      \
    kreg0 = *(const u32x4*)(kbase + (size_t)(row_ + lr) * ldk + lc * 8);                                     \
    kreg1 = *(const u32x4*)(kbase + (size_t)(row_ + lr + 32) * ldk + lc * 8);                                \
    _Pragma("unroll") for (int i_ = 0; i_ < NVL; ++i_)                                                       \
        vreg[i_] = *(const u32x4*)(vt + (size_t)(lr + 32 * i_) * KEYS + pos_ + lc * 8);                      \
  }
#define AT_STORE(c_)                                                                                         \
  {                                                                                                          \
    char* sb_ = smem + ((c_) & 1) * STAGE;                                                                   \
    *(u32x4*)(sb_ + ksw0) = kreg0;                                                                           \
    *(u32x4*)(sb_ + ksw1) = kreg1;                                                                           \
    _Pragma("unroll") for (int i_ = 0; i_ < NVL; ++i_)                                                       \
        *(u32x4*)(sb_ + 8192 + sw128(lr + 32 * i_, lc)) = vreg[i_];                                          \
  }
  if (nch > 0) { AT_LOAD(0); AT_STORE(0); }
  for (int c = 0; c < nch; ++c) {
    __syncthreads();
    const bool more = (c + 1 < nch);
    const char* sK = smem + (c & 1) * STAGE;
    const char* sV = sK + 8192;
    if (more) AT_LOAD(c + 1);
    f32x4 stall[4 / KT][KT][QT];
#pragma unroll
    for (int sbk = 0; sbk < 4 / KT; ++sbk) {
#pragma unroll
      for (int kt = 0; kt < KT; ++kt)
#pragma unroll
        for (int qt = 0; qt < QT; ++qt) stall[sbk][kt][qt] = (f32x4){0.f, 0.f, 0.f, 0.f};
#pragma unroll
      for (int s = 0; s < 2; ++s)
#pragma unroll
        for (int kt = 0; kt < KT; ++kt) {
          const bf16x8 ka = *(const bf16x8*)(sK + sw128(sbk * KT * 16 + kt * 16 + r, s * 4 + q));
#pragma unroll
          for (int qt = 0; qt < QT; ++qt) stall[sbk][kt][qt] = mfma16(ka, Qf[qt][s], stall[sbk][kt][qt]);
        }
    }
#pragma unroll
    for (int sbk = 0; sbk < 4 / KT; ++sbk) {
      f32x4 (&st)[KT][QT] = stall[sbk];
      bf16x8 pb[KT / 2][QT];
      if (MODE == 1) {
#pragma unroll
        for (int kt = 0; kt < KT; ++kt)
#pragma unroll
          for (int qt = 0; qt < QT; ++qt)
#pragma unroll
            for (int j = 0; j < 4; ++j) {
              float v = st[kt][qt][j] * SC;
              if (c < nloc) {
                const int kc = sbk * KT * 16 + kt * 16 + 4 * q + j;
                const int qc = wid * 16 + r;
                int wst = qc - 8; wst = wst < 0 ? 0 : (wst > 48 ? 48 : wst);
                const bool valid = (kc >= wst) && (kc < wst + 16);
                int co = kc - qc + 15; co = co < 0 ? 0 : (co > 30 ? 30 : co);
                const float bias = rpb_s[(roff0 + c) * 31 + co] * L2E;
                v = valid ? (v + bias) : -INFINITY;
              }
              st[kt][qt][j] = v;
            }
      }
#pragma unroll
      for (int qt = 0; qt < QT; ++qt) {
        float mx = max3f(st[0][qt][0], st[0][qt][1], st[0][qt][2]);
        mx = max3f(mx, st[0][qt][3], st[1][qt][0]);
        mx = max3f(mx, st[1][qt][1], st[1][qt][2]);
#pragma unroll
        for (int kt = 2; kt < KT; ++kt) {
          mx = max3f(mx, st[kt - 1][qt][3], st[kt][qt][0]);
          mx = max3f(mx, st[kt][qt][1], st[kt][qt][2]);
        }
        mx = max3f(mx, st[KT - 1][qt][3], st[KT - 1][qt][3]);
        if (MODE != 1) mx *= SC;
        if (__any(mx > mrun[qt] + 8.f)) {
          mx = fmaxf(mx, shx<16>(mx, lane));
          mx = fmaxf(mx, shx<32>(mx, lane));
          const float mnew2 = fmaxf(mrun[qt], mx);
          const float alpha = fexp2(mrun[qt] - mnew2);
          mrun[qt] = mnew2;
          lsum[qt] *= alpha;
#pragma unroll
          for (int dt = 0; dt < DV / 16; ++dt) {
            O[dt][qt][0] *= alpha; O[dt][qt][1] *= alpha; O[dt][qt][2] *= alpha; O[dt][qt][3] *= alpha;
          }
        }
        const float mnew = mrun[qt];
        f32x2_t ps2 = {0.f, 0.f};
#pragma unroll
        for (int kt = 0; kt < KT; ++kt) {
          float e0, e1, e2, e3;
          if (MODE == 1) {
            e0 = fexp2(st[kt][qt][0] - mnew); e1 = fexp2(st[kt][qt][1] - mnew);
            e2 = fexp2(st[kt][qt][2] - mnew); e3 = fexp2(st[kt][qt][3] - mnew);
          } else {
            e0 = fexp2(__builtin_fmaf(st[kt][qt][0], SC, -mnew)); e1 = fexp2(__builtin_fmaf(st[kt][qt][1], SC, -mnew));
            e2 = fexp2(__builtin_fmaf(st[kt][qt][2], SC, -mnew)); e3 = fexp2(__builtin_fmaf(st[kt][qt][3], SC, -mnew));
          }
          st[kt][qt][0] = e0; st[kt][qt][1] = e1; st[kt][qt][2] = e2; st[kt][qt][3] = e3;
          const f32x2_t a01 = {e0, e1}, a23 = {e2, e3};
          ps2 = ps2 + a01;
          ps2 = ps2 + a23;
        }
        lsum[qt] += ps2.x + ps2.y;
#pragma unroll
        for (int ks = 0; ks < KT / 2; ++ks) {
          u32x4 pk;
          pk.x = pack2(st[2 * ks][qt][0], st[2 * ks][qt][1]);
          pk.y = pack2(st[2 * ks][qt][2], st[2 * ks][qt][3]);
          pk.z = pack2(st[2 * ks + 1][qt][0], st[2 * ks + 1][qt][1]);
          pk.w = pack2(st[2 * ks + 1][qt][2], st[2 * ks + 1][qt][3]);
          pb[ks][qt] = __builtin_bit_cast(bf16x8, pk);
        }
      }
#pragma unroll
      for (int dt = 0; dt < DV / 16; ++dt)
#pragma unroll
        for (int ks = 0; ks < KT / 2; ++ks) {
          const bf16x8 va = *(const bf16x8*)(sV + sw128(dt * 16 + r, (sbk * (KT / 2) + ks) * 4 + q));
#pragma unroll
          for (int qt = 0; qt < QT; ++qt) O[dt][qt] = mfma16(va, pb[ks][qt], O[dt][qt]);
        }
    }
    if (more) AT_STORE(c + 1);
  }
#undef AT_LOAD
#undef AT_STORE
  __syncthreads();
#pragma unroll
  for (int qt = 0; qt < QT; ++qt) {
    float L = lsum[qt];
    L += shx<16>(L, lane);
    L += shx<32>(L, lane);
    lsum[qt] = L;
  }
}

DI void diff_attn_item(const Params& p, int l, int b, int head, int qrow0, bool ctxq, char* smem) {
  const int tid = opaque_tid(), lane = tid & 63, wid = tid >> 6, r = lane & 15, q = lane >> 4;
  const bfr* proj = (const bfr*)(p.ws + OFF_PROJ);
  const bfr* VT = (const bfr*)(p.ws + OFF_VT);
  bfr* U = (bfr*)(p.ws + OFF_U);
  const float* lamv = (const float*)(p.ws + OFF_LAM);
  const float lam = lamv[l >> 1], lam_init = lamv[2 + (l >> 1)];
  f32x4 O[8][2];
  float ls[2];
  char* parkb = smem + 49152 + tid * 16;
  attn_engine<128, 2, 2, 0>(proj + (size_t)qrow0 * NEV + 2048 + head * 128, NEV, proj + head * 128, NEV,
                            VT + (size_t)(b * 1024 + head * 128) * KEYS, ctxq ? 0 : 64, b * 4096, 0, 4,
                            ML + b * 256, nullptr, 0, smem, O, ls);
  u32x4 pkr0, pkr1;
  {
    const float i0 = 1.f / ls[0], i1 = 1.f / ls[1];
#pragma unroll
    for (int dt = 0; dt < 8; dt += 2) {
      u32x4 v0, v1;
      v0.x = pack2(O[dt][0][0] * i0, O[dt][0][1] * i0);
      v0.y = pack2(O[dt][0][2] * i0, O[dt][0][3] * i0);
      v0.z = pack2(O[dt + 1][0][0] * i0, O[dt + 1][0][1] * i0);
      v0.w = pack2(O[dt + 1][0][2] * i0, O[dt + 1][0][3] * i0);
      v1.x = pack2(O[dt][1][0] * i1, O[dt][1][1] * i1);
      v1.y = pack2(O[dt][1][2] * i1, O[dt][1][3] * i1);
      v1.z = pack2(O[dt + 1][1][0] * i1, O[dt + 1][1][1] * i1);
      v1.w = pack2(O[dt + 1][1][2] * i1, O[dt + 1][1][3] * i1);
      if (dt < 6) {
        *(u32x4*)(parkb + (dt / 2) * 4096) = v0;
        *(u32x4*)(parkb + (3 + dt / 2) * 4096) = v1;
      } else { pkr0 = v0; pkr1 = v1; }
    }
  }
  attn_engine<128, 2, 2, 0>(proj + (size_t)qrow0 * NEV + 2048 + head * 128 + 64, NEV, proj + head * 128 + 64, NEV,
                            VT + (size_t)(b * 1024 + head * 128) * KEYS, ctxq ? 0 : 64, b * 4096, 0, 4,
                            ML + b * 256, nullptr, 0, smem, O, ls);
  const float* subln = p.ev_subln + (l >> 1) * 128;
#pragma unroll
  for (int qt = 0; qt < 2; ++qt) {
    const float i1 = lam / ls[qt];
    float ss = 0.f;
#pragma unroll
    for (int dt = 0; dt < 8; ++dt) {
      unsigned pa, pc;
      if (dt < 6) {
        const u32x2 pk2 = *(const u32x2*)(parkb + (qt * 3 + dt / 2) * 4096 + (dt & 1) * 8);
        pa = pk2.x; pc = pk2.y;
      } else {
        const u32x4 pr = qt ? pkr1 : pkr0;
        pa = (dt & 1) ? pr.z : pr.x; pc = (dt & 1) ? pr.w : pr.y;
      }
      const float o0 = lo_bf(pa) - O[dt][qt][0] * i1;
      const float o1 = hi_bf(pa) - O[dt][qt][1] * i1;
      const float o2 = lo_bf(pc) - O[dt][qt][2] * i1;
      const float o3 = hi_bf(pc) - O[dt][qt][3] * i1;
      O[dt][qt][0] = o0; O[dt][qt][1] = o1; O[dt][qt][2] = o2; O[dt][qt][3] = o3;
      ss += o0 * o0 + o1 * o1 + o2 * o2 + o3 * o3;
    }
    ss += shx<16>(ss, lane);
    ss += shx<32>(ss, lane);
    const float rn = rsqrtf(ss * (1.f / 128.f) + 1e-6f) * (1.f - lam_init);
    const int row = qrow0 + wid * 32 + qt * 16 + r;
#pragma unroll
    for (int dt = 0; dt < 8; ++dt) {
      const int dv = dt * 16 + 4 * q;
      const u32x2 ag = *(const u32x2*)(proj + (size_t)row * NEV + 3072 + head * 128 + dv);
      const float4 sl = *(const float4*)(subln + dv);
      u32x2 o;
      o.x = pack2(O[dt][qt][0] * rn * sl.x * silu(lo_bf(ag.x)), O[dt][qt][1] * rn * sl.y * silu(hi_bf(ag.x)));
      o.y = pack2(O[dt][qt][2] * rn * sl.z * silu(lo_bf(ag.y)), O[dt][qt][3] * rn * sl.w * silu(hi_bf(ag.y)));
      *(u32x2*)(U + (size_t)row * 2048 + head * 128 + dv) = o;
    }
  }
}

DI void na_item(const Params& p, int l, int b, int head, int rho, bool ctxq, int cq0, char* smem) {
  const int tid = opaque_tid(), lane = tid & 63, wid = tid >> 6, r = lane & 15, q = lane >> 4;
  const bfr* proj = (const bfr*)(p.ws + OFF_PROJ);
  const bfr* VT = (const bfr*)(p.ws + OFF_VT);
  bfr* U = (bfr*)(p.ws + OFF_U);
  float* rpb_s = (float*)(smem + 2 * (8192 + 64 * 128));
  int rs = rho - 4; rs = rs < 0 ? 0 : (rs > 56 ? 56 : rs);
  const int qrow0 = ctxq ? (ML + b * 256 + cq0) : (b * 4096 + rho * 64);
  f32x4 O[4][1];
  float ls[1];
  if (!ctxq) {
    const float* rp = p.od_rpb + ((size_t)(l >> 1) * 16 + head) * 465;
    for (int i = tid; i < 465; i += 256) rpb_s[i] = rp[i];
    attn_engine<64, 1, 4, 1>(proj + (size_t)qrow0 * NOD + 3584 + head * 64, NOD, proj + head * 64, NOD,
                                VT + (size_t)(b * 1024 + head * 64) * KEYS, 8, b * 4096 + rs * 64, rs * 64, 4,
                                ML + b * 256, rpb_s, rs - rho + 7, smem, O, ls);
  } else {
    attn_engine<64, 1, 4, 0>(proj + (size_t)qrow0 * NOD + 3584 + head * 64, NOD, proj + head * 64, NOD,
                                VT + (size_t)(b * 1024 + head * 64) * KEYS, 0, 0, 0, 4, ML + b * 256, nullptr, 0,
                                smem, O, ls);
  }
  const float inv = 1.f / ls[0];
  const int row = qrow0 + wid * 16 + r;
#pragma unroll
  for (int dt = 0; dt < 4; ++dt) {
    const int dv = dt * 16 + 4 * q;
    const u32x2 cgv = *(const u32x2*)(proj + (size_t)row * NOD + 5120 + head * 64 + dv);
    u32x2 o;
    o.x = pack2(O[dt][0][0] * inv * silu(lo_bf(cgv.x)), O[dt][0][1] * inv * silu(hi_bf(cgv.x)));
    o.y = pack2(O[dt][0][2] * inv * silu(lo_bf(cgv.y)), O[dt][0][3] * inv * silu(hi_bf(cgv.y)));
    *(u32x2*)(U + (size_t)row * 2048 + head * 64 + dv) = o;
  }
}

DI void conv_item(const Params& p, int l, int item) {
  const int tid = opaque_tid();
  const bfr* proj = (const bfr*)(p.ws + OFF_PROJ);
  bfr* U = (bfr*)(p.ws + OFF_U);
  const float* cw = p.ev_conv + (size_t)(l >> 1) * 3 * 1024;
#pragma unroll 1
  for (int i = 0; i < 8; ++i) {
    const int v = tid + 256 * i;
    const int ri = v >> 7, ch = (v & 127) * 8;
    const int m = item * 16 + ri;
    int t, T;
    if (m < ML) { t = m & 4095; T = 4096; } else { t = (m - ML) & 255; T = 256; }
    const bfr* pr = proj + (size_t)m * NEV;
    float acc[8];
#pragma unroll
    for (int e = 0; e < 8; ++e) acc[e] = 0.f;
#pragma unroll
    for (int w = 0; w < 3; ++w) {
      const int tt = t + w - 1;
      if (tt >= 0 && tt < T) {
        const bfr* prw = pr + (ptrdiff_t)(w - 1) * NEV;
        const u32x4 bh = *(const u32x4*)(prw + 4096 + ch);
        const u32x4 bc = *(const u32x4*)(prw + 6144 + ch);
        const float4 w0 = *(const float4*)(cw + w * 1024 + ch);
        const float4 w1 = *(const float4*)(cw + w * 1024 + ch + 4);
        acc[0] += w0.x * lo_bf(bh.x) * lo_bf(bc.x); acc[1] += w0.y * hi_bf(bh.x) * hi_bf(bc.x);
        acc[2] += w0.z * lo_bf(bh.y) * lo_bf(bc.y); acc[3] += w0.w * hi_bf(bh.y) * hi_bf(bc.y);
        acc[4] += w1.x * lo_bf(bh.z) * lo_bf(bc.z); acc[5] += w1.y * hi_bf(bh.z) * hi_bf(bc.z);
        acc[6] += w1.z * lo_bf(bh.w) * lo_bf(bc.w); acc[7] += w1.w * hi_bf(bh.w) * hi_bf(bc.w);
      }
    }
    const u32x4 bb = *(const u32x4*)(pr + 5120 + ch);
    const u32x4 bg = *(const u32x4*)(pr + 7168 + ch);
    u32x4 o;
    o.x = pack2(lo_bf(bb.x) * acc[0] * silu(lo_bf(bg.x)), hi_bf(bb.x) * acc[1] * silu(hi_bf(bg.x)));
    o.y = pack2(lo_bf(bb.y) * acc[2] * silu(lo_bf(bg.y)), hi_bf(bb.y) * acc[3] * silu(hi_bf(bg.y)));
    o.z = pack2(lo_bf(bb.z) * acc[4] * silu(lo_bf(bg.z)), hi_bf(bb.z) * acc[5] * silu(hi_bf(bg.z)));
    o.w = pack2(lo_bf(bb.w) * acc[6] * silu(lo_bf(bg.w)), hi_bf(bb.w) * acc[7] * silu(hi_bf(bg.w)));
    *(u32x4*)(U + (size_t)m * 2048 + 1024 + ch) = o;
  }
}

DI void gla_item(const Params& p, int l, int item, char* smem) {
  const int tid0 = opaque_tid();
  const int slice = item & 7, dir = (item >> 3) & 1, head = (item >> 4) & 3, b = item >> 6;
  const bfr* proj = (const bfr*)(p.ws + OFF_PROJ);
  const char* etb = p.ws + (dir ? OFF_ETB : OFF_ETF) + (size_t)head * 16384;
  const float* decb = (const float*)(p.ws + OFF_DEC) + ((size_t)dir * (MR / 64) * 4 + head) * 128;
  char* sQb = smem;
  char* sKc = smem + 16384;
  char* sKbT = smem + 32768;
  char* sVt = smem + 49152;
  char* sAtt = smem + 53248;
  char* sST = smem + 61440;
  float* sDec = (float*)(smem + 77824);
  const float qscale = 0.08838834764831845f;

  f32x4 S[2][2];
#pragma unroll
  for (int a = 0; a < 2; ++a)
#pragma unroll
    for (int c2 = 0; c2 < 2; ++c2) S[a][c2] = (f32x4){0.f, 0.f, 0.f, 0.f};
  __syncthreads();
  for (int i = tid0; i < 512; i += 256) ((u32x4*)sST)[i] = (u32x4){0u, 0u, 0u, 0u};

  u32x4 pq0, pq1, pq2, pq3, pk0, pk1, pk2, pk3, pv, pe0, pe1, pe2, pe3, pdec;
#define GLA_ROW0(ci_) (((ci_) < 4) ? (ML + b * 256 + (dir ? (3 - (ci_)) : (ci_)) * 64) : (b * 4096 + (dir ? (67 - (ci_)) : ((ci_) - 4)) * 64))
#define GLA_LOAD(ci_)                                                                                         \
  {                                                                                                           \
    const int prow = tid >> 4, pch = tid & 15, vs = tid >> 2, vpart = tid & 3;                                \
    const int r0_ = GLA_ROW0(ci_);                                                                            \
    const bfr* pr_ = proj + (size_t)(r0_ + prow) * NOD + head * 128 + pch * 8;                                \
    pq0 = *(const u32x4*)(pr_ + 4608);                     pk0 = *(const u32x4*)(pr_ + 2048);                 \
    pq1 = *(const u32x4*)(pr_ + 4608 + (size_t)16 * NOD);  pk1 = *(const u32x4*)(pr_ + 2048 + (size_t)16 * NOD); \
    pq2 = *(const u32x4*)(pr_ + 4608 + (size_t)32 * NOD);  pk2 = *(const u32x4*)(pr_ + 2048 + (size_t)32 * NOD); \
    pq3 = *(const u32x4*)(pr_ + 4608 + (size_t)48 * NOD);  pk3 = *(const u32x4*)(pr_ + 2048 + (size_t)48 * NOD); \
    pv = *(const u32x4*)(proj + (size_t)(r0_ + vs) * NOD + 2560 + head * 256 + slice * 32 + vpart * 8);       \
    const char* et_ = etb + (size_t)(r0_ >> 6) * 65536 + tid * 16;                                            \
    pe0 = *(const u32x4*)(et_);         pe1 = *(const u32x4*)(et_ + 4096);                                    \
    pe2 = *(const u32x4*)(et_ + 8192);  pe3 = *(const u32x4*)(et_ + 12288);                                   \
    if (tid < 32) pdec = *(const u32x4*)(decb + (size_t)(r0_ >> 6) * 512 + tid * 4);                          \
  }
  { const int tid = tid0; GLA_LOAD(0); }
  for (int ci = 0; ci < 68; ++ci) {
    int tid = tid0; asm volatile("" : "+v"(tid));
    const int lane = tid & 63, wid = tid >> 6, r = lane & 15, q = lane >> 4;
    const int d = tid & 127, half = tid >> 7;
    const int prow = tid >> 4, pch = tid & 15, vs = tid >> 2, vpart = tid & 3;
    const int row0 = GLA_ROW0(ci);
    const char* stc = sST + (ci & 1) * 8192;
    char* stn = sST + ((ci + 1) & 1) * 8192;
    __syncthreads();
    {
      *(u32x4*)(sQb + sw256(prow, pch)) = pq0;       *(u32x4*)(sKc + sw256(prow, pch)) = pk0;
      *(u32x4*)(sQb + sw256(prow + 16, pch)) = pq1;  *(u32x4*)(sKc + sw256(prow + 16, pch)) = pk1;
      *(u32x4*)(sQb + sw256(prow + 32, pch)) = pq2;  *(u32x4*)(sKc + sw256(prow + 32, pch)) = pk2;
      *(u32x4*)(sQb + sw256(prow + 48, pch)) = pq3;  *(u32x4*)(sKc + sw256(prow + 48, pch)) = pk3;
      *(u32x4*)(sKbT + tid * 16) = pe0;              *(u32x4*)(sKbT + tid * 16 + 4096) = pe1;
      *(u32x4*)(sKbT + tid * 16 + 8192) = pe2;       *(u32x4*)(sKbT + tid * 16 + 12288) = pe3;
      if (tid < 32) *(u32x4*)((char*)sDec + tid * 16) = pdec;
      const unsigned vv[4] = {pv.x, pv.y, pv.z, pv.w};
#pragma unroll
      for (int j = 0; j < 4; ++j) {
        const int e0 = vpart * 8 + 2 * j;
        *(bfr*)(sVt + sw128(e0, vs >> 3) + (vs & 7) * 2) = (bfr)(vv[j] & 0xffffu);
        *(bfr*)(sVt + sw128(e0 + 1, vs >> 3) + (vs & 7) * 2) = (bfr)(vv[j] >> 16);
      }
    }
    __syncthreads();
    {
      const float dec = sDec[d];
#pragma unroll
      for (int i8 = 0; i8 < 4; ++i8) {
        const u32x4 ev = *(const u32x4*)(sKbT + sw128(d, half * 4 + i8));
        const unsigned ew[4] = {ev.x, ev.y, ev.z, ev.w};
        unsigned kb[4];
#pragma unroll
        for (int ii = 0; ii < 8; ++ii) {
          const int s = half * 32 + i8 * 8 + ii;
          const float E = (ii & 1) ? hi_bf(ew[ii >> 1]) : lo_bf(ew[ii >> 1]);
          const float Ei = __builtin_amdgcn_rcpf(E);
          bfr* qa_ = (bfr*)(sQb + sw256(s, d >> 3) + (d & 7) * 2);
          bfr* ka_ = (bfr*)(sKc + sw256(s, d >> 3) + (d & 7) * 2);
          const float qv = bf2f(*qa_) * qscale * E;
          const float kc = bf2f(*ka_) * Ei;
          *qa_ = f2bf(qv);
          *ka_ = f2bf(kc);
          const unsigned kbv = f2bf(kc * dec);
          if (ii & 1) kb[ii >> 1] |= kbv << 16; else kb[ii >> 1] = kbv;
        }
        *(u32x4*)(sKbT + sw128(d, half * 4 + i8)) = (u32x4){kb[0], kb[1], kb[2], kb[3]};
      }
    }
    __syncthreads();
    if (ci + 1 < 68) GLA_LOAD(ci + 1);
    {
      f32x4 at[4];
#pragma unroll
      for (int st = 0; st < 4; ++st) at[st] = (f32x4){0.f, 0.f, 0.f, 0.f};
#pragma unroll
      for (int ks = 0; ks < 4; ++ks) {
        const bf16x8 qa = *(const bf16x8*)(sQb + sw256(wid * 16 + r, ks * 4 + q));
#pragma unroll
        for (int st = 0; st < 4; ++st) {
          const bf16x8 kb2 = *(const bf16x8*)(sKc + sw256(st * 16 + r, ks * 4 + q));
          at[st] = mfma16(qa, kb2, at[st]);
        }
      }
#pragma unroll
      for (int st = 0; st < 4; ++st)
#pragma unroll
        for (int j = 0; j < 4; ++j) {
          const int t = wid * 16 + 4 * q + j, s = st * 16 + r;
          const bool keep = dir ? (s >= t) : (s <= t);
          *(bfr*)(sAtt + sw128(t, s >> 3) + (s & 7) * 2) = f2bf(keep ? at[st][j] : 0.f);
        }
    }
    {
#pragma unroll
      for (int dti = 0; dti < 2; ++dti) {
        const float dc = sDec[(2 * wid + dti) * 16 + r];
#pragma unroll
        for (int et = 0; et < 2; ++et) {
          S[et][dti][0] *= dc; S[et][dti][1] *= dc; S[et][dti][2] *= dc; S[et][dti][3] *= dc;
        }
      }
#pragma unroll
      for (int ks = 0; ks < 2; ++ks) {
        bf16x8 va[2], kb2[2];
#pragma unroll
        for (int et = 0; et < 2; ++et) va[et] = *(const bf16x8*)(sVt + sw128(et * 16 + r, ks * 4 + q));
#pragma unroll
        for (int dti = 0; dti < 2; ++dti) kb2[dti] = *(const bf16x8*)(sKbT + sw128((2 * wid + dti) * 16 + r, ks * 4 + q));
#pragma unroll
        for (int et = 0; et < 2; ++et)
#pragma unroll
          for (int dti = 0; dti < 2; ++dti) S[et][dti] = mfma16(va[et], kb2[dti], S[et][dti]);
      }
#pragma unroll
      for (int et = 0; et < 2; ++et)
#pragma unroll
        for (int dti = 0; dti < 2; ++dti)
#pragma unroll
          for (int j = 0; j < 4; ++j) {
            const int e = et * 16 + 4 * q + j, dd = (2 * wid + dti) * 16 + r;
            *(bfr*)(stn + sw256(e, dd >> 3) + (dd & 7) * 2) = f2bf(S[et][dti][j]);
          }
    }
    __syncthreads();
    {
      f32x4 o[2];
      o[0] = (f32x4){0.f, 0.f, 0.f, 0.f};
      o[1] = (f32x4){0.f, 0.f, 0.f, 0.f};
#pragma unroll
      for (int ks = 0; ks < 4; ++ks) {
        const bf16x8 qa = *(const bf16x8*)(sQb + sw256(wid * 16 + r, ks * 4 + q));
#pragma unroll
        for (int et = 0; et < 2; ++et) {
          const bf16x8 sb2 = *(const bf16x8*)(stc + sw256(et * 16 + r, ks * 4 + q));
          o[et] = mfma16(qa, sb2, o[et]);
        }
      }
#pragma unroll
      for (int ks = 0; ks < 2; ++ks) {
        const bf16x8 aa = *(const bf16x8*)(sAtt + sw128(wid * 16 + r, ks * 4 + q));
#pragma unroll
        for (int et = 0; et < 2; ++et) {
          const bf16x8 vb = *(const bf16x8*)(sVt + sw128(et * 16 + r, ks * 4 + q));
          o[et] = mfma16(aa, vb, o[et]);
        }
      }
      {
        const int lam = head * 8 + slice;
#pragma unroll
        for (int j = 0; j < 4; ++j) {
          const int row = row0 + wid * 16 + 4 * q + j;
          const int m2 = row >> 1, par = row & 1;
          bfr* lp = dir ? ((bfr*)(p.ws + OFF_H) + ((size_t)m2 * 32 + lam) * 64)
                        : ((bfr*)(p.ws + OFF_U) + (size_t)(2 * m2 + (lam >> 4)) * 2048 + 1024 + (lam & 15) * 64);
#pragma unroll
          for (int et = 0; et < 2; ++et) lp[par * 32 + et * 16 + r] = f2bf(o[et][j]);
        }
      }
    }
  }
#undef GLA_LOAD
#undef GLA_ROW0
  __syncthreads();
}

DI void phase_gla_combine(const Params& p, int l) {
  const int tid = opaque_tid(), lane = tid & 63, wid = tid >> 6;
  const bfr* proj = (const bfr*)(p.ws + OFF_PROJ);
  const bfr* OB = (const bfr*)(p.ws + OFF_H);
  bfr* U = (bfr*)(p.ws + OFF_U);
  const int h = lane >> 4, e16 = (lane & 15) * 16;
  const int lam = h * 8 + ((lane & 15) >> 1), ein = (lane & 1) * 16;
  const float* gn = p.od_gnorm + (l >> 1) * 256 + e16;
  for (int m2 = blockIdx.x * 4 + wid; m2 < MR / 2; m2 += gridDim.x * 4) {
    const bfr* ofl = U + (size_t)(2 * m2 + (lam >> 4)) * 2048 + 1024 + (lam & 15) * 64 + ein;
    const bfr* obl = OB + ((size_t)m2 * 32 + lam) * 64 + ein;
    u32x4 a[2][2], bq[2][2], g[2][2];
#pragma unroll
    for (int par = 0; par < 2; ++par) {
      a[par][0] = *(const u32x4*)(ofl + par * 32);  a[par][1] = *(const u32x4*)(ofl + par * 32 + 8);
      bq[par][0] = *(const u32x4*)(obl + par * 32); bq[par][1] = *(const u32x4*)(obl + par * 32 + 8);
      const bfr* gp = proj + (size_t)(2 * m2 + par) * NOD + 6144 + h * 256 + e16;
      g[par][0] = *(const u32x4*)gp; g[par][1] = *(const u32x4*)(gp + 8);
    }
    u32x4 res[2][2];
#pragma unroll
    for (int par = 0; par < 2; ++par) {
      float o[16], dg[16];
      float ss = 0.f;
#pragma unroll
      for (int hv = 0; hv < 2; ++hv)
#pragma unroll
        for (int i = 0; i < 4; ++i) {
          const unsigned av = a[par][hv][i], bv = bq[par][hv][i], gv = g[par][hv][i];
          const int k = hv * 8 + i * 2;
          o[k] = lo_bf(av) + lo_bf(bv); o[k + 1] = hi_bf(av) + hi_bf(bv);
          dg[k] = lo_bf(gv); dg[k + 1] = hi_bf(gv);
          ss += o[k] * o[k] + o[k + 1] * o[k + 1];
        }
      ss += shx<1>(ss, lane); ss += shx<2>(ss, lane); ss += shx<4>(ss, lane); ss += shx<8>(ss, lane);
      const float rn = rsqrtf(ss * (1.f / 256.f) + 1e-6f);
#pragma unroll
      for (int hv = 0; hv < 2; ++hv)
#pragma unroll
        for (int i = 0; i < 4; ++i) {
          const int k = hv * 8 + i * 2;
          res[par][hv][i] = pack2(o[k] * rn * gn[k] * silu(dg[k]), o[k + 1] * rn * gn[k + 1] * silu(dg[k + 1]));
        }
    }
#pragma unroll
    for (int par = 0; par < 2; ++par) {
      bfr* up = U + (size_t)(2 * m2 + par) * 2048 + 1024 + h * 256 + e16;
      *(u32x4*)up = res[par][0];
      *(u32x4*)(up + 8) = res[par][1];
    }
  }
}

DI int next_item(int* ctr, int* slot) {
  __syncthreads();
  if (threadIdx.x == 0) *slot = atomicAdd(ctr, 1);
  __syncthreads();
  return *slot;
}

DI void phase_mix_even(const Params& p, int l, int g, char* smem, int coff = 0) {
  int* ctr0 = (int*)(p.ws + OFF_CTR) + ((g * 2 + (l >> 1)) * 8) + coff;
  int* slot = (int*)(smem + SMEM_BYTES - 16);
  const int PER_LAT = GB * 32, PER_CTX = GB * 2, PER_CONV = MR / 16 / 8;
  const int per_q = PER_LAT + PER_CTX + PER_CONV;
  const int myq = (int)(__builtin_amdgcn_s_getreg((3 << 11) | 20) & 7u);
  for (int dq = 0; dq < 8; ++dq) {
    const int x = (myq + dq) & 7;
    for (;;) {
      int it = next_item(ctr0 + x, slot);
      if (it >= per_q) break;
      if (it < PER_LAT) {
        const int qb = it & 31, b = it >> 5;
        diff_attn_item(p, l, b, x, b * 4096 + qb * 128, false, smem);
      } else if (it < PER_LAT + PER_CTX) {
        it -= PER_LAT;
        const int qb = it & 1, b = it >> 1;
        diff_attn_item(p, l, b, x, ML + b * 256 + qb * 128, true, smem);
      } else {
        conv_item(p, l, (it - PER_LAT - PER_CTX) * 8 + x);
      }
    }
  }
}

DI void phase_mix_odd(const Params& p, int l, int g, char* smem) {
  int* ctr = (int*)(p.ws + OFF_CTR) + (g * 4 + l);
  int* slot = (int*)(smem + SMEM_BYTES - 16);
  const int N_GLA = GB * 4 * 2 * 8, N_NA = GB * 16 * 64, N_CTX = (l == 3) ? 0 : GB * 16 * 4;
  const int total = N_GLA + N_NA + N_CTX;
  (void)ctr; (void)slot; (void)total;
  const int nb = gridDim.x, bx = blockIdx.x;
  const int nup = (nb > N_GLA) ? (nb - N_GLA) : 0;
  const int NA_UP = 17;
  for (int k = 0;; ++k) {
    int it;
    if (nup == 0) { it = bx + k * nb; if (it >= total) break; }
    else if (bx < N_GLA) {
      if (k == 0) it = bx;
      else { it = N_GLA + NA_UP * nup + bx + (k - 1) * N_GLA; if (it >= total) break; }
    } else {
      if (k >= NA_UP) break;
      it = N_GLA + (bx - N_GLA) + k * nup;
      if (it >= total) break;
    }
    __syncthreads();
    if (it < N_GLA) {
      __builtin_amdgcn_s_setprio(3);
      gla_item(p, l, it, smem);
      __builtin_amdgcn_s_setprio(0);
    } else if (it < N_GLA + N_NA) {
      it -= N_GLA;
      const int rho = it & 63, bh = it >> 6;
      na_item(p, l, bh >> 4, bh & 15, rho, false, 0, smem);
    } else {
      it -= N_GLA + N_NA;
      const int qb = it & 3, bh = it >> 2;
      na_item(p, l, bh >> 4, bh & 15, 0, true, qb * 64, smem);
    }
  }
}


DI void grid_barrier(unsigned* bar, unsigned& bgen, unsigned xcc, unsigned nxcc, unsigned nx) {
  asm volatile("s_waitcnt vmcnt(0)" ::: "memory");
  __syncthreads();
  const unsigned target = bgen + 1;
  if (threadIdx.x == 0) {
    const unsigned old = __hip_atomic_fetch_add(bar + xcc * 64, 1u, __ATOMIC_RELAXED, __HIP_MEMORY_SCOPE_AGENT);
    if (old == target * nxcc - 1) {
      __builtin_amdgcn_fence(__ATOMIC_RELEASE, "agent");
      asm volatile("s_waitcnt vmcnt(0)" ::: "memory");
      const unsigned o2 = __hip_atomic_fetch_add(bar + 16 * 64, 1u, __ATOMIC_RELAXED, __HIP_MEMORY_SCOPE_AGENT);
      if (o2 == target * nx - 1) __hip_atomic_store(bar + 17 * 64, target, __ATOMIC_RELAXED, __HIP_MEMORY_SCOPE_AGENT);
    }
    while (__hip_atomic_load(bar + 17 * 64, __ATOMIC_RELAXED, __HIP_MEMORY_SCOPE_AGENT) < target) __builtin_amdgcn_s_sleep(1);
    __builtin_amdgcn_fence(__ATOMIC_ACQUIRE, "agent");
    asm volatile("s_waitcnt vmcnt(0)" ::: "memory");
  }
  bgen = target;
  __syncthreads();
}
typedef const __attribute__((address_space(4))) Params* KParamsPtr;
DI Params load_params() {
#if defined(__HIP_DEVICE_COMPILE__)
  KParamsPtr kp = (KParamsPtr)__builtin_amdgcn_kernarg_segment_ptr();
  asm volatile("" : "+s"(kp));
  Params r;
  __builtin_memcpy(&r, kp, sizeof(Params));
  return r;
#else
  return Params{};
#endif
}
#define PH(call) { const Params p = load_params(); call; }
__global__ void __launch_bounds__(256, 2) mega_kernel(Params p_unused) {
  extern __shared__ __attribute__((aligned(16))) char smem[];
  cg::grid_group grid = cg::this_grid();
  unsigned bgen = 0;
  const unsigned xcc = (unsigned)__builtin_amdgcn_s_getreg((3 << 11) | 20) & 15u;
  if (threadIdx.x == 0) {
    const Params pb = load_params();
    __hip_atomic_fetch_add((unsigned*)(pb.ws + OFF_BAR) + (18 + xcc) * 64, 1u, __ATOMIC_RELAXED, __HIP_MEMORY_SCOPE_AGENT);
  }
  PH(phase0(p, smem));
  grid.sync();
  unsigned nxcc = 0, nx = 0;
  {
    const Params pb = load_params();
    const unsigned* cen = (const unsigned*)(pb.ws + OFF_BAR) + 18 * 64;
    for (unsigned j = 0; j < 16; ++j) {
      const unsigned cj = __hip_atomic_load(cen + j * 64, __ATOMIC_RELAXED, __HIP_MEMORY_SCOPE_AGENT);
      nx += (cj != 0);
      if (j == xcc) nxcc = cj;
    }
  }
#define GBAR() { const Params pb = load_params(); grid_barrier((unsigned*)(pb.ws + OFF_BAR), bgen, xcc, nxcc, nx); }
#pragma unroll 1
  for (int g = 0; g < NGRP; ++g) {
#pragma unroll 1
    for (int l = 0; l < 4; ++l) {
      PH(phase_norm(p, l, g));
      GBAR();
      PH(phase_gemm_in(p, l, smem, g * 4 + l));
      GBAR();
      if (l & 1) {
        PH(phase_mix_odd(p, l, g, smem));
        GBAR();
        PH(phase_gla_combine(p, l));
      } else {
        PH(phase_mix_even(p, l, g, smem));
      }
      GBAR();
      PH(phase_gemm_out(p, l, smem, 8 + g * 4 + l));
      GBAR();
    }
    PH(phase_norm(p, 4, g));
  }
}

extern "C" void kernel_launch(void* const* d_in, const int* in_sizes, int n_in, void* d_out, int out_size, void* d_ws,
                              size_t ws_size, hipStream_t stream) {
  static int grid_blocks = 0;
  if (!grid_blocks) {
    int dev = 0, cus = 0, per_cu = 0;
    hipGetDevice(&dev);
    hipDeviceGetAttribute(&cus, hipDeviceAttributeMultiprocessorCount, dev);
    hipFuncSetAttribute((const void*)mega_kernel, hipFuncAttributeMaxDynamicSharedMemorySize, SMEM_BYTES);
    hipOccupancyMaxActiveBlocksPerMultiprocessor(&per_cu, mega_kernel, 256, SMEM_BYTES);
    if (per_cu > 2) per_cu = 2;
    if (per_cu < 1) per_cu = 1;
    grid_blocks = cus * per_cu;
    grid_blocks &= ~15;
  }
  if (ws_size < WS_NEED) { fprintf(stderr, "workspace too small: %zu < %zu\n", ws_size, (size_t)WS_NEED); return; }
  Params p{};
  p.x = (const float*)d_in[0]; p.c = (const float*)d_in[1]; p.ctx = (const float*)d_in[2]; p.c_ctx = (const float*)d_in[3];
  p.w_mod = (const float*)d_in[4]; p.b_mod = (const float*)d_in[5]; p.g_pre = (const float*)d_in[6]; p.g_post = (const float*)d_in[7];
  p.w_out = (const float*)d_in[8]; p.ev_w_in = (const float*)d_in[9]; p.ev_lambda = (const float*)d_in[10]; p.ev_subln = (const float*)d_in[11];
  p.ev_conv = (const float*)d_in[12]; p.od_w_in = (const float*)d_in[13]; p.od_rpb = (const float*)d_in[14]; p.od_gate_up = (const float*)d_in[15];
  p.od_gate_bias = (const float*)d_in[16]; p.od_gnorm = (const float*)d_in[17];
  p.out = (float*)d_out;
  p.ws = (char*)d_ws;
  (void)hipMemsetAsync((char*)d_ws + OFF_BAR, 0, BAR_BYTES, stream);
  void* args[] = {&p};
  hipError_t e = hipLaunchCooperativeKernel((const void*)mega_kernel, dim3(grid_blocks), dim3(256), args, SMEM_BYTES, stream);
  if (e != hipSuccess) fprintf(stderr, "cooperative launch failed: %s (grid %d)\n", hipGetErrorString(e), grid_blocks);
}
```

```cpp
#include <hip/hip_runtime.h>
#include <hip/hip_cooperative_groups.h>
#include <cstdio>
namespace cg = cooperative_groups;

typedef unsigned short bfr;
typedef __attribute__((ext_vector_type(8))) short bf16x8;
typedef __attribute__((ext_vector_type(4))) float f32x4;
typedef __attribute__((ext_vector_type(4))) unsigned u32x4;
typedef __attribute__((ext_vector_type(2))) unsigned u32x2;
typedef __attribute__((ext_vector_type(16))) unsigned u32x16;
typedef __attribute__((ext_vector_type(2))) __bf16 bf16x2_t;
#define DI __device__ __forceinline__
DI float dot2bf(unsigned a, unsigned b, float c) { return __builtin_amdgcn_fdot2_f32_bf16(__builtin_bit_cast(bf16x2_t, a), __builtin_bit_cast(bf16x2_t, b), c, false); }
DI int opaque_tid() { int t = threadIdx.x; asm volatile("" : "+v"(t)); return t; }

constexpr int GB   = 4;
constexpr int NGRP = 2;
constexpr int ML   = GB * 4096;
constexpr int MC   = GB * 256;
constexpr int MR   = ML + MC;
constexpr int NEV  = 8192;
constexpr int NOD  = 7296;
constexpr int KEYS = 4352;
constexpr float L2E = 1.4426950408889634f;
constexpr float LN2 = 0.6931471805599453f;

constexpr size_t SZ_PROJ = (size_t)MR * 8192 * 2;
constexpr size_t SZ_H    = (size_t)MR * 1024 * 2;
constexpr size_t SZ_U    = (size_t)MR * 2048 * 2;
constexpr size_t SZ_VT   = (size_t)GB * 1024 * KEYS * 2;
constexpr size_t SZ_WE   = (size_t)NEV * 1024 * 2;
constexpr size_t SZ_WO   = (size_t)NOD * 1024 * 2;
constexpr size_t SZ_WOUT = (size_t)1024 * 2048 * 2;
constexpr size_t OFF_PROJ = 0;
constexpr size_t OFF_H    = OFF_PROJ + SZ_PROJ;
constexpr size_t OFF_U    = OFF_H + SZ_H;
constexpr size_t OFF_VT   = OFF_U + SZ_U;
constexpr size_t OFF_WIN  = OFF_VT + SZ_VT;
constexpr size_t OFF_WOUT = OFF_WIN + 2 * SZ_WE + 2 * SZ_WO;
constexpr size_t OFF_XC   = OFF_WOUT + 4 * SZ_WOUT;
constexpr size_t OFF_MOD  = OFF_XC + (size_t)8 * 256 * 1024 * 4;
constexpr size_t OFF_CS   = OFF_MOD + (size_t)4 * 9 * 3072 * 4;
constexpr size_t OFF_LAM  = OFF_CS + 64 * 16 * 8;
constexpr size_t OFF_CTR  = OFF_LAM + 256;
constexpr size_t OFF_BAR  = OFF_CTR + 256;
constexpr size_t BAR_BYTES = 34 * 256 + 192 * 64;
constexpr size_t SZ_ET    = (size_t)(MR / 64) * 4 * 16384;
constexpr size_t OFF_ETF  = OFF_PROJ + (size_t)MR * NOD * 2;
constexpr size_t OFF_ETB  = (OFF_BAR + BAR_BYTES + 255) & ~(size_t)255;
constexpr size_t OFF_DEC  = OFF_ETB + SZ_ET;
constexpr size_t WS_NEED  = OFF_DEC + (size_t)2 * (MR / 64) * 4 * 128 * 4;
static_assert(OFF_ETF + SZ_ET <= OFF_H, "E^T forward tiles must fit behind the odd proj rows");

constexpr int SMEM_BYTES = 80896;

struct Params {
  const float *x, *c, *ctx, *c_ctx, *w_mod, *b_mod, *g_pre, *g_post, *w_out, *ev_w_in, *ev_lambda, *ev_subln,
      *ev_conv, *od_w_in, *od_rpb, *od_gate_up, *od_gate_bias, *od_gnorm;
  float* out;
  char* ws;
};

DI size_t win_off(int l) { return OFF_WIN + (size_t)(l >> 1) * (SZ_WE + SZ_WO) + ((l & 1) ? SZ_WE : 0); }

DI float bf2f(bfr v) { return __uint_as_float(((unsigned)v) << 16); }
typedef __attribute__((ext_vector_type(2))) float f32x2_t;
DI bfr f2bf(float x) { return __builtin_bit_cast(bfr, (__bf16)x); }
DI unsigned pack2(float a, float b) { f32x2_t v = {a, b}; return __builtin_bit_cast(unsigned, __builtin_convertvector(v, bf16x2_t)); }
DI float lo_bf(unsigned u) { return __uint_as_float(u << 16); }
DI float hi_bf(unsigned u) { return __uint_as_float(u & 0xffff0000u); }
DI float fexp2(float x) { return __builtin_amdgcn_exp2f(x); }
DI float flog2(float x) { return __builtin_amdgcn_logf(x); }
DI float silu(float x) { return x / (1.f + fexp2(-x * L2E)); }
DI float max3f(float a, float b, float c) { float r; asm("v_max3_f32 %0, %1, %2, %3" : "=v"(r) : "v"(a), "v"(b), "v"(c)); return r; }
template <int M>
DI float shx(float v, int lane) {
  if (M < 32) return __builtin_bit_cast(float, __builtin_amdgcn_ds_swizzle(__builtin_bit_cast(int, v), (M << 10) | 0x1f));
  return __builtin_bit_cast(float, __builtin_amdgcn_ds_bpermute((lane ^ 32) << 2, __builtin_bit_cast(int, v)));
}
DI float wave_sum(float v, int lane) {
  v += shx<1>(v, lane); v += shx<2>(v, lane); v += shx<4>(v, lane); v += shx<8>(v, lane); v += shx<16>(v, lane); v += shx<32>(v, lane);
  return v;
}
DI f32x4 mfma16(bf16x8 a, bf16x8 b, f32x4 c) { return __builtin_amdgcn_mfma_f32_16x16x32_bf16(a, b, c, 0, 0, 0); }
DI int sw128(int row, int chunk) { return row * 128 + ((chunk ^ ((row >> 1) & 7)) << 4); }
DI int sw256(int row, int chunk) { return row * 256 + ((chunk ^ (row & 15)) << 4); }

DI void store_pair16(bfr* tile_i_ptr, const f32x4& a, const f32x4& b, int q) {
  const unsigned ax = pack2(a[0], a[1]), ay = pack2(a[2], a[3]), bx = pack2(b[0], b[1]), by = pack2(b[2], b[3]);
  const u32x2 r0 = __builtin_amdgcn_permlane16_swap(ax, bx, false, false);
  const u32x2 r1 = __builtin_amdgcn_permlane16_swap(ay, by, false, false);
  *(u32x4*)(tile_i_ptr + (q & 1) * 16 + (q >> 1) * 8) = (u32x4){r0.x, r1.x, r0.y, r1.y};
}

struct GemmStage { u32x4 xa0[4], ya0[4], xa1[4], ya1[4]; };
DI void gemm_prologue(const bfr* __restrict__ X, int ldx, const bfr* __restrict__ Y, int ldy, GemmStage& st) {
  const int tid = opaque_tid();
  const int lr = tid >> 3, lc = tid & 7;
  const bfr* xp = X + (size_t)lr * ldx + lc * 8;
  const bfr* yp = Y + (size_t)lr * ldy + lc * 8;
#pragma unroll
  for (int i = 0; i < 4; ++i) {
    st.xa0[i] = *(const u32x4*)(xp + (size_t)(32 * i) * ldx);
    st.ya0[i] = *(const u32x4*)(yp + (size_t)(32 * i) * ldy);
    st.xa1[i] = *(const u32x4*)(xp + (size_t)(32 * i) * ldx + 64);
    st.ya1[i] = *(const u32x4*)(yp + (size_t)(32 * i) * ldy + 64);
  }
}
DI void gemm_mainloop(const bfr* __restrict__ X, int ldx, const bfr* __restrict__ Y, int ldy, int K,
                      const bfr* __restrict__ Xn, const bfr* __restrict__ Yn, bool hasnext, char* smem,
                      f32x4 (&acc)[4][4], GemmStage& st) {
  const int tid = opaque_tid(), lane = tid & 63, wid = tid >> 6, r = lane & 15, q = lane >> 4;
  const int wx = wid >> 1, wy = wid & 1;
  const int lr = tid >> 3, lc = tid & 7;
  const bfr* xp = X + (size_t)lr * ldx + lc * 8;
  const bfr* yp = Y + (size_t)lr * ldy + lc * 8;
  const bfr* xpn = Xn + (size_t)lr * ldx + lc * 8;
  const bfr* ypn = Yn + (size_t)lr * ldy + lc * 8;
  const int nk = K >> 6;
#define GEMM_STEP(XR, YR, BUF, KT)                                                                       \
  {                                                                                                      \
    char* sX = smem + (BUF) * 32768;                                                                     \
    char* sY = sX + 16384;                                                                               \
    _Pragma("unroll") for (int i = 0; i < 4; ++i) {                                                      \
      *(u32x4*)(sX + sw128(lr + 32 * i, lc)) = XR[i];                                                    \
      *(u32x4*)(sY + sw128(lr + 32 * i, lc)) = YR[i];                                                    \
    }                                                                                                    \
    __syncthreads();                                                                                     \
    if ((KT) + 2 < nk) {                                                                                 \
      const int ko = ((KT) + 2) * 64;                                                                    \
      _Pragma("unroll") for (int i = 0; i < 4; ++i) {                                                    \
        XR[i] = *(const u32x4*)(xp + (size_t)(32 * i) * ldx + ko);                                       \
        YR[i] = *(const u32x4*)(yp + (size_t)(32 * i) * ldy + ko);                                       \
      }                                                                                                  \
    } else if (hasnext) {                                                                                \
      const int ko = ((KT) + 2 - nk) * 64;                                                               \
      _Pragma("unroll") for (int i = 0; i < 4; ++i) {                                                    \
        XR[i] = *(const u32x4*)(xpn + (size_t)(32 * i) * ldx + ko);                                      \
        YR[i] = *(const u32x4*)(ypn + (size_t)(32 * i) * ldy + ko);                                      \
      }                                                                                                  \
    }                                                                                                    \
    _Pragma("unroll") for (int s = 0; s < 2; ++s) {                                                      \
      bf16x8 xf[4], yf[4];                                                                               \
      _Pragma("unroll") for (int i = 0; i < 4; ++i)                                                      \
          xf[i] = *(const bf16x8*)(sX + sw128(wx * 64 + i * 16 + r, s * 4 + q));                         \
      _Pragma("unroll") for (int j = 0; j < 4; ++j)                                                      \
          yf[j] = *(const bf16x8*)(sY + sw128(wy * 64 + j * 16 + r, s * 4 + q));                         \
      __builtin_amdgcn_s_setprio(1);                                                                     \
      _Pragma("unroll") for (int i = 0; i < 4; ++i)                                                      \
          _Pragma("unroll") for (int j = 0; j < 4; ++j) acc[i][j] = mfma16(xf[i], yf[j], acc[i][j]);     \
      __builtin_amdgcn_s_setprio(0);                                                                     \
    }                                                                                                    \
  }
  for (int kt = 0; kt < nk; kt += 2) {
    GEMM_STEP(st.xa0, st.ya0, 0, kt);
    GEMM_STEP(st.xa1, st.ya1, 1, kt + 1);
  }
#undef GEMM_STEP
  __syncthreads();
}

DI bool tile_map(int T, int MT, int NT, int& mt, int& nt) {
  const int pm_n = MT >> 3;
  const int P = (T >> 9) * 8 + (T & 7);
  const int li = (T & 511) >> 3;
  const int pm = P % pm_n, pn = P / pm_n;
  mt = pm * 8 + (li & 7);
  nt = pn * 8 + (li >> 3);
  return nt < NT;
}

DI int odd_col_src(int n) {
  if (n < 3584) return n;
  if (n < 7168) return n + 32;
  if (n < 7200) return n - 7168 + 3584;
  return -1;
}

struct TrItem { const float* src; bfr* dst; int K, Nsrc, k0, n0; bool oddmap; };
DI TrItem tr_decode(const Params& p, int it) {
  TrItem t;
  int rr = it, l, ktile, ntile;
  t.oddmap = false;
  if (rr < 7744) {
    if (rr < 2048) { l = 0; } else if (rr < 3872) { l = 1; rr -= 2048; } else if (rr < 5920) { l = 2; rr -= 3872; } else { l = 3; rr -= 5920; }
    ktile = rr & 15; ntile = rr >> 4; t.K = 1024;
    t.oddmap = (l & 1);
    t.Nsrc = t.oddmap ? 7200 : 8192;
    t.src = (t.oddmap ? p.od_w_in : p.ev_w_in) + (size_t)(l >> 1) * 1024 * t.Nsrc;
    t.dst = (bfr*)(p.ws + win_off(l));
  } else {
    rr -= 7744; l = rr >> 9; rr &= 511;
    ktile = rr & 31; ntile = rr >> 5; t.K = 2048; t.Nsrc = 1024;
    t.src = p.w_out + (size_t)l * 2048 * 1024;
    t.dst = (bfr*)(p.ws + OFF_WOUT + (size_t)l * SZ_WOUT);
  }
  t.k0 = ktile * 64; t.n0 = ntile * 64;
  return t;
}
DI void tr_load(const TrItem& t, int tid, float (&v)[16]) {
  const int nd = t.n0 + (tid & 63);
  const int ns = t.oddmap ? odd_col_src(nd) : nd;
#pragma unroll
  for (int i = 0; i < 16; ++i) {
    const int kk = (tid >> 6) + 4 * i;
    v[i] = (ns >= 0) ? t.src[(size_t)(t.k0 + kk) * t.Nsrc + ns] : 0.f;
  }
}
DI void tr_emit(const TrItem& t, const float* tl, int tid) {
  const int kk8 = (tid & 7) * 8;
#pragma unroll
  for (int i2 = 0; i2 < 2; ++i2) {
    const int nn = (tid >> 3) + 32 * i2;
    u32x4 v;
    v.x = pack2(tl[(kk8 + 0) * 65 + nn], tl[(kk8 + 1) * 65 + nn]);
    v.y = pack2(tl[(kk8 + 2) * 65 + nn], tl[(kk8 + 3) * 65 + nn]);
    v.z = pack2(tl[(kk8 + 4) * 65 + nn], tl[(kk8 + 5) * 65 + nn]);
    v.w = pack2(tl[(kk8 + 6) * 65 + nn], tl[(kk8 + 7) * 65 + nn]);
    *(u32x4*)(t.dst + (size_t)(t.n0 + nn) * t.K + t.k0 + kk8) = v;
  }
}
DI void phase0(const Params& p, char* smem) {
  const int tid = opaque_tid();
  if (blockIdx.x < 384) {
    float* sc = (float*)smem;
    float* red = sc + 9 * 1024;
    for (int i = tid; i < 9 * 1024; i += 256) {
      const int b = i >> 10, k = i & 1023;
      const float v = (b < 8) ? p.c[b * 1024 + k] : p.c_ctx[k];
      sc[i] = v / (1.f + __expf(-v));
    }
    __syncthreads();
    float* modb = (float*)(p.ws + OFF_MOD);
    for (int it = blockIdx.x; it < 384; it += gridDim.x) {
      const int l = it / 96, cgp = it % 96;
      const int col = cgp * 32 + (tid & 31), ks = tid >> 5;
      float a[9];
#pragma unroll
      for (int b = 0; b < 9; ++b) a[b] = 0.f;
      const float* w = p.w_mod + ((size_t)l * 1024 + ks * 128) * 3072 + col;
#pragma unroll 16
      for (int k = 0; k < 128; ++k) {
        const float wv = w[(size_t)k * 3072];
#pragma unroll
        for (int b = 0; b < 9; ++b) a[b] += sc[b * 1024 + ks * 128 + k] * wv;
      }
#pragma unroll
      for (int b = 0; b < 9; ++b) red[(ks * 9 + b) * 32 + (tid & 31)] = a[b];
      __syncthreads();
      for (int idx = tid; idx < 288; idx += 256) {
        const int b = idx >> 5, cc = idx & 31;
        float s = p.b_mod[l * 3072 + cgp * 32 + cc];
#pragma unroll
        for (int k2 = 0; k2 < 8; ++k2) s += red[(k2 * 9 + b) * 32 + cc];
        modb[(size_t)(l * 9 + b) * 3072 + cgp * 32 + cc] = s;
      }
      __syncthreads();
    }
  }
  if (blockIdx.x == gridDim.x - 1) {
    float2* cs = (float2*)(p.ws + OFF_CS);
    for (int idx = tid; idx < 1024; idx += 256) {
      const int pos = idx >> 4, f = idx & 15;
      const float inv = 1.0f / powf(10000.f, (float)f * 0.0625f);
      const float ang = (float)pos * inv;
      const double ad = (double)ang;
      const double n = rint(ad * 0.15915494309189535);
      const float rr = (float)(ad - n * 6.283185307179586);
      cs[idx] = make_float2(__cosf(rr), __sinf(rr));
    }
    if (tid < 2) {
      const float* lp = p.ev_lambda + tid * 256;
      float s1 = 0.f, s2 = 0.f;
      for (int i = 0; i < 64; ++i) { s1 += lp[i] * lp[64 + i]; s2 += lp[128 + i] * lp[192 + i]; }
      const float li = (tid == 0) ? 0.2f : (0.8f - 0.6f * 0.5488116360940264f);
      float* lam = (float*)(p.ws + OFF_LAM);
      lam[tid] = __expf(s1) - __expf(s2) + li;
      lam[2 + tid] = li;
    }
    if (tid < 32) ((int*)(p.ws + OFF_CTR))[tid] = 0;
  }
  float* tile = (float*)smem;
  __syncthreads();
  float* tile1 = tile + 64 * 65;
  for (int it = blockIdx.x * 2; it < 9792; it += gridDim.x * 2) {
    const TrItem A = tr_decode(p, it), B = tr_decode(p, it + 1);
    float va[16], vb[16];
    tr_load(A, tid, va);
    tr_load(B, tid, vb);
    {
      const int nn = tid & 63;
#pragma unroll
      for (int i = 0; i < 16; ++i) {
        const int kk = (tid >> 6) + 4 * i;
        tile[kk * 65 + nn] = va[i];
        tile1[kk * 65 + nn] = vb[i];
      }
    }
    __syncthreads();
    tr_emit(A, tile, tid);
    tr_emit(B, tile1, tid);
    __syncthreads();
  }
}

DI void phase_norm(const Params& p, int l, int g) {
  const int tid = opaque_tid(), lane = tid & 63, wid = tid >> 6;
  const int rows = (l == 4) ? ML : MR;
  const float* modb = (const float*)(p.ws + OFF_MOD);
  const bfr* ybuf = (const bfr*)(p.ws + OFF_PROJ);
  bfr* hbuf = (bfr*)(p.ws + OFF_H);
  float* xcb = (float*)(p.ws + OFF_XC);
  for (int row = blockIdx.x * 4 + wid; row < rows; row += gridDim.x * 4) {
    const bool lat = row < ML;
    const int mb = lat ? (g * GB + (row >> 12)) : 8;
    const size_t grow = lat ? ((size_t)g * ML + row) : ((size_t)g * MC + (row - ML));
    const float* xin;
    float* xst;
    if (lat) { xin = ((l <= 1) ? p.x : (const float*)p.out) + grow * 1024; xst = p.out + grow * 1024; }
    else     { xin = ((l <= 1) ? p.ctx : (const float*)xcb) + grow * 1024; xst = xcb + grow * 1024; }
    float4 xv[4];
#pragma unroll
    for (int i = 0; i < 4; ++i) xv[i] = *(const float4*)(xin + lane * 4 + 256 * i);
    if (l >= 1) {
      float4 yv[4];
      float ss = 0.f;
#pragma unroll
      for (int i = 0; i < 4; ++i) {
        const u32x2 yr = *(const u32x2*)(ybuf + (size_t)row * 1024 + lane * 4 + 256 * i);
        yv[i] = make_float4(lo_bf(yr.x), hi_bf(yr.x), lo_bf(yr.y), hi_bf(yr.y));
        ss += yv[i].x * yv[i].x + yv[i].y * yv[i].y + yv[i].z * yv[i].z + yv[i].w * yv[i].w;
      }
      ss = wave_sum(ss, lane);
      const float rn = rsqrtf(ss * (1.f / 1024.f) + 1e-6f);
      const float* gate = modb + (size_t)((l - 1) * 9 + mb) * 3072 + 2048;
      const float* gp = p.g_post + (l - 1) * 1024;
#pragma unroll
      for (int i = 0; i < 4; ++i) {
        const int c0 = lane * 4 + 256 * i;
        const float4 gt = *(const float4*)(gate + c0);
        const float4 gg = *(const float4*)(gp + c0);
        xv[i].x += gt.x * (yv[i].x * rn * gg.x);
        xv[i].y += gt.y * (yv[i].y * rn * gg.y);
        xv[i].z += gt.z * (yv[i].z * rn * gg.z);
        xv[i].w += gt.w * (yv[i].w * rn * gg.w);
        *(float4*)(xst + c0) = xv[i];
      }
    }
    if (l < 4) {
      float ss = 0.f;
#pragma unroll
      for (int i = 0; i < 4; ++i) ss += xv[i].x * xv[i].x + xv[i].y * xv[i].y + xv[i].z * xv[i].z + xv[i].w * xv[i].w;
      ss = wave_sum(ss, lane);
      const float rn = rsqrtf(ss * (1.f / 1024.f) + 1e-6f);
      const float* mrow = modb + (size_t)(l * 9 + mb) * 3072;
      const float* gpre = p.g_pre + l * 1024;
#pragma unroll
      for (int i = 0; i < 4; ++i) {
        const int c0 = lane * 4 + 256 * i;
        const float4 sh = *(const float4*)(mrow + c0);
        const float4 scl = *(const float4*)(mrow + 1024 + c0);
        const float4 gg = *(const float4*)(gpre + c0);
        u32x2 o;
        o.x = pack2(xv[i].x * rn * gg.x * (1.f + scl.x) + sh.x, xv[i].y * rn * gg.y * (1.f + scl.y) + sh.y);
        o.y = pack2(xv[i].z * rn * gg.z * (1.f + scl.z) + sh.z, xv[i].w * rn * gg.w * (1.f + scl.w) + sh.w);
        *(u32x2*)(hbuf + (size_t)row * 1024 + c0) = o;
      }
    }
  }
}

DI void gla_gate_precompute(const Params& p, int l, int m0, const char* sLr, float* sHs) {
  const int tid = opaque_tid();
  const int d = tid & 127, half = tid >> 7;
  const int jl = l >> 1;
#pragma unroll 1
  for (int unit = 0; unit < 16; ++unit) {
    const int cc = unit & 1, dir = (unit >> 1) & 1, head = unit >> 2;
    unsigned gu[8];
#pragma unroll
    for (int k = 0; k < 8; ++k)
      gu[k] = pack2(p.od_gate_up[(((size_t)jl * 2 + dir) * 16 + 2 * k) * 512 + head * 128 + d],
                    p.od_gate_up[(((size_t)jl * 2 + dir) * 16 + 2 * k + 1) * 512 + head * 128 + d]);
    const float gbias = p.od_gate_bias[((size_t)jl * 2 + dir) * 512 + head * 128 + d];
    float gl[32];
    float tot = 0.f;
#pragma unroll
    for (int i = 0; i < 32; ++i) {
      const int tk = cc * 64 + half * 32 + i;
      const u32x4 la = *(const u32x4*)(sLr + tk * 64 + dir * 32);
      const u32x4 lb = *(const u32x4*)(sLr + tk * 64 + dir * 32 + 16);
      float z = gbias;
      z = dot2bf(la.x, gu[0], z); z = dot2bf(la.y, gu[1], z); z = dot2bf(la.z, gu[2], z); z = dot2bf(la.w, gu[3], z);
      z = dot2bf(lb.x, gu[4], z); z = dot2bf(lb.y, gu[5], z); z = dot2bf(lb.z, gu[6], z); z = dot2bf(lb.w, gu[7], z);
      const float tneg = fexp2(-fabsf(z) * L2E);
      const float g = (fminf(z, 0.f) - flog2(1.f + tneg) * LN2) * (L2E / 16.f);
      gl[i] = g;
      tot += g;
    }
    if (dir == 0) {
      float run = 0.f;
#pragma unroll
      for (int i = 0; i < 32; ++i) { run += gl[i]; gl[i] = run; }
    } else {
      float run = 0.f;
#pragma unroll
      for (int i = 31; i >= 0; --i) { run += gl[i]; gl[i] = run; }
    }
    __syncthreads();
    sHs[half * 128 + d] = tot;
    __syncthreads();
    const float other = sHs[(1 - half) * 128 + d];
    const float offs = (dir == 0) ? (half ? other : 0.f) : (half ? 0.f : other);
    const int chunk = (m0 >> 6) + cc;
    char* et = p.ws + (dir ? OFF_ETB : OFF_ETF) + ((size_t)chunk * 4 + head) * 16384;
#pragma unroll
    for (int i8 = 0; i8 < 4; ++i8) {
      u32x4 v;
      v.x = pack2(fexp2(gl[i8 * 8 + 0] + offs), fexp2(gl[i8 * 8 + 1] + offs));
      v.y = pack2(fexp2(gl[i8 * 8 + 2] + offs), fexp2(gl[i8 * 8 + 3] + offs));
      v.z = pack2(fexp2(gl[i8 * 8 + 4] + offs), fexp2(gl[i8 * 8 + 5] + offs));
      v.w = pack2(fexp2(gl[i8 * 8 + 6] + offs), fexp2(gl[i8 * 8 + 7] + offs));
      *(u32x4*)(et + sw128(d, half * 4 + i8)) = v;
    }
    if (half == 0)
      ((float*)(p.ws + OFF_DEC))[(((size_t)dir * (MR / 64) + chunk) * 4 + head) * 128 + d] = fexp2(tot + other);
  }
}

struct TileQ {
  unsigned* base;
  int* slot;
  int x, dq, pend;
  bool has_pend;
};
DI int tileq_fetch(TileQ& tq) {
  __syncthreads();
  if (threadIdx.x == 0) {
    int j = tq.has_pend ? tq.pend : (int)__hip_atomic_fetch_add(tq.base + tq.x * 16, 1u, __ATOMIC_RELAXED, __HIP_MEMORY_SCOPE_AGENT);
    *tq.slot = j;
  }
  tq.has_pend = false;
  __syncthreads();
  return *tq.slot;
}
DI void tileq_prefetch(TileQ& tq) {
  if (threadIdx.x == 0) {
    tq.pend = (int)__hip_atomic_fetch_add(tq.base + tq.x * 16, 1u, __ATOMIC_RELAXED, __HIP_MEMORY_SCOPE_AGENT);
  }
  tq.has_pend = true;
}

DI bool tileq_next(TileQ& tq, int pm_n, int NP, int NT, int xcc0, int& mt, int& nt) {
  for (;;) {
    if (tq.dq >= 8) return false;
    const int j = tileq_fetch(tq);
    const int P = (j >> 6) * 8 + tq.x;
    if (P >= NP) { ++tq.dq; tq.x = (xcc0 + tq.dq) & 7; tq.has_pend = false; continue; }
    const int li = j & 63;
    mt = (P % pm_n) * 8 + (li & 7);
    nt = (P / pm_n) * 8 + (li >> 3);
    if (nt >= NT) continue;
    tileq_prefetch(tq);
    return true;
  }
}

DI void phase_gemm_in(const Params& p, int l, char* smem, int inst) {
  const int tid = opaque_tid(), lane = tid & 63, wid = tid >> 6, r = lane & 15, q = lane >> 4;
  const int wx = wid >> 1, wy = wid & 1;
  const bool even = !(l & 1);
  const int ldp = even ? NEV : NOD;
  const int NT = even ? 64 : 56, MT = MR >> 7;
  const bfr* WT = (const bfr*)(p.ws + win_off(l));
  const bfr* H = (const bfr*)(p.ws + OFF_H);
  bfr* proj = (bfr*)(p.ws + OFF_PROJ);
  bfr* VT = (bfr*)(p.ws + OFF_VT);
  const float2* cs = (const float2*)(p.ws + OFF_CS);
  const int pm_n = MT >> 3, NP = pm_n * ((NT + 7) >> 3);
  TileQ tq;
  tq.base = (unsigned*)(p.ws + OFF_BAR) + 34 * 64 + inst * 128;
  tq.slot = (int*)(smem + SMEM_BYTES - 16);
  tq.has_pend = false; tq.pend = 0;
  const int xcc0 = (int)(__builtin_amdgcn_s_getreg((3 << 11) | 20) & 7u);
  if (!even) {
    TileQ lq;
    lq.base = (unsigned*)(p.ws + OFF_BAR) + 34 * 64 + (16 + inst) * 128;
    lq.slot = tq.slot; lq.has_pend = false; lq.pend = 0; lq.x = 0; lq.dq = 0;
    for (;;) {
      const int j = tileq_fetch(lq);
      if (j >= MT) break;
      const int m0 = j * 128, n0 = 7168;
      GemmStage g2;
      gemm_prologue(WT + (size_t)n0 * 1024, 1024, H + (size_t)m0 * 1024, 1024, g2);
      f32x4 acc[4][4];
#pragma unroll
      for (int i = 0; i < 4; ++i)
#pragma unroll
        for (int jj = 0; jj < 4; ++jj) acc[i][jj] = (f32x4){0.f, 0.f, 0.f, 0.f};
      gemm_mainloop(WT + (size_t)n0 * 1024, 1024, H + (size_t)m0 * 1024, 1024, 1024, WT, H, false, smem, acc, g2);
#pragma unroll
      for (int jn = 0; jn < 4; ++jn) {
        const int m = m0 + wy * 64 + jn * 16 + r;
#pragma unroll
        for (int i = 0; i < 4; ++i) {
          const int n = n0 + wx * 64 + i * 16 + 4 * q;
          u32x2 o;
          o.x = pack2(acc[i][jn][0], acc[i][jn][1]);
          o.y = pack2(acc[i][jn][2], acc[i][jn][3]);
          *(u32x2*)(proj + (size_t)m * ldp + n) = o;
        }
      }
      char* sLr = smem;
      float* sHs = (float*)(smem + 8192);
      if (wx == 0) {
#pragma unroll
        for (int jn = 0; jn < 4; ++jn)
#pragma unroll
          for (int i = 0; i < 2; ++i) {
            u32x2 o;
            o.x = pack2(acc[i][jn][0], acc[i][jn][1]);
            o.y = pack2(acc[i][jn][2], acc[i][jn][3]);
            *(u32x2*)(sLr + (wy * 64 + jn * 16 + r) * 64 + (i * 16 + 4 * q) * 2) = o;
          }
      }
      __syncthreads();
      gla_gate_precompute(p, l, m0, sLr, sHs);
      __syncthreads();
    }
  }
  tq.dq = 0; tq.x = xcc0;
  GemmStage gst;
  int mt = 0, nt = 0;
  bool have = tileq_next(tq, pm_n, NP, NT, xcc0, mt, nt);
  bool loaded = false;
  {
   while (have) {
    const int m0 = mt * 128, n0 = nt * 128;
    const bool vt = (n0 >= 1024 && n0 < 2048);
    const bfr* X = vt ? (H + (size_t)m0 * 1024) : (WT + (size_t)n0 * 1024);
    const bfr* Y = vt ? (WT + (size_t)n0 * 1024) : (H + (size_t)m0 * 1024);
    if (!loaded) gemm_prologue(X, 1024, Y, 1024, gst);
    int mtn = 0, ntn = 0;
    const bool haven = tileq_next(tq, pm_n, NP, NT, xcc0, mtn, ntn);
    const bool stream = haven;
    const int m0n = mtn * 128, n0n = ntn * 128;
    const bool vtn = (n0n >= 1024 && n0n < 2048);
    const bfr* Xn = vtn ? (H + (size_t)m0n * 1024) : (WT + (size_t)n0n * 1024);
    const bfr* Yn = vtn ? (WT + (size_t)n0n * 1024) : (H + (size_t)m0n * 1024);
    f32x4 acc[4][4];
#pragma unroll
    for (int i = 0; i < 4; ++i)
#pragma unroll
      for (int j = 0; j < 4; ++j) acc[i][j] = (f32x4){0.f, 0.f, 0.f, 0.f};
    gemm_mainloop(X, 1024, Y, 1024, 1024, Xn, Yn, stream, smem, acc, gst);
    loaded = stream;
    if (vt) {
#pragma unroll
      for (int i = 0; i < 4; i += 2) {
        const int mbase = m0 + wx * 64 + i * 16;
        int b, kp;
        if (mbase < ML) { b = mbase >> 12; kp = mbase & 4095; } else { const int mm = mbase - ML; b = mm >> 8; kp = 4096 + (mm & 255); }
        const int pos = (kp & ~31) + q * 8;
#pragma unroll
        for (int jn = 0; jn < 4; ++jn) {
          const int f = n0 - 1024 + wy * 64 + jn * 16 + r;
          u32x4 o;
          o.x = pack2(acc[i][jn][0], acc[i][jn][1]);
          o.y = pack2(acc[i][jn][2], acc[i][jn][3]);
          o.z = pack2(acc[i + 1][jn][0], acc[i + 1][jn][1]);
          o.w = pack2(acc[i + 1][jn][2], acc[i + 1][jn][3]);
          *(u32x4*)(VT + ((size_t)(b * 1024 + f)) * KEYS + pos) = o;
        }
      }
    } else {
      const bool rope = even && (n0 < 1024 || (n0 >= 2048 && n0 < 3072)) && (m0 < ML);
      if (rope) {
#pragma unroll
        for (int jn = 0; jn < 4; ++jn) {
          asm volatile("" ::: "memory");
          const int m = m0 + wy * 64 + jn * 16 + r;
          const int t = m & 4095;
          const int grow = t >> 6, gcol = t & 63;
#pragma unroll
          for (int j = 0; j < 4; ++j) {
            const float2 a = cs[grow * 16 + 4 * q + j];
            const float2 c = cs[gcol * 16 + 4 * q + j];
            const float x0 = acc[0][jn][j], x1 = acc[1][jn][j], x2 = acc[2][jn][j], x3 = acc[3][jn][j];
            acc[0][jn][j] = x0 * a.x - x1 * a.y;
            acc[1][jn][j] = x1 * a.x + x0 * a.y;
            acc[2][jn][j] = x2 * c.x - x3 * c.y;
            acc[3][jn][j] = x3 * c.x + x2 * c.y;
          }
        }
      }
#pragma unroll
      for (int jn = 0; jn < 4; ++jn) {
        const int m = m0 + wy * 64 + jn * 16 + r;
        bfr* rp = proj + (size_t)m * ldp + n0 + wx * 64;
        store_pair16(rp, acc[0][jn], acc[1][jn], q);
        store_pair16(rp + 32, acc[2][jn], acc[3][jn], q);
      }
    }
    mt = mtn; nt = ntn; have = haven;
  }
 }
}

DI void phase_gemm_out(const Params& p, int l, char* smem, int inst) {
  const int tid = opaque_tid(), lane = tid & 63, wid = tid >> 6, r = lane & 15, q = lane >> 4;
  const int wx = wid >> 1, wy = wid & 1;
  const bfr* WT = (const bfr*)(p.ws + OFF_WOUT + (size_t)l * SZ_WOUT);
  const bfr* U = (const bfr*)(p.ws + OFF_U);
  bfr* ybuf = (bfr*)(p.ws + OFF_PROJ);
  const int MT = (l == 3) ? (ML >> 7) : (MR >> 7);
  const int pm_n = MT >> 3, NP = pm_n;
  TileQ tq;
  tq.base = (unsigned*)(p.ws + OFF_BAR) + 34 * 64 + inst * 128;
  tq.slot = (int*)(smem + SMEM_BYTES - 16);
  tq.has_pend = false; tq.pend = 0;
  const int xcc0 = (int)(__builtin_amdgcn_s_getreg((3 << 11) | 20) & 7u);
  tq.dq = 0; tq.x = xcc0;
  GemmStage gst;
  int mt = 0, nt = 0;
  bool have = tileq_next(tq, pm_n, NP, 8, xcc0, mt, nt);
  bool loaded = false;
  while (have) {
    const int m0 = mt * 128, n0 = nt * 128;
    const bfr* X = WT + (size_t)n0 * 2048;
    const bfr* Y = U + (size_t)m0 * 2048;
    if (!loaded) gemm_prologue(X, 2048, Y, 2048, gst);
    int mtn = 0, ntn = 0;
    const bool haven = tileq_next(tq, pm_n, NP, 8, xcc0, mtn, ntn);
    const bfr* Xn = WT + (size_t)(ntn * 128) * 2048;
    const bfr* Yn = U + (size_t)(mtn * 128) * 2048;
    f32x4 acc[4][4];
#pragma unroll
    for (int i = 0; i < 4; ++i)
#pragma unroll
      for (int j = 0; j < 4; ++j) acc[i][j] = (f32x4){0.f, 0.f, 0.f, 0.f};
    gemm_mainloop(X, 2048, Y, 2048, 2048, Xn, Yn, haven, smem, acc, gst);
    loaded = haven;
#pragma unroll
    for (int jn = 0; jn < 4; ++jn) {
      const int m = m0 + wy * 64 + jn * 16 + r;
      bfr* rp = ybuf + (size_t)m * 1024 + n0 + wx * 64;
      store_pair16(rp, acc[0][jn], acc[1][jn], q);
      store_pair16(rp + 32, acc[2][jn], acc[3][jn], q);
    }
    mt = mtn; nt = ntn; have = haven;
  }
}

template <int DV, int QT, int KT, int MODE>
DI void attn_engine(const bfr* __restrict__ qbase, int ldq, const bfr* __restrict__ kbase, int ldk,
                    const bfr* __restrict__ vt, int nloc, int loc_row0, int loc_pos0, int nctx, int ctx_row0,
                    const float* rpb_s, int roff0, char* smem, f32x4 (&O)[DV / 16][QT], float (&lsum)[QT]) {
  constexpr int STAGE = 8192 + DV * 128;
  constexpr int NVL = DV / 32;
  const int tid = opaque_tid(), lane = tid & 63, wid = tid >> 6, r = lane & 15, q = lane >> 4;
  const int lr = tid >> 3, lc = tid & 7;
  constexpr float SC = 0.125f * L2E;

  bf16x8 Qf[QT][2];
#pragma unroll
  for (int qt = 0; qt < QT; ++qt)
#pragma unroll
    for (int s = 0; s < 2; ++s)
      Qf[qt][s] = *(const bf16x8*)(qbase + (size_t)(wid * 16 * QT + qt * 16 + r) * ldq + s * 32 + q * 8);
  float mrun[QT];
#pragma unroll
  for (int qt = 0; qt < QT; ++qt) {
    mrun[qt] = -1e30f;
    lsum[qt] = 0.f;
#pragma unroll
    for (int dt = 0; dt < DV / 16; ++dt) O[dt][qt] = (f32x4){0.f, 0.f, 0.f, 0.f};
  }

  const int nch = nloc + nctx;
  u32x4 kreg0, kreg1, vreg[NVL];
  const int ksw0 = sw128(lr, lc), ksw1 = sw128(lr + 32, lc);
#define AT_LOAD(c_)                                                                                          \
  {                                                                                                          \
    const int cc_ = (c_);                                                                                    \
    const int row_ = (cc_ < nloc) ? (loc_row0 + cc_ * 64) : (ctx_row0 + (cc_ - nloc) * 64);                  \
    const int pos_ = (cc_ < nloc) ? (loc_pos0 + cc_ * 64) : (4096 + (cc_ - nloc) * 64);                      \
    kreg0 = *(const u32x4*)(kbase + (size_t)(row_ + lr) * ldk + lc * 8);                                     \
    kreg1 = *(const u32x4*)(kbase + (size_t)(row_ + lr + 32) * ldk + lc * 8);                                \
    _Pragma("unroll") for (int i_ = 0; i_ < NVL; ++i_)                                                       \
        vreg[i_] = *(const u32x4*)(vt + (size_t)(lr + 32 * i_) * KEYS + pos_ + lc * 8);                      \
  }
#define AT_STORE(c_)                                                                                         \
  {                                                                                                          \
    char* sb_ = smem + ((c_) & 1) * STAGE;                                                                   \
    *(u32x4*)(sb_ + ksw0) = kreg0;                                                                           \
    *(u32x4*)(sb_ + ksw1) = kreg1;                                                                           \
    _Pragma("unroll") for (int i_ = 0; i_ < NVL; ++i_)                                                       \
        *(u32x4*)(sb_ + 8192 + sw128(lr + 32 * i_, lc)) = vreg[i_];                                          \
  }
  if (nch > 0) { AT_LOAD(0); AT_STORE(0); }
  for (int c = 0; c < nch; ++c) {
    __syncthreads();
    const bool more = (c + 1 < nch);
    const char* sK = smem + (c & 1) * STAGE;
    const char* sV = sK + 8192;
    if (more) AT_LOAD(c + 1);
    f32x4 stall[4 / KT][KT][QT];
#pragma unroll
    for (int sbk = 0; sbk < 4 / KT; ++sbk) {
#pragma unroll
      for (int kt = 0; kt < KT; ++kt)
#pragma unroll
        for (int qt = 0; qt < QT; ++qt) stall[sbk][kt][qt] = (f32x4){0.f, 0.f, 0.f, 0.f};
#pragma unroll
      for (int s = 0; s < 2; ++s)
#pragma unroll
        for (int kt = 0; kt < KT; ++kt) {
          const bf16x8 ka = *(const bf16x8*)(sK + sw128(sbk * KT * 16 + kt * 16 + r, s * 4 + q));
#pragma unroll
          for (int qt = 0; qt < QT; ++qt) stall[sbk][kt][qt] = mfma16(ka, Qf[qt][s], stall[sbk][kt][qt]);
        }
    }
#pragma unroll
    for (int sbk = 0; sbk < 4 / KT; ++sbk) {
      f32x4 (&st)[KT][QT] = stall[sbk];
      bf16x8 pb[KT / 2][QT];
      if (MODE == 1) {
#pragma unroll
        for (int kt = 0; kt < KT; ++kt)
#pragma unroll
          for (int qt = 0; qt < QT; ++qt)
#pragma unroll
            for (int j = 0; j < 4; ++j) {
              float v = st[kt][qt][j] * SC;
              if (c < nloc) {
                const int kc = sbk * KT * 16 + kt * 16 + 4 * q + j;
                const int qc = wid * 16 + r;
                int wst = qc - 8; wst = wst < 0 ? 0 : (wst > 48 ? 48 : wst);
                const bool valid = (kc >= wst) && (kc < wst + 16);
                int co = kc - qc + 15; co = co < 0 ? 0 : (co > 30 ? 30 : co);
                const float bias = rpb_s[(roff0 + c) * 31 + co] * L2E;
                v = valid ? (v + bias) : -INFINITY;
              }
              st[kt][qt][j] = v;
            }
      }
#pragma unroll
      for (int qt = 0; qt < QT; ++qt) {
        float mx = max3f(st[0][qt][0], st[0][qt][1], st[0][qt][2]);
        mx = max3f(mx, st[0][qt][3], st[1][qt][0]);
        mx = max3f(mx, st[1][qt][1], st[1][qt][2]);
#pragma unroll
        for (int kt = 2; kt < KT; ++kt) {
          mx = max3f(mx, st[kt - 1][qt][3], st[kt][qt][0]);
          mx = max3f(mx, st[kt][qt][1], st[kt][qt][2]);
        }
        mx = max3f(mx, st[KT - 1][qt][3], st[KT - 1][qt][3]);
        if (MODE != 1) mx *= SC;
        if (__any(mx > mrun[qt] + 8.f)) {
          mx = fmaxf(mx, shx<16>(mx, lane));
          mx = fmaxf(mx, shx<32>(mx, lane));
          const float mnew2 = fmaxf(mrun[qt], mx);
          const float alpha = fexp2(mrun[qt] - mnew2);
          mrun[qt] = mnew2;
          lsum[qt] *= alpha;
#pragma unroll
          for (int dt = 0; dt < DV / 16; ++dt) {
            O[dt][qt][0] *= alpha; O[dt][qt][1] *= alpha; O[dt][qt][2] *= alpha; O[dt][qt][3] *= alpha;
          }
        }
        const float mnew = mrun[qt];
        f32x2_t ps2 = {0.f, 0.f};
#pragma unroll
        for (int kt = 0; kt < KT; ++kt) {
          float e0, e1, e2, e3;
          if (MODE == 1) {
            e0 = fexp2(st[kt][qt][0] - mnew); e1 = fexp2(st[kt][qt][1] - mnew);
            e2 = fexp2(st[kt][qt][2] - mnew); e3 = fexp2(st[kt][qt][3] - mnew);
          } else {
            e0 = fexp2(__builtin_fmaf(st[kt][qt][0], SC, -mnew)); e1 = fexp2(__builtin_fmaf(st[kt][qt][1], SC, -mnew));
            e2 = fexp2(__builtin_fmaf(st[kt][qt][2], SC, -mnew)); e3 = fexp2(__builtin_fmaf(st[kt][qt][3], SC, -mnew));
          }
          st[kt][qt][0] = e0; st[kt][qt][1] = e1; st[kt][qt][2] = e2; st[kt][qt][3] = e3;
          const f32x2_t a01 = {e0, e1}, a23 = {e2, e3};
          ps2 = ps2 + a01;
          ps2 = ps2 + a23;
        }
        lsum[qt] += ps2.x + ps2.y;
#pragma unroll
        for (int ks = 0; ks < KT / 2; ++ks) {
          u32x4 pk;
          pk.x = pack2(st[2 * ks][qt][0], st[2 * ks][qt][1]);
          pk.y = pack2(st[2 * ks][qt][2], st[2 * ks][qt][3]);
          pk.z = pack2(st[2 * ks + 1][qt][0], st[2 * ks + 1][qt][1]);
          pk.w = pack2(st[2 * ks + 1][qt][2], st[2 * ks + 1][qt][3]);
          pb[ks][qt] = __builtin_bit_cast(bf16x8, pk);
        }
      }
#pragma unroll
      for (int dt = 0; dt < DV / 16; ++dt)
#pragma unroll
        for (int ks = 0; ks < KT / 2; ++ks) {
          const bf16x8 va = *(const bf16x8*)(sV + sw128(dt * 16 + r, (sbk * (KT / 2) + ks) * 4 + q));
#pragma unroll
          for (int qt = 0; qt < QT; ++qt) O[dt][qt] = mfma16(va, pb[ks][qt], O[dt][qt]);
        }
    }
    if (more) AT_STORE(c + 1);
  }
#undef AT_LOAD
#undef AT_STORE
  __syncthreads();
#pragma unroll
  for (int qt = 0; qt < QT; ++qt) {
    float L = lsum[qt];
    L += shx<16>(L, lane);
    L += shx<32>(L, lane);
    lsum[qt] = L;
  }
}

DI void diff_attn_item(const Params& p, int l, int b, int head, int qrow0, bool ctxq, char* smem) {
  const int tid = opaque_tid(), lane = tid & 63, wid = tid >> 6, r = lane & 15, q = lane >> 4;
  const bfr* proj = (const bfr*)(p.ws + OFF_PROJ);
  const bfr* VT = (const bfr*)(p.ws + OFF_VT);
  bfr* U = (bfr*)(p.ws + OFF_U);
  const float* lamv = (const float*)(p.ws + OFF_LAM);
  const float lam = lamv[l >> 1], lam_init = lamv[2 + (l >> 1)];
  f32x4 O[8][2];
  float ls[2];
  char* parkb = smem + 49152 + tid * 16;
  attn_engine<128, 2, 2, 0>(proj + (size_t)qrow0 * NEV + 2048 + head * 128, NEV, proj + head * 128, NEV,
                            VT + (size_t)(b * 1024 + head * 128) * KEYS, ctxq ? 0 : 64, b * 4096, 0, 4,
                            ML + b * 256, nullptr, 0, smem, O, ls);
  u32x4 pkr0, pkr1;
  {
    const float i0 = 1.f / ls[0], i1 = 1.f / ls[1];
#pragma unroll
    for (int dt = 0; dt < 8; dt += 2) {
      u32x4 v0, v1;
      v0.x = pack2(O[dt][0][0] * i0, O[dt][0][1] * i0);
      v0.y = pack2(O[dt][0][2] * i0, O[dt][0][3] * i0);
      v0.z = pack2(O[dt + 1][0][0] * i0, O[dt + 1][0][1] * i0);
      v0.w = pack2(O[dt + 1][0][2] * i0, O[dt + 1][0][3] * i0);
      v1.x = pack2(O[dt][1][0] * i1, O[dt][1][1] * i1);
      v1.y = pack2(O[dt][1][2] * i1, O[dt][1][3] * i1);
      v1.z = pack2(O[dt + 1][1][0] * i1, O[dt + 1][1][1] * i1);
      v1.w = pack2(O[dt + 1][1][2] * i1, O[dt + 1][1][3] * i1);
      if (dt < 6) {
        *(u32x4*)(parkb + (dt / 2) * 4096) = v0;
        *(u32x4*)(parkb + (3 + dt / 2) * 4096) = v1;
      } else { pkr0 = v0; pkr1 = v1; }
    }
  }
  attn_engine<128, 2, 2, 0>(proj + (size_t)qrow0 * NEV + 2048 + head * 128 + 64, NEV, proj + head * 128 + 64, NEV,
                            VT + (size_t)(b * 1024 + head * 128) * KEYS, ctxq ? 0 : 64, b * 4096, 0, 4,
                            ML + b * 256, nullptr, 0, smem, O, ls);
  const float* subln = p.ev_subln + (l >> 1) * 128;
#pragma unroll
  for (int qt = 0; qt < 2; ++qt) {
    const float i1 = lam / ls[qt];
    float ss = 0.f;
#pragma unroll
    for (int dt = 0; dt < 8; ++dt) {
      unsigned pa, pc;
      if (dt < 6) {
        const u32x2 pk2 = *(const u32x2*)(parkb + (qt * 3 + dt / 2) * 4096 + (dt & 1) * 8);
        pa = pk2.x; pc = pk2.y;
      } else {
        const u32x4 pr = qt ? pkr1 : pkr0;
        pa = (dt & 1) ? pr.z : pr.x; pc = (dt & 1) ? pr.w : pr.y;
      }
      const float o0 = lo_bf(pa) - O[dt][qt][0] * i1;
      const float o1 = hi_bf(pa) - O[dt][qt][1] * i1;
      const float o2 = lo_bf(pc) - O[dt][qt][2] * i1;
      const float o3 = hi_bf(pc) - O[dt][qt][3] * i1;
      O[dt][qt][0] = o0; O[dt][qt][1] = o1; O[dt][qt][2] = o2; O[dt][qt][3] = o3;
      ss += o0 * o0 + o1 * o1 + o2 * o2 + o3 * o3;
    }
    ss += shx<16>(ss, lane);
    ss += shx<32>(ss, lane);
    const float rn = rsqrtf(ss * (1.f / 128.f) + 1e-6f) * (1.f - lam_init);
    const int row = qrow0 + wid * 32 + qt * 16 + r;
#pragma unroll
    for (int dt = 0; dt < 8; ++dt) {
      const int dv = dt * 16 + 4 * q;
      const u32x2 ag = *(const u32x2*)(proj + (size_t)row * NEV + 3072 + head * 128 + dv);
      const float4 sl = *(const float4*)(subln + dv);
      u32x2 o;
      o.x = pack2(O[dt][qt][0] * rn * sl.x * silu(lo_bf(ag.x)), O[dt][qt][1] * rn * sl.y * silu(hi_bf(ag.x)));
      o.y = pack2(O[dt][qt][2] * rn * sl.z * silu(lo_bf(ag.y)), O[dt][qt][3] * rn * sl.w * silu(hi_bf(ag.y)));
      *(u32x2*)(U + (size_t)row * 2048 + head * 128 + dv) = o;
    }
  }
}

DI void na_item(const Params& p, int l, int b, int head, int rho, bool ctxq, int cq0, char* smem) {
  const int tid = opaque_tid(), lane = tid & 63, wid = tid >> 6, r = lane & 15, q = lane >> 4;
  const bfr* proj = (const bfr*)(p.ws + OFF_PROJ);
  const bfr* VT = (const bfr*)(p.ws + OFF_VT);
  bfr* U = (bfr*)(p.ws + OFF_U);
  float* rpb_s = (float*)(smem + 2 * (8192 + 64 * 128));
  int rs = rho - 4; rs = rs < 0 ? 0 : (rs > 56 ? 56 : rs);
  const int qrow0 = ctxq ? (ML + b * 256 + cq0) : (b * 4096 + rho * 64);
  f32x4 O[4][1];
  float ls[1];
  if (!ctxq) {
    const float* rp = p.od_rpb + ((size_t)(l >> 1) * 16 + head) * 465;
    for (int i = tid; i < 465; i += 256) rpb_s[i] = rp[i];
    attn_engine<64, 1, 4, 1>(proj + (size_t)qrow0 * NOD + 3584 + head * 64, NOD, proj + head * 64, NOD,
                                VT + (size_t)(b * 1024 + head * 64) * KEYS, 8, b * 4096 + rs * 64, rs * 64, 4,
                                ML + b * 256, rpb_s, rs - rho + 7, smem, O, ls);
  } else {
    attn_engine<64, 1, 4, 0>(proj + (size_t)qrow0 * NOD + 3584 + head * 64, NOD, proj + head * 64, NOD,
                                VT + (size_t)(b * 1024 + head * 64) * KEYS, 0, 0, 0, 4, ML + b * 256, nullptr, 0,
                                smem, O, ls);
  }
  const float inv = 1.f / ls[0];
  const int row = qrow0 + wid * 16 + r;
#pragma unroll
  for (int dt = 0; dt < 4; ++dt) {
    const int dv = dt * 16 + 4 * q;
    const u32x2 cgv = *(const u32x2*)(proj + (size_t)row * NOD + 5120 + head * 64 + dv);
    u32x2 o;
    o.x = pack2(O[dt][0][0] * inv * silu(lo_bf(cgv.x)), O[dt][0][1] * inv * silu(hi_bf(cgv.x)));
    o.y = pack2(O[dt][0][2] * inv * silu(lo_bf(cgv.y)), O[dt][0][3] * inv * silu(hi_bf(cgv.y)));
    *(u32x2*)(U + (size_t)row * 2048 + head * 64 + dv) = o;
  }
}

DI void conv_item(const Params& p, int l, int item) {
  const int tid = opaque_tid();
  const bfr* proj = (const bfr*)(p.ws + OFF_PROJ);
  bfr* U = (bfr*)(p.ws + OFF_U);
  const float* cw = p.ev_conv + (size_t)(l >> 1) * 3 * 1024;
#pragma unroll 1
  for (int i = 0; i < 8; ++i) {
    const int v = tid + 256 * i;
    const int ri = v >> 7, ch = (v & 127) * 8;
    const int m = item * 16 + ri;
    int t, T;
    if (m < ML) { t = m & 4095; T = 4096; } else { t = (m - ML) & 255; T = 256; }
    const bfr* pr = proj + (size_t)m * NEV;
    float acc[8];
#pragma unroll
    for (int e = 0; e < 8; ++e) acc[e] = 0.f;
#pragma unroll
    for (int w = 0; w < 3; ++w) {
      const int tt = t + w - 1;
      if (tt >= 0 && tt < T) {
        const bfr* prw = pr + (ptrdiff_t)(w - 1) * NEV;
        const u32x4 bh = *(const u32x4*)(prw + 4096 + ch);
        const u32x4 bc = *(const u32x4*)(prw + 6144 + ch);
        const float4 w0 = *(const float4*)(cw + w * 1024 + ch);
        const float4 w1 = *(const float4*)(cw + w * 1024 + ch + 4);
        acc[0] += w0.x * lo_bf(bh.x) * lo_bf(bc.x); acc[1] += w0.y * hi_bf(bh.x) * hi_bf(bc.x);
        acc[2] += w0.z * lo_bf(bh.y) * lo_bf(bc.y); acc[3] += w0.w * hi_bf(bh.y) * hi_bf(bc.y);
        acc[4] += w1.x * lo_bf(bh.z) * lo_bf(bc.z); acc[5] += w1.y * hi_bf(bh.z) * hi_bf(bc.z);
        acc[6] += w1.z * lo_bf(bh.w) * lo_bf(bc.w); acc[7] += w1.w * hi_bf(bh.w) * hi_bf(bc.w);
      }
    }
    const u32x4 bb = *(const u32x4*)(pr + 5120 + ch);
    const u32x4 bg = *(const u32x4*)(pr + 7168 + ch);
    u32x4 o;
    o.x = pack2(lo_bf(bb.x) * acc[0] * silu(lo_bf(bg.x)), hi_bf(bb.x) * acc[1] * silu(hi_bf(bg.x)));
    o.y = pack2(lo_bf(bb.y) * acc[2] * silu(lo_bf(bg.y)), hi_bf(bb.y) * acc[3] * silu(hi_bf(bg.y)));
    o.z = pack2(lo_bf(bb.z) * acc[4] * silu(lo_bf(bg.z)), hi_bf(bb.z) * acc[5] * silu(hi_bf(bg.z)));
    o.w = pack2(lo_bf(bb.w) * acc[6] * silu(lo_bf(bg.w)), hi_bf(bb.w) * acc[7] * silu(hi_bf(bg.w)));
    *(u32x4*)(U + (size_t)m * 2048 + 1024 + ch) = o;
  }
}

DI void gla_item(const Params& p, int l, int item, char* smem) {
  const int tid0 = opaque_tid();
  const int slice = item & 7, dir = (item >> 3) & 1, head = (item >> 4) & 3, b = item >> 6;
  const bfr* proj = (const bfr*)(p.ws + OFF_PROJ);
  const char* etb = p.ws + (dir ? OFF_ETB : OFF_ETF) + (size_t)head * 16384;
  const float* decb = (const float*)(p.ws + OFF_DEC) + ((size_t)dir * (MR / 64) * 4 + head) * 128;
  char* sQb = smem;
  char* sKc = smem + 16384;
  char* sKbT = smem + 32768;
  char* sVt = smem + 49152;
  char* sAtt = smem + 53248;
  char* sST = smem + 61440;
  float* sDec = (float*)(smem + 77824);
  const float qscale = 0.08838834764831845f;

  f32x4 S[2][2];
#pragma unroll
  for (int a = 0; a < 2; ++a)
#pragma unroll
    for (int c2 = 0; c2 < 2; ++c2) S[a][c2] = (f32x4){0.f, 0.f, 0.f, 0.f};
  __syncthreads();
  for (int i = tid0; i < 512; i += 256) ((u32x4*)sST)[i] = (u32x4){0u, 0u, 0u, 0u};

  u32x4 pq0, pq1, pq2, pq3, pk0, pk1, pk2, pk3, pv, pe0, pe1, pe2, pe3, pdec;
#define GLA_ROW0(ci_) (((ci_) < 4) ? (ML + b * 256 + (dir ? (3 - (ci_)) : (ci_)) * 64) : (b * 4096 + (dir ? (67 - (ci_)) : ((ci_) - 4)) * 64))
#define GLA_LOAD(ci_)                                                                                         \
  {                                                                                                           \
    const int prow = tid >> 4, pch = tid & 15, vs = tid >> 2, vpart = tid & 3;                                \
    const int r0_ = GLA_ROW0(ci_);                                                                            \
    const bfr* pr_ = proj + (size_t)(r0_ + prow) * NOD + head * 128 + pch * 8;                                \
    pq0 = *(const u32x4*)(pr_ + 4608);                     pk0 = *(const u32x4*)(pr_ + 2048);                 \
    pq1 = *(const u32x4*)(pr_ + 4608 + (size_t)16 * NOD);  pk1 = *(const u32x4*)(pr_ + 2048 + (size_t)16 * NOD); \
    pq2 = *(const u32x4*)(pr_ + 4608 + (size_t)32 * NOD);  pk2 = *(const u32x4*)(pr_ + 2048 + (size_t)32 * NOD); \
    pq3 = *(const u32x4*)(pr_ + 4608 + (size_t)48 * NOD);  pk3 = *(const u32x4*)(pr_ + 2048 + (size_t)48 * NOD); \
    pv = *(const u32x4*)(proj + (size_t)(r0_ + vs) * NOD + 2560 + head * 256 + slice * 32 + vpart * 8);       \
    const char* et_ = etb + (size_t)(r0_ >> 6) * 65536 + tid * 16;                                            \
    pe0 = *(const u32x4*)(et_);         pe1 = *(const u32x4*)(et_ + 4096);                                    \
    pe2 = *(const u32x4*)(et_ + 8192);  pe3 = *(const u32x4*)(et_ + 12288);                                   \
    if (tid < 32) pdec = *(const u32x4*)(decb + (size_t)(r0_ >> 6) * 512 + tid * 4);                          \
  }
  { const int tid = tid0; GLA_LOAD(0); }
  for (int ci = 0; ci < 68; ++ci) {
    int tid = tid0; asm volatile("" : "+v"(tid));
    const int lane = tid & 63, wid = tid >> 6, r = lane & 15, q = lane >> 4;
    const int d = tid & 127, half = tid >> 7;
    const int prow = tid >> 4, pch = tid & 15, vs = tid >> 2, vpart = tid & 3;
    const int row0 = GLA_ROW0(ci);
    const char* stc = sST + (ci & 1) * 8192;
    char* stn = sST + ((ci + 1) & 1) * 8192;
    __syncthreads();
    {
      *(u32x4*)(sQb + sw256(prow, pch)) = pq0;       *(u32x4*)(sKc + sw256(prow, pch)) = pk0;
      *(u32x4*)(sQb + sw256(prow + 16, pch)) = pq1;  *(u32x4*)(sKc + sw256(prow + 16, pch)) = pk1;
      *(u32x4*)(sQb + sw256(prow + 32, pch)) = pq2;  *(u32x4*)(sKc + sw256(prow + 32, pch)) = pk2;
      *(u32x4*)(sQb + sw256(prow + 48, pch)) = pq3;  *(u32x4*)(sKc + sw256(prow + 48, pch)) = pk3;
      *(u32x4*)(sKbT + tid * 16) = pe0;              *(u32x4*)(sKbT + tid * 16 + 4096) = pe1;
      *(u32x4*)(sKbT + tid * 16 + 8192) = pe2;       *(u32x4*)(sKbT + tid * 16 + 12288) = pe3;
      if (tid < 32) *(u32x4*)((char*)sDec + tid * 16) = pdec;
      const unsigned vv[4] = {pv.x, pv.y, pv.z, pv.w};
#pragma unroll
      for (int j = 0; j < 4; ++j) {
        const int e0 = vpart * 8 + 2 * j;
        *(bfr*)(sVt + sw128(e0, vs >> 3) + (vs & 7) * 2) = (bfr)(vv[j] & 0xffffu);
        *(bfr*)(sVt + sw128(e0 + 1, vs >> 3) + (vs & 7) * 2) = (bfr)(vv[j] >> 16);
      }
    }
    __syncthreads();
    {
      const float dec = sDec[d];
#pragma unroll
      for (int i8 = 0; i8 < 4; ++i8) {
        const u32x4 ev = *(const u32x4*)(sKbT + sw128(d, half * 4 + i8));
        const unsigned ew[4] = {ev.x, ev.y, ev.z, ev.w};
        unsigned kb[4];
#pragma unroll
        for (int ii = 0; ii < 8; ++ii) {
          const int s = half * 32 + i8 * 8 + ii;
          const float E = (ii & 1) ? hi_bf(ew[ii >> 1]) : lo_bf(ew[ii >> 1]);
          const float Ei = __builtin_amdgcn_rcpf(E);
          bfr* qa_ = (bfr*)(sQb + sw256(s, d >> 3) + (d & 7) * 2);
          bfr* ka_ = (bfr*)(sKc + sw256(s, d >> 3) + (d & 7) * 2);
          const float qv = bf2f(*qa_) * qscale * E;
          const float kc = bf2f(*ka_) * Ei;
          *qa_ = f2bf(qv);
          *ka_ = f2bf(kc);
          const unsigned kbv = f2bf(kc * dec);
          if (ii & 1) kb[ii >> 1] |= kbv << 16; else kb[ii >> 1] = kbv;
        }
        *(u32x4*)(sKbT + sw128(d, half * 4 + i8)) = (u32x4){kb[0], kb[1], kb[2], kb[3]};
      }
    }
    __syncthreads();
    if (ci + 1 < 68) GLA_LOAD(ci + 1);
    {
      f32x4 at[4];
#pragma unroll
      for (int st = 0; st < 4; ++st) at[st] = (f32x4){0.f, 0.f, 0.f, 0.f};
#pragma unroll
      for (int ks = 0; ks < 4; ++ks) {
        const bf16x8 qa = *(const bf16x8*)(sQb + sw256(wid * 16 + r, ks * 4 + q));
#pragma unroll
        for (int st = 0; st < 4; ++st) {
          const bf16x8 kb2 = *(const bf16x8*)(sKc + sw256(st * 16 + r, ks * 4 + q));
          at[st] = mfma16(qa, kb2, at[st]);
        }
      }
#pragma unroll
      for (int st = 0; st < 4; ++st)
#pragma unroll
        for (int j = 0; j < 4; ++j) {
          const int t = wid * 16 + 4 * q + j, s = st * 16 + r;
          const bool keep = dir ? (s >= t) : (s <= t);
          *(bfr*)(sAtt + sw128(t, s >> 3) + (s & 7) * 2) = f2bf(keep ? at[st][j] : 0.f);
        }
    }
    {
#pragma unroll
      for (int dti = 0; dti < 2; ++dti) {
        const float dc = sDec[(2 * wid + dti) * 16 + r];
#pragma unroll
        for (int et = 0; et < 2; ++et) {
          S[et][dti][0] *= dc; S[et][dti][1] *= dc; S[et][dti][2] *= dc; S[et][dti][3] *= dc;
        }
      }
#pragma unroll
      for (int ks = 0; ks < 2; ++ks) {
        bf16x8 va[2], kb2[2];
#pragma unroll
        for (int et = 0; et < 2; ++et) va[et] = *(const bf16x8*)(sVt + sw128(et * 16 + r, ks * 4 + q));
#pragma unroll
        for (int dti = 0; dti < 2; ++dti) kb2[dti] = *(const bf16x8*)(sKbT + sw128((2 * wid + dti) * 16 + r, ks * 4 + q));
#pragma unroll
        for (int et = 0; et < 2; ++et)
#pragma unroll
          for (int dti = 0; dti < 2; ++dti) S[et][dti] = mfma16(va[et], kb2[dti], S[et][dti]);
      }
#pragma unroll
      for (int et = 0; et < 2; ++et)
#pragma unroll
        for (int dti = 0; dti < 2; ++dti)
#pragma unroll
          for (int j = 0; j < 4; ++j) {
            const int e = et * 16 + 4 * q + j, dd = (2 * wid + dti) * 16 + r;
            *(bfr*)(stn + sw256(e, dd >> 3) + (dd & 7) * 2) = f2bf(S[et][dti][j]);
          }
    }
    __syncthreads();
    {
      f32x4 o[2];
      o[0] = (f32x4){0.f, 0.f, 0.f, 0.f};
      o[1] = (f32x4){0.f, 0.f, 0.f, 0.f};
#pragma unroll
      for (int ks = 0; ks < 4; ++ks) {
        const bf16x8 qa = *(const bf16x8*)(sQb + sw256(wid * 16 + r, ks * 4 + q));
#pragma unroll
        for (int et = 0; et < 2; ++et) {
          const bf16x8 sb2 = *(const bf16x8*)(stc + sw256(et * 16 + r, ks * 4 + q));
          o[et] = mfma16(qa, sb2, o[et]);
        }
      }
#pragma unroll
      for (int ks = 0; ks < 2; ++ks) {
        const bf16x8 aa = *(const bf16x8*)(sAtt + sw128(wid * 16 + r, ks * 4 + q));
#pragma unroll
        for (int et = 0; et < 2; ++et) {
          const bf16x8 vb = *(const bf16x8*)(sVt + sw128(et * 16 + r, ks * 4 + q));
          o[et] = mfma16(aa, vb, o[et]);
        }
      }
      {
        const int lam = head * 8 + slice;
#pragma unroll
        for (int j = 0; j < 4; ++j) {
          const int row = row0 + wid * 16 + 4 * q + j;
          const int m2 = row >> 1, par = row & 1;
          bfr* lp = dir ? ((bfr*)(p.ws + OFF_H) + ((size_t)m2 * 32 + lam) * 64)
                        : ((bfr*)(p.ws + OFF_U) + (size_t)(2 * m2 + (lam >> 4)) * 2048 + 1024 + (lam & 15) * 64);
#pragma unroll
          for (int et = 0; et < 2; ++et) lp[par * 32 + et * 16 + r] = f2bf(o[et][j]);
        }
      }
    }
  }
#undef GLA_LOAD
#undef GLA_ROW0
  __syncthreads();
}

DI void phase_gla_combine(const Params& p, int l) {
  const int tid = opaque_tid(), lane = tid & 63, wid = tid >> 6;
  const bfr* proj = (const bfr*)(p.ws + OFF_PROJ);
  const bfr* OB = (const bfr*)(p.ws + OFF_H);
  bfr* U = (bfr*)(p.ws + OFF_U);
  const int h = lane >> 4, e16 = (lane & 15) * 16;
  const int lam = h * 8 + ((lane & 15) >> 1), ein = (lane & 1) * 16;
  const float* gn = p.od_gnorm + (l >> 1) * 256 + e16;
  for (int m2 = blockIdx.x * 4 + wid; m2 < MR / 2; m2 += gridDim.x * 4) {
    const bfr* ofl = U + (size_t)(2 * m2 + (lam >> 4)) * 2048 + 1024 + (lam & 15) * 64 + ein;
    const bfr* obl = OB + ((size_t)m2 * 32 + lam) * 64 + ein;
    u32x4 a[2][2], bq[2][2], g[2][2];
#pragma unroll
    for (int par = 0; par < 2; ++par) {
      a[par][0] = *(const u32x4*)(ofl + par * 32);  a[par][1] = *(const u32x4*)(ofl + par * 32 + 8);
      bq[par][0] = *(const u32x4*)(obl + par * 32); bq[par][1] = *(const u32x4*)(obl + par * 32 + 8);
      const bfr* gp = proj + (size_t)(2 * m2 + par) * NOD + 6144 + h * 256 + e16;
      g[par][0] = *(const u32x4*)gp; g[par][1] = *(const u32x4*)(gp + 8);
    }
    u32x4 res[2][2];
#pragma unroll
    for (int par = 0; par < 2; ++par) {
      float o[16], dg[16];
      float ss = 0.f;
#pragma unroll
      for (int hv = 0; hv < 2; ++hv)
#pragma unroll
        for (int i = 0; i < 4; ++i) {
          const unsigned av = a[par][hv][i], bv = bq[par][hv][i], gv = g[par][hv][i];
          const int k = hv * 8 + i * 2;
          o[k] = lo_bf(av) + lo_bf(bv); o[k + 1] = hi_bf(av) + hi_bf(bv);
          dg[k] = lo_bf(gv); dg[k + 1] = hi_bf(gv);
          ss += o[k] * o[k] + o[k + 1] * o[k + 1];
        }
      ss += shx<1>(ss, lane); ss += shx<2>(ss, lane); ss += shx<4>(ss, lane); ss += shx<8>(ss, lane);
      const float rn = rsqrtf(ss * (1.f / 256.f) + 1e-6f);
#pragma unroll
      for (int hv = 0; hv < 2; ++hv)
#pragma unroll
        for (int i = 0; i < 4; ++i) {
          const int k = hv * 8 + i * 2;
          res[par][hv][i] = pack2(o[k] * rn * gn[k] * silu(dg[k]), o[k + 1] * rn * gn[k + 1] * silu(dg[k + 1]));
        }
    }
#pragma unroll
    for (int par = 0; par < 2; ++par) {
      bfr* up = U + (size_t)(2 * m2 + par) * 2048 + 1024 + h * 256 + e16;
      *(u32x4*)up = res[par][0];
      *(u32x4*)(up + 8) = res[par][1];
    }
  }
}

DI int next_item(int* ctr, int* slot) {
  __syncthreads();
  if (threadIdx.x == 0) *slot = atomicAdd(ctr, 1);
  __syncthreads();
  return *slot;
}

DI void phase_mix_even(const Params& p, int l, int g, char* smem, int coff = 0) {
  int* ctr0 = (int*)(p.ws + OFF_CTR) + ((g * 2 + (l >> 1)) * 8) + coff;
  int* slot = (int*)(smem + SMEM_BYTES - 16);
  const int PER_LAT = GB * 32, PER_CTX = GB * 2, PER_CONV = MR / 16 / 8;
  const int per_q = PER_LAT + PER_CTX + PER_CONV;
  const int myq = (int)(__builtin_amdgcn_s_getreg((3 << 11) | 20) & 7u);
  for (int dq = 0; dq < 8; ++dq) {
    const int x = (myq + dq) & 7;
    for (;;) {
      int it = next_item(ctr0 + x, slot);
      if (it >= per_q) break;
      if (it < PER_LAT) {
        const int qb = it & 31, b = it >> 5;
        diff_attn_item(p, l, b, x, b * 4096 + qb * 128, false, smem);
      } else if (it < PER_LAT + PER_CTX) {
        it -= PER_LAT;
        const int qb = it & 1, b = it >> 1;
        diff_attn_item(p, l, b, x, ML + b * 256 + qb * 128, true, smem);
      } else {
        conv_item(p, l, (it - PER_LAT - PER_CTX) * 8 + x);
      }
    }
  }
}

DI void phase_mix_odd(const Params& p, int l, int g, char* smem) {
  int* ctr = (int*)(p.ws + OFF_CTR) + (g * 4 + l);
  int* slot = (int*)(smem + SMEM_BYTES - 16);
  const int N_GLA = GB * 4 * 2 * 8, N_NA = GB * 16 * 64, N_CTX = (l == 3) ? 0 : GB * 16 * 4;
  const int total = N_GLA + N_NA + N_CTX;
  (void)ctr; (void)slot; (void)total;
  const int nb = gridDim.x, bx = blockIdx.x;
  const int nup = (nb > N_GLA) ? (nb - N_GLA) : 0;
  const int NA_UP = 17;
  for (int k = 0;; ++k) {
    int it;
    if (nup == 0) { it = bx + k * nb; if (it >= total) break; }
    else if (bx < N_GLA) {
      if (k == 0) it = bx;
      else { it = N_GLA + NA_UP * nup + bx + (k - 1) * N_GLA; if (it >= total) break; }
    } else {
      if (k >= NA_UP) break;
      it = N_GLA + (bx - N_GLA) + k * nup;
      if (it >= total) break;
    }
    __syncthreads();
    if (it < N_GLA) {
      __builtin_amdgcn_s_setprio(3);
      gla_item(p, l, it, smem);
      __builtin_amdgcn_s_setprio(0);
    } else if (it < N_GLA + N_NA) {
      it -= N_GLA;
      const int rho = it & 63, bh = it >> 6;
      na_item(p, l, bh >> 4, bh & 15, rho, false, 0, smem);
    } else {
      it -= N_GLA + N_NA;
      const int qb = it & 3, bh = it >> 2;
      na_item(p, l, bh >> 4, bh & 15, 0, true, qb * 64, smem);
    }
  }
}


DI void grid_barrier(unsigned* bar, unsigned& bgen, unsigned xcc, unsigned nxcc, unsigned nx) {
  asm volatile("s_waitcnt vmcnt(0)" ::: "memory");
  __syncthreads();
  const unsigned target = bgen + 1;
  if (threadIdx.x == 0) {
    const unsigned old = __hip_atomic_fetch_add(bar + xcc * 64, 1u, __ATOMIC_RELAXED, __HIP_MEMORY_SCOPE_AGENT);
    if (old == target * nxcc - 1) {
      __builtin_amdgcn_fence(__ATOMIC_RELEASE, "agent");
      asm volatile("s_waitcnt vmcnt(0)" ::: "memory");
      const unsigned o2 = __hip_atomic_fetch_add(bar + 16 * 64, 1u, __ATOMIC_RELAXED, __HIP_MEMORY_SCOPE_AGENT);
      if (o2 == target * nx - 1) __hip_atomic_store(bar + 17 * 64, target, __ATOMIC_RELAXED, __HIP_MEMORY_SCOPE_AGENT);
    }
    while (__hip_atomic_load(bar + 17 * 64, __ATOMIC_RELAXED, __HIP_MEMORY_SCOPE_AGENT) < target) __builtin_amdgcn_s_sleep(1);
    __builtin_amdgcn_fence(__ATOMIC_ACQUIRE, "agent");
    asm volatile("s_waitcnt vmcnt(0)" ::: "memory");
  }
  bgen = target;
  __syncthreads();
}
typedef const __attribute__((address_space(4))) Params* KParamsPtr;
DI Params load_params() {
#if defined(__HIP_DEVICE_COMPILE__)
  KParamsPtr kp = (KParamsPtr)__builtin_amdgcn_kernarg_segment_ptr();
  asm volatile("" : "+s"(kp));
  Params r;
  __builtin_memcpy(&r, kp, sizeof(Params));
  return r;
#else
  return Params{};
#endif
}
#define PH(call) { const Params p = load_params(); call; }
__global__ void __launch_bounds__(256, 2) mega_kernel(Params p_unused) {
  extern __shared__ __attribute__((aligned(16))) char smem[];
  cg::grid_group grid = cg::this_grid();
  unsigned bgen = 0;
  const unsigned xcc = (unsigned)__builtin_amdgcn_s_getreg((3 << 11) | 20) & 15u;
  if (threadIdx.x == 0) {
    const Params pb = load_params();
    __hip_atomic_fetch_add((unsigned*)(pb.ws + OFF_BAR) + (18 + xcc) * 64, 1u, __ATOMIC_RELAXED, __HIP_MEMORY_SCOPE_AGENT);
  }
  PH(phase0(p, smem));
  grid.sync();
  unsigned nxcc = 0, nx = 0;
  {
    const Params pb = load_params();
    const unsigned* cen = (const unsigned*)(pb.ws + OFF_BAR) + 18 * 64;
    for (unsigned j = 0; j < 16; ++j) {
      const unsigned cj = __hip_atomic_load(cen + j * 64, __ATOMIC_RELAXED, __HIP_MEMORY_SCOPE_AGENT);
      nx += (cj != 0);
      if (j == xcc) nxcc = cj;
    }
  }
#define GBAR() { const Params pb = load_params(); grid_barrier((unsigned*)(pb.ws + OFF_BAR), bgen, xcc, nxcc, nx); }
#pragma unroll 1
  for (int g = 0; g < NGRP; ++g) {
#pragma unroll 1
    for (int l = 0; l < 4; ++l) {
      PH(phase_norm(p, l, g));
      GBAR();
      PH(phase_gemm_in(p, l, smem, g * 4 + l));
      GBAR();
      if (l & 1) {
        PH(phase_mix_odd(p, l, g, smem));
        GBAR();
        PH(phase_gla_combine(p, l));
      } else {
        PH(phase_mix_even(p, l, g, smem));
      }
      GBAR();
      PH(phase_gemm_out(p, l, smem, 8 + g * 4 + l));
      GBAR();
    }
    PH(phase_norm(p, 4, g));
  }
}

extern "C" void kernel_launch(void* const* d_in, const int* in_sizes, int n_in, void* d_out, int out_size, void* d_ws,
                              size_t ws_size, hipStream_t stream) {
  static int grid_blocks = 0;
  if (!grid_blocks) {
    int dev = 0, cus = 0, per_cu = 0;
    hipGetDevice(&dev);
    hipDeviceGetAttribute(&cus, hipDeviceAttributeMultiprocessorCount, dev);
    hipFuncSetAttribute((const void*)mega_kernel, hipFuncAttributeMaxDynamicSharedMemorySize, SMEM_BYTES);
    hipOccupancyMaxActiveBlocksPerMultiprocessor(&per_cu, mega_kernel, 256, SMEM_BYTES);
    if (per_cu > 2) per_cu = 2;
    if (per_cu < 1) per_cu = 1;
    grid_blocks = cus * per_cu;
    grid_blocks &= ~15;
  }
  if (ws_size < WS_NEED) { fprintf(stderr, "workspace too small: %zu < %zu\n", ws_size, (size_t)WS_NEED); return; }
  Params p{};
  p.x = (const float*)d_in[0]; p.c = (const float*)d_in[1]; p.ctx = (const float*)d_in[2]; p.c_ctx = (const float*)d_in[3];
  p.w_mod = (const float*)d_in[4]; p.b_mod = (const float*)d_in[5]; p.g_pre = (const float*)d_in[6]; p.g_post = (const float*)d_in[7];
  p.w_out = (const float*)d_in[8]; p.ev_w_in = (const float*)d_in[9]; p.ev_lambda = (const float*)d_in[10]; p.ev_subln = (const float*)d_in[11];
  p.ev_conv = (const float*)d_in[12]; p.od_w_in = (const float*)d_in[13]; p.od_rpb = (const float*)d_in[14]; p.od_gate_up = (const float*)d_in[15];
  p.od_gate_bias = (const float*)d_in[16]; p.od_gnorm = (const float*)d_in[17];
  p.out = (float*)d_out;
  p.ws = (char*)d_ws;
  (void)hipMemsetAsync((char*)d_ws + OFF_BAR, 0, BAR_BYTES, stream);
  void* args[] = {&p};
  hipError_t e = hipLaunchCooperativeKernel((const void*)mega_kernel, dim3(grid_blocks), dim3(256), args, SMEM_BYTES, stream);
  if (e != hipSuccess) fprintf(stderr, "cooperative launch failed: %s (grid %d)\n", hipGetErrorString(e), grid_blocks);
}
```

```cpp
#include <hip/hip_runtime.h>
#include <hip/hip_cooperative_groups.h>
#include <cstdio>
namespace cg = cooperative_groups;

typedef unsigned short bfr;
typedef __attribute__((ext_vector_type(8))) short bf16x8;
typedef __attribute__((ext_vector_type(4))) float f32x4;
typedef __attribute__((ext_vector_type(4))) unsigned u32x4;
typedef __attribute__((ext_vector_type(2))) unsigned u32x2;
typedef __attribute__((ext_vector_type(16))) unsigned u32x16;
typedef __attribute__((ext_vector_type(2))) __bf16 bf16x2_t;
#define DI __device__ __forceinline__
DI float dot2bf(unsigned a, unsigned b, float c) { return __builtin_amdgcn_fdot2_f32_bf16(__builtin_bit_cast(bf16x2_t, a), __builtin_bit_cast(bf16x2_t, b), c, false); }
DI int opaque_tid() { int t = threadIdx.x; asm volatile("" : "+v"(t)); return t; }

constexpr int GB   = 4;
constexpr int NGRP = 2;
constexpr int ML   = GB * 4096;
constexpr int MC   = GB * 256;
constexpr int MR   = ML + MC;
constexpr int NEV  = 8192;
constexpr int NOD  = 7296;
constexpr int KEYS = 4352;
constexpr float L2E = 1.4426950408889634f;
constexpr float LN2 = 0.6931471805599453f;

constexpr size_t SZ_PROJ = (size_t)MR * 8192 * 2;
constexpr size_t SZ_H    = (size_t)MR * 1024 * 2;
constexpr size_t SZ_U    = (size_t)MR * 2048 * 2;
constexpr size_t SZ_VT   = (size_t)GB * 1024 * KEYS * 2;
constexpr size_t SZ_WE   = (size_t)NEV * 1024 * 2;
constexpr size_t SZ_WO   = (size_t)NOD * 1024 * 2;
constexpr size_t SZ_WOUT = (size_t)1024 * 2048 * 2;
constexpr size_t OFF_PROJ = 0;
constexpr size_t OFF_H    = OFF_PROJ + SZ_PROJ;
constexpr size_t OFF_U    = OFF_H + SZ_H;
constexpr size_t OFF_VT   = OFF_U + SZ_U;
constexpr size_t OFF_WIN  = OFF_VT + SZ_VT;
constexpr size_t OFF_WOUT = OFF_WIN + 2 * SZ_WE + 2 * SZ_WO;
constexpr size_t OFF_XC   = OFF_WOUT + 4 * SZ_WOUT;
constexpr size_t OFF_MOD  = OFF_XC + (size_t)8 * 256 * 1024 * 4;
constexpr size_t OFF_CS   = OFF_MOD + (size_t)4 * 9 * 3072 * 4;
constexpr size_t OFF_LAM  = OFF_CS + 64 * 16 * 8;
constexpr size_t OFF_CTR  = OFF_LAM + 256;
constexpr size_t OFF_BAR  = OFF_CTR + 256;
constexpr size_t BAR_BYTES = 34 * 256 + 192 * 64;
constexpr size_t SZ_ET    = (size_t)(MR / 64) * 4 * 16384;
constexpr size_t OFF_ETF  = OFF_PROJ + (size_t)MR * NOD * 2;
constexpr size_t OFF_ETB  = (OFF_BAR + BAR_BYTES + 255) & ~(size_t)255;
constexpr size_t OFF_DEC  = OFF_ETB + SZ_ET;
constexpr size_t WS_NEED  = OFF_DEC + (size_t)2 * (MR / 64) * 4 * 128 * 4;
static_assert(OFF_ETF + SZ_ET <= OFF_H, "E^T forward tiles must fit behind the odd proj rows");

constexpr int SMEM_BYTES = 80896;

struct Params {
  const float *x, *c, *ctx, *c_ctx, *w_mod, *b_mod, *g_pre, *g_post, *w_out, *ev_w_in, *ev_lambda, *ev_subln,
      *ev_conv, *od_w_in, *od_rpb, *od_gate_up, *od_gate_bias, *od_gnorm;
  float* out;
  char* ws;
};

DI size_t win_off(int l) { return OFF_WIN + (size_t)(l >> 1) * (SZ_WE + SZ_WO) + ((l & 1) ? SZ_WE : 0); }

DI float bf2f(bfr v) { return __uint_as_float(((unsigned)v) << 16); }
typedef __attribute__((ext_vector_type(2))) float f32x2_t;
DI bfr f2bf(float x) { return __builtin_bit_cast(bfr, (__bf16)x); }
DI unsigned pack2(float a, float b) { f32x2_t v = {a, b}; return __builtin_bit_cast(unsigned, __builtin_convertvector(v, bf16x2_t)); }
DI float lo_bf(unsigned u) { return __uint_as_float(u << 16); }
DI float hi_bf(unsigned u) { return __uint_as_float(u & 0xffff0000u); }
DI float fexp2(float x) { return __builtin_amdgcn_exp2f(x); }
DI float flog2(float x) { return __builtin_amdgcn_logf(x); }
DI float silu(float x) { return x / (1.f + fexp2(-x * L2E)); }
DI float max3f(float a, float b, float c) { float r; asm("v_max3_f32 %0, %1, %2, %3" : "=v"(r) : "v"(a), "v"(b), "v"(c)); return r; }
template <int M>
DI float shx(float v, int lane) {
  if (M < 32) return __builtin_bit_cast(float, __builtin_amdgcn_ds_swizzle(__builtin_bit_cast(int, v), (M << 10) | 0x1f));
  return __builtin_bit_cast(float, __builtin_amdgcn_ds_bpermute((lane ^ 32) << 2, __builtin_bit_cast(int, v)));
}
DI float wave_sum(float v, int lane) {
  v += shx<1>(v, lane); v += shx<2>(v, lane); v += shx<4>(v, lane); v += shx<8>(v, lane); v += shx<16>(v, lane); v += shx<32>(v, lane);
  return v;
}
DI f32x4 mfma16(bf16x8 a, bf16x8 b, f32x4 c) { return __builtin_amdgcn_mfma_f32_16x16x32_bf16(a, b, c, 0, 0, 0); }
DI int sw128(int row, int chunk) { return row * 128 + ((chunk ^ ((row >> 1) & 7)) << 4); }
DI int sw256(int row, int chunk) { return row * 256 + ((chunk ^ (row & 15)) << 4); }

DI void store_pair16(bfr* tile_i_ptr, const f32x4& a, const f32x4& b, int q) {
  const unsigned ax = pack2(a[0], a[1]), ay = pack2(a[2], a[3]), bx = pack2(b[0], b[1]), by = pack2(b[2], b[3]);
  const u32x2 r0 = __builtin_amdgcn_permlane16_swap(ax, bx, false, false);
  const u32x2 r1 = __builtin_amdgcn_permlane16_swap(ay, by, false, false);
  *(u32x4*)(tile_i_ptr + (q & 1) * 16 + (q >> 1) * 8) = (u32x4){r0.x, r1.x, r0.y, r1.y};
}

struct GemmStage { u32x4 xa0[4], ya0[4], xa1[4], ya1[4]; };
DI void gemm_prologue(const bfr* __restrict__ X, int ldx, const bfr* __restrict__ Y, int ldy, GemmStage& st) {
  const int tid = opaque_tid();
  const int lr = tid >> 3, lc = tid & 7;
  const bfr* xp = X + (size_t)lr * ldx + lc * 8;
  const bfr* yp = Y + (size_t)lr * ldy + lc * 8;
#pragma unroll
  for (int i = 0; i < 4; ++i) {
    st.xa0[i] = *(const u32x4*)(xp + (size_t)(32 * i) * ldx);
    st.ya0[i] = *(const u32x4*)(yp + (size_t)(32 * i) * ldy);
    st.xa1[i] = *(const u32x4*)(xp + (size_t)(32 * i) * ldx + 64);
    st.ya1[i] = *(const u32x4*)(yp + (size_t)(32 * i) * ldy + 64);
  }
}
DI void gemm_mainloop(const bfr* __restrict__ X, int ldx, const bfr* __restrict__ Y, int ldy, int K,
                      const bfr* __restrict__ Xn, const bfr* __restrict__ Yn, bool hasnext, char* smem,
                      f32x4 (&acc)[4][4], GemmStage& st) {
  const int tid = opaque_tid(), lane = tid & 63, wid = tid >> 6, r = lane & 15, q = lane >> 4;
  const int wx = wid >> 1, wy = wid & 1;
  const int lr = tid >> 3, lc = tid & 7;
  const bfr* xp = X + (size_t)lr * ldx + lc * 8;
  const bfr* yp = Y + (size_t)lr * ldy + lc * 8;
  const bfr* xpn = Xn + (size_t)lr * ldx + lc * 8;
  const bfr* ypn = Yn + (size_t)lr * ldy + lc * 8;
  const int nk = K >> 6;
#define GEMM_STEP(XR, YR, BUF, KT)                                                                       \
  {                                                                                                      \
    char* sX = smem + (BUF) * 32768;                                                                     \
    char* sY = sX + 16384;                                                                               \
    _Pragma("unroll") for (int i = 0; i < 4; ++i) {                                                      \
      *(u32x4*)(sX + sw128(lr + 32 * i, lc)) = XR[i];                                                    \
      *(u32x4*)(sY + sw128(lr + 32 * i, lc)) = YR[i];                                                    \
    }                                                                                                    \
    __syncthreads();                                                                                     \
    if ((KT) + 2 < nk) {                                                                                 \
      const int ko = ((KT) + 2) * 64;                                                                    \
      _Pragma("unroll") for (int i = 0; i < 4; ++i) {                                                    \
        XR[i] = *(const u32x4*)(xp + (size_t)(32 * i) * ldx + ko);                                       \
        YR[i] = *(const u32x4*)(yp + (size_t)(32 * i) * ldy + ko);                                       \
      }                                                                                                  \
    } else if (hasnext) {                                                                                \
      const int ko = ((KT) + 2 - nk) * 64;                                                               \
      _Pragma("unroll") for (int i = 0; i < 4; ++i) {                                                    \
        XR[i] = *(const u32x4*)(xpn + (size_t)(32 * i) * ldx + ko);                                      \
        YR[i] = *(const u32x4*)(ypn + (size_t)(32 * i) * ldy + ko);                                      \
      }                                                                                                  \
    }                                                                                                    \
    _Pragma("unroll") for (int s = 0; s < 2; ++s) {                                                      \
      bf16x8 xf[4], yf[4];                                                                               \
      _Pragma("unroll") for (int i = 0; i < 4; ++i)                                                      \
          xf[i] = *(const bf16x8*)(sX + sw128(wx * 64 + i * 16 + r, s * 4 + q));                         \
      _Pragma("unroll") for (int j = 0; j < 4; ++j)                                                      \
          yf[j] = *(const bf16x8*)(sY + sw128(wy * 64 + j * 16 + r, s * 4 + q));                         \
      __builtin_amdgcn_s_setprio(1);                                                                     \
      _Pragma("unroll") for (int i = 0; i < 4; ++i)                                                      \
          _Pragma("unroll") for (int j = 0; j < 4; ++j) acc[i][j] = mfma16(xf[i], yf[j], acc[i][j]);     \
      __builtin_amdgcn_s_setprio(0);                                                                     \
    }                                                                                                    \
  }
  for (int kt = 0; kt < nk; kt += 2) {
    GEMM_STEP(st.xa0, st.ya0, 0, kt);
    GEMM_STEP(st.xa1, st.ya1, 1, kt + 1);
  }
#undef GEMM_STEP
  __syncthreads();
}

DI bool tile_map(int T, int MT, int NT, int& mt, int& nt) {
  const int pm_n = MT >> 3;
  const int P = (T >> 9) * 8 + (T & 7);
  const int li = (T & 511) >> 3;
  const int pm = P % pm_n, pn = P / pm_n;
  mt = pm * 8 + (li & 7);
  nt = pn * 8 + (li >> 3);
  return nt < NT;
}

DI int odd_col_src(int n) {
  if (n < 3584) return n;
  if (n < 7168) return n + 32;
  if (n < 7200) return n - 7168 + 3584;
  return -1;
}

struct TrItem { const float* src; bfr* dst; int K, Nsrc, k0, n0; bool oddmap; };
DI TrItem tr_decode(const Params& p, int it) {
  TrItem t;
  int rr = it, l, ktile, ntile;
  t.oddmap = false;
  if (rr < 7744) {
    if (rr < 2048) { l = 0; } else if (rr < 3872) { l = 1; rr -= 2048; } else if (rr < 5920) { l = 2; rr -= 3872; } else { l = 3; rr -= 5920; }
    ktile = rr & 15; ntile = rr >> 4; t.K = 1024;
    t.oddmap = (l & 1);
    t.Nsrc = t.oddmap ? 7200 : 8192;
    t.src = (t.oddmap ? p.od_w_in : p.ev_w_in) + (size_t)(l >> 1) * 1024 * t.Nsrc;
    t.dst = (bfr*)(p.ws + win_off(l));
  } else {
    rr -= 7744; l = rr >> 9; rr &= 511;
    ktile = rr & 31; ntile = rr >> 5; t.K = 2048; t.Nsrc = 1024;
    t.src = p.w_out + (size_t)l * 2048 * 1024;
    t.dst = (bfr*)(p.ws + OFF_WOUT + (size_t)l * SZ_WOUT);
  }
  t.k0 = ktile * 64; t.n0 = ntile * 64;
  return t;
}
DI void tr_load(const TrItem& t, int tid, float (&v)[16]) {
  const int nd = t.n0 + (tid & 63);
  const int ns = t.oddmap ? odd_col_src(nd) : nd;
#pragma unroll
  for (int i = 0; i < 16; ++i) {
    const int kk = (tid >> 6) + 4 * i;
    v[i] = (ns >= 0) ? t.src[(size_t)(t.k0 + kk) * t.Nsrc + ns] : 0.f;
  }
}
DI void tr_emit(const TrItem& t, const float* tl, int tid) {
  const int kk8 = (tid & 7) * 8;
#pragma unroll
  for (int i2 = 0; i2 < 2; ++i2) {
    const int nn = (tid >> 3) + 32 * i2;
    u32x4 v;
    v.x = pack2(tl[(kk8 + 0) * 65 + nn], tl[(kk8 + 1) * 65 + nn]);
    v.y = pack2(tl[(kk8 + 2) * 65 + nn], tl[(kk8 + 3) * 65 + nn]);
    v.z = pack2(tl[(kk8 + 4) * 65 + nn], tl[(kk8 + 5) * 65 + nn]);
    v.w = pack2(tl[(kk8 + 6) * 65 + nn], tl[(kk8 + 7) * 65 + nn]);
    *(u32x4*)(t.dst + (size_t)(t.n0 + nn) * t.K + t.k0 + kk8) = v;
  }
}
DI void phase0(const Params& p, char* smem) {
  const int tid = opaque_tid();
  if (blockIdx.x < 384) {
    float* sc = (float*)smem;
    float* red = sc + 9 * 1024;
    for (int i = tid; i < 9 * 1024; i += 256) {
      const int b = i >> 10, k = i & 1023;
      const float v = (b < 8) ? p.c[b * 1024 + k] : p.c_ctx[k];
      sc[i] = v / (1.f + __expf(-v));
    }
    __syncthreads();
    float* modb = (float*)(p.ws + OFF_MOD);
    for (int it = blockIdx.x; it < 384; it += gridDim.x) {
      const int l = it / 96, cgp = it % 96;
      const int col = cgp * 32 + (tid & 31), ks = tid >> 5;
      float a[9];
#pragma unroll
      for (int b = 0; b < 9; ++b) a[b] = 0.f;
      const float* w = p.w_mod + ((size_t)l * 1024 + ks * 128) * 3072 + col;
#pragma unroll 32
      for (int k = 0; k < 128; ++k) {
        const float wv = w[(size_t)k * 3072];
#pragma unroll
        for (int b = 0; b < 9; ++b) a[b] += sc[b * 1024 + ks * 128 + k] * wv;
      }
#pragma unroll
      for (int b = 0; b < 9; ++b) red[(ks * 9 + b) * 32 + (tid & 31)] = a[b];
      __syncthreads();
      for (int idx = tid; idx < 288; idx += 256) {
        const int b = idx >> 5, cc = idx & 31;
        float s = p.b_mod[l * 3072 + cgp * 32 + cc];
#pragma unroll
        for (int k2 = 0; k2 < 8; ++k2) s += red[(k2 * 9 + b) * 32 + cc];
        modb[(size_t)(l * 9 + b) * 3072 + cgp * 32 + cc] = s;
      }
      __syncthreads();
    }
  }
  if (blockIdx.x == gridDim.x - 1) {
    float2* cs = (float2*)(p.ws + OFF_CS);
    for (int idx = tid; idx < 1024; idx += 256) {
      const int pos = idx >> 4, f = idx & 15;
      const float inv = 1.0f / powf(10000.f, (float)f * 0.0625f);
      const float ang = (float)pos * inv;
      const double ad = (double)ang;
      const double n = rint(ad * 0.15915494309189535);
      const float rr = (float)(ad - n * 6.283185307179586);
      cs[idx] = make_float2(__cosf(rr), __sinf(rr));
    }
    if (tid < 2) {
      const float* lp = p.ev_lambda + tid * 256;
      float s1 = 0.f, s2 = 0.f;
      for (int i = 0; i < 64; ++i) { s1 += lp[i] * lp[64 + i]; s2 += lp[128 + i] * lp[192 + i]; }
      const float li = (tid == 0) ? 0.2f : (0.8f - 0.6f * 0.5488116360940264f);
      float* lam = (float*)(p.ws + OFF_LAM);
      lam[tid] = __expf(s1) - __expf(s2) + li;
      lam[2 + tid] = li;
    }
    if (tid < 32) ((int*)(p.ws + OFF_CTR))[tid] = 0;
  }
  float* tile = (float*)smem;
  __syncthreads();
  for (int it = blockIdx.x * 4; it < 9792; it += gridDim.x * 4) {
    const TrItem A = tr_decode(p, it), B = tr_decode(p, it + 1), C = tr_decode(p, it + 2), D = tr_decode(p, it + 3);
    float va[16], vb[16], vc[16], vd[16];
    tr_load(A, tid, va);
    tr_load(B, tid, vb);
    tr_load(C, tid, vc);
    tr_load(D, tid, vd);
    {
      const int nn = tid & 63;
#pragma unroll
      for (int i = 0; i < 16; ++i) {
        const int kk = (tid >> 6) + 4 * i;
        tile[kk * 65 + nn] = va[i];
        tile[4160 + kk * 65 + nn] = vb[i];
        tile[8320 + kk * 65 + nn] = vc[i];
        tile[12480 + kk * 65 + nn] = vd[i];
      }
    }
    __syncthreads();
    tr_emit(A, tile, tid);
    tr_emit(B, tile + 4160, tid);
    tr_emit(C, tile + 8320, tid);
    tr_emit(D, tile + 12480, tid);
    __syncthreads();
  }
}

DI void phase_norm(const Params& p, int l, int g) {
  const int tid = opaque_tid(), lane = tid & 63, wid = tid >> 6;
  const int rows = (l == 4) ? ML : MR;
  const float* modb = (const float*)(p.ws + OFF_MOD);
  const bfr* ybuf = (const bfr*)(p.ws + OFF_PROJ);
  bfr* hbuf = (bfr*)(p.ws + OFF_H);
  float* xcb = (float*)(p.ws + OFF_XC);
  for (int row = blockIdx.x * 4 + wid; row < rows; row += gridDim.x * 4) {
    const bool lat = row < ML;
    const int mb = lat ? (g * GB + (row >> 12)) : 8;
    const size_t grow = lat ? ((size_t)g * ML + row) : ((size_t)g * MC + (row - ML));
    const float* xin;
    float* xst;
    if (lat) { xin = ((l <= 1) ? p.x : (const float*)p.out) + grow * 1024; xst = p.out + grow * 1024; }
    else     { xin = ((l <= 1) ? p.ctx : (const float*)xcb) + grow * 1024; xst = xcb + grow * 1024; }
    float4 xv[4];
#pragma unroll
    for (int i = 0; i < 4; ++i) xv[i] = *(const float4*)(xin + lane * 4 + 256 * i);
    if (l >= 1) {
      float4 yv[4];
      float ss = 0.f;
#pragma unroll
      for (int i = 0; i < 4; ++i) {
        const u32x2 yr = *(const u32x2*)(ybuf + (size_t)row * 1024 + lane * 4 + 256 * i);
        yv[i] = make_float4(lo_bf(yr.x), hi_bf(yr.x), lo_bf(yr.y), hi_bf(yr.y));
        ss += yv[i].x * yv[i].x + yv[i].y * yv[i].y + yv[i].z * yv[i].z + yv[i].w * yv[i].w;
      }
      ss = wave_sum(ss, lane);
      const float rn = rsqrtf(ss * (1.f / 1024.f) + 1e-6f);
      const float* gate = modb + (size_t)((l - 1) * 9 + mb) * 3072 + 2048;
      const float* gp = p.g_post + (l - 1) * 1024;
#pragma unroll
      for (int i = 0; i < 4; ++i) {
        const int c0 = lane * 4 + 256 * i;
        const float4 gt = *(const float4*)(gate + c0);
        const float4 gg = *(const float4*)(gp + c0);
        xv[i].x += gt.x * (yv[i].x * rn * gg.x);
        xv[i].y += gt.y * (yv[i].y * rn * gg.y);
        xv[i].z += gt.z * (yv[i].z * rn * gg.z);
        xv[i].w += gt.w * (yv[i].w * rn * gg.w);
        *(float4*)(xst + c0) = xv[i];
      }
    }
    if (l < 4) {
      float ss = 0.f;
#pragma unroll
      for (int i = 0; i < 4; ++i) ss += xv[i].x * xv[i].x + xv[i].y * xv[i].y + xv[i].z * xv[i].z + xv[i].w * xv[i].w;
      ss = wave_sum(ss, lane);
      const float rn = rsqrtf(ss * (1.f / 1024.f) + 1e-6f);
      const float* mrow = modb + (size_t)(l * 9 + mb) * 3072;
      const float* gpre = p.g_pre + l * 1024;
#pragma unroll
      for (int i = 0; i < 4; ++i) {
        const int c0 = lane * 4 + 256 * i;
        const float4 sh = *(const float4*)(mrow + c0);
        const float4 scl = *(const float4*)(mrow + 1024 + c0);
        const float4 gg = *(const float4*)(gpre + c0);
        u32x2 o;
        o.x = pack2(xv[i].x * rn * gg.x * (1.f + scl.x) + sh.x, xv[i].y * rn * gg.y * (1.f + scl.y) + sh.y);
        o.y = pack2(xv[i].z * rn * gg.z * (1.f + scl.z) + sh.z, xv[i].w * rn * gg.w * (1.f + scl.w) + sh.w);
        *(u32x2*)(hbuf + (size_t)row * 1024 + c0) = o;
      }
    }
  }
}

DI void gla_gate_precompute(const Params& p, int l, int m0, const char* sLr, float* sHs) {
  const int tid = opaque_tid();
  const int d = tid & 127, half = tid >> 7;
  const int jl = l >> 1;
#pragma unroll 1
  for (int unit = 0; unit < 16; ++unit) {
    const int cc = unit & 1, dir = (unit >> 1) & 1, head = unit >> 2;
    unsigned gu[8];
#pragma unroll
    for (int k = 0; k < 8; ++k)
      gu[k] = pack2(p.od_gate_up[(((size_t)jl * 2 + dir) * 16 + 2 * k) * 512 + head * 128 + d],
                    p.od_gate_up[(((size_t)jl * 2 + dir) * 16 + 2 * k + 1) * 512 + head * 128 + d]);
    const float gbias = p.od_gate_bias[((size_t)jl * 2 + dir) * 512 + head * 128 + d];
    float gl[32];
    float tot = 0.f;
#pragma unroll
    for (int i = 0; i < 32; ++i) {
      const int tk = cc * 64 + half * 32 + i;
      const u32x4 la = *(const u32x4*)(sLr + tk * 64 + dir * 32);
      const u32x4 lb = *(const u32x4*)(sLr + tk * 64 + dir * 32 + 16);
      float z = gbias;
      z = dot2bf(la.x, gu[0], z); z = dot2bf(la.y, gu[1], z); z = dot2bf(la.z, gu[2], z); z = dot2bf(la.w, gu[3], z);
      z = dot2bf(lb.x, gu[4], z); z = dot2bf(lb.y, gu[5], z); z = dot2bf(lb.z, gu[6], z); z = dot2bf(lb.w, gu[7], z);
      const float tneg = fexp2(-fabsf(z) * L2E);
      const float g = (fminf(z, 0.f) - flog2(1.f + tneg) * LN2) * (L2E / 16.f);
      gl[i] = g;
      tot += g;
    }
    if (dir == 0) {
      float run = 0.f;
#pragma unroll
      for (int i = 0; i < 32; ++i) { run += gl[i]; gl[i] = run; }
    } else {
      float run = 0.f;
#pragma unroll
      for (int i = 31; i >= 0; --i) { run += gl[i]; gl[i] = run; }
    }
    __syncthreads();
    sHs[half * 128 + d] = tot;
    __syncthreads();
    const float other = sHs[(1 - half) * 128 + d];
    const float offs = (dir == 0) ? (half ? other : 0.f) : (half ? 0.f : other);
    const int chunk = (m0 >> 6) + cc;
    char* et = p.ws + (dir ? OFF_ETB : OFF_ETF) + ((size_t)chunk * 4 + head) * 16384;
#pragma unroll
    for (int i8 = 0; i8 < 4; ++i8) {
      u32x4 v;
      v.x = pack2(fexp2(gl[i8 * 8 + 0] + offs), fexp2(gl[i8 * 8 + 1] + offs));
      v.y = pack2(fexp2(gl[i8 * 8 + 2] + offs), fexp2(gl[i8 * 8 + 3] + offs));
      v.z = pack2(fexp2(gl[i8 * 8 + 4] + offs), fexp2(gl[i8 * 8 + 5] + offs));
      v.w = pack2(fexp2(gl[i8 * 8 + 6] + offs), fexp2(gl[i8 * 8 + 7] + offs));
      *(u32x4*)(et + sw128(d, half * 4 + i8)) = v;
    }
    if (half == 0)
      ((float*)(p.ws + OFF_DEC))[(((size_t)dir * (MR / 64) + chunk) * 4 + head) * 128 + d] = fexp2(tot + other);
  }
}

struct TileQ {
  unsigned* base;
  int* slot;
  int x, dq, pend;
  bool has_pend;
};
DI int tileq_fetch(TileQ& tq) {
  __syncthreads();
  if (threadIdx.x == 0) {
    int j = tq.has_pend ? tq.pend : (int)__hip_atomic_fetch_add(tq.base + tq.x * 16, 1u, __ATOMIC_RELAXED, __HIP_MEMORY_SCOPE_AGENT);
    *tq.slot = j;
  }
  tq.has_pend = false;
  __syncthreads();
  return *tq.slot;
}
DI void tileq_prefetch(TileQ& tq) {
  if (threadIdx.x == 0) {
    tq.pend = (int)__hip_atomic_fetch_add(tq.base + tq.x * 16, 1u, __ATOMIC_RELAXED, __HIP_MEMORY_SCOPE_AGENT);
  }
  tq.has_pend = true;
}

DI bool tileq_next(TileQ& tq, int pm_n, int NP, int NT, int xcc0, int& mt, int& nt) {
  for (;;) {
    if (tq.dq >= 8) return false;
    const int j = tileq_fetch(tq);
    const int P = (j >> 6) * 8 + tq.x;
    if (P >= NP) { ++tq.dq; tq.x = (xcc0 + tq.dq) & 7; tq.has_pend = false; continue; }
    const int li = j & 63;
    mt = (P % pm_n) * 8 + (li & 7);
    nt = (P / pm_n) * 8 + (li >> 3);
    if (nt >= NT) continue;
    tileq_prefetch(tq);
    return true;
  }
}

DI void phase_gemm_in(const Params& p, int l, char* smem, int inst) {
  const int tid = opaque_tid(), lane = tid & 63, wid = tid >> 6, r = lane & 15, q = lane >> 4;
  const int wx = wid >> 1, wy = wid & 1;
  const bool even = !(l & 1);
  const int ldp = even ? NEV : NOD;
  const int NT = even ? 64 : 56, MT = MR >> 7;
  const bfr* WT = (const bfr*)(p.ws + win_off(l));
  const bfr* H = (const bfr*)(p.ws + OFF_H);
  bfr* proj = (bfr*)(p.ws + OFF_PROJ);
  bfr* VT = (bfr*)(p.ws + OFF_VT);
  const float2* cs = (const float2*)(p.ws + OFF_CS);
  const int pm_n = MT >> 3, NP = pm_n * ((NT + 7) >> 3);
  TileQ tq;
  tq.base = (unsigned*)(p.ws + OFF_BAR) + 34 * 64 + inst * 128;
  tq.slot = (int*)(smem + SMEM_BYTES - 16);
  tq.has_pend = false; tq.pend = 0;
  const int xcc0 = (int)(__builtin_amdgcn_s_getreg((3 << 11) | 20) & 7u);
  if (!even) {
    TileQ lq;
    lq.base = (unsigned*)(p.ws + OFF_BAR) + 34 * 64 + (16 + inst) * 128;
    lq.slot = tq.slot; lq.has_pend = false; lq.pend = 0; lq.x = 0; lq.dq = 0;
    for (;;) {
      const int j = tileq_fetch(lq);
      if (j >= MT) break;
      const int m0 = j * 128, n0 = 7168;
      GemmStage g2;
      gemm_prologue(WT + (size_t)n0 * 1024, 1024, H + (size_t)m0 * 1024, 1024, g2);
      f32x4 acc[4][4];
#pragma unroll
      for (int i = 0; i < 4; ++i)
#pragma unroll
        for (int jj = 0; jj < 4; ++jj) acc[i][jj] = (f32x4){0.f, 0.f, 0.f, 0.f};
      gemm_mainloop(WT + (size_t)n0 * 1024, 1024, H + (size_t)m0 * 1024, 1024, 1024, WT, H, false, smem, acc, g2);
#pragma unroll
      for (int jn = 0; jn < 4; ++jn) {
        const int m = m0 + wy * 64 + jn * 16 + r;
#pragma unroll
        for (int i = 0; i < 4; ++i) {
          const int n = n0 + wx * 64 + i * 16 + 4 * q;
          u32x2 o;
          o.x = pack2(acc[i][jn][0], acc[i][jn][1]);
          o.y = pack2(acc[i][jn][2], acc[i][jn][3]);
          *(u32x2*)(proj + (size_t)m * ldp + n) = o;
        }
      }
      char* sLr = smem;
      float* sHs = (float*)(smem + 8192);
      if (wx == 0) {
#pragma unroll
        for (int jn = 0; jn < 4; ++jn)
#pragma unroll
          for (int i = 0; i < 2; ++i) {
            u32x2 o;
            o.x = pack2(acc[i][jn][0], acc[i][jn][1]);
            o.y = pack2(acc[i][jn][2], acc[i][jn][3]);
            *(u32x2*)(sLr + (wy * 64 + jn * 16 + r) * 64 + (i * 16 + 4 * q) * 2) = o;
          }
      }
      __syncthreads();
      gla_gate_precompute(p, l, m0, sLr, sHs);
      __syncthreads();
    }
  }
  tq.dq = 0; tq.x = xcc0;
  GemmStage gst;
  int mt = 0, nt = 0;
  bool have = tileq_next(tq, pm_n, NP, NT, xcc0, mt, nt);
  bool loaded = false;
  {
   while (have) {
    const int m0 = mt * 128, n0 = nt * 128;
    const bool vt = (n0 >= 1024 && n0 < 2048);
    const bfr* X = vt ? (H + (size_t)m0 * 1024) : (WT + (size_t)n0 * 1024);
    const bfr* Y = vt ? (WT + (size_t)n0 * 1024) : (H + (size_t)m0 * 1024);
    if (!loaded) gemm_prologue(X, 1024, Y, 1024, gst);
    int mtn = 0, ntn = 0;
    const bool haven = tileq_next(tq, pm_n, NP, NT, xcc0, mtn, ntn);
    const bool stream = haven;
    const int m0n = mtn * 128, n0n = ntn * 128;
    const bool vtn = (n0n >= 1024 && n0n < 2048);
    const bfr* Xn = vtn ? (H + (size_t)m0n * 1024) : (WT + (size_t)n0n * 1024);
    const bfr* Yn = vtn ? (WT + (size_t)n0n * 1024) : (H + (size_t)m0n * 1024);
    f32x4 acc[4][4];
#pragma unroll
    for (int i = 0; i < 4; ++i)
#pragma unroll
      for (int j = 0; j < 4; ++j) acc[i][j] = (f32x4){0.f, 0.f, 0.f, 0.f};
    gemm_mainloop(X, 1024, Y, 1024, 1024, Xn, Yn, stream, smem, acc, gst);
    loaded = stream;
    if (vt) {
#pragma unroll
      for (int i = 0; i < 4; i += 2) {
        const int mbase = m0 + wx * 64 + i * 16;
        int b, kp;
        if (mbase < ML) { b = mbase >> 12; kp = mbase & 4095; } else { const int mm = mbase - ML; b = mm >> 8; kp = 4096 + (mm & 255); }
        const int pos = (kp & ~31) + q * 8;
#pragma unroll
        for (int jn = 0; jn < 4; ++jn) {
          const int f = n0 - 1024 + wy * 64 + jn * 16 + r;
          u32x4 o;
          o.x = pack2(acc[i][jn][0], acc[i][jn][1]);
          o.y = pack2(acc[i][jn][2], acc[i][jn][3]);
          o.z = pack2(acc[i + 1][jn][0], acc[i + 1][jn][1]);
          o.w = pack2(acc[i + 1][jn][2], acc[i + 1][jn][3]);
          *(u32x4*)(VT + ((size_t)(b * 1024 + f)) * KEYS + pos) = o;
        }
      }
    } else {
      const bool rope = even && (n0 < 1024 || (n0 >= 2048 && n0 < 3072)) && (m0 < ML);
      if (rope) {
#pragma unroll
        for (int jn = 0; jn < 4; ++jn) {
          asm volatile("" ::: "memory");
          const int m = m0 + wy * 64 + jn * 16 + r;
          const int t = m & 4095;
          const int grow = t >> 6, gcol = t & 63;
#pragma unroll
          for (int j = 0; j < 4; ++j) {
            const float2 a = cs[grow * 16 + 4 * q + j];
            const float2 c = cs[gcol * 16 + 4 * q + j];
            const float x0 = acc[0][jn][j], x1 = acc[1][jn][j], x2 = acc[2][jn][j], x3 = acc[3][jn][j];
            acc[0][jn][j] = x0 * a.x - x1 * a.y;
            acc[1][jn][j] = x1 * a.x + x0 * a.y;
            acc[2][jn][j] = x2 * c.x - x3 * c.y;
            acc[3][jn][j] = x3 * c.x + x2 * c.y;
          }
        }
      }
#pragma unroll
      for (int jn = 0; jn < 4; ++jn) {
        const int m = m0 + wy * 64 + jn * 16 + r;
        bfr* rp = proj + (size_t)m * ldp + n0 + wx * 64;
        store_pair16(rp, acc[0][jn], acc[1][jn], q);
        store_pair16(rp + 32, acc[2][jn], acc[3][jn], q);
      }
    }
    mt = mtn; nt = ntn; have = haven;
  }
 }
}

DI void phase_gemm_out(const Params& p, int l, char* smem, int inst) {
  const int tid = opaque_tid(), lane = tid & 63, wid = tid >> 6, r = lane & 15, q = lane >> 4;
  const int wx = wid >> 1, wy = wid & 1;
  const bfr* WT = (const bfr*)(p.ws + OFF_WOUT + (size_t)l * SZ_WOUT);
  const bfr* U = (const bfr*)(p.ws + OFF_U);
  bfr* ybuf = (bfr*)(p.ws + OFF_PROJ);
  const int MT = (l == 3) ? (ML >> 7) : (MR >> 7);
  const int pm_n = MT >> 3, NP = pm_n;
  TileQ tq;
  tq.base = (unsigned*)(p.ws + OFF_BAR) + 34 * 64 + inst * 128;
  tq.slot = (int*)(smem + SMEM_BYTES - 16);
  tq.has_pend = false; tq.pend = 0;
  const int xcc0 = (int)(__builtin_amdgcn_s_getreg((3 << 11) | 20) & 7u);
  tq.dq = 0; tq.x = xcc0;
  GemmStage gst;
  int mt = 0, nt = 0;
  bool have = tileq_next(tq, pm_n, NP, 8, xcc0, mt, nt);
  bool loaded = false;
  while (have) {
    const int m0 = mt * 128, n0 = nt * 128;
    const bfr* X = WT + (size_t)n0 * 2048;
    const bfr* Y = U + (size_t)m0 * 2048;
    if (!loaded) gemm_prologue(X, 2048, Y, 2048, gst);
    int mtn = 0, ntn = 0;
    const bool haven = tileq_next(tq, pm_n, NP, 8, xcc0, mtn, ntn);
    const bfr* Xn = WT + (size_t)(ntn * 128) * 2048;
    const bfr* Yn = U + (size_t)(mtn * 128) * 2048;
    f32x4 acc[4][4];
#pragma unroll
    for (int i = 0; i < 4; ++i)
#pragma unroll
      for (int j = 0; j < 4; ++j) acc[i][j] = (f32x4){0.f, 0.f, 0.f, 0.f};
    gemm_mainloop(X, 2048, Y, 2048, 2048, Xn, Yn, haven, smem, acc, gst);
    loaded = haven;
#pragma unroll
    for (int jn = 0; jn < 4; ++jn) {
      const int m = m0 + wy * 64 + jn * 16 + r;
      bfr* rp = ybuf + (size_t)m * 1024 + n0 + wx * 64;
      store_pair16(rp, acc[0][jn], acc[1][jn], q);
      store_pair16(rp + 32, acc[2][jn], acc[3][jn], q);
    }
    mt = mtn; nt = ntn; have = haven;
  }
}

template <int DV, int QT, int KT, int MODE>
DI void attn_engine(const bfr* __restrict__ qbase, int ldq, const bfr* __restrict__ kbase, int ldk,
                    const bfr* __restrict__ vt, int nloc, int loc_row0, int loc_pos0, int nctx, int ctx_row0,
                    const float* rpb_s, int roff0, char* smem, f32x4 (&O)[DV / 16][QT], float (&lsum)[QT]) {
  constexpr int STAGE = 8192 + DV * 128;
  constexpr int NVL = DV / 32;
  const int tid = opaque_tid(), lane = tid & 63, wid = tid >> 6, r = lane & 15, q = lane >> 4;
  const int lr = tid >> 3, lc = tid & 7;
  constexpr float SC = 0.125f * L2E;

  bf16x8 Qf[QT][2];
#pragma unroll
  for (int qt = 0; qt < QT; ++qt)
#pragma unroll
    for (int s = 0; s < 2; ++s)
      Qf[qt][s] = *(const bf16x8*)(qbase + (size_t)(wid * 16 * QT + qt * 16 + r) * ldq + s * 32 + q * 8);
  float mrun[QT];
#pragma unroll
  for (int qt = 0; qt < QT; ++qt) {
    mrun[qt] = -1e30f;
    lsum[qt] = 0.f;
#pragma unroll
    for (int dt = 0; dt < DV / 16; ++dt) O[dt][qt] = (f32x4){0.f, 0.f, 0.f, 0.f};
  }

  const int nch = nloc + nctx;
  u32x4 kreg0, kreg1, vreg[NVL];
  const int ksw0 = sw128(lr, lc), ksw1 = sw128(lr + 32, lc);
#define AT_LOAD(c_)                                                                                          \
  {                                                                                                          \
    const int cc_ = (c_);                                                                                    \
    const int row_ = (cc_ < nloc) ? (loc_row0 + cc_ * 64) : (ctx_row0 + (cc_ - nloc) * 64);                  \
    const int pos_ = (cc_ < nloc) ? (loc_pos0 + cc_ * 64) : (4096 + (cc_ - nloc) * 64);                      \
    kreg0 = *(const u32x4*)(kbase + (size_t)(row_ + lr) * ldk + lc * 8);                                     \
    kreg1 = *(const u32x4*)(kbase + (size_t)(row_ + lr + 32) * ldk + lc * 8);                                \
    _Pragma("unroll") for (int i_ = 0; i_ < NVL; ++i_)                                                       \
        vreg[i_] = *(const u32x4*)(vt + (size_t)(lr + 32 * i_) * KEYS + pos_ + lc * 8);                      \
  }
#define AT_STORE(c_)                                                                                         \
  {                                                                                                          \
    char* sb_ = smem + ((c_) & 1) * STAGE;                                                                   \
    *(u32x4*)(sb_ + ksw0) = kreg0;                                                                           \
    *(u32x4*)(sb_ + ksw1) = kreg1;                                                                           \
    _Pragma("unroll") for (int i_ = 0; i_ < NVL; ++i_)                                                       \
        *(u32x4*)(sb_ + 8192 + sw128(lr + 32 * i_, lc)) = vreg[i_];                                          \
  }
  if (nch > 0) { AT_LOAD(0); AT_STORE(0); }
  for (int c = 0; c < nch; ++c) {
    __syncthreads();
    const bool more = (c + 1 < nch);
    const char* sK = smem + (c & 1) * STAGE;
    const char* sV = sK + 8192;
    if (more) AT_LOAD(c + 1);
    f32x4 stall[4 / KT][KT][QT];
#pragma unroll
    for (int sbk = 0; sbk < 4 / KT; ++sbk) {
#pragma unroll
      for (int kt = 0; kt < KT; ++kt)
#pragma unroll
        for (int qt = 0; qt < QT; ++qt) stall[sbk][kt][qt] = (f32x4){0.f, 0.f, 0.f, 0.f};
#pragma unroll
      for (int s = 0; s < 2; ++s)
#pragma unroll
        for (int kt = 0; kt < KT; ++kt) {
          const bf16x8 ka = *(const bf16x8*)(sK + sw128(sbk * KT * 16 + kt * 16 + r, s * 4 + q));
#pragma unroll
          for (int qt = 0; qt < QT; ++qt) stall[sbk][kt][qt] = mfma16(ka, Qf[qt][s], stall[sbk][kt][qt]);
        }
    }
#pragma unroll
    for (int sbk = 0; sbk < 4 / KT; ++sbk) {
      f32x4 (&st)[KT][QT] = stall[sbk];
      bf16x8 pb[KT / 2][QT];
      if (MODE == 1) {
#pragma unroll
        for (int kt = 0; kt < KT; ++kt)
#pragma unroll
          for (int qt = 0; qt < QT; ++qt)
#pragma unroll
            for (int j = 0; j < 4; ++j) {
              float v = st[kt][qt][j] * SC;
              if (c < nloc) {
                const int kc = sbk * KT * 16 + kt * 16 + 4 * q + j;
                const int qc = wid * 16 + r;
                int wst = qc - 8; wst = wst < 0 ? 0 : (wst > 48 ? 48 : wst);
                const bool valid = (kc >= wst) && (kc < wst + 16);
                int co = kc - qc + 15; co = co < 0 ? 0 : (co > 30 ? 30 : co);
                const float bias = rpb_s[(roff0 + c) * 31 + co] * L2E;
                v = valid ? (v + bias) : -INFINITY;
              }
              st[kt][qt][j] = v;
            }
      }
#pragma unroll
      for (int qt = 0; qt < QT; ++qt) {
        float mx = max3f(st[0][qt][0], st[0][qt][1], st[0][qt][2]);
        mx = max3f(mx, st[0][qt][3], st[1][qt][0]);
        mx = max3f(mx, st[1][qt][1], st[1][qt][2]);
#pragma unroll
        for (int kt = 2; kt < KT; ++kt) {
          mx = max3f(mx, st[kt - 1][qt][3], st[kt][qt][0]);
          mx = max3f(mx, st[kt][qt][1], st[kt][qt][2]);
        }
        mx = max3f(mx, st[KT - 1][qt][3], st[KT - 1][qt][3]);
        if (MODE != 1) mx *= SC;
        if (__any(mx > mrun[qt] + 8.f)) {
          mx = fmaxf(mx, shx<16>(mx, lane));
          mx = fmaxf(mx, shx<32>(mx, lane));
          const float mnew2 = fmaxf(mrun[qt], mx);
          const float alpha = fexp2(mrun[qt] - mnew2);
          mrun[qt] = mnew2;
          lsum[qt] *= alpha;
#pragma unroll
          for (int dt = 0; dt < DV / 16; ++dt) {
            O[dt][qt][0] *= alpha; O[dt][qt][1] *= alpha; O[dt][qt][2] *= alpha; O[dt][qt][3] *= alpha;
          }
        }
        const float mnew = mrun[qt];
        f32x2_t ps2 = {0.f, 0.f};
#pragma unroll
        for (int kt = 0; kt < KT; ++kt) {
          float e0, e1, e2, e3;
          if (MODE == 1) {
            e0 = fexp2(st[kt][qt][0] - mnew); e1 = fexp2(st[kt][qt][1] - mnew);
            e2 = fexp2(st[kt][qt][2] - mnew); e3 = fexp2(st[kt][qt][3] - mnew);
          } else {
            e0 = fexp2(__builtin_fmaf(st[kt][qt][0], SC, -mnew)); e1 = fexp2(__builtin_fmaf(st[kt][qt][1], SC, -mnew));
            e2 = fexp2(__builtin_fmaf(st[kt][qt][2], SC, -mnew)); e3 = fexp2(__builtin_fmaf(st[kt][qt][3], SC, -mnew));
          }
          st[kt][qt][0] = e0; st[kt][qt][1] = e1; st[kt][qt][2] = e2; st[kt][qt][3] = e3;
          const f32x2_t a01 = {e0, e1}, a23 = {e2, e3};
          ps2 = ps2 + a01;
          ps2 = ps2 + a23;
        }
        lsum[qt] += ps2.x + ps2.y;
#pragma unroll
        for (int ks = 0; ks < KT / 2; ++ks) {
          u32x4 pk;
          pk.x = pack2(st[2 * ks][qt][0], st[2 * ks][qt][1]);
          pk.y = pack2(st[2 * ks][qt][2], st[2 * ks][qt][3]);
          pk.z = pack2(st[2 * ks + 1][qt][0], st[2 * ks + 1][qt][1]);
          pk.w = pack2(st[2 * ks + 1][qt][2], st[2 * ks + 1][qt][3]);
          pb[ks][qt] = __builtin_bit_cast(bf16x8, pk);
        }
      }
#pragma unroll
      for (int dt = 0; dt < DV / 16; ++dt)
#pragma unroll
        for (int ks = 0; ks < KT / 2; ++ks) {
          const bf16x8 va = *(const bf16x8*)(sV + sw128(dt * 16 + r, (sbk * (KT / 2) + ks) * 4 + q));
#pragma unroll
          for (int qt = 0; qt < QT; ++qt) O[dt][qt] = mfma16(va, pb[ks][qt], O[dt][qt]);
        }
    }
    if (more) AT_STORE(c + 1);
  }
#undef AT_LOAD
#undef AT_STORE
  __syncthreads();
#pragma unroll
  for (int qt = 0; qt < QT; ++qt) {
    float L = lsum[qt];
    L += shx<16>(L, lane);
    L += shx<32>(L, lane);
    lsum[qt] = L;
  }
}

DI void diff_attn_item(const Params& p, int l, int b, int head, int qrow0, bool ctxq, char* smem) {
  const int tid = opaque_tid(), lane = tid & 63, wid = tid >> 6, r = lane & 15, q = lane >> 4;
  const bfr* proj = (const bfr*)(p.ws + OFF_PROJ);
  const bfr* VT = (const bfr*)(p.ws + OFF_VT);
  bfr* U = (bfr*)(p.ws + OFF_U);
  const float* lamv = (const float*)(p.ws + OFF_LAM);
  const float lam = lamv[l >> 1], lam_init = lamv[2 + (l >> 1)];
  f32x4 O[8][2];
  float ls[2];
  char* parkb = smem + 49152 + tid * 16;
  attn_engine<128, 2, 2, 0>(proj + (size_t)qrow0 * NEV + 2048 + head * 128, NEV, proj + head * 128, NEV,
                            VT + (size_t)(b * 1024 + head * 128) * KEYS, ctxq ? 0 : 64, b * 4096, 0, 4,
                            ML + b * 256, nullptr, 0, smem, O, ls);
  u32x4 pkr0, pkr1;
  {
    const float i0 = 1.f / ls[0], i1 = 1.f / ls[1];
#pragma unroll
    for (int dt = 0; dt < 8; dt += 2) {
      u32x4 v0, v1;
      v0.x = pack2(O[dt][0][0] * i0, O[dt][0][1] * i0);
      v0.y = pack2(O[dt][0][2] * i0, O[dt][0][3] * i0);
      v0.z = pack2(O[dt + 1][0][0] * i0, O[dt + 1][0][1] * i0);
      v0.w = pack2(O[dt + 1][0][2] * i0, O[dt + 1][0][3] * i0);
      v1.x = pack2(O[dt][1][0] * i1, O[dt][1][1] * i1);
      v1.y = pack2(O[dt][1][2] * i1, O[dt][1][3] * i1);
      v1.z = pack2(O[dt + 1][1][0] * i1, O[dt + 1][1][1] * i1);
      v1.w = pack2(O[dt + 1][1][2] * i1, O[dt + 1][1][3] * i1);
      if (dt < 6) {
        *(u32x4*)(parkb + (dt / 2) * 4096) = v0;
        *(u32x4*)(parkb + (3 + dt / 2) * 4096) = v1;
      } else { pkr0 = v0; pkr1 = v1; }
    }
  }
  attn_engine<128, 2, 2, 0>(proj + (size_t)qrow0 * NEV + 2048 + head * 128 + 64, NEV, proj + head * 128 + 64, NEV,
                            VT + (size_t)(b * 1024 + head * 128) * KEYS, ctxq ? 0 : 64, b * 4096, 0, 4,
                            ML + b * 256, nullptr, 0, smem, O, ls);
  const float* subln = p.ev_subln + (l >> 1) * 128;
#pragma unroll
  for (int qt = 0; qt < 2; ++qt) {
    const float i1 = lam / ls[qt];
    float ss = 0.f;
#pragma unroll
    for (int dt = 0; dt < 8; ++dt) {
      unsigned pa, pc;
      if (dt < 6) {
        const u32x2 pk2 = *(const u32x2*)(parkb + (qt * 3 + dt / 2) * 4096 + (dt & 1) * 8);
        pa = pk2.x; pc = pk2.y;
      } else {
        const u32x4 pr = qt ? pkr1 : pkr0;
        pa = (dt & 1) ? pr.z : pr.x; pc = (dt & 1) ? pr.w : pr.y;
      }
      const float o0 = lo_bf(pa) - O[dt][qt][0] * i1;
      const float o1 = hi_bf(pa) - O[dt][qt][1] * i1;
      const float o2 = lo_bf(pc) - O[dt][qt][2] * i1;
      const float o3 = hi_bf(pc) - O[dt][qt][3] * i1;
      O[dt][qt][0] = o0; O[dt][qt][1] = o1; O[dt][qt][2] = o2; O[dt][qt][3] = o3;
      ss += o0 * o0 + o1 * o1 + o2 * o2 + o3 * o3;
    }
    ss += shx<16>(ss, lane);
    ss += shx<32>(ss, lane);
    const float rn = rsqrtf(ss * (1.f / 128.f) + 1e-6f) * (1.f - lam_init);
    const int row = qrow0 + wid * 32 + qt * 16 + r;
#pragma unroll
    for (int dt = 0; dt < 8; ++dt) {
      const int dv = dt * 16 + 4 * q;
      const u32x2 ag = *(const u32x2*)(proj + (size_t)row * NEV + 3072 + head * 128 + dv);
      const float4 sl = *(const float4*)(subln + dv);
      u32x2 o;
      o.x = pack2(O[dt][qt][0] * rn * sl.x * silu(lo_bf(ag.x)), O[dt][qt][1] * rn * sl.y * silu(hi_bf(ag.x)));
      o.y = pack2(O[dt][qt][2] * rn * sl.z * silu(lo_bf(ag.y)), O[dt][qt][3] * rn * sl.w * silu(hi_bf(ag.y)));
      *(u32x2*)(U + (size_t)row * 2048 + head * 128 + dv) = o;
    }
  }
}

DI void na_item(const Params& p, int l, int b, int head, int rho, bool ctxq, int cq0, char* smem) {
  const int tid = opaque_tid(), lane = tid & 63, wid = tid >> 6, r = lane & 15, q = lane >> 4;
  const bfr* proj = (const bfr*)(p.ws + OFF_PROJ);
  const bfr* VT = (const bfr*)(p.ws + OFF_VT);
  bfr* U = (bfr*)(p.ws + OFF_U);
  float* rpb_s = (float*)(smem + 2 * (8192 + 64 * 128));
  int rs = rho - 4; rs = rs < 0 ? 0 : (rs > 56 ? 56 : rs);
  const int qrow0 = ctxq ? (ML + b * 256 + cq0) : (b * 4096 + rho * 64);
  f32x4 O[4][1];
  float ls[1];
  if (!ctxq) {
    const float* rp = p.od_rpb + ((size_t)(l >> 1) * 16 + head) * 465;
    for (int i = tid; i < 465; i += 256) rpb_s[i] = rp[i];
    attn_engine<64, 1, 4, 1>(proj + (size_t)qrow0 * NOD + 3584 + head * 64, NOD, proj + head * 64, NOD,
                                VT + (size_t)(b * 1024 + head * 64) * KEYS, 8, b * 4096 + rs * 64, rs * 64, 4,
                                ML + b * 256, rpb_s, rs - rho + 7, smem, O, ls);
  } else {
    attn_engine<64, 1, 4, 0>(proj + (size_t)qrow0 * NOD + 3584 + head * 64, NOD, proj + head * 64, NOD,
                                VT + (size_t)(b * 1024 + head * 64) * KEYS, 0, 0, 0, 4, ML + b * 256, nullptr, 0,
                                smem, O, ls);
  }
  const float inv = 1.f / ls[0];
  const int row = qrow0 + wid * 16 + r;
#pragma unroll
  for (int dt = 0; dt < 4; ++dt) {
    const int dv = dt * 16 + 4 * q;
    const u32x2 cgv = *(const u32x2*)(proj + (size_t)row * NOD + 5120 + head * 64 + dv);
    u32x2 o;
    o.x = pack2(O[dt][0][0] * inv * silu(lo_bf(cgv.x)), O[dt][0][1] * inv * silu(hi_bf(cgv.x)));
    o.y = pack2(O[dt][0][2] * inv * silu(lo_bf(cgv.y)), O[dt][0][3] * inv * silu(hi_bf(cgv.y)));
    *(u32x2*)(U + (size_t)row * 2048 + head * 64 + dv) = o;
  }
}

DI void conv_item(const Params& p, int l, int item) {
  const int tid = opaque_tid();
  const bfr* proj = (const bfr*)(p.ws + OFF_PROJ);
  bfr* U = (bfr*)(p.ws + OFF_U);
  const float* cw = p.ev_conv + (size_t)(l >> 1) * 3 * 1024;
#pragma unroll 1
  for (int i = 0; i < 8; ++i) {
    const int v = tid + 256 * i;
    const int ri = v >> 7, ch = (v & 127) * 8;
    const int m = item * 16 + ri;
    int t, T;
    if (m < ML) { t = m & 4095; T = 4096; } else { t = (m - ML) & 255; T = 256; }
    const bfr* pr = proj + (size_t)m * NEV;
    float acc[8];
#pragma unroll
    for (int e = 0; e < 8; ++e) acc[e] = 0.f;
#pragma unroll
    for (int w = 0; w < 3; ++w) {
      const int tt = t + w - 1;
      if (tt >= 0 && tt < T) {
        const bfr* prw = pr + (ptrdiff_t)(w - 1) * NEV;
        const u32x4 bh = *(const u32x4*)(prw + 4096 + ch);
        const u32x4 bc = *(const u32x4*)(prw + 6144 + ch);
        const float4 w0 = *(const float4*)(cw + w * 1024 + ch);
        const float4 w1 = *(const float4*)(cw + w * 1024 + ch + 4);
        acc[0] += w0.x * lo_bf(bh.x) * lo_bf(bc.x); acc[1] += w0.y * hi_bf(bh.x) * hi_bf(bc.x);
        acc[2] += w0.z * lo_bf(bh.y) * lo_bf(bc.y); acc[3] += w0.w * hi_bf(bh.y) * hi_bf(bc.y);
        acc[4] += w1.x * lo_bf(bh.z) * lo_bf(bc.z); acc[5] += w1.y * hi_bf(bh.z) * hi_bf(bc.z);
        acc[6] += w1.z * lo_bf(bh.w) * lo_bf(bc.w); acc[7] += w1.w * hi_bf(bh.w) * hi_bf(bc.w);
      }
    }
    const u32x4 bb = *(const u32x4*)(pr + 5120 + ch);
    const u32x4 bg = *(const u32x4*)(pr + 7168 + ch);
    u32x4 o;
    o.x = pack2(lo_bf(bb.x) * acc[0] * silu(lo_bf(bg.x)), hi_bf(bb.x) * acc[1] * silu(hi_bf(bg.x)));
    o.y = pack2(lo_bf(bb.y) * acc[2] * silu(lo_bf(bg.y)), hi_bf(bb.y) * acc[3] * silu(hi_bf(bg.y)));
    o.z = pack2(lo_bf(bb.z) * acc[4] * silu(lo_bf(bg.z)), hi_bf(bb.z) * acc[5] * silu(hi_bf(bg.z)));
    o.w = pack2(lo_bf(bb.w) * acc[6] * silu(lo_bf(bg.w)), hi_bf(bb.w) * acc[7] * silu(hi_bf(bg.w)));
    *(u32x4*)(U + (size_t)m * 2048 + 1024 + ch) = o;
  }
}

DI void gla_item(const Params& p, int l, int item, char* smem) {
  const int tid0 = opaque_tid();
  const int slice = item & 7, dir = (item >> 3) & 1, head = (item >> 4) & 3, b = item >> 6;
  const bfr* proj = (const bfr*)(p.ws + OFF_PROJ);
  const char* etb = p.ws + (dir ? OFF_ETB : OFF_ETF) + (size_t)head * 16384;
  const float* decb = (const float*)(p.ws + OFF_DEC) + ((size_t)dir * (MR / 64) * 4 + head) * 128;
  char* sQb = smem;
  char* sKc = smem + 16384;
  char* sKbT = smem + 32768;
  char* sVt = smem + 49152;
  char* sAtt = smem + 53248;
  char* sST = smem + 61440;
  float* sDec = (float*)(smem + 77824);
  const float qscale = 0.08838834764831845f;

  f32x4 S[2][2];
#pragma unroll
  for (int a = 0; a < 2; ++a)
#pragma unroll
    for (int c2 = 0; c2 < 2; ++c2) S[a][c2] = (f32x4){0.f, 0.f, 0.f, 0.f};
  __syncthreads();
  for (int i = tid0; i < 512; i += 256) ((u32x4*)sST)[i] = (u32x4){0u, 0u, 0u, 0u};

  u32x4 pq0, pq1, pq2, pq3, pk0, pk1, pk2, pk3, pv, pe0, pe1, pe2, pe3, pdec;
#define GLA_ROW0(ci_) (((ci_) < 4) ? (ML + b * 256 + (dir ? (3 - (ci_)) : (ci_)) * 64) : (b * 4096 + (dir ? (67 - (ci_)) : ((ci_) - 4)) * 64))
#define GLA_LOAD(ci_)                                                                                         \
  {                                                                                                           \
    const int prow = tid >> 4, pch = tid & 15, vs = tid >> 2, vpart = tid & 3;                                \
    const int r0_ = GLA_ROW0(ci_);                                                                            \
    const bfr* pr_ = proj + (size_t)(r0_ + prow) * NOD + head * 128 + pch * 8;                                \
    pq0 = *(const u32x4*)(pr_ + 4608);                     pk0 = *(const u32x4*)(pr_ + 2048);                 \
    pq1 = *(const u32x4*)(pr_ + 4608 + (size_t)16 * NOD);  pk1 = *(const u32x4*)(pr_ + 2048 + (size_t)16 * NOD); \
    pq2 = *(const u32x4*)(pr_ + 4608 + (size_t)32 * NOD);  pk2 = *(const u32x4*)(pr_ + 2048 + (size_t)32 * NOD); \
    pq3 = *(const u32x4*)(pr_ + 4608 + (size_t)48 * NOD);  pk3 = *(const u32x4*)(pr_ + 2048 + (size_t)48 * NOD); \
    pv = *(const u32x4*)(proj + (size_t)(r0_ + vs) * NOD + 2560 + head * 256 + slice * 32 + vpart * 8);       \
    const char* et_ = etb + (size_t)(r0_ >> 6) * 65536 + tid * 16;                                            \
    pe0 = *(const u32x4*)(et_);         pe1 = *(const u32x4*)(et_ + 4096);                                    \
    pe2 = *(const u32x4*)(et_ + 8192);  pe3 = *(const u32x4*)(et_ + 12288);                                   \
    if (tid < 32) pdec = *(const u32x4*)(decb + (size_t)(r0_ >> 6) * 512 + tid * 4);                          \
  }
  { const int tid = tid0; GLA_LOAD(0); }
  for (int ci = 0; ci < 68; ++ci) {
    int tid = tid0; asm volatile("" : "+v"(tid));
    const int lane = tid & 63, wid = tid >> 6, r = lane & 15, q = lane >> 4;
    const int d = tid & 127, half = tid >> 7;
    const int prow = tid >> 4, pch = tid & 15, vs = tid >> 2, vpart = tid & 3;
    const int row0 = GLA_ROW0(ci);
    const char* stc = sST + (ci & 1) * 8192;
    char* stn = sST + ((ci + 1) & 1) * 8192;
    __syncthreads();
    {
      *(u32x4*)(sQb + sw256(prow, pch)) = pq0;       *(u32x4*)(sKc + sw256(prow, pch)) = pk0;
      *(u32x4*)(sQb + sw256(prow + 16, pch)) = pq1;  *(u32x4*)(sKc + sw256(prow + 16, pch)) = pk1;
      *(u32x4*)(sQb + sw256(prow + 32, pch)) = pq2;  *(u32x4*)(sKc + sw256(prow + 32, pch)) = pk2;
      *(u32x4*)(sQb + sw256(prow + 48, pch)) = pq3;  *(u32x4*)(sKc + sw256(prow + 48, pch)) = pk3;
      *(u32x4*)(sKbT + tid * 16) = pe0;              *(u32x4*)(sKbT + tid * 16 + 4096) = pe1;
      *(u32x4*)(sKbT + tid * 16 + 8192) = pe2;       *(u32x4*)(sKbT + tid * 16 + 12288) = pe3;
      if (tid < 32) *(u32x4*)((char*)sDec + tid * 16) = pdec;
      const unsigned vv[4] = {pv.x, pv.y, pv.z, pv.w};
#pragma unroll
      for (int j = 0; j < 4; ++j) {
        const int e0 = vpart * 8 + 2 * j;
        *(bfr*)(sVt + sw128(e0, vs >> 3) + (vs & 7) * 2) = (bfr)(vv[j] & 0xffffu);
        *(bfr*)(sVt + sw128(e0 + 1, vs >> 3) + (vs & 7) * 2) = (bfr)(vv[j] >> 16);
      }
    }
    __syncthreads();
    {
      const float dec = sDec[d];
#pragma unroll
      for (int i8 = 0; i8 < 4; ++i8) {
        const u32x4 ev = *(const u32x4*)(sKbT + sw128(d, half * 4 + i8));
        const unsigned ew[4] = {ev.x, ev.y, ev.z, ev.w};
        unsigned kb[4];
#pragma unroll
        for (int ii = 0; ii < 8; ++ii) {
          const int s = half * 32 + i8 * 8 + ii;
          const float E = (ii & 1) ? hi_bf(ew[ii >> 1]) : lo_bf(ew[ii >> 1]);
          const float Ei = __builtin_amdgcn_rcpf(E);
          bfr* qa_ = (bfr*)(sQb + sw256(s, d >> 3) + (d & 7) * 2);
          bfr* ka_ = (bfr*)(sKc + sw256(s, d >> 3) + (d & 7) * 2);
          const float qv = bf2f(*qa_) * qscale * E;
          const float kc = bf2f(*ka_) * Ei;
          *qa_ = f2bf(qv);
          *ka_ = f2bf(kc);
          const unsigned kbv = f2bf(kc * dec);
          if (ii & 1) kb[ii >> 1] |= kbv << 16; else kb[ii >> 1] = kbv;
        }
        *(u32x4*)(sKbT + sw128(d, half * 4 + i8)) = (u32x4){kb[0], kb[1], kb[2], kb[3]};
      }
    }
    __syncthreads();
    if (ci + 1 < 68) GLA_LOAD(ci + 1);
    {
      f32x4 at[4];
#pragma unroll
      for (int st = 0; st < 4; ++st) at[st] = (f32x4){0.f, 0.f, 0.f, 0.f};
#pragma unroll
      for (int ks = 0; ks < 4; ++ks) {
        const bf16x8 qa = *(const bf16x8*)(sQb + sw256(wid * 16 + r, ks * 4 + q));
#pragma unroll
        for (int st = 0; st < 4; ++st) {
          const bf16x8 kb2 = *(const bf16x8*)(sKc + sw256(st * 16 + r, ks * 4 + q));
          at[st] = mfma16(qa, kb2, at[st]);
        }
      }
#pragma unroll
      for (int st = 0; st < 4; ++st)
#pragma unroll
        for (int j = 0; j < 4; ++j) {
          const int t = wid * 16 + 4 * q + j, s = st * 16 + r;
          const bool keep = dir ? (s >= t) : (s <= t);
          *(bfr*)(sAtt + sw128(t, s >> 3) + (s & 7) * 2) = f2bf(keep ? at[st][j] : 0.f);
        }
    }
    {
#pragma unroll
      for (int dti = 0; dti < 2; ++dti) {
        const float dc = sDec[(2 * wid + dti) * 16 + r];
#pragma unroll
        for (int et = 0; et < 2; ++et) {
          S[et][dti][0] *= dc; S[et][dti][1] *= dc; S[et][dti][2] *= dc; S[et][dti][3] *= dc;
        }
      }
#pragma unroll
      for (int ks = 0; ks < 2; ++ks) {
        bf16x8 va[2], kb2[2];
#pragma unroll
        for (int et = 0; et < 2; ++et) va[et] = *(const bf16x8*)(sVt + sw128(et * 16 + r, ks * 4 + q));
#pragma unroll
        for (int dti = 0; dti < 2; ++dti) kb2[dti] = *(const bf16x8*)(sKbT + sw128((2 * wid + dti) * 16 + r, ks * 4 + q));
#pragma unroll
        for (int et = 0; et < 2; ++et)
#pragma unroll
          for (int dti = 0; dti < 2; ++dti) S[et][dti] = mfma16(va[et], kb2[dti], S[et][dti]);
      }
#pragma unroll
      for (int et = 0; et < 2; ++et)
#pragma unroll
        for (int dti = 0; dti < 2; ++dti)
#pragma unroll
          for (int j = 0; j < 4; ++j) {
            const int e = et * 16 + 4 * q + j, dd = (2 * wid + dti) * 16 + r;
            *(bfr*)(stn + sw256(e, dd >> 3) + (dd & 7) * 2) = f2bf(S[et][dti][j]);
          }
    }
    __syncthreads();
    {
      f32x4 o[2];
      o[0] = (f32x4){0.f, 0.f, 0.f, 0.f};
      o[1] = (f32x4){0.f, 0.f, 0.f, 0.f};
#pragma unroll
      for (int ks = 0; ks < 4; ++ks) {
        const bf16x8 qa = *(const bf16x8*)(sQb + sw256(wid * 16 + r, ks * 4 + q));
#pragma unroll
        for (int et = 0; et < 2; ++et) {
          const bf16x8 sb2 = *(const bf16x8*)(stc + sw256(et * 16 + r, ks * 4 + q));
          o[et] = mfma16(qa, sb2, o[et]);
        }
      }
#pragma unroll
      for (int ks = 0; ks < 2; ++ks) {
        const bf16x8 aa = *(const bf16x8*)(sAtt + sw128(wid * 16 + r, ks * 4 + q));
#pragma unroll
        for (int et = 0; et < 2; ++et) {
          const bf16x8 vb = *(const bf16x8*)(sVt + sw128(et * 16 + r, ks * 4 + q));
          o[et] = mfma16(aa, vb, o[et]);
        }
      }
      {
        const int lam = head * 8 + slice;
#pragma unroll
        for (int j = 0; j < 4; ++j) {
          const int row = row0 + wid * 16 + 4 * q + j;
          const int m2 = row >> 1, par = row & 1;
          bfr* lp = dir ? ((bfr*)(p.ws + OFF_H) + ((size_t)m2 * 32 + lam) * 64)
                        : ((bfr*)(p.ws + OFF_U) + (size_t)(2 * m2 + (lam >> 4)) * 2048 + 1024 + (lam & 15) * 64);
#pragma unroll
          for (int et = 0; et < 2; ++et) lp[par * 32 + et * 16 + r] = f2bf(o[et][j]);
        }
      }
    }
  }
#undef GLA_LOAD
#undef GLA_ROW0
  __syncthreads();
}

DI void phase_gla_combine(const Params& p, int l) {
  const int tid = opaque_tid(), lane = tid & 63, wid = tid >> 6;
  const bfr* proj = (const bfr*)(p.ws + OFF_PROJ);
  const bfr* OB = (const bfr*)(p.ws + OFF_H);
  bfr* U = (bfr*)(p.ws + OFF_U);
  const int h = lane >> 4, e16 = (lane & 15) * 16;
  const int lam = h * 8 + ((lane & 15) >> 1), ein = (lane & 1) * 16;
  const float* gn = p.od_gnorm + (l >> 1) * 256 + e16;
  for (int m2 = blockIdx.x * 4 + wid; m2 < MR / 2; m2 += gridDim.x * 4) {
    const bfr* ofl = U + (size_t)(2 * m2 + (lam >> 4)) * 2048 + 1024 + (lam & 15) * 64 + ein;
    const bfr* obl = OB + ((size_t)m2 * 32 + lam) * 64 + ein;
    u32x4 a[2][2], bq[2][2], g[2][2];
#pragma unroll
    for (int par = 0; par < 2; ++par) {
      a[par][0] = *(const u32x4*)(ofl + par * 32);  a[par][1] = *(const u32x4*)(ofl + par * 32 + 8);
      bq[par][0] = *(const u32x4*)(obl + par * 32); bq[par][1] = *(const u32x4*)(obl + par * 32 + 8);
      const bfr* gp = proj + (size_t)(2 * m2 + par) * NOD + 6144 + h * 256 + e16;
      g[par][0] = *(const u32x4*)gp; g[par][1] = *(const u32x4*)(gp + 8);
    }
    u32x4 res[2][2];
#pragma unroll
    for (int par = 0; par < 2; ++par) {
      float o[16], dg[16];
      float ss = 0.f;
#pragma unroll
      for (int hv = 0; hv < 2; ++hv)
#pragma unroll
        for (int i = 0; i < 4; ++i) {
          const unsigned av = a[par][hv][i], bv = bq[par][hv][i], gv = g[par][hv][i];
          const int k = hv * 8 + i * 2;
          o[k] = lo_bf(av) + lo_bf(bv); o[k + 1] = hi_bf(av) + hi_bf(bv);
          dg[k] = lo_bf(gv); dg[k + 1] = hi_bf(gv);
          ss += o[k] * o[k] + o[k + 1] * o[k + 1];
        }
      ss += shx<1>(ss, lane); ss += shx<2>(ss, lane); ss += shx<4>(ss, lane); ss += shx<8>(ss, lane);
      const float rn = rsqrtf(ss * (1.f / 256.f) + 1e-6f);
#pragma unroll
      for (int hv = 0; hv < 2; ++hv)
#pragma unroll
        for (int i = 0; i < 4; ++i) {
          const int k = hv * 8 + i * 2;
          res[par][hv][i] = pack2(o[k] * rn * gn[k] * silu(dg[k]), o[k + 1] * rn * gn[k + 1] * silu(dg[k + 1]));
        }
    }
#pragma unroll
    for (int par = 0; par < 2; ++par) {
      bfr* up = U + (size_t)(2 * m2 + par) * 2048 + 1024 + h * 256 + e16;
      *(u32x4*)up = res[par][0];
      *(u32x4*)(up + 8) = res[par][1];
    }
  }
}

DI int next_item(int* ctr, int* slot) {
  __syncthreads();
  if (threadIdx.x == 0) *slot = atomicAdd(ctr, 1);
  __syncthreads();
  return *slot;
}

DI void phase_mix_even(const Params& p, int l, int g, char* smem, int coff = 0) {
  int* ctr0 = (int*)(p.ws + OFF_CTR) + ((g * 2 + (l >> 1)) * 8) + coff;
  int* slot = (int*)(smem + SMEM_BYTES - 16);
  const int PER_LAT = GB * 32, PER_CTX = GB * 2, PER_CONV = MR / 16 / 8;
  const int per_q = PER_LAT + PER_CTX + PER_CONV;
  const int myq = (int)(__builtin_amdgcn_s_getreg((3 << 11) | 20) & 7u);
  for (int dq = 0; dq < 8; ++dq) {
    const int x = (myq + dq) & 7;
    for (;;) {
      int it = next_item(ctr0 + x, slot);
      if (it >= per_q) break;
      if (it < PER_LAT) {
        const int qb = it & 31, b = it >> 5;
        diff_attn_item(p, l, b, x, b * 4096 + qb * 128, false, smem);
      } else if (it < PER_LAT + PER_CTX) {
        it -= PER_LAT;
        const int qb = it & 1, b = it >> 1;
        diff_attn_item(p, l, b, x, ML + b * 256 + qb * 128, true, smem);
      } else {
        conv_item(p, l, (it - PER_LAT - PER_CTX) * 8 + x);
      }
    }
  }
}

DI void phase_mix_odd(const Params& p, int l, int g, char* smem) {
  int* ctr = (int*)(p.ws + OFF_CTR) + (g * 4 + l);
  int* slot = (int*)(smem + SMEM_BYTES - 16);
  const int N_GLA = GB * 4 * 2 * 8, N_NA = GB * 16 * 64, N_CTX = (l == 3) ? 0 : GB * 16 * 4;
  const int total = N_GLA + N_NA + N_CTX;
  (void)ctr; (void)slot; (void)total;
  const int nb = gridDim.x, bx = blockIdx.x;
  const int nup = (nb > N_GLA) ? (nb - N_GLA) : 0;
  const int NA_UP = 17;
  for (int k = 0;; ++k) {
    int it;
    if (nup == 0) { it = bx + k * nb; if (it >= total) break; }
    else if (bx < N_GLA) {
      if (k == 0) it = bx;
      else { it = N_GLA + NA_UP * nup + bx + (k - 1) * N_GLA; if (it >= total) break; }
    } else {
      if (k >= NA_UP) break;
      it = N_GLA + (bx - N_GLA) + k * nup;
      if (it >= total) break;
    }
    __syncthreads();
    if (it < N_GLA) {
      __builtin_amdgcn_s_setprio(3);
      gla_item(p, l, it, smem);
      __builtin_amdgcn_s_setprio(0);
    } else if (it < N_GLA + N_NA) {
      it -= N_GLA;
      const int rho = it & 63, bh = it >> 6;
      na_item(p, l, bh >> 4, bh & 15, rho, false, 0, smem);
    } else {
      it -= N_GLA + N_NA;
      const int qb = it & 3, bh = it >> 2;
      na_item(p, l, bh >> 4, bh & 15, 0, true, qb * 64, smem);
    }
  }
}


DI void grid_barrier(unsigned* bar, unsigned& bgen, unsigned xcc, unsigned nxcc, unsigned nx) {
  asm volatile("s_waitcnt vmcnt(0)" ::: "memory");
  __syncthreads();
  const unsigned target = bgen + 1;
  if (threadIdx.x == 0) {
    const unsigned old = __hip_atomic_fetch_add(bar + xcc * 64, 1u, __ATOMIC_RELAXED, __HIP_MEMORY_SCOPE_AGENT);
    if (old == target * nxcc - 1) {
      __builtin_amdgcn_fence(__ATOMIC_RELEASE, "agent");
      asm volatile("s_waitcnt vmcnt(0)" ::: "memory");
      const unsigned o2 = __hip_atomic_fetch_add(bar + 16 * 64, 1u, __ATOMIC_RELAXED, __HIP_MEMORY_SCOPE_AGENT);
      if (o2 == target * nx - 1) __hip_atomic_store(bar + 17 * 64, target, __ATOMIC_RELAXED, __HIP_MEMORY_SCOPE_AGENT);
    }
    while (__hip_atomic_load(bar + 17 * 64, __ATOMIC_RELAXED, __HIP_MEMORY_SCOPE_AGENT) < target) __builtin_amdgcn_s_sleep(1);
    __builtin_amdgcn_fence(__ATOMIC_ACQUIRE, "agent");
    asm volatile("s_waitcnt vmcnt(0)" ::: "memory");
  }
  bgen = target;
  __syncthreads();
}
typedef const __attribute__((address_space(4))) Params* KParamsPtr;
DI Params load_params() {
#if defined(__HIP_DEVICE_COMPILE__)
  KParamsPtr kp = (KParamsPtr)__builtin_amdgcn_kernarg_segment_ptr();
  asm volatile("" : "+s"(kp));
  Params r;
  __builtin_memcpy(&r, kp, sizeof(Params));
  return r;
#else
  return Params{};
#endif
}
#define PH(call) { const Params p = load_params(); call; }
__global__ void __launch_bounds__(256, 2) mega_kernel(Params p_unused) {
  extern __shared__ __attribute__((aligned(16))) char smem[];
  cg::grid_group grid = cg::this_grid();
  unsigned bgen = 0;
  const unsigned xcc = (unsigned)__builtin_amdgcn_s_getreg((3 << 11) | 20) & 15u;
  if (threadIdx.x == 0) {
    const Params pb = load_params();
    __hip_atomic_fetch_add((unsigned*)(pb.ws + OFF_BAR) + (18 + xcc) * 64, 1u, __ATOMIC_RELAXED, __HIP_MEMORY_SCOPE_AGENT);
  }
  PH(phase0(p, smem));
  grid.sync();
  unsigned nxcc = 0, nx = 0;
  {
    const Params pb = load_params();
    const unsigned* cen = (const unsigned*)(pb.ws + OFF_BAR) + 18 * 64;
    for (unsigned j = 0; j < 16; ++j) {
      const unsigned cj = __hip_atomic_load(cen + j * 64, __ATOMIC_RELAXED, __HIP_MEMORY_SCOPE_AGENT);
      nx += (cj != 0);
      if (j == xcc) nxcc = cj;
    }
  }
#define GBAR() { const Params pb = load_params(); grid_barrier((unsigned*)(pb.ws + OFF_BAR), bgen, xcc, nxcc, nx); }
#pragma unroll 1
  for (int g = 0; g < NGRP; ++g) {
#pragma unroll 1
    for (int l = 0; l < 4; ++l) {
      PH(phase_norm(p, l, g));
      GBAR();
      PH(phase_gemm_in(p, l, smem, g * 4 + l));
      GBAR();
      if (l & 1) {
        PH(phase_mix_odd(p, l, g, smem));
        GBAR();
        PH(phase_gla_combine(p, l));
      } else {
        PH(phase_mix_even(p, l, g, smem));
      }
      GBAR();
      PH(phase_gemm_out(p, l, smem, 8 + g * 4 + l));
      GBAR();
    }
    PH(phase_norm(p, 4, g));
  }
}

extern "C" void kernel_launch(void* const* d_in, const int* in_sizes, int n_in, void* d_out, int out_size, void* d_ws,
                              size_t ws_size, hipStream_t stream) {
  static int grid_blocks = 0;
  if (!grid_blocks) {
    int dev = 0, cus = 0, per_cu = 0;
    hipGetDevice(&dev);
    hipDeviceGetAttribute(&cus, hipDeviceAttributeMultiprocessorCount, dev);
    hipFuncSetAttribute((const void*)mega_kernel, hipFuncAttributeMaxDynamicSharedMemorySize, SMEM_BYTES);
    hipOccupancyMaxActiveBlocksPerMultiprocessor(&per_cu, mega_kernel, 256, SMEM_BYTES);
    if (per_cu > 2) per_cu = 2;
    if (per_cu < 1) per_cu = 1;
    grid_blocks = cus * per_cu;
    grid_blocks &= ~15;
  }
  if (ws_size < WS_NEED) { fprintf(stderr, "workspace too small: %zu < %zu\n", ws_size, (size_t)WS_NEED); return; }
  Params p{};
  p.x = (const float*)d_in[0]; p.c = (const float*)d_in[1]; p.ctx = (const float*)d_in[2]; p.c_ctx = (const float*)d_in[3];
  p.w_mod = (const float*)d_in[4]; p.b_mod = (const float*)d_in[5]; p.g_pre = (const float*)d_in[6]; p.g_post = (const float*)d_in[7];
  p.w_out = (const float*)d_in[8]; p.ev_w_in = (const float*)d_in[9]; p.ev_lambda = (const float*)d_in[10]; p.ev_subln = (const float*)d_in[11];
  p.ev_conv = (const float*)d_in[12]; p.od_w_in = (const float*)d_in[13]; p.od_rpb = (const float*)d_in[14]; p.od_gate_up = (const float*)d_in[15];
  p.od_gate_bias = (const float*)d_in[16]; p.od_gnorm = (const float*)d_in[17];
  p.out = (float*)d_out;
  p.ws = (char*)d_ws;
  (void)hipMemsetAsync((char*)d_ws + OFF_BAR, 0, BAR_BYTES, stream);
  void* args[] = {&p};
  hipError_t e = hipLaunchCooperativeKernel((const void*)mega_kernel, dim3(grid_blocks), dim3(256), args, SMEM_BYTES, stream);
  if (e != hipSuccess) fprintf(stderr, "cooperative launch failed: %s (grid %d)\n", hipGetErrorString(e), grid_blocks);
}
```
